# Optimizing an MI355X kernel written in HIP

```python
import math
import jax, jax.numpy as jnp
from jax import lax
import numpy as np


D_MODEL = 1024
BATCH = 8
SEQ = 4096
DEPTH = 4

F32 = jnp.float32
GRID_W = 64
HEAD_DIM = 64
BRANCH_WIDTH = 256
N_BRANCHES = 4
LN_EPS = 1e-5
RMS_EPS = 1e-6

HY_WIDTH = 256
HY_ORDER = 2
HY_POS_EMB = 33
HY_FILT_HID = 64
HY_TARGET = 1e-2
HY_SHORT_DECAY_PCT = 0.3
HY_LONG_DECAY_PCT = 1.5

DIL_GROUPS = ((128, 1), (512, 4), (2048, 16))
DIL_N_GROUPS = 3
DIL_HEADS_PER_GROUP = 4
DIL_N_HEADS = DIL_N_GROUPS * DIL_HEADS_PER_GROUP
DIL_WIDTH = DIL_N_HEADS * HEAD_DIM
DIL_BLOCK = 128

S5_WIDTH = 256
S5_GROUP = 16
S5_N_GROUPS = S5_WIDTH // S5_GROUP
S5_STATE = 64
S5_DT_MIN = 1e-3
S5_DT_MAX = 1e-1

GQA_HEADS = 4
GQA_KV_HEADS = 2
GQA_WIDTH = GQA_HEADS * HEAD_DIM
GQA_KV_WIDTH = GQA_KV_HEADS * HEAD_DIM
GQA_BLOCK = 128
ROPE_THETA = 10000.0

IN_SPLITS = (3 * HY_WIDTH, 3 * DIL_WIDTH, S5_WIDTH, GQA_WIDTH, GQA_KV_WIDTH, GQA_KV_WIDTH, N_BRANCHES * D_MODEL)
N_IN = sum(IN_SPLITS)

N_EXPERTS = 16
EC_CAPACITY = 2
EXPERT_FF = 1024

DN_ALPHA = (2 * DEPTH) ** 0.25
DN_BETA = (8 * DEPTH) ** -0.25

kernel_name = 'hybrid_parallel_gated_encoder'


def layer_norm(x, g, b):
    xf = x.astype(F32)
    mu = jnp.mean(xf, axis=-1, keepdims=True)
    var = jnp.mean(jnp.square(xf - mu), axis=-1, keepdims=True)
    return ((xf - mu) * lax.rsqrt(var + LN_EPS) * g + b).astype(x.dtype)


def rms_norm_heads(x, g):
    xf = x.astype(F32)
    return (xf * lax.rsqrt(jnp.mean(xf * xf, axis=-1, keepdims=True) + RMS_EPS) * g).astype(x.dtype)


def short_conv_centred(u, w, b):
    s = u.shape[1]
    up = jnp.pad(u, ((0, 0), (1, 1), (0, 0)))
    return up[:, :s] * w[0] + up[:, 1:s + 1] * w[1] + up[:, 2:] * w[2] + b


def hyena_pos_features(seq_len):
    t = jnp.linspace(0.0, 1.0, seq_len, dtype=F32)[:, None]
    bands = (HY_POS_EMB - 1) // 2
    f = jnp.linspace(1e-4, bands - 1, bands, dtype=F32)[None, :]
    w = 2.0 * math.pi * jnp.arange(seq_len, dtype=F32)[:, None] / seq_len
    z = jnp.concatenate([t, jnp.cos(f * w), -jnp.sin(f * w)], axis=-1)
    return t, z


def hyena_filters(t, z, w1, b1, w2, b2, w3, freq):
    seq_len = z.shape[0]
    f = jnp.sin(freq[0] * (z @ w1 + b1))
    f = jnp.sin(freq[1] * (f @ w2 + b2))
    f = (f @ w3).astype(F32).reshape(seq_len, 2, HY_ORDER, HY_WIDTH)
    max_decay = math.log(HY_TARGET) / HY_SHORT_DECAY_PCT
    min_decay = math.log(HY_TARGET) / HY_LONG_DECAY_PCT
    deltas = jnp.abs(jnp.linspace(min_decay, max_decay, HY_WIDTH, dtype=F32))
    f = f * jnp.exp(-t * deltas)[:, None, None, :]
    fwd, bwd = f[:, 0], f[:, 1]
    k = jnp.concatenate([fwd, jnp.zeros_like(fwd[:1]), bwd[:0:-1]], axis=0)
    return k * lax.rsqrt(jnp.sum(k * k, axis=0, keepdims=True))


def fft_long_conv(u, filt_freq, bias):
    s = u.shape[1]
    uf = u.astype(F32)
    y = jnp.fft.irfft(jnp.fft.rfft(uf, n=2 * s, axis=1) * filt_freq, n=2 * s, axis=1)[:, :s]
    return (y + uf * bias).astype(u.dtype)


def hyena_mixer(proj, conv_w, conv_b, filt, bias):
    u = short_conv_centred(proj, conv_w, conv_b)
    parts = jnp.split(u, HY_ORDER + 1, axis=-1)
    z = parts[0]
    filt_freq = jnp.fft.rfft(filt, axis=0)
    for n in range(HY_ORDER):
        z = parts[n + 1] * fft_long_conv(z, filt_freq[:, n], bias[n])
    return z


def dilated_attention(q, k, v):
    bsz, s = q.shape[0], q.shape[1]
    offs = np.stack([np.arange(-(w // 2), w // 2 + 1, d) for (w, d) in DIL_GROUPS])
    offs = np.repeat(offs, DIL_HEADS_PER_GROUP, axis=0)
    slopes = 2.0 ** (-8.0 * np.arange(1, DIL_N_HEADS + 1) / DIL_N_HEADS)
    off = jnp.asarray(offs, dtype=jnp.int32)
    alibi = jnp.asarray(-slopes[:, None] * np.abs(offs), dtype=F32)
    hidx = jnp.arange(DIL_N_HEADS)[:, None, None]
    scale = HEAD_DIM ** -0.5
    q = q.transpose(0, 2, 1, 3)
    k = k.transpose(0, 2, 1, 3)
    v = v.transpose(0, 2, 1, 3)
    nblk = s // DIL_BLOCK
    qb = q.reshape(bsz, DIL_N_HEADS, nblk, DIL_BLOCK, HEAD_DIM).transpose(2, 0, 1, 3, 4)
    starts = jnp.arange(nblk, dtype=jnp.int32) * DIL_BLOCK

    def one_block(args):
        qblk, start = args
        pos = start + jnp.arange(DIL_BLOCK, dtype=jnp.int32)[None, :, None] + off[:, None, :]
        valid = (pos >= 0) & (pos < s)
        pos = jnp.clip(pos, 0, s - 1)
        kg = k[:, hidx, pos]
        vg = v[:, hidx, pos]
        sc = jnp.einsum('bhqd,bhqkd->bhqk', qblk, kg).astype(F32) * scale + alibi[:, None, :]
        sc = jnp.where(valid[None], sc, -jnp.inf)
        lse = jax.nn.logsumexp(sc, axis=-1)
        p = jnp.exp(sc - lse[..., None]).astype(vg.dtype)
        o = jnp.einsum('bhqk,bhqkd->bhqd', p, vg)
        o = o.reshape(bsz, DIL_N_GROUPS, DIL_HEADS_PER_GROUP, DIL_BLOCK, HEAD_DIM)
        wgt = jax.nn.softmax(lse.reshape(bsz, DIL_N_GROUPS, DIL_HEADS_PER_GROUP, DIL_BLOCK), axis=1)
        return jnp.einsum('bghq,bghqd->bhqd', wgt.astype(o.dtype), o)

    out = lax.map(one_block, (qb, starts))
    return out.transpose(1, 0, 3, 2, 4).reshape(bsz, s, DIL_HEADS_PER_GROUP * HEAD_DIM)


def _ssm_combine(e1, e2):
    a1, b1 = e1
    a2, b2 = e2
    return a1 * a2, a2 * b1 + b2


def s5_mixer(u, lam_re, lam_im, log_dt, b_re, b_im, c_re, c_im, d, glu_w, glu_b):
    bsz, s = u.shape[0], u.shape[1]
    uf = u.astype(F32)
    ug = uf.reshape(bsz, s, S5_N_GROUPS, S5_GROUP).astype(jnp.complex64)
    y = d.astype(F32) * uf
    for direction in range(2):
        lam = lax.complex(lam_re[direction].astype(F32), lam_im[direction].astype(F32))
        dt = jnp.exp(log_dt[direction].astype(F32))[:, None]
        a_bar = jnp.exp(lam * dt)
        bmat = lax.complex(b_re[direction].astype(F32), b_im[direction].astype(F32))
        b_bar = ((a_bar - 1.0) / lam)[..., None] * bmat
        bu = jnp.einsum('bsgc,gpc->bsgp', ug, b_bar)
        a = jnp.broadcast_to(a_bar, bu.shape)
        _, xs = lax.associative_scan(_ssm_combine, (a, bu), axis=1, reverse=(direction == 1))
        cmat = lax.complex(c_re[direction].astype(F32), c_im[direction].astype(F32))
        y = y + jnp.real(jnp.einsum('bsgp,gcp->bsgc', xs, cmat)).reshape(bsz, s, S5_WIDTH)
    z = jax.nn.gelu(y)
    return (z * jax.nn.sigmoid(z @ glu_w + glu_b)).astype(u.dtype)


def axial_rope_angles(s):
    n_rows = s // GRID_W
    rows = jnp.repeat(jnp.arange(n_rows, dtype=F32), GRID_W)
    cols = (jnp.arange(s) % GRID_W).astype(F32)
    half = HEAD_DIM // 2
    inv = ROPE_THETA ** (-jnp.arange(0, half, 2, dtype=F32) / half)
    return rows[:, None] * inv, cols[:, None] * inv


def _rope_half(x, ang):
    c = jnp.cos(ang)[:, None, :]
    sn = jnp.sin(ang)[:, None, :]
    x1, x2 = jnp.split(x, 2, axis=-1)
    return jnp.concatenate([x1 * c - x2 * sn, x2 * c + x1 * sn], axis=-1)


def apply_axial_rope(x, ang_r, ang_c):
    xf = x.astype(F32)
    half = HEAD_DIM // 2
    return jnp.concatenate([_rope_half(xf[..., :half], ang_r), _rope_half(xf[..., half:], ang_c)], axis=-1).astype(x.dtype)


def gqa_attention(q, k, v, q_norm, k_norm, ang_r, ang_c):
    bsz, s = q.shape[0], q.shape[1]
    rep = GQA_HEADS // GQA_KV_HEADS
    q = apply_axial_rope(rms_norm_heads(q, q_norm), ang_r, ang_c)
    k = apply_axial_rope(rms_norm_heads(k, k_norm), ang_r, ang_c)
    nblk = s // GQA_BLOCK
    qb = q.reshape(bsz, nblk, GQA_BLOCK, GQA_KV_HEADS, rep, HEAD_DIM).transpose(1, 0, 3, 4, 2, 5)
    kt = k.transpose(0, 2, 1, 3)
    vt = v.transpose(0, 2, 1, 3)
    scale = HEAD_DIM ** -0.5

    def one_block(qblk):
        sc = jnp.einsum('bgrqd,bgkd->bgrqk', qblk, kt).astype(F32) * scale
        p = jax.nn.softmax(sc, axis=-1).astype(vt.dtype)
        return jnp.einsum('bgrqk,bgkd->bgrqd', p, vt)

    o = lax.map(one_block, qb)
    return o.transpose(1, 0, 4, 2, 3, 5).reshape(bsz, s, GQA_WIDTH)


def mixing_sublayer(h, w_in, hy_conv_w, hy_conv_b, hy_w1, hy_b1, hy_w2, hy_b2, hy_w3, hy_freq, hy_bias,
                    s5_lam_re, s5_lam_im, s5_log_dt, s5_b_re, s5_b_im, s5_c_re, s5_c_im, s5_d, s5_glu_w, s5_glu_b,
                    gqa_q_norm, gqa_k_norm, w_branch, w_out, pos_t, pos_z, ang_r, ang_c):
    bsz, s = h.shape[0], h.shape[1]
    proj = h @ w_in
    split_points = np.cumsum(IN_SPLITS)[:-1].tolist()
    hy_in, dil_qkv, s5_in, gq, gk, gv, gate_logits = jnp.split(proj, split_points, axis=-1)
    filt = hyena_filters(pos_t, pos_z, hy_w1, hy_b1, hy_w2, hy_b2, hy_w3, hy_freq)
    y_a = hyena_mixer(hy_in, hy_conv_w, hy_conv_b, filt, hy_bias)
    dq, dk, dv = [t.reshape(bsz, s, DIL_N_HEADS, HEAD_DIM) for t in jnp.split(dil_qkv, 3, axis=-1)]
    y_b = dilated_attention(dq, dk, dv)
    y_c = s5_mixer(s5_in, s5_lam_re, s5_lam_im, s5_log_dt, s5_b_re, s5_b_im, s5_c_re, s5_c_im, s5_d, s5_glu_w, s5_glu_b)
    y_d = gqa_attention(gq.reshape(bsz, s, GQA_HEADS, HEAD_DIM), gk.reshape(bsz, s, GQA_KV_HEADS, HEAD_DIM),
                        gv.reshape(bsz, s, GQA_KV_HEADS, HEAD_DIM), gqa_q_norm, gqa_k_norm, ang_r, ang_c)
    gate_logits = gate_logits.reshape(bsz, s, N_BRANCHES, D_MODEL)
    merged = None
    for i, y in enumerate((y_a, y_b, y_c, y_d)):
        term = jax.nn.sigmoid(gate_logits[:, :, i]) * (y @ w_branch[i])
        merged = term if merged is None else merged + term
    return merged @ w_out


def expert_choice_moe(h, router_w, w_gate, w_up, w_down):
    bsz, s = h.shape[0], h.shape[1]
    cap = (EC_CAPACITY * s) // N_EXPERTS
    aff = jax.nn.softmax((h @ router_w).astype(F32), axis=-1)
    g, idx = lax.top_k(aff.transpose(0, 2, 1), cap)
    bidx = jnp.arange(bsz)[:, None, None]
    xs = h[bidx, idx]
    hid = jax.nn.silu(jnp.einsum('becd,edf->becf', xs, w_gate)) * jnp.einsum('becd,edf->becf', xs, w_up)
    out = jnp.einsum('becf,efd->becd', hid, w_down) * g[..., None].astype(h.dtype)
    return jnp.zeros_like(h).at[bidx, idx].add(out)


def setup_inputs(seed: int = 0) -> dict:
    key = jax.random.key(seed)
    ks = iter(jax.random.split(key, 40))

    def nrm(shape, scale):
        return scale * jax.random.normal(next(ks), shape, F32)

    L = DEPTH
    G, P, CG = S5_N_GROUPS, S5_STATE, S5_GROUP
    lam_im0 = math.pi * jnp.arange(P, dtype=F32)
    return {
        'x': nrm((BATCH, SEQ, D_MODEL), 1.0),
        'ln_in_g': 1.0 + nrm((D_MODEL,), 0.02),
        'ln_in_b': nrm((D_MODEL,), 0.02),
        'w_in': nrm((L, D_MODEL, N_IN), D_MODEL ** -0.5),
        'hy_conv_w': nrm((L, 3, 3 * HY_WIDTH), 3 ** -0.5),
        'hy_conv_b': nrm((L, 3 * HY_WIDTH), 0.02),
        'hy_w1': nrm((L, HY_POS_EMB, HY_FILT_HID), HY_POS_EMB ** -0.5),
        'hy_b1': nrm((L, HY_FILT_HID), 0.1),
        'hy_w2': nrm((L, HY_FILT_HID, HY_FILT_HID), HY_FILT_HID ** -0.5),
        'hy_b2': nrm((L, HY_FILT_HID), 0.1),
        'hy_w3': nrm((L, HY_FILT_HID, 2 * HY_ORDER * HY_WIDTH), HY_FILT_HID ** -0.5),
        'hy_freq': 1.0 + nrm((L, 2, HY_FILT_HID), 0.02),
        'hy_bias': nrm((L, HY_ORDER, HY_WIDTH), 0.5),
        's5_lam_re': -0.5 + nrm((L, 2, G, P), 0.01),
        's5_lam_im': lam_im0 + nrm((L, 2, G, P), 0.01),
        's5_log_dt': jax.random.uniform(next(ks), (L, 2, G), F32, math.log(S5_DT_MIN), math.log(S5_DT_MAX)),
        's5_b_re': nrm((L, 2, G, P, CG), (2 * CG) ** -0.5),
        's5_b_im': nrm((L, 2, G, P, CG), (2 * CG) ** -0.5),
        's5_c_re': nrm((L, 2, G, CG, P), 0.5),
        's5_c_im': nrm((L, 2, G, CG, P), 0.5),
        's5_d': nrm((L, S5_WIDTH), 1.0),
        's5_glu_w': nrm((L, S5_WIDTH, S5_WIDTH), S5_WIDTH ** -0.5),
        's5_glu_b': nrm((L, S5_WIDTH), 0.02),
        'gqa_q_norm': 1.0 + nrm((L, HEAD_DIM), 0.02),
        'gqa_k_norm': 1.0 + nrm((L, HEAD_DIM), 0.02),
        'w_branch': nrm((L, N_BRANCHES, BRANCH_WIDTH, D_MODEL), BRANCH_WIDTH ** -0.5),
        'w_out': nrm((L, D_MODEL, D_MODEL), DN_BETA * D_MODEL ** -0.5),
        'ln1_g': 1.0 + nrm((L, D_MODEL), 0.02),
        'ln1_b': nrm((L, D_MODEL), 0.02),
        'router_w': nrm((L, D_MODEL, N_EXPERTS), D_MODEL ** -0.5),
        'exp_w_gate': nrm((L, N_EXPERTS, D_MODEL, EXPERT_FF), D_MODEL ** -0.5),
        'exp_w_up': nrm((L, N_EXPERTS, D_MODEL, EXPERT_FF), D_MODEL ** -0.5),
        'exp_w_down': nrm((L, N_EXPERTS, EXPERT_FF, D_MODEL), DN_BETA * EXPERT_FF ** -0.5),
        'ln2_g': 1.0 + nrm((L, D_MODEL), 0.02),
        'ln2_b': nrm((L, D_MODEL), 0.02),
    }


def reference(x, ln_in_g, ln_in_b, w_in, hy_conv_w, hy_conv_b, hy_w1, hy_b1, hy_w2, hy_b2, hy_w3, hy_freq, hy_bias,
              s5_lam_re, s5_lam_im, s5_log_dt, s5_b_re, s5_b_im, s5_c_re, s5_c_im, s5_d, s5_glu_w, s5_glu_b,
              gqa_q_norm, gqa_k_norm, w_branch, w_out, ln1_g, ln1_b,
              router_w, exp_w_gate, exp_w_up, exp_w_down, ln2_g, ln2_b):
    s = x.shape[1]
    pos_t, pos_z = hyena_pos_features(s)
    ang_r, ang_c = axial_rope_angles(s)
    h = layer_norm(x, ln_in_g, ln_in_b)
    for l in range(DEPTH):
        mix = mixing_sublayer(h, w_in[l], hy_conv_w[l], hy_conv_b[l], hy_w1[l], hy_b1[l], hy_w2[l], hy_b2[l],
                              hy_w3[l], hy_freq[l], hy_bias[l],
                              s5_lam_re[l], s5_lam_im[l], s5_log_dt[l], s5_b_re[l], s5_b_im[l], s5_c_re[l],
                              s5_c_im[l], s5_d[l], s5_glu_w[l], s5_glu_b[l],
                              gqa_q_norm[l], gqa_k_norm[l], w_branch[l], w_out[l], pos_t, pos_z, ang_r, ang_c)
        h = layer_norm(DN_ALPHA * h + mix, ln1_g[l], ln1_b[l])
        ffn = expert_choice_moe(h, router_w[l], exp_w_gate[l], exp_w_up[l], exp_w_down[l])
        h = layer_norm(DN_ALPHA * h + ffn, ln2_g[l], ln2_b[l])
    return h
```

```cpp
#include <hip/hip_runtime.h>
#include <hip/hip_bf16.h>
#include <cstdio>
#include <cstdint>
#include <cmath>

#ifndef MK_STATIC_Q
#define MK_STATIC_Q 0
#endif
#ifndef MK_ONE_LAUNCH
#define MK_ONE_LAUNCH 1
#endif

constexpr int BATCH = 8, SEQ = 4096, DM = 1024, DEPTH = 4, M = BATCH * SEQ;
constexpr int NIN = 7936;
constexpr int NE = 16, CAP = 512, FFD = 1024;
constexpr float LN_EPS = 1e-5f, RMS_EPS = 1e-6f;
constexpr float DN_ALPHA = 1.6817928305074292f;
constexpr int PC_DQ = 0, PC_DK = 768, PC_DV = 1536, PC_S5 = 2304, PC_GQ = 2560, PC_GK = 2816, PC_GV = 2944, PROJ2_W = 3072;
enum { I_X = 0, I_LNIN_G, I_LNIN_B, I_WIN, I_HY_CW, I_HY_CB, I_HY_W1, I_HY_B1, I_HY_W2, I_HY_B2, I_HY_W3, I_HY_FREQ, I_HY_BIAS,
       I_S5_LRE, I_S5_LIM, I_S5_LDT, I_S5_BRE, I_S5_BIM, I_S5_CRE, I_S5_CIM, I_S5_D, I_S5_GW, I_S5_GB, I_GQ_QN, I_GQ_KN,
       I_WBR, I_WOUT, I_LN1G, I_LN1B, I_ROUTER, I_EWG, I_EWU, I_EWD, I_LN2G, I_LN2B, N_INPUTS };

constexpr size_t MiB = 1u << 20, KiB = 1u << 10;
constexpr size_t WS_CTL = 0, CTL_ZERO_BYTES = 1 * MiB;
constexpr size_t WS_AFF = 1 * MiB;
constexpr size_t WS_IDX = 3 * MiB;
constexpr size_t WS_GW = 3 * MiB + 256 * KiB;
constexpr size_t WS_INV = 4 * MiB;
constexpr size_t WS_DLSE = 5 * MiB;
constexpr size_t WS_ROPE = 7 * MiB;
constexpr size_t WS_S5A32 = 7 * MiB + 256 * KiB;
constexpr size_t WS_HF2 = 8 * MiB;
constexpr size_t WS_S5W = 12 * MiB;
constexpr size_t S5W_LAYER = 16 * MiB, S5_WST_OFF = 0, S5_WCAT_OFF = 4 * MiB;
constexpr size_t WS_W = 76 * MiB;
constexpr size_t W_WIN = 0;
constexpr size_t W_WB = W_WIN + (size_t)NIN * DM * 2;
constexpr size_t W_WO = W_WB + (size_t)4 * 1024 * 256 * 2;
constexpr size_t W_GLU = W_WO + (size_t)1024 * 1024 * 2;
constexpr size_t W_GU = W_GLU + (size_t)256 * 256 * 2;
constexpr size_t W_DN = W_GU + (size_t)16 * 2048 * 1024 * 2;
constexpr size_t W_END = W_DN + (size_t)16 * 1024 * 1024 * 2;
static_assert(W_END <= 116 * MiB, "weights region");
constexpr size_t WS_HB = 192 * MiB;
constexpr size_t WS_RA = 256 * MiB;
constexpr size_t WS_RB = 512 * MiB;
constexpr size_t RB_HYT = 0, RB_PROJ2 = 48 * MiB, RB_MF32 = 0, RB_PRE = 0, RB_HID = 0, RB_MB = 128 * MiB;
constexpr size_t RA_G = 0, RA_XS = 0, RA_EOUT = 128 * MiB;
constexpr size_t WS_Y = 768 * MiB;
constexpr size_t WS_RD = 832 * MiB;
constexpr size_t RD_YAT = 0;
constexpr size_t RD_DILO = 16 * MiB;
constexpr size_t RD_S5Z = 64 * MiB;
constexpr size_t RD_HV = 80 * MiB;
constexpr size_t RD_QKVG = 112 * MiB;
constexpr size_t WS_END = 976 * MiB;

constexpr int CW_BAR = 4096;
constexpr int CW_Q = 8192;

constexpr int LDS_SCRATCH = 147456;
constexpr int MISC_OFF = LDS_SCRATCH;
constexpr int LDS_BYTES = LDS_SCRATCH + 1024;

#define GAS __attribute__((address_space(1)))
#define LAS __attribute__((address_space(3)))
typedef unsigned short bf16;
typedef unsigned v4u __attribute__((ext_vector_type(4)));
typedef unsigned v2u __attribute__((ext_vector_type(2)));
typedef float f32x4 __attribute__((ext_vector_type(4)));
typedef float f32x2 __attribute__((ext_vector_type(2)));
typedef float f32x16 __attribute__((ext_vector_type(16)));
typedef short bf16x8 __attribute__((ext_vector_type(8)));
typedef short s16x4 __attribute__((ext_vector_type(4)));
typedef GAS unsigned gu32;
#define RLX_AGENT __ATOMIC_RELAXED, __HIP_MEMORY_SCOPE_AGENT
#define LDS_WAIT() asm volatile("s_waitcnt lgkmcnt(0)" ::: "memory")
#define VM_WAIT() asm volatile("s_waitcnt vmcnt(0)" ::: "memory")

__device__ __forceinline__ unsigned f2bf(float f) { unsigned u = __builtin_bit_cast(unsigned, f); return (u + 0x7fffu + ((u >> 16) & 1u)) >> 16; }
__device__ __forceinline__ unsigned pk2(float lo, float hi) { return f2bf(lo) | (f2bf(hi) << 16); }
__device__ __forceinline__ float bf2f(unsigned short b) { return __builtin_bit_cast(float, (unsigned)b << 16); }
__device__ __forceinline__ float bflo(unsigned w) { return __builtin_bit_cast(float, w << 16); }
__device__ __forceinline__ float bfhi(unsigned w) { return __builtin_bit_cast(float, w & 0xffff0000u); }
__device__ __forceinline__ float sigmoidf_(float x) { return __builtin_amdgcn_rcpf(1.0f + __builtin_amdgcn_exp2f(-1.4426950408889634f * x)); }
__device__ __forceinline__ float wave_sum(float v) {
#pragma unroll
    for (int o = 1; o < 64; o <<= 1) v += __shfl_xor(v, o);
    return v;
}
__device__ __forceinline__ float wave_max(float v) {
#pragma unroll
    for (int o = 1; o < 64; o <<= 1) v = fmaxf(v, __shfl_xor(v, o));
    return v;
}

namespace pg8 {
#define PG8_LAS __attribute__((address_space(3)))
typedef unsigned short bf16_t;
typedef unsigned u32x4 __attribute__((ext_vector_type(4)));
constexpr int BM = 256, BK = 64, HALF = 128, HTB = HALF * BK * 2  , STAGE_BYTES = 8 * HTB, NXCD = 8, WGM = 8;

__host__ __device__ __forceinline__ int lds_byte(int r, int c) { const int st = (r >> 4) * 2 + (c >> 5), rr = r & 15, cc = c & 31, ob = rr * 64 + cc * 2; return st * 1024 + (ob ^ (((ob >> 9) & 1) << 5)); }
__host__ __device__ __forceinline__ void stage_rc(int b, int& R, int& C) { const int st = b / 1024, sb = b % 1024, swz = sb ^ (((sb >> 9) & 1) << 5); R = (st >> 1) * 16 + swz / 64; C = (st & 1) * 32 + (swz % 64) / 2; }
__host__ __device__ __forceinline__ int perm32(int rho) { const int n = rho >> 4, i = rho & 15; return 8 * (i >> 2) + 4 * n + (i & 3); }

struct Unit { const char* A; const char* B; int orow, ocol, z; };
struct Gemm { int K, lda, ldb; };

__device__ __forceinline__ void tile_of(int L, int nM, int nN, int& pm, int& pn) {
    const int nwg = nM * nN; int wgid = L; { const int q = nwg / NXCD, r = nwg % NXCD, xcd = wgid % NXCD, off = wgid / NXCD; wgid = (xcd < r ? xcd * (q + 1) : r * (q + 1) + (xcd - r) * q) + off; }
    const int nig = WGM * nN, gid = wgid / nig, fm = gid * WGM, gsz = (nM - fm) < WGM ? (nM - fm) : WGM;
    pm = fm + ((wgid % nig) % gsz); pn = (wgid % nig) / gsz;
}

typedef __bf16 bf16x2_t __attribute__((ext_vector_type(2)));
__device__ __forceinline__ unsigned cvt_pk_bf16(float lo, float hi) { const f32x2 v = {lo, hi}; const bf16x2_t b = __builtin_convertvector(v, bf16x2_t); return __builtin_bit_cast(unsigned, b); }
template <int ACT  > struct EpiBf16 {
    static constexpr bool PERM = true;
    bf16_t* O; int ldc;
    __device__ __forceinline__ void operator()(const f32x4 (&acc)[2][2][4][2], const Unit& u, int wr, int wc, int fr, int fq) const {
        const int row0 = u.orow + wr * 64 + fr, col0 = u.ocol + wc * 32 + 8 * fq;
#pragma unroll
        for (int ai = 0; ai < 2; ++ai)
#pragma unroll
            for (int m = 0; m < 4; ++m) { bf16_t* rowp = O + (size_t)(row0 + ai * HALF + m * 16) * ldc + col0;
#pragma unroll
                for (int bj = 0; bj < 2; ++bj) { f32x4 v0 = acc[ai][bj][m][0], v1 = acc[ai][bj][m][1];
                    if (ACT == 1) {
#pragma unroll
                        for (int j = 0; j < 4; ++j) { v0[j] = sigmoidf_(v0[j]); v1[j] = sigmoidf_(v1[j]); }
#ifdef DBG_HALF
                        for (int j = 0; j < 4; ++j) { v0[j] = 0.5f; v1[j] = 0.5f; }
#endif
                    }
                    u32x4 w; w.x = cvt_pk_bf16(v0[0], v0[1]); w.y = cvt_pk_bf16(v0[2], v0[3]); w.z = cvt_pk_bf16(v1[0], v1[1]); w.w = cvt_pk_bf16(v1[2], v1[3]);
                    *(u32x4*)(rowp + bj * HALF) = w; } }
    }
};
struct EpiMerge {
    static constexpr bool PERM = true;
    const bf16_t* G; float* F; bf16_t* MB;
    __device__ __forceinline__ void operator()(const f32x4 (&acc)[2][2][4][2], const Unit& u, int wr, int wc, int fr, int fq) const {
        const int row0 = u.orow + wr * 64 + fr, col0 = u.ocol + wc * 32 + 8 * fq, i = u.z;
#pragma unroll
        for (int ai = 0; ai < 2; ++ai)
#pragma unroll
            for (int m = 0; m < 4; ++m) { const size_t row = (size_t)(row0 + ai * HALF + m * 16);
#pragma unroll
                for (int bj = 0; bj < 2; ++bj) { const int col = col0 + bj * HALF;
                    const u32x4 g = *(const u32x4*)(G + row * 4096 + i * 1024 + col);
                    f32x4 v0 = acc[ai][bj][m][0], v1 = acc[ai][bj][m][1];
                    v0[0] *= bflo(g.x); v0[1] *= bfhi(g.x); v0[2] *= bflo(g.y); v0[3] *= bfhi(g.y);
                    v1[0] *= bflo(g.z); v1[1] *= bfhi(g.z); v1[2] *= bflo(g.w); v1[3] *= bfhi(g.w);
                    float* fp = F + row * 1024 + col;
                    if (i > 0) { f32x4 p0, p1;
                        asm volatile("global_load_dwordx4 %0, %2, off sc0 sc1\n\tglobal_load_dwordx4 %1, %2, off offset:16 sc0 sc1\n\ts_waitcnt vmcnt(0)" : "=&v"(p0), "=&v"(p1) : "v"(fp) : "memory");
                        v0 += p0; v1 += p1; }
                    if (i < 3) { *(f32x4*)fp = v0; *(f32x4*)(fp + 4) = v1; }
                    else { u32x4 w; w.x = cvt_pk_bf16(v0[0], v0[1]); w.y = cvt_pk_bf16(v0[2], v0[3]); w.z = cvt_pk_bf16(v1[0], v1[1]); w.w = cvt_pk_bf16(v1[2], v1[3]);
                        *(u32x4*)(MB + row * 1024 + col) = w; } } }
    }
};
struct EpiPre {
    static constexpr bool PERM = false;
    const float* H; float* P; float alpha;
    __device__ __forceinline__ void operator()(const f32x4 (&acc)[2][2][4][2], const Unit& u, int wr, int wc, int fr, int fq) const {
        const int row0 = u.orow + wr * 64 + fr, col0 = u.ocol + wc * 32 + 4 * fq;
#pragma unroll
        for (int ai = 0; ai < 2; ++ai)
#pragma unroll
            for (int m = 0; m < 4; ++m) { const size_t off = (size_t)(row0 + ai * HALF + m * 16) * 1024 + col0;
#pragma unroll
                for (int bj = 0; bj < 2; ++bj)
#pragma unroll
                    for (int n = 0; n < 2; ++n) { const f32x4 h = *(const f32x4*)(H + off + bj * HALF + n * 16); *(f32x4*)(P + off + bj * HALF + n * 16) = h * alpha + acc[ai][bj][m][n]; } }
    }
};
struct EpiSwiglu {
    static constexpr bool PERM = true;
    bf16_t* O;
    __device__ __forceinline__ void operator()(const f32x4 (&acc)[2][2][4][2], const Unit& u, int wr, int wc, int fr, int fq) const {
        const int row0 = u.orow + wr * 64 + fr, col0 = u.ocol + wc * 32 + 8 * fq;
#pragma unroll
        for (int ai = 0; ai < 2; ++ai)
#pragma unroll
            for (int m = 0; m < 4; ++m) { f32x4 v[2];
#pragma unroll
                for (int n = 0; n < 2; ++n)
#pragma unroll
                    for (int j = 0; j < 4; ++j) { const float g = acc[ai][0][m][n][j]; v[n][j] = g * sigmoidf_(g) * acc[ai][1][m][n][j]; }
                u32x4 w; w.x = cvt_pk_bf16(v[0][0], v[0][1]); w.y = cvt_pk_bf16(v[0][2], v[0][3]); w.z = cvt_pk_bf16(v[1][0], v[1][1]); w.w = cvt_pk_bf16(v[1][2], v[1][3]);
                *(u32x4*)(O + (size_t)(row0 + ai * HALF + m * 16) * 1024 + col0) = w; }
    }
};
struct EpiRowScale {
    static constexpr bool PERM = true;
    bf16_t* O; const float* rs;
    __device__ __forceinline__ void operator()(const f32x4 (&acc)[2][2][4][2], const Unit& u, int wr, int wc, int fr, int fq) const {
        const int row0 = u.orow + wr * 64 + fr, col0 = u.ocol + wc * 32 + 8 * fq;
#pragma unroll
        for (int ai = 0; ai < 2; ++ai)
#pragma unroll
            for (int m = 0; m < 4; ++m) { const int row = row0 + ai * HALF + m * 16; const float s = rs[row];
#pragma unroll
                for (int bj = 0; bj < 2; ++bj) { const f32x4 v0 = acc[ai][bj][m][0] * s, v1 = acc[ai][bj][m][1] * s;
                    u32x4 w; w.x = cvt_pk_bf16(v0[0], v0[1]); w.y = cvt_pk_bf16(v0[2], v0[3]); w.z = cvt_pk_bf16(v1[0], v1[1]); w.w = cvt_pk_bf16(v1[2], v1[3]);
                    *(u32x4*)(O + (size_t)row * 1024 + col0 + bj * HALF) = w; } }
    }
};
struct EpiGlu {
    static constexpr bool PERM = true;
    const bf16_t* Z; bf16_t* O; const float* gb;
    __device__ __forceinline__ void operator()(const f32x4 (&acc)[2][2][4][2], const Unit& u, int wr, int wc, int fr, int fq) const {
        const int row0 = u.orow + wr * 64 + fr, col0 = wc * 32 + 8 * fq;
#pragma unroll
        for (int ai = 0; ai < 2; ++ai)
#pragma unroll
            for (int m = 0; m < 4; ++m) { const size_t row = (size_t)(row0 + ai * HALF + m * 16);
#pragma unroll
                for (int bj = 0; bj < 2; ++bj) { const int col = col0 + bj * HALF;
                    const u32x4 z = *(const u32x4*)(Z + row * 256 + col); const f32x4 b0 = *(const f32x4*)(gb + col), b1 = *(const f32x4*)(gb + col + 4);
                    const f32x4 a0 = acc[ai][bj][m][0] + b0, a1 = acc[ai][bj][m][1] + b1; f32x4 v0, v1;
                    v0[0] = bflo(z.x) * sigmoidf_(a0[0]); v0[1] = bfhi(z.x) * sigmoidf_(a0[1]); v0[2] = bflo(z.y) * sigmoidf_(a0[2]); v0[3] = bfhi(z.y) * sigmoidf_(a0[3]);
                    v1[0] = bflo(z.z) * sigmoidf_(a1[0]); v1[1] = bfhi(z.z) * sigmoidf_(a1[1]); v1[2] = bflo(z.w) * sigmoidf_(a1[2]); v1[3] = bfhi(z.w) * sigmoidf_(a1[3]);
                    u32x4 w; w.x = cvt_pk_bf16(v0[0], v0[1]); w.y = cvt_pk_bf16(v0[2], v0[3]); w.z = cvt_pk_bf16(v1[0], v1[1]); w.w = cvt_pk_bf16(v1[2], v1[3]);
                    *(u32x4*)(O + row * 1024 + 512 + col) = w; }
                asm volatile("" ::: "memory"); }
    }
};

#ifndef PG8_SP2
#define PG8_SP2 0
#endif
template <class Epi, class Sched>
__device__ __forceinline__ void gemm_phase(PG8_LAS unsigned char* lds, const Gemm g, const Sched& S, const Epi& E) {
    int tid = threadIdx.x; asm volatile("" : "+v"(tid));
    const int wid = __builtin_amdgcn_readfirstlane(tid >> 6), lane = tid & 63, wr = wid >> 2, wc = wid & 3, fr = lane & 15, fq = lane >> 4;
    int K = g.K; asm volatile("" : "+s"(K)); const int nt = K / BK;
    unsigned voffA[2], voffB[2];
#pragma unroll
    for (int i = 0; i < 2; ++i) { int R, C; stage_rc(tid * 16 + i * 8192, R, C); const int Rb = Epi::PERM ? ((R & ~31) + perm32(R & 31)) : R;
        voffA[i] = (unsigned)(R * g.lda + C) * 2u; voffB[i] = (unsigned)(Rb * g.ldb + C) * 2u; }
    const size_t kstep = (size_t)(BK * 2);
    const size_t hstepA = (size_t)HALF * g.lda * 2, hstepB = (size_t)HALF * g.ldb * 2;
    const unsigned ldsw = (unsigned)wid * 1024u;
    const int aoff = lds_byte(wr * 64 + fr, fq * 8), boff = lds_byte(wc * 32 + fr, fq * 8);
#define PG8_SA(b, h) (((b) * 2 + (h)) * HTB)
#define PG8_SB(b, h) ((4 + (b) * 2 + (h)) * HTB)
#define PG8_STAGE(bufoff, gbase, voff) do { _Pragma("unroll") for (int _i = 0; _i < 2; ++_i) \
        __builtin_amdgcn_global_load_lds((const unsigned*)((const char*)(gbase) + (voff)[_i]), (PG8_LAS unsigned*)(lds + (bufoff) + ldsw + _i * 8192), 16, 0, 0); } while (0)
#define PG8_LDA(dst, b, h) do { _Pragma("unroll") for (int m = 0; m < 4; ++m) _Pragma("unroll") for (int k = 0; k < 2; ++k) dst[m][k] = *(const PG8_LAS bf16x8*)(lds + PG8_SA(b, h) + aoff + m * 2048 + k * 1024); } while (0)
#define PG8_LDB(dst, b, h) do { _Pragma("unroll") for (int n = 0; n < 2; ++n) _Pragma("unroll") for (int k = 0; k < 2; ++k) dst[n][k] = *(const PG8_LAS bf16x8*)(lds + PG8_SB(b, h) + boff + n * 2048 + k * 1024); } while (0)
#define PG8_MMA(ai, bj, At, Bt) do { __builtin_amdgcn_s_setprio(1); _Pragma("unroll") for (int m = 0; m < 4; ++m) _Pragma("unroll") for (int n = 0; n < 2; ++n) _Pragma("unroll") for (int k = 0; k < 2; ++k) \
        acc[ai][bj][m][n] = __builtin_amdgcn_mfma_f32_16x16x32_bf16(Bt[n][k], At[m][k], acc[ai][bj][m][n], 0, 0, 0); __builtin_amdgcn_s_setprio(0); } while (0)
#define PG8_WAIT_V(n) asm volatile("s_waitcnt vmcnt(" #n ")" ::: "memory")
#define PG8_WAIT_L(n) asm volatile("s_waitcnt lgkmcnt(" #n ")" ::: "memory")
#define PG8_BAR __builtin_amdgcn_s_barrier()
#define PG8_SCHED __builtin_amdgcn_sched_barrier(0)
    Unit cur, nxt; int ui = 0;
    if (!S.next(0, cur)) return;
    f32x4 acc[2][2][4][2];
#pragma unroll
    for (int a = 0; a < 2; ++a)
#pragma unroll
        for (int b = 0; b < 2; ++b)
#pragma unroll
            for (int m = 0; m < 4; ++m)
#pragma unroll
                for (int n = 0; n < 2; ++n) acc[a][b][m][n] = (f32x4){0.f, 0.f, 0.f, 0.f};
    bf16x8 At[4][2], B0[2][2], B1[2][2];
    const char* cA = cur.A; const char* cB = cur.B;
#if PG8_SP2
    PG8_STAGE(PG8_SB(0, 0), cB, voffB); PG8_STAGE(PG8_SB(0, 1), cB + hstepB, voffB); PG8_STAGE(PG8_SA(0, 0), cA, voffA); PG8_STAGE(PG8_SA(0, 1), cA + hstepA, voffA);
    if (wr == 1) PG8_BAR;
    PG8_WAIT_V(2); PG8_BAR;
    PG8_STAGE(PG8_SB(1, 0), cB + kstep, voffB); PG8_STAGE(PG8_SA(1, 0), cA + kstep, voffA); PG8_STAGE(PG8_SB(1, 1), cB + hstepB + kstep, voffB);
    PG8_WAIT_V(6); PG8_BAR;
#else
    PG8_STAGE(PG8_SB(0, 0), cB, voffB); PG8_STAGE(PG8_SA(0, 0), cA, voffA); PG8_STAGE(PG8_SB(0, 1), cB + hstepB, voffB); PG8_STAGE(PG8_SA(0, 1), cA + hstepA, voffA);
    if (wr == 1) PG8_BAR;
    PG8_WAIT_V(4); PG8_BAR;
    PG8_STAGE(PG8_SB(1, 0), cB + kstep, voffB); PG8_STAGE(PG8_SA(1, 0), cA + kstep, voffA); PG8_STAGE(PG8_SB(1, 1), cB + hstepB + kstep, voffB);
    PG8_WAIT_V(6); PG8_BAR;
#endif
    for (;;) {
        const bool has_next = S.next(ui + 1, nxt);
        const char* nA = has_next ? nxt.A : cA; const char* nB = has_next ? nxt.B : cB;
#pragma unroll 1
        for (int t = 0; t < nt; t += 2) {
            const bool last = (t == nt - 2);
            const char* a1 = cA + (size_t)(t + 1) * kstep;
            const char* a2 = last ? nA : cA + (size_t)(t + 2) * kstep; const char* b2 = last ? nB : cB + (size_t)(t + 2) * kstep;
            const char* a3 = a2 + kstep; const char* b3 = b2 + kstep;
#if PG8_SP2
            PG8_LDB(B0, 0, 0); PG8_LDB(B1, 0, 1); PG8_SCHED; PG8_LDA(At, 0, 0); PG8_STAGE(PG8_SA(1, 1), a1 + hstepA, voffA);
            PG8_WAIT_V(8); PG8_WAIT_L(0); PG8_BAR; PG8_MMA(0, 0, At, B0); PG8_MMA(0, 1, At, B1); PG8_BAR; PG8_SCHED;
            PG8_LDA(At, 0, 1); PG8_STAGE(PG8_SB(0, 0), b2, voffB); PG8_STAGE(PG8_SB(0, 1), b2 + hstepB, voffB); PG8_STAGE(PG8_SA(0, 0), a2, voffA);
            PG8_WAIT_V(8); PG8_WAIT_L(0); PG8_BAR; PG8_MMA(1, 0, At, B0); PG8_MMA(1, 1, At, B1); PG8_BAR; PG8_SCHED;
            PG8_LDB(B0, 1, 0); PG8_LDB(B1, 1, 1); PG8_SCHED; PG8_LDA(At, 1, 0); PG8_STAGE(PG8_SA(0, 1), a2 + hstepA, voffA);
            PG8_WAIT_V(8); PG8_WAIT_L(0); PG8_BAR; PG8_MMA(0, 0, At, B0); PG8_MMA(0, 1, At, B1); PG8_BAR; PG8_SCHED;
            PG8_LDA(At, 1, 1); PG8_STAGE(PG8_SB(1, 0), b3, voffB); PG8_STAGE(PG8_SB(1, 1), b3 + hstepB, voffB); PG8_STAGE(PG8_SA(1, 0), a3, voffA);
            PG8_WAIT_V(8); PG8_WAIT_L(0); PG8_BAR; PG8_MMA(1, 0, At, B0); PG8_MMA(1, 1, At, B1); PG8_BAR; PG8_SCHED;
#else
            PG8_LDB(B0, 0, 0); PG8_SCHED; PG8_LDA(At, 0, 0); PG8_STAGE(PG8_SA(1, 1), a1 + hstepA, voffA);
            PG8_WAIT_L(8); PG8_BAR; PG8_WAIT_L(0); PG8_MMA(0, 0, At, B0); PG8_BAR; PG8_SCHED;
            PG8_LDB(B1, 0, 1); PG8_STAGE(PG8_SB(0, 0), b2, voffB);
            PG8_BAR; PG8_WAIT_L(0); PG8_MMA(0, 1, At, B1); PG8_BAR;
            PG8_LDA(At, 0, 1); PG8_STAGE(PG8_SA(0, 0), a2, voffA);
            PG8_BAR; PG8_WAIT_L(0); PG8_MMA(1, 0, At, B0); PG8_BAR; PG8_SCHED;
            PG8_STAGE(PG8_SB(0, 1), b2 + hstepB, voffB);
            PG8_WAIT_V(6); PG8_BAR; PG8_MMA(1, 1, At, B1); PG8_BAR;
            PG8_LDB(B0, 1, 0); PG8_SCHED; PG8_LDA(At, 1, 0); PG8_STAGE(PG8_SA(0, 1), a2 + hstepA, voffA);
            PG8_WAIT_L(8); PG8_BAR; PG8_WAIT_L(0); PG8_MMA(0, 0, At, B0); PG8_BAR; PG8_SCHED;
            PG8_LDB(B1, 1, 1); PG8_STAGE(PG8_SB(1, 0), b3, voffB);
            PG8_BAR; PG8_WAIT_L(0); PG8_MMA(0, 1, At, B1); PG8_BAR;
            PG8_LDA(At, 1, 1); PG8_STAGE(PG8_SA(1, 0), a3, voffA);
            PG8_BAR; PG8_WAIT_L(0); PG8_MMA(1, 0, At, B0); PG8_BAR; PG8_SCHED;
            PG8_STAGE(PG8_SB(1, 1), b3 + hstepB, voffB);
            PG8_WAIT_V(6); PG8_BAR; PG8_MMA(1, 1, At, B1); PG8_BAR;
#endif
        }
        if (wr == 0) PG8_BAR;
        E(acc, cur, wr, wc, fr, fq);
        if (!has_next) break;
#pragma unroll
        for (int a = 0; a < 2; ++a)
#pragma unroll
            for (int b = 0; b < 2; ++b)
#pragma unroll
                for (int m = 0; m < 4; ++m)
#pragma unroll
                    for (int n = 0; n < 2; ++n) acc[a][b][m][n] = (f32x4){0.f, 0.f, 0.f, 0.f};
        cur = nxt; cA = nA; cB = nB; ++ui;
        if (wr == 1) PG8_BAR;
    }
    PG8_WAIT_V(0);
    PG8_BAR;
#undef PG8_SA
#undef PG8_SB
#undef PG8_STAGE
#undef PG8_LDA
#undef PG8_LDB
#undef PG8_MMA
#undef PG8_WAIT_V
#undef PG8_WAIT_L
#undef PG8_BAR
#undef PG8_SCHED
}
}
#define XB_TMO      128
#define XB_XCNT(j)  (256  + 64 * (j))
#define XB_XSUB(j)  (1280 + 64 * (j))
#define XB_XGEN(j)  (2304 + 64 * (j))
#define XB_TOP      3328
#define XB_TOPGEN   3392
#define XCD_BAR_WORDS 3456
#define XB_SPIN_CAP (1u << 18)

__device__ __forceinline__ unsigned xb_ld(unsigned* p)              { return __hip_atomic_load(p, __ATOMIC_RELAXED, __HIP_MEMORY_SCOPE_AGENT); }
__device__ __forceinline__ unsigned xb_add(unsigned* p, unsigned v) { return __hip_atomic_fetch_add(p, v, __ATOMIC_RELAXED, __HIP_MEMORY_SCOPE_AGENT); }
__device__ __forceinline__ unsigned xb_xcc_id() { return (unsigned)__builtin_amdgcn_s_getreg((3 << 11) | 20) & 0xFu; }
#define XB_SPIN(cond, bar) do { unsigned _sp = 0; while (cond) { __builtin_amdgcn_s_sleep(1); \
    if ((++_sp & 255u) == 0u) { if (xb_ld(&(bar)[XB_TMO])) break; if (_sp > XB_SPIN_CAP) { atomicAdd(&(bar)[XB_TMO], 1u); break; } } } } while (0)

struct XcdBarrier {
    unsigned* bar; unsigned x;
    volatile LAS unsigned* st;
};

__device__ __forceinline__ XcdBarrier xcd_barrier_post(unsigned* bar, volatile LAS unsigned* st) {
    XcdBarrier b; b.bar = bar; b.x = xb_xcc_id(); b.st = st;
    if (threadIdx.x == 0) (void)xb_add(&bar[XB_XCNT(b.x)], 1u);
    return b;
}
__device__ __forceinline__ void xcd_barrier_complete(unsigned* bar, unsigned x, unsigned& nloc, unsigned& nx) {
    const unsigned G = gridDim.x * gridDim.y * gridDim.z;
    unsigned sum, cnt, mine, sp = 0u;
    for (;;) {
        sum = 0u; cnt = 0u; mine = 0u;
#pragma unroll
        for (unsigned j = 0; j < 16; ++j) { const unsigned c = xb_ld(&bar[XB_XCNT(j)]); sum += c; cnt += (c > 0u) ? 1u : 0u; mine = (j == x) ? c : mine; }
        if (sum == G) break;
        __builtin_amdgcn_s_sleep(1);
        if ((++sp & 255u) == 0u) { if (xb_ld(&bar[XB_TMO])) break; if (sp > XB_SPIN_CAP) { atomicAdd(&bar[XB_TMO], 1u); break; } }
    }
    nloc = mine > 0u ? mine : 1u; nx = cnt > 0u ? cnt : 1u;
}

__device__ __forceinline__ void xcd_barrier(const XcdBarrier& b) {
    asm volatile("s_waitcnt vmcnt(0)" ::: "memory");
    __syncthreads();
    if (threadIdx.x == 0) {
        unsigned* bar = b.bar;
        __builtin_amdgcn_s_waitcnt(0);
        unsigned nloc = b.st[0], nx = b.st[1];
        if (nloc == 0u) { xcd_barrier_complete(bar, b.x, nloc, nx); b.st[0] = nloc; b.st[1] = nx; }
        const unsigned old = xb_add(&bar[XB_XSUB(b.x)], 1u);
        const unsigned gen = old / nloc;
        if (old + 1u == (gen + 1u) * nloc) {
            __builtin_amdgcn_fence(__ATOMIC_RELEASE, "agent");
            asm volatile("s_waitcnt vmcnt(0)" ::: "memory");
            const unsigned og = xb_add(&bar[XB_TOP], 1u);
            const unsigned tg = og / nx;
            if (og + 1u == (tg + 1u) * nx) xb_add(&bar[XB_TOPGEN], 1u);
            else XB_SPIN(xb_ld(&bar[XB_TOPGEN]) == tg, bar);
            __builtin_amdgcn_fence(__ATOMIC_ACQUIRE, "agent");
            xb_add(&bar[XB_XGEN(b.x)], 1u);
            asm volatile("s_waitcnt vmcnt(0)" ::: "memory");
        } else {
            XB_SPIN(xb_ld(&bar[XB_XGEN(b.x)]) == gen, bar);
            __builtin_amdgcn_fence(__ATOMIC_ACQUIRE, "agent");
            asm volatile("s_waitcnt vmcnt(0)" ::: "memory");
        }
    }
    __syncthreads();
}

struct Args { const float* in[N_INPUTS]; float* out; unsigned char* ws; int ph_lo, ph_hi, l_lo, l_hi; };
struct Frame {
    LAS unsigned char* lds;
    volatile LAS unsigned* MISC;
    gu32* ctl;
    int tid, lane, wave, G, bid;
    unsigned char* ws;
    float* out;
};
#define FIN(k) (args.in[k])
#define WSP(T, off) ((T*)(F.ws + (off)))

__device__ __forceinline__ int wq_grab(Frame& F, int qid) {
    __syncthreads();
    if (F.tid == 0) F.MISC[16] = __hip_atomic_fetch_add((unsigned*)(F.ctl + CW_Q + qid * 64), 1u, RLX_AGENT);
    __syncthreads();
    return (int)F.MISC[16];
}
__device__ __forceinline__ float block_sum(Frame& F, float v, LAS float* red  ) {
    v = wave_sum(v);
    __syncthreads();
    if (F.lane == 0) red[F.wave] = v;
    __syncthreads();
    float s = 0.f;
#pragma unroll
    for (int w = 0; w < 8; ++w) s += red[w];
    return s;
}

__device__ __forceinline__ void ln_row(f32x4 (&v)[4], const float* g, const float* b, int lane) {
    float s = 0.f;
#pragma unroll
    for (int j = 0; j < 4; ++j) s += (v[j].x + v[j].y) + (v[j].z + v[j].w);
    const float mean = wave_sum(s) * (1.f / DM); float s2 = 0.f;
#pragma unroll
    for (int j = 0; j < 4; ++j) { v[j] = v[j] - mean; s2 += (v[j].x * v[j].x + v[j].y * v[j].y) + (v[j].z * v[j].z + v[j].w * v[j].w); }
    const float rstd = 1.f / sqrtf(wave_sum(s2) * (1.f / DM) + LN_EPS);
#pragma unroll
    for (int j = 0; j < 4; ++j) { const f32x4 gg = *(const f32x4*)(g + 4 * lane + 256 * j), bb = *(const f32x4*)(b + 4 * lane + 256 * j); v[j] = v[j] * rstd * gg + bb; }
}
__device__ __forceinline__ void store_row_f32_bf16(const f32x4 (&v)[4], float* o32, bf16* o16, int lane) {
#pragma unroll
    for (int j = 0; j < 4; ++j) { *(f32x4*)(o32 + 4 * lane + 256 * j) = v[j];
        v2u w; w.x = pk2(v[j].x, v[j].y); w.y = pk2(v[j].z, v[j].w); *(v2u*)(o16 + 4 * lane + 256 * j) = w; }
}

template <class RowPtr>
__device__ __forceinline__ void transpose_item(const float* W, int ldw, int k0, int n0, const RowPtr& rp, LAS float* scr, int lane) {
#pragma unroll 8
    for (int i = 0; i < 32; ++i) { const int kk = 2 * i + (lane >> 5); scr[kk * 33 + (lane & 31)] = W[(size_t)(k0 + kk) * ldw + n0 + (lane & 31)]; }
    LDS_WAIT(); asm volatile("" ::: "memory");
    const int c = lane & 7;
#pragma unroll
    for (int j = 0; j < 4; ++j) { const int n = (lane >> 3) + 8 * j; const LAS float* s = scr + (8 * c) * 33 + n;
        v4u o; o.x = pk2(s[0 * 33], s[1 * 33]); o.y = pk2(s[2 * 33], s[3 * 33]); o.z = pk2(s[4 * 33], s[5 * 33]); o.w = pk2(s[6 * 33], s[7 * 33]);
        *(v4u*)(rp(n0 + n) + k0 + 8 * c) = o; }
    LDS_WAIT(); asm volatile("" ::: "memory");
}
struct RowPlain { bf16* base; int ld; __device__ __forceinline__ bf16* operator()(int n) const { return base + (size_t)n * ld; } };
struct RowGU { bf16* base; int half; __device__ __forceinline__ bf16* operator()(int f) const { return base + (size_t)((f >> 7) * 256 + half * 128 + (f & 127)) * 1024; } };

__device__ __forceinline__ void convert_layer(Frame& F, const Args& args, int l, int gw, int NGW) {
    LAS float* scr = (LAS float*)(F.lds + F.wave * 8448);
    unsigned char* wb = F.ws + WS_W;
    constexpr int I_IN = 16 * 248, I_BR = 4 * 4 * 32, I_OUT = 16 * 32, I_GLU = 4 * 8, I_EX = 16 * 512;
    constexpr int NIT = I_IN + I_BR + I_OUT + I_GLU + 3 * I_EX;
    for (int it = gw; it < NIT; it += NGW) {
        int r = it;
        if (r < I_IN) { const int kb = r / 248, nb = r % 248; transpose_item(FIN(I_WIN) + (size_t)l * DM * NIN, NIN, 64 * kb, 32 * nb, RowPlain{(bf16*)(wb + W_WIN), 1024}, scr, F.lane); continue; } r -= I_IN;
        if (r < I_BR) { const int i = r / 128, q = r % 128, kb = q / 32, nb = q % 32;
            transpose_item(FIN(I_WBR) + ((size_t)l * 4 + i) * 256 * 1024, 1024, 64 * kb, 32 * nb, RowPlain{(bf16*)(wb + W_WB) + (size_t)i * 1024 * 256, 256}, scr, F.lane); continue; } r -= I_BR;
        if (r < I_OUT) { const int kb = r / 32, nb = r % 32; transpose_item(FIN(I_WOUT) + (size_t)l * 1024 * 1024, 1024, 64 * kb, 32 * nb, RowPlain{(bf16*)(wb + W_WO), 1024}, scr, F.lane); continue; } r -= I_OUT;
        if (r < I_GLU) { const int kb = r / 8, nb = r % 8; transpose_item(FIN(I_S5_GW) + (size_t)l * 256 * 256, 256, 64 * kb, 32 * nb, RowPlain{(bf16*)(wb + W_GLU), 256}, scr, F.lane); continue; } r -= I_GLU;
        const int which = r / I_EX, q = r % I_EX, e = q / 512, q2 = q % 512, kb = q2 / 32, nb = q2 % 32;
        const size_t esz = (size_t)1024 * 1024;
        if (which == 0) transpose_item(FIN(I_EWG) + ((size_t)l * NE + e) * esz, 1024, 64 * kb, 32 * nb, RowGU{(bf16*)(wb + W_GU) + (size_t)e * 2048 * 1024, 0}, scr, F.lane);
        else if (which == 1) transpose_item(FIN(I_EWU) + ((size_t)l * NE + e) * esz, 1024, 64 * kb, 32 * nb, RowGU{(bf16*)(wb + W_GU) + (size_t)e * 2048 * 1024, 1}, scr, F.lane);
        else transpose_item(FIN(I_EWD) + ((size_t)l * NE + e) * esz, 1024, 64 * kb, 32 * nb, RowPlain{(bf16*)(wb + W_DN) + (size_t)e * esz, 1024}, scr, F.lane);
    }
}

__device__ __forceinline__ f32x2 cmul(f32x2 a, f32x2 b) { return (f32x2){a.x * b.x - a.y * b.y, a.x * b.y + a.y * b.x}; }

__device__ __forceinline__ void s5_build_item(Frame& F, const Args& args, int l, int g) {
    LAS f32x2* ap = (LAS f32x2*)F.lds;
    LAS f32x2* bb = ap + 2 * 64 * 33;
    LAS f32x2* cm = bb + 2 * 64 * 16;
    LAS float* kern = (LAS float*)(cm + 2 * 16 * 64);
    const int tid = F.tid;
    __syncthreads();
    if (tid < 128) {
        const int dir = tid >> 6, p = tid & 63; const size_t gi = ((size_t)(l * 2 + dir) * 16 + g);
        const float lre = FIN(I_S5_LRE)[gi * 64 + p], lim = FIN(I_S5_LIM)[gi * 64 + p], dt = expf(FIN(I_S5_LDT)[gi]);
        const float x = lre * dt, y = lim * dt;
        for (int tau = 0; tau <= 32; ++tau) { float s, c; sincosf((float)tau * y, &s, &c); const float e = expf((float)tau * x); ap[(dir * 64 + p) * 33 + tau] = (f32x2){e * c, e * s}; }
        { float s, c; sincosf(32.f * y, &s, &c); const float e = expf(32.f * x); WSP(f32x2, WS_S5A32)[gi * 64 + p] = (f32x2){e * c, e * s}; }
        float s1, c1; sincosf(y, &s1, &c1); const float sh = sinf(0.5f * y);
        const f32x2 em1 = (f32x2){expm1f(x) * c1 - 2.f * sh * sh, expf(x) * s1};
        const float inv = 1.f / (lre * lre + lim * lim);
        const f32x2 q = (f32x2){(em1.x * lre + em1.y * lim) * inv, (em1.y * lre - em1.x * lim) * inv};
        for (int ci = 0; ci < 16; ++ci) { const f32x2 bm = (f32x2){FIN(I_S5_BRE)[(gi * 64 + p) * 16 + ci], FIN(I_S5_BIM)[(gi * 64 + p) * 16 + ci]}; bb[(dir * 64 + p) * 16 + ci] = cmul(q, bm); }
    }
    for (int i = tid; i < 2 * 16 * 64; i += 512) { const int dir = i >> 10, co = (i >> 6) & 15, p = i & 63; const size_t gi = ((size_t)(l * 2 + dir) * 16 + g);
        cm[i] = (f32x2){FIN(I_S5_CRE)[(gi * 16 + co) * 64 + p], FIN(I_S5_CIM)[(gi * 16 + co) * 64 + p]}; }
    __syncthreads();
    for (int e = tid; e < 63 * 256; e += 512) {
        const int ti = e >> 8, co = (e >> 4) & 15, ci = e & 15, tau = ti - 31; float acc = 0.f;
        if (tau >= 0) for (int p = 0; p < 64; ++p) { const f32x2 w = cmul(cm[(0 * 16 + co) * 64 + p], ap[(0 * 64 + p) * 33 + tau]); const f32x2 b = bb[(0 * 64 + p) * 16 + ci]; acc += w.x * b.x - w.y * b.y; }
        if (tau <= 0) for (int p = 0; p < 64; ++p) { const f32x2 w = cmul(cm[(1 * 16 + co) * 64 + p], ap[(1 * 64 + p) * 33 - tau]); const f32x2 b = bb[(1 * 64 + p) * 16 + ci]; acc += w.x * b.x - w.y * b.y; }
        if (tau == 0 && co == ci) acc += FIN(I_S5_D)[l * 256 + g * 16 + co];
        kern[e] = acc;
    }
    __syncthreads();
    bf16* wcat = (bf16*)(F.ws + WS_S5W + (size_t)l * S5W_LAYER + S5_WCAT_OFF) + (size_t)g * 512 * 768;
    for (int ch = tid; ch < 512 * 96; ch += 512) {
        const int m = ch / 96, k8 = ch % 96, t = m >> 4, co = m & 15; float v[8];
        if (k8 < 64) { const int j = k8 >> 1, ci0 = (k8 & 1) * 8;
#pragma unroll
            for (int e = 0; e < 8; ++e) v[e] = kern[(t - j + 31) * 256 + co * 16 + ci0 + e]; }
        else { const int kk = (k8 - 64) * 8, dir = kk >> 7, p0 = (kk & 127) >> 1, tau = dir == 0 ? t + 1 : 32 - t;
#pragma unroll
            for (int pp = 0; pp < 4; ++pp) { const f32x2 w = cmul(cm[(dir * 16 + co) * 64 + p0 + pp], ap[(dir * 64 + p0 + pp) * 33 + tau]); v[2 * pp] = w.x; v[2 * pp + 1] = -w.y; } }
        v4u o; o.x = pk2(v[0], v[1]); o.y = pk2(v[2], v[3]); o.z = pk2(v[4], v[5]); o.w = pk2(v[6], v[7]);
        *(v4u*)(wcat + (size_t)m * 768 + k8 * 8) = o;
    }
    bf16* wst = (bf16*)(F.ws + WS_S5W + (size_t)l * S5W_LAYER + S5_WST_OFF) + (size_t)g * 2 * 128 * 512;
    for (int ch = tid; ch < 2 * 128 * 64; ch += 512) {
        const int dir = ch >> 13, o = (ch >> 6) & 127, k8 = ch & 63, p = o >> 1, ri = o & 1, j = k8 >> 1, ci0 = (k8 & 1) * 8; float v[8];
        const f32x2 a = ap[(dir * 64 + p) * 33 + (dir == 0 ? 31 - j : j)];
#pragma unroll
        for (int e = 0; e < 8; ++e) { const f32x2 w = cmul(a, bb[(dir * 64 + p) * 16 + ci0 + e]); v[e] = ri ? w.y : w.x; }
        v4u q; q.x = pk2(v[0], v[1]); q.y = pk2(v[2], v[3]); q.z = pk2(v[4], v[5]); q.w = pk2(v[6], v[7]);
        *(v4u*)(wst + ((size_t)dir * 128 + o) * 512 + k8 * 8) = q;
    }
    __syncthreads();
}

__device__ __forceinline__ void hf2_item(Frame& F, const Args& args, int l, int t) {
    const int lane = F.lane;
    const float tn = (float)t * (1.f / 4095.f), w = 6.283185307179586f * (float)t * (1.f / 4096.f);
    float zv = 0.f;
    if (lane == 0) zv = tn;
    else if (lane <= 16) { const float f = 1e-4f + (float)(lane - 1) * ((15.f - 1e-4f) / 15.f); zv = cosf(f * w); }
    else if (lane <= 32) { const float f = 1e-4f + (float)(lane - 17) * ((15.f - 1e-4f) / 15.f); zv = -sinf(f * w); }
    float acc = FIN(I_HY_B1)[l * 64 + lane];
    const float* w1 = FIN(I_HY_W1) + (size_t)l * 33 * 64;
    for (int i = 0; i < 33; ++i) acc += __shfl(zv, i) * w1[i * 64 + lane];
    const float f1 = sinf(FIN(I_HY_FREQ)[(l * 2 + 0) * 64 + lane] * acc);
    float acc2 = FIN(I_HY_B2)[l * 64 + lane];
    const float* w2 = FIN(I_HY_W2) + (size_t)l * 64 * 64;
    for (int i = 0; i < 64; ++i) acc2 += __shfl(f1, i) * w2[i * 64 + lane];
    WSP(float, WS_HF2)[((size_t)l * 4096 + t) * 64 + lane] = sinf(FIN(I_HY_FREQ)[(l * 2 + 1) * 64 + lane] * acc2);
}

__device__ __forceinline__ void prologue_phase(Frame& F, const Args& args) {
    const int gw = F.bid * 8 + F.wave, NGW = F.G * 8;
    for (int it = F.bid; it < DEPTH * 16; it += F.G) s5_build_item(F, args, it >> 4, it & 15);
    __syncthreads();
    { const int gi = F.bid * 512 + F.tid; if (gi < 1024) { const int pos = gi >> 4, i = gi & 15; const float inv = expf(-(float)(2 * i) * (1.f / 32.f) * 9.210340371976184f);
        float s, c; sincosf((float)pos * inv, &s, &c); WSP(f32x2, WS_ROPE)[gi] = (f32x2){c, s}; } }
    for (int it = gw; it < DEPTH * 4096; it += NGW) hf2_item(F, args, it >> 12, it & 4095);
    for (int m = gw; m < M; m += NGW) { f32x4 v[4];
#pragma unroll
        for (int j = 0; j < 4; ++j) v[j] = *(const f32x4*)(FIN(I_X) + (size_t)m * DM + 4 * F.lane + 256 * j);
        ln_row(v, FIN(I_LNIN_G), FIN(I_LNIN_B), F.lane);
        store_row_f32_bf16(v, F.out + (size_t)m * DM, WSP(bf16, WS_HB) + (size_t)m * DM, F.lane); }
    convert_layer(F, args, 0, gw, NGW);
}
namespace attn_body {
using bf16=__hip_bfloat16;
using bf16x8=__attribute__((ext_vector_type(8)))short;
using s16x4=__attribute__((ext_vector_type(4)))short;
using f32x16=__attribute__((ext_vector_type(16)))float;
using u32x4=__attribute__((ext_vector_type(4)))unsigned;
constexpr int SEQ=4096,D=64,QP=512,KP=512,VP=512,OP=1024;
constexpr int NW=8,QBLK=32,QB=QBLK*NW,KVBLK=64,NQB=SEQ/QB;
constexpr int ATTN_UNIT_ROWS=QB;
__device__ __forceinline__ int crow(int r,int hi){return (r&3)+8*(r>>2)+4*hi;}
#define SBAR() __builtin_amdgcn_sched_barrier(0)
__device__ __forceinline__ void cmask(f32x16&p0,f32x16&p1,int jb,int qrel,int hi){
  const float NEG=-INFINITY; int kb=64*jb+4*hi;
  #pragma unroll
  for(int r=0;r<16;++r){int kv=kb+(r&3)+8*(r>>2); if(kv>qrel)p0[r]=NEG; if(kv+32>qrel)p1[r]=NEG;}
}

constexpr int NSLOT=3, SLOTB=8192;
constexpr int LDS_K=0, LDS_V=NSLOT*SLOTB, LDS_WS=2*NSLOT*SLOTB, LDS_OST=LDS_WS+NW*64*4, LDS_BYTES=LDS_OST+NW*4096;
constexpr float C2=0.125f*1.4426950408889634f;
__device__ __forceinline__ void glds16(const void*gsrc,unsigned lds_dst){unsigned keep;
  asm volatile("s_mov_b32 %0, m0\n\ts_mov_b32 m0, %2\n\ts_nop 0\n\tglobal_load_lds_dwordx4 %1, off\n\ts_mov_b32 m0, %0":"=&s"(keep):"v"(gsrc),"s"(lds_dst):"memory");}
__device__ __forceinline__ float max3f(float a,float b,float c){float r;asm("v_max3_f32 %0, %1, %2, %3":"=v"(r):"v"(a),"v"(b),"v"(c));return r;}
__device__ __forceinline__ float max2f(float a,float b){float r;asm("v_max_f32_e32 %0, %1, %2":"=v"(r):"v"(a),"v"(b));return r;}
__device__ __forceinline__ float fadd_s(float a,float b){float r;asm("v_add_f32_e32 %0, %1, %2":"=v"(r):"v"(a),"v"(b));return r;}
__device__ __forceinline__ float fsub_s(float a,float b){float r;asm("v_sub_f32_e32 %0, %1, %2":"=v"(r):"v"(a),"v"(b));return r;}
typedef float f32x2_t __attribute__((ext_vector_type(2))); typedef __bf16 bf16x2_t __attribute__((ext_vector_type(2)));
__device__ __forceinline__ unsigned cvtpk_s(float lo,float hi){f32x2_t v={lo,hi};bf16x2_t b=__builtin_convertvector(v,bf16x2_t);return __builtin_bit_cast(unsigned,b);}
#define WAIT_BAR(N) asm volatile("s_waitcnt vmcnt(" #N ") lgkmcnt(0)\n\ts_barrier":::"memory")

__device__ __forceinline__ void qkt(f32x16&p0,f32x16&p1,const char*Kslot,const bf16x8*qr,const f32x16&negm,int r32,int hi){
  const char*kb=Kslot+hi*1024+r32*16;
  #pragma unroll
  for(int d0=0;d0<4;++d0){
    const bf16x8 b0=*reinterpret_cast<const bf16x8*>(kb+d0*2048);
    const bf16x8 b1=*reinterpret_cast<const bf16x8*>(kb+d0*2048+512);
    if(d0==0){p0=__builtin_amdgcn_mfma_f32_32x32x16_bf16(b0,qr[0],negm,0,0,0);p1=__builtin_amdgcn_mfma_f32_32x32x16_bf16(b1,qr[0],negm,0,0,0);}
    else{p0=__builtin_amdgcn_mfma_f32_32x32x16_bf16(b0,qr[d0],p0,0,0,0);p1=__builtin_amdgcn_mfma_f32_32x32x16_bf16(b1,qr[d0],p1,0,0,0);}}
}
typedef __attribute__((address_space(3))) const char* lds_cptr;
typedef short v4i16_t __attribute__((ext_vector_type(4)));
__device__ __forceinline__ void kload8(bf16x8*kf,lds_cptr kp){
  kf[0]=*(const __attribute__((address_space(3))) bf16x8*)(kp);      kf[1]=*(const __attribute__((address_space(3))) bf16x8*)(kp+512);
  kf[2]=*(const __attribute__((address_space(3))) bf16x8*)(kp+2048); kf[3]=*(const __attribute__((address_space(3))) bf16x8*)(kp+2560);
  kf[4]=*(const __attribute__((address_space(3))) bf16x8*)(kp+4096); kf[5]=*(const __attribute__((address_space(3))) bf16x8*)(kp+4608);
  kf[6]=*(const __attribute__((address_space(3))) bf16x8*)(kp+6144); kf[7]=*(const __attribute__((address_space(3))) bf16x8*)(kp+6656);
}
__device__ __forceinline__ void kload2(bf16x8*kf,lds_cptr kp,int j){ kf[2*j]=*(const __attribute__((address_space(3))) bf16x8*)(kp+j*2048); kf[2*j+1]=*(const __attribute__((address_space(3))) bf16x8*)(kp+j*2048+512); }
__device__ __forceinline__ s16x4 vtr(lds_cptr p){ return __builtin_bit_cast(s16x4,__builtin_amdgcn_ds_read_tr16_b64_v4i16((__attribute__((address_space(3))) v4i16_t*)p)); }
__device__ __forceinline__ float rowmax(const f32x16&p0,const f32x16&p1){
  float a=max3f(p0[0],p0[1],p1[0]),b=max3f(p0[2],p0[3],p1[1]);a=max3f(a,p1[2],p1[3]);
  #pragma unroll
  for(int r=4;r<16;r+=4){a=max3f(a,p0[r],p0[r+1]);b=max3f(b,p0[r+2],p0[r+3]);a=max3f(a,p1[r],p1[r+1]);b=max3f(b,p1[r+2],p1[r+3]);}
  const float m=max2f(a,b);
  auto rr=__builtin_amdgcn_permlane32_swap(__float_as_uint(m),__float_as_uint(m),false,false);
  return max2f(__uint_as_float(rr[0]),__uint_as_float(rr[1]));
}
__device__ __forceinline__ void pv(f32x16*o,int vb,bf16x8 pa0,bf16x8 pa1,bf16x8 pa2,bf16x8 pa3){
  #pragma unroll
  for(int d0=0;d0<2;++d0){s16x4 lo[4],hi[4];
    #pragma unroll
    for(int ks=0;ks<4;++ks){
      asm volatile("ds_read_b64_tr_b16 %0,%1 offset:%c2":"=&v"(lo[ks]):"v"(vb),"i"(d0*4096+ks*1024):"memory");
      asm volatile("ds_read_b64_tr_b16 %0,%1 offset:%c2":"=&v"(hi[ks]):"v"(vb),"i"(d0*4096+ks*1024+512):"memory");}
    asm volatile("s_waitcnt lgkmcnt(0)":::"memory");SBAR();
    #define PK(k) (bf16x8){lo[k][0],lo[k][1],lo[k][2],lo[k][3],hi[k][0],hi[k][1],hi[k][2],hi[k][3]}
    o[d0]=__builtin_amdgcn_mfma_f32_32x32x16_bf16(pa0,PK(0),o[d0],0,0,0);
    o[d0]=__builtin_amdgcn_mfma_f32_32x32x16_bf16(pa1,PK(1),o[d0],0,0,0);
    o[d0]=__builtin_amdgcn_mfma_f32_32x32x16_bf16(pa2,PK(2),o[d0],0,0,0);
    o[d0]=__builtin_amdgcn_mfma_f32_32x32x16_bf16(pa3,PK(3),o[d0],0,0,0);
    #undef PK
  }
}

#ifndef ATTN_STORE16
#define ATTN_STORE16(p,v) (*(u32x4*)(p)=(v))
#endif
template<int THRL> __device__ __forceinline__ void attn_unit(int b,int h,int qb,const bf16*Q,const bf16*__restrict__ K,const bf16*__restrict__ V,bf16*O,char*shm){
  int tid=threadIdx.x; asm volatile("":"+v"(tid)); const int lane=tid&63,r32=lane&31,hi=lane>>5; const int wid=__builtin_amdgcn_readfirstlane(tid>>6);
  const long rowbase=(long)b*SEQ; const int q0=qb*QB;
  const bf16*Qw=Q+(rowbase+q0+wid*QBLK)*QP+h*D;
  const bf16*Kh=K+rowbase*KP+(h>>1)*D,*Vh=V+rowbase*VP+(h>>1)*D;
  const unsigned lds0=(unsigned)(uintptr_t)shm;
  float*wsf=(float*)(shm+LDS_WS)+wid*64;
  const bf16*ksrc=Kh+(long)lane*KP+wid*8;
  const bf16*vsrc=Vh+(long)(16*(wid&3)+(lane>>2))*VP+(wid>>2)*32+(lane&3)*8;
  const unsigned kdst=lds0+LDS_K+wid*1024, vdst=lds0+LDS_V+wid*1024;
  #define DMA_K(t,slot) glds16(ksrc+(long)(t)*KVBLK*KP,(unsigned)__builtin_amdgcn_readfirstlane(kdst+(slot)))
  #define DMA_V(t,slot) glds16(vsrc+(long)(t)*KVBLK*VP,(unsigned)__builtin_amdgcn_readfirstlane(vdst+(slot)))
  const int vb0=(int)(lds0+LDS_V)+((lane>>4)&1)*32+(lane&3)*8+(4*hi+((lane&15)>>2))*64;
  const char*Kbase=shm+LDS_K; bf16x8 kf[8];
  const lds_cptr shm3=(lds_cptr)shm; const lds_cptr kp0=shm3+LDS_K+hi*1024+r32*16; const lds_cptr vp0=shm3+LDS_V+((lane>>4)&1)*32+(lane&3)*8+(4*hi+((lane&15)>>2))*64;
  const int NT=SEQ/KVBLK;
  DMA_K(0,0);DMA_V(0,0);DMA_K(1,SLOTB);
  bf16x8 qr[4];
  #pragma unroll
  for(int d0=0;d0<4;++d0)qr[d0]=*reinterpret_cast<const bf16x8*>(&Qw[(long)r32*QP+d0*16+hi*8]);
  float mhat=0.f,l_reg=0.f;f32x16 o[2];o[0]=f32x16{};o[1]=f32x16{};f32x16 negm=f32x16{};asm volatile("":"+v"(negm));
  #define CMASK(P0,P1,t) do{}while(0)
  bool resc=false;
  #define START(P0,P1) do{ const float rm=rowmax(P0,P1); resc=false; \
    { const float dl=rm; mhat=fadd_s(mhat,dl); \
      _Pragma("unroll") for(int r=0;r<16;++r){P0[r]=fsub_s(P0[r],dl);P1[r]=fsub_s(P1[r],dl);} \
      _Pragma("unroll") for(int r=0;r<16;++r)negm[r]=-mhat; asm volatile("":"+v"(negm)); } \
    _Pragma("unroll") for(int r=0;r<16;++r)P0[r]=__builtin_amdgcn_exp2f(P0[r]); }while(0)
  #define RESC() do{ if(resc){ asm volatile("s_waitcnt lgkmcnt(0)":::"memory"); \
      _Pragma("unroll") for(int d_=0;d_<2;++d_) _Pragma("unroll") for(int r=0;r<16;++r)o[d_][r]*=wsf[crow(r,hi)]; } }while(0)
  f32x16 pA0,pA1,pB0,pB1;
  int sl_prev=0,sl_cur=0,sl_next=SLOTB;
  #define ROT() do{sl_prev=sl_cur;sl_cur=sl_next;sl_next=(sl_next==(NSLOT-1)*SLOTB)?0:sl_next+SLOTB;}while(0)
  DMA_K(2,2*SLOTB);
  WAIT_BAR(3);
  qkt(pA0,pA1,Kbase,qr,negm,r32,hi);asm volatile("s_nop 15\n\ts_nop 7":"+v"(pA0),"+v"(pA1));CMASK(pA0,pA1,0);
  START(pA0,pA1);
  _Pragma("unroll") for(int r=0;r<16;++r)pA1[r]=__builtin_amdgcn_exp2f(pA1[r]);
  WAIT_BAR(0);
  DMA_K(3,0);DMA_V(1,SLOTB);
  ROT();
  kload8(kf,kp0+sl_cur);
  WAIT_BAR(2);
  s16x4 vlo[8],vhi[8]; u32x4 pw0,pw1,pw2,pw3;
  #define PKW(P,B) cvtpk_s(P[B],P[B+1])
  #define PAF(k) __builtin_bit_cast(bf16x8,pw##k)
  #define VFR(i) (bf16x8){vlo[i][0],vlo[i][1],vlo[i][2],vlo[i][3],vhi[i][0],vhi[i][1],vhi[i][2],vhi[i][3]}
  #define PIN(x) asm volatile("":"+v"(x))
  #define MX3(a,b,c) __builtin_fmaxf(__builtin_fmaxf((a),(b)),(c))
  #define GAPA(MF,A0,A1,A2,A3,W0,W1,PW) do{ MF; sacc+=A0; sacc+=A1; sacc+=A2; sacc+=A3; PIN(sacc); W0; W1; PIN(PW); SBAR(); }while(0)
  #define EX(v) __builtin_amdgcn_exp2f(v)
  #define GAPB(MF,X,B) do{ MF; X[B]=EX(X[B]); X[B+1]=EX(X[B+1]); X[B+2]=EX(X[B+2]); X[B+3]=EX(X[B+3]); PIN(X); SBAR(); }while(0)
  #define VRD(i) do{ vlo[i]=vtr(vp_+(((i)>>2)*4096+((i)&3)*1024)); vhi[i]=vtr(vp_+(((i)>>2)*4096+((i)&3)*1024+512)); }while(0)
  #define KRD(G,j) do{ if(G){ kload2(kf,kp0+sl_next,j); SBAR(); } }while(0)
  #define STEP(C0,C1,P0,P1,t,GK,GV,GL) do{ SBAR(); \
    const lds_cptr vp_=vp0+sl_prev; \
    VRD(0); SBAR(); float sacc=(P0[0]+P0[1]); \
    GAPA(C0=__builtin_amdgcn_mfma_f32_32x32x16_bf16(kf[0],qr[0],negm,0,0,0), P0[2],P0[3],P0[4],P0[5],     pw0[0]=PKW(P0,0), pw0[1]=PKW(P0,2), pw0); \
    VRD(4); SBAR(); GAPA(C1=__builtin_amdgcn_mfma_f32_32x32x16_bf16(kf[1],qr[0],negm,0,0,0), P0[6],P0[7],P0[8],P0[9],     pw0[2]=PKW(P0,4), pw0[3]=PKW(P0,6), pw0); \
    VRD(1); SBAR(); GAPA(C0=__builtin_amdgcn_mfma_f32_32x32x16_bf16(kf[2],qr[1],C0,0,0,0),   P0[10],P0[11],P0[12],P0[13], pw1[0]=PKW(P0,8), pw1[1]=PKW(P0,10), pw1); \
    VRD(5); SBAR(); GAPA(C1=__builtin_amdgcn_mfma_f32_32x32x16_bf16(kf[3],qr[1],C1,0,0,0),   P0[14],P0[15],P1[0],P1[1],   pw1[2]=PKW(P0,12),pw1[3]=PKW(P0,14), pw1); \
    VRD(2); SBAR(); GAPA(C0=__builtin_amdgcn_mfma_f32_32x32x16_bf16(kf[4],qr[2],C0,0,0,0),   P1[2],P1[3],P1[4],P1[5],     pw2[0]=PKW(P1,0), pw2[1]=PKW(P1,2), pw2); \
    VRD(6); SBAR(); GAPA(C1=__builtin_amdgcn_mfma_f32_32x32x16_bf16(kf[5],qr[2],C1,0,0,0),   P1[6],P1[7],P1[8],P1[9],     pw2[2]=PKW(P1,4), pw2[3]=PKW(P1,6), pw2); \
    VRD(3); SBAR(); GAPA(C0=__builtin_amdgcn_mfma_f32_32x32x16_bf16(kf[6],qr[3],C0,0,0,0),   P1[10],P1[11],P1[12],P1[13], pw3[0]=PKW(P1,8), pw3[1]=PKW(P1,10), pw3); \
    VRD(7); SBAR(); GAPA(C1=__builtin_amdgcn_mfma_f32_32x32x16_bf16(kf[7],qr[3],C1,0,0,0),   P1[14],P1[15],0.f,0.f,       pw3[2]=PKW(P1,12),pw3[3]=PKW(P1,14), pw3); \
    l_reg+=sacc; \
    if(GK){DMA_K((t)+3,sl_cur);} if(GV){DMA_V((t)+1,sl_next);} \
    CMASK(C0,C1,t); \
    { float a=MX3(C0[0],C0[1],C1[0]),b=MX3(C0[2],C0[3],C1[1]); a=MX3(a,C1[2],C1[3]); \
      _Pragma("unroll") for(int r=4;r<16;r+=4){a=MX3(a,C0[r],C0[r+1]);b=MX3(b,C0[r+2],C0[r+3]);a=MX3(a,C1[r],C1[r+1]);b=MX3(b,C1[r+2],C1[r+3]);} \
      float rm=__builtin_fmaxf(a,b); { auto rr=__builtin_amdgcn_permlane32_swap(__float_as_uint(rm),__float_as_uint(rm),false,false); rm=__builtin_fmaxf(__uint_as_float(rr[0]),__uint_as_float(rr[1])); } \
      resc=false; \
      if(__builtin_expect(__any(rm>(float)THRL),0)){ const float dl=__builtin_fmaxf(rm,0.f); mhat+=dl; \
        _Pragma("unroll") for(int r=0;r<16;++r){C0[r]-=dl;C1[r]-=dl;} \
        _Pragma("unroll") for(int r=0;r<16;++r)negm[r]=-mhat; asm volatile("":"+v"(negm)); \
        const float f=__builtin_amdgcn_exp2f(-dl); l_reg*=f; if(hi==0)wsf[r32]=f; resc=true; } } \
    SBAR(); \
    GAPB(o[0]=__builtin_amdgcn_mfma_f32_32x32x16_bf16(PAF(0),VFR(0),o[0],0,0,0), C0,0); \
    GAPB(o[1]=__builtin_amdgcn_mfma_f32_32x32x16_bf16(PAF(0),VFR(4),o[1],0,0,0), C0,4); \
    KRD(GL,0); GAPB(o[0]=__builtin_amdgcn_mfma_f32_32x32x16_bf16(PAF(1),VFR(1),o[0],0,0,0), C0,8); \
    KRD(GL,1); GAPB(o[1]=__builtin_amdgcn_mfma_f32_32x32x16_bf16(PAF(1),VFR(5),o[1],0,0,0), C0,12); \
    KRD(GL,2); GAPB(o[0]=__builtin_amdgcn_mfma_f32_32x32x16_bf16(PAF(2),VFR(2),o[0],0,0,0), C1,0); \
    KRD(GL,3); GAPB(o[1]=__builtin_amdgcn_mfma_f32_32x32x16_bf16(PAF(2),VFR(6),o[1],0,0,0), C1,4); \
    GAPB(o[0]=__builtin_amdgcn_mfma_f32_32x32x16_bf16(PAF(3),VFR(3),o[0],0,0,0), C1,8); \
    GAPB(o[1]=__builtin_amdgcn_mfma_f32_32x32x16_bf16(PAF(3),VFR(7),o[1],0,0,0), C1,12); \
    }while(0)
  int t=1;
  #undef CMASK
  #define CMASK(P0,P1,t) do{}while(0)
  for(;t+5<NT;t+=2){
    STEP(pB0,pB1,pA0,pA1,t,true,true,true);     WAIT_BAR(2); RESC(); ROT();
    STEP(pA0,pA1,pB0,pB1,t+1,true,true,true);   WAIT_BAR(2); RESC(); ROT();
  }
  #undef CMASK
  #define CMASK(P0,P1,t) do{}while(0)
  #define ENDW(tt) do{ if((tt)+3<NT){WAIT_BAR(2);} else if((tt)+2<NT){WAIT_BAR(1);} else {WAIT_BAR(0);} }while(0)
  for(;t+1<NT;t+=2){
    STEP(pB0,pB1,pA0,pA1,t,(t+3<NT),(t+1<NT),(t+1<NT));       ENDW(t);   RESC(); ROT();
    STEP(pA0,pA1,pB0,pB1,t+1,(t+4<NT),(t+2<NT),(t+2<NT));     ENDW(t+1); RESC(); ROT();
  }
  STEP(pB0,pB1,pA0,pA1,NT-1,false,false,false); RESC();
  { float sacc=pB0[0]+pB0[1]; _Pragma("unroll") for(int r=2;r<16;++r)sacc+=pB0[r]; _Pragma("unroll") for(int r=0;r<16;++r)sacc+=pB1[r]; l_reg+=sacc;
    pw0=(u32x4){PKW(pB0,0),PKW(pB0,2),PKW(pB0,4),PKW(pB0,6)};pw1=(u32x4){PKW(pB0,8),PKW(pB0,10),PKW(pB0,12),PKW(pB0,14)};pw2=(u32x4){PKW(pB1,0),PKW(pB1,2),PKW(pB1,4),PKW(pB1,6)};pw3=(u32x4){PKW(pB1,8),PKW(pB1,10),PKW(pB1,12),PKW(pB1,14)};
    SBAR(); pv(o,vb0+sl_cur,PAF(0),PAF(1),PAF(2),PAF(3)); }
  #undef PKW
  #undef PAF
  #undef VFR
  #undef PIN
  #undef MX3
  #undef GAPA
  #undef GAPB
  #undef EX
  #undef VRD
  #undef KRD
  #undef STEP
  #undef ENDW
  {auto rr=__builtin_amdgcn_permlane32_swap(__float_as_uint(l_reg),__float_as_uint(l_reg),false,false);l_reg=__uint_as_float(rr[0])+__uint_as_float(rr[1]);}
  if(hi==0)wsf[32+r32]=l_reg;asm volatile("s_waitcnt lgkmcnt(0)":::"memory");
  float rli[16];
  #pragma unroll
  for(int r=0;r<16;++r)rli[r]=__builtin_amdgcn_rcpf(wsf[32+crow(r,hi)]);
  bf16*Ow=O+(rowbase+q0+wid*QBLK)*OP+h*D;
  { bf16*stg=(bf16*)(shm+LDS_OST)+wid*2048;
    #pragma unroll
    for(int r=0;r<16;++r){const int orow=crow(r,hi);
      #pragma unroll
      for(int d0=0;d0<2;++d0)stg[orow*64+d0*32+r32]=__float2bfloat16(o[d0][r]*rli[r]);}
    asm volatile("s_waitcnt lgkmcnt(0)":::"memory");
    #pragma unroll
    for(int i=0;i<4;++i){const int row=i*8+(lane>>3),ch=lane&7; const u32x4 v=*(const u32x4*)(stg+row*64+ch*8); ATTN_STORE16(Ow+(long)row*OP+ch*8,v);} }
  asm volatile("s_waitcnt lgkmcnt(0)\n\ts_barrier":::"memory");
  #undef DMA_K
  #undef DMA_V
  #undef CMASK
  #undef START
  #undef RESC
  #undef ROT
}
constexpr int ATTN_LDS_BYTES=LDS_BYTES;
#undef SBAR
#undef WAIT_BAR
}

constexpr int FBUF = 8720;
__device__ __forceinline__ int fpad(int i) { return i + (i >> 5) + 18 * (i >> 9); }
constexpr float kTwC[16] = {1.000000000e+00f, 9.807852804e-01f, 9.238795325e-01f, 8.314696123e-01f, 7.071067812e-01f, 5.555702330e-01f, 3.826834324e-01f, 1.950903220e-01f,
                            0.0f, -1.950903220e-01f, -3.826834324e-01f, -5.555702330e-01f, -7.071067812e-01f, -8.314696123e-01f, -9.238795325e-01f, -9.807852804e-01f};
constexpr float kTwS[16] = {0.000000000e+00f, 1.950903220e-01f, 3.826834324e-01f, 5.555702330e-01f, 7.071067812e-01f, 8.314696123e-01f, 9.238795325e-01f, 9.807852804e-01f,
                            1.000000000e+00f, 9.807852804e-01f, 9.238795325e-01f, 8.314696123e-01f, 7.071067812e-01f, 5.555702330e-01f, 3.826834324e-01f, 1.950903220e-01f};
template <int N> __device__ __forceinline__ void dft_dif(f32x2 (&v)[N]) {
#pragma unroll
    for (int len = N; len >= 2; len >>= 1) {
        const int half = len / 2;
#pragma unroll
        for (int base = 0; base < N; base += len)
#pragma unroll
            for (int j = 0; j < half; ++j) {
                const f32x2 a = v[base + j], b = v[base + j + half];
                v[base + j] = a + b;
                const f32x2 d = a - b;
                const int ti = j * (32 / len);
                v[base + j + half] = (ti == 0) ? d : (f32x2){d.x * kTwC[ti] + d.y * kTwS[ti], d.y * kTwC[ti] - d.x * kTwS[ti]};
            }
    }
}
__host__ __device__ constexpr int brev(int i, int bits) { int r = 0; for (int b = 0; b < bits; ++b) r |= ((i >> b) & 1) << (bits - 1 - b); return r; }

__device__ __forceinline__ void fft8192(LAS f32x2* buf, int tid_in) {
    int tid = tid_in; asm volatile("" : "+v"(tid));
    {
        const int n2 = tid; f32x2 v[16];
        LAS f32x2* p = buf + n2 + (n2 >> 5);
#pragma unroll
        for (int n1 = 0; n1 < 16; ++n1) v[n1] = p[546 * n1];
        dft_dif<16>(v);
        float s, c; sincosf(-7.669903939428206e-4f * (float)n2, &s, &c);
        f32x2 pw[16]; pw[0] = (f32x2){1.f, 0.f}; pw[1] = (f32x2){c, s};
#pragma unroll
        for (int k = 2; k < 16; ++k) pw[k] = cmul(pw[k - 1], pw[1]);
#pragma unroll
        for (int i = 0; i < 16; ++i) { const int k1 = brev(i, 4); p[546 * k1] = cmul(v[i], pw[k1]); }
    }
    __syncthreads();
    {
        const int k1 = tid >> 5, b = tid & 31; f32x2 v[16];
        LAS f32x2* p = buf + 546 * k1 + b;
#pragma unroll
        for (int a = 0; a < 16; ++a) v[a] = p[33 * a];
        dft_dif<16>(v);
        float s, c; sincosf(-1.2271846303085129e-2f * (float)b, &s, &c);
        f32x2 pw[16]; pw[0] = (f32x2){1.f, 0.f}; pw[1] = (f32x2){c, s};
#pragma unroll
        for (int k = 2; k < 16; ++k) pw[k] = cmul(pw[k - 1], pw[1]);
#pragma unroll
        for (int i = 0; i < 16; ++i) { const int ka = brev(i, 4); p[33 * ka] = cmul(v[i], pw[ka]); }
    }
    __syncthreads();
    {
        const int ka = (tid >> 4) & 15, k1 = tid & 15; f32x2 v[32];
        if (tid < 256) {
            const LAS f32x2* p = buf + 546 * k1 + 33 * ka;
#pragma unroll
            for (int b = 0; b < 32; ++b) v[b] = p[b];
            dft_dif<32>(v);
        }
        __syncthreads();
        if (tid < 256) {
            LAS f32x2* q = buf + k1 + 16 * ka + (ka >> 1);
#pragma unroll
            for (int i = 0; i < 32; ++i) { const int kb = brev(i, 5); q[264 * kb + 18 * (kb >> 1)] = v[i]; }
        }
    }
    __syncthreads();
}

__device__ __forceinline__ float hy_sconv(const bf16* xrow, unsigned t, float w0, float w1, float w2, float bias) {
    const unsigned tm = t > 0u ? t - 1u : 0u, tp = t < (unsigned)(SEQ - 1) ? t + 1u : (unsigned)(SEQ - 1);
    const float xm = t > 0u ? bf2f(xrow[tm]) : 0.f, x0 = bf2f(xrow[t]), xp = t < (unsigned)(SEQ - 1) ? bf2f(xrow[tp]) : 0.f;
    return xm * w0 + x0 * w1 + xp * w2 + bias;
}

__device__ __forceinline__ void hyena_item(Frame& F, const Args& args, int l, int c) {
    LAS f32x2* A = (LAS f32x2*)F.lds;
    LAS f32x2* B = A + FBUF;
    LAS float* W3L = (LAS float*)(B + FBUF);
    LAS float* red = W3L + 256;
    const bf16* hyT = WSP(bf16, WS_RB + RB_HYT);
    float* HV = WSP(float, WS_RD + RD_HV) + (size_t)c * 8 * SEQ;
    bf16* yaT = WSP(bf16, WS_RD + RD_YAT) + (size_t)c * M;
    const float* f2 = WSP(float, WS_HF2) + (size_t)l * 4096 * 64;
    __syncthreads();
    if (F.tid < 256) { const int q = F.tid >> 6, i = F.tid & 63, dir = q >> 1, n = q & 1; W3L[F.tid] = FIN(I_HY_W3)[((size_t)l * 64 + i) * 1024 + dir * 512 + n * 256 + c]; }
    const float delta = fabsf(-3.0701134573253945f + (float)c * ((-15.350567286626973f + 3.0701134573253945f) / 255.f));
    const float* cw = FIN(I_HY_CW) + (size_t)l * 3 * 768; const float* cb = FIN(I_HY_CB) + (size_t)l * 768;
    __syncthreads();
#pragma unroll 1
    for (int n = 0; n < 2; ++n) {
        int tid = F.tid; asm volatile("" : "+v"(tid));
        float ss = 0.f;
#pragma unroll 1
        for (int t = tid; t < SEQ; t += 512) {
            const f32x4* fr = (const f32x4*)(f2 + (size_t)t * 64); float fw = 0.f, bw = 0.f;
#pragma unroll 4
            for (int i = 0; i < 16; ++i) { const f32x4 x = fr[i]; const f32x4 wf = *(const LAS f32x4*)(W3L + (0 + n) * 64 + 4 * i), wbk = *(const LAS f32x4*)(W3L + (2 + n) * 64 + 4 * i);
                fw += x.x * wf.x + x.y * wf.y + x.z * wf.z + x.w * wf.w; bw += x.x * wbk.x + x.y * wbk.y + x.z * wbk.z + x.w * wbk.w; }
            const float dec = expf(-(float)t * (1.f / 4095.f) * delta); fw *= dec; bw *= dec;
            A[fpad(t)] = (f32x2){fw, 0.f}; ss += fw * fw;
            if (t >= 1) { A[fpad(8192 - t)] = (f32x2){bw, 0.f}; ss += bw * bw; }
        }
        if (tid == 0) A[fpad(4096)] = (f32x2){0.f, 0.f};
        ss = block_sum(F, ss, red);
        const float scale = (1.f / sqrtf(ss)) * (1.f / 8192.f);
        fft8192(A, tid);
#pragma unroll
        for (int j = 0; j < 16; ++j) { LAS f32x2* p = A + tid + (tid >> 5) + 546 * j; *p = *p * scale; }
        const float zw0 = cw[n * 256 + c], zw1 = cw[768 + n * 256 + c], zw2 = cw[1536 + n * 256 + c], zb = cb[n * 256 + c];
        const float gw0 = cw[(n + 1) * 256 + c], gw1 = cw[768 + (n + 1) * 256 + c], gw2 = cw[1536 + (n + 1) * 256 + c], gb = cb[(n + 1) * 256 + c];
        const float bias = FIN(I_HY_BIAS)[((size_t)l * 2 + n) * 256 + c];
#pragma unroll 1
        for (int pb = 0; pb < 4; ++pb) {
            int tq = tid; asm volatile("" : "+v"(tq));
            const bf16* zr0 = hyT + (size_t)c * M + (size_t)(2 * pb) * SEQ; const bf16* zr1 = zr0 + SEQ;
            const bf16* gr0 = hyT + (size_t)((n + 1) * 256 + c) * M + (size_t)(2 * pb) * SEQ; const bf16* gr1 = gr0 + SEQ;
            float* hv0 = HV + (size_t)(2 * pb) * SEQ; float* hv1 = hv0 + SEQ;
            float z0[8], z1[8];
            __syncthreads();
#pragma unroll
            for (int j = 0; j < 8; ++j) { const unsigned t = (unsigned)tq + 512u * j;
                if (n == 0) { z0[j] = hy_sconv(zr0, t, zw0, zw1, zw2, zb); z1[j] = hy_sconv(zr1, t, zw0, zw1, zw2, zb); }
                else { z0[j] = hv0[t]; z1[j] = hv1[t]; }
                B[tq + (tq >> 5) + 546 * j] = (f32x2){z0[j], z1[j]}; B[tq + (tq >> 5) + 546 * (j + 8)] = (f32x2){0.f, 0.f}; }
            __syncthreads();
            fft8192(B, tq);
#pragma unroll
            for (int j = 0; j < 16; ++j) { const int p = tq + (tq >> 5) + 546 * j; const f32x2 y = cmul(B[p], A[p]); B[p] = (f32x2){y.x, -y.y}; }
            __syncthreads();
            fft8192(B, tq);
#pragma unroll
            for (int j = 0; j < 8; ++j) { const unsigned t = (unsigned)tq + 512u * j; const f32x2 y = B[tq + (tq >> 5) + 546 * j];
                const float g0 = hy_sconv(gr0, t, gw0, gw1, gw2, gb), g1 = hy_sconv(gr1, t, gw0, gw1, gw2, gb);
                const float o0 = g0 * (y.x + bias * z0[j]), o1 = g1 * (-y.y + bias * z1[j]);
                if (n == 0) { hv0[t] = o0; hv1[t] = o1; }
                else { yaT[(size_t)(2 * pb) * SEQ + t] = (bf16)f2bf(o0); yaT[(size_t)(2 * pb + 1) * SEQ + t] = (bf16)f2bf(o1); }
                asm volatile("" ::: "memory"); }
        }
        __syncthreads();
    }
}

__device__ __forceinline__ f32x16 mfma32(bf16x8 a, bf16x8 b, f32x16 c) { return __builtin_amdgcn_mfma_f32_32x32x16_bf16(a, b, c, 0, 0, 0); }
__device__ __forceinline__ int crow(int r, int hi) { return (r & 3) + 8 * (r >> 2) + 4 * hi; }
__device__ __forceinline__ float gelu_tanh(float x) {
    const float u = 0.7978845608028654f * (x + 0.044715f * x * x * x);
    const float e = __builtin_amdgcn_exp2f(2.885390081777927f * u);
    const float th = 1.f - 2.f * __builtin_amdgcn_rcpf(e + 1.f);
    return 0.5f * x * (1.f + th);
}
__device__ __forceinline__ void s5_item(Frame& F, const Args& args, int l, int b, int g) {
    constexpr int SP = 129, XP = 136;
    LAS float* S = (LAS float*)F.lds;
    LAS bf16* XB = (LAS bf16*)(F.lds + 128 * SP * 4);
    const int tid = F.tid, lane = F.lane, w = F.wave, r32 = lane & 31, hi = lane >> 5;
    const bf16* U = WSP(bf16, WS_RB + RB_PROJ2) + (size_t)b * SEQ * PROJ2_W + PC_S5 + g * 16;
    const bf16* wst = WSP(bf16, WS_S5W + (size_t)l * S5W_LAYER + S5_WST_OFF) + (size_t)g * 2 * 128 * 512;
    const bf16* wcat = WSP(bf16, WS_S5W + (size_t)l * S5W_LAYER + S5_WCAT_OFF) + (size_t)g * 512 * 768;
    bf16* Z = WSP(bf16, WS_RD + RD_S5Z) + (size_t)b * SEQ * 256 + g * 16;
    __syncthreads();
    for (int dir = 0; dir < 2; ++dir) {
        {
            const int rt = w >> 1, ct0 = 2 * (w & 1);
            f32x16 acc[2]; acc[0] = f32x16{}; acc[1] = f32x16{};
            const bf16* ap = wst + ((size_t)dir * 128 + rt * 32 + r32) * 512 + 8 * hi;
            const bf16* bp0 = U + (size_t)(32 * (ct0 * 32 + r32)) * PROJ2_W + 8 * hi;
            const bf16* bp1 = bp0 + (size_t)(32 * 32) * PROJ2_W;
#pragma unroll 4
            for (int ks = 0; ks < 32; ++ks) {
                const bf16x8 a = *(const bf16x8*)(ap + 16 * ks);
                const bf16x8 b0 = *(const bf16x8*)(bp0 + (size_t)ks * PROJ2_W), b1 = *(const bf16x8*)(bp1 + (size_t)ks * PROJ2_W);
                acc[0] = mfma32(a, b0, acc[0]); acc[1] = mfma32(a, b1, acc[1]);
            }
#pragma unroll
            for (int q = 0; q < 2; ++q)
#pragma unroll
                for (int r = 0; r < 16; ++r) S[((ct0 + q) * 32 + r32) * SP + rt * 32 + crow(r, hi)] = acc[q][r];
        }
        __syncthreads();
        if (tid < 64) {
            const f32x2 a32 = WSP(f32x2, WS_S5A32)[((size_t)(l * 2 + dir) * 16 + g) * 64 + tid];
            f32x2 X = (f32x2){0.f, 0.f};
#pragma unroll 8
            for (int cc = 0; cc < 128; ++cc) { const int c = dir == 0 ? cc : 127 - cc;
                const f32x2 s = (f32x2){S[c * SP + 2 * tid], S[c * SP + 2 * tid + 1]};
                X = cmul(a32, X) + s;
                *(LAS unsigned*)(XB + ((size_t)dir * 128 + c) * XP + 2 * tid) = pk2(X.x, X.y); }
        }
        __syncthreads();
    }
    {
        f32x16 acc[2][4];
#pragma unroll
        for (int i = 0; i < 2; ++i)
#pragma unroll
            for (int j = 0; j < 4; ++j) acc[i][j] = f32x16{};
        const bf16* ap = wcat + (size_t)(2 * w * 32 + r32) * 768 + 8 * hi;
        const bf16* bp = U + (size_t)(32 * r32) * PROJ2_W + 8 * hi;
#pragma unroll 2
        for (int ks = 0; ks < 32; ++ks) {
            const bf16x8 a0 = *(const bf16x8*)(ap + 16 * ks), a1 = *(const bf16x8*)(ap + 32 * 768 + 16 * ks);
#pragma unroll
            for (int ct = 0; ct < 4; ++ct) { const bf16x8 bv = *(const bf16x8*)(bp + (size_t)(32 * 32 * ct + ks) * PROJ2_W);
                acc[0][ct] = mfma32(a0, bv, acc[0][ct]); acc[1][ct] = mfma32(a1, bv, acc[1][ct]); }
        }
#pragma unroll 2
        for (int ks = 0; ks < 16; ++ks) {
            const int dir = ks >> 3, kk = ks & 7;
            const bf16x8 a0 = *(const bf16x8*)(ap + 512 + 16 * ks), a1 = *(const bf16x8*)(ap + 32 * 768 + 512 + 16 * ks);
#pragma unroll
            for (int ct = 0; ct < 4; ++ct) { const int c = ct * 32 + r32, cs = dir == 0 ? c - 1 : c + 1;
                bf16x8 bv = (bf16x8){0, 0, 0, 0, 0, 0, 0, 0};
                if (cs >= 0 && cs < 128) bv = *(const LAS bf16x8*)(XB + ((size_t)dir * 128 + cs) * XP + 16 * kk + 8 * hi);
                acc[0][ct] = mfma32(a0, bv, acc[0][ct]); acc[1][ct] = mfma32(a1, bv, acc[1][ct]); }
        }
#pragma unroll
        for (int i = 0; i < 2; ++i)
#pragma unroll
            for (int ct = 0; ct < 4; ++ct)
#pragma unroll
                for (int q = 0; q < 4; ++q) {
                    const int tl = (2 * w + i) * 2 + (q >> 1), co = 8 * (q & 1) + 4 * hi, c = ct * 32 + r32;
                    v2u o; o.x = pk2(gelu_tanh(acc[i][ct][4 * q]), gelu_tanh(acc[i][ct][4 * q + 1])); o.y = pk2(gelu_tanh(acc[i][ct][4 * q + 2]), gelu_tanh(acc[i][ct][4 * q + 3]));
                    *(v2u*)(Z + (size_t)(32 * c + tl) * 256 + co) = o; }
    }
    __syncthreads();
}

__device__ __forceinline__ void dil_unit(Frame& F, const Args& args, int u) {
    int lane = F.lane; asm volatile("" : "+v"(lane));
    const int r32 = lane & 31, hi = lane >> 5;
    const int g = u >> 12, b = (u >> 9) & 7, hh = (u >> 7) & 3, tile = u & 127;
    const int dsh = 2 * g, Lp = SEQ >> dsh, tpr = Lp >> 5, rho = tile / tpr, tau0 = (tile % tpr) * 32, h = g * 4 + hh;
    const float slope2 = exp2f(-8.f * (float)(h + 1) * (1.f / 12.f)) * (float)(1 << dsh) * 1.4426950408889634f;
    const char* P2 = (const char*)(WSP(bf16, WS_RB + RB_PROJ2) + (size_t)b * SEQ * PROJ2_W);
#define DIL_ROWB(tp) ((unsigned)(rho + ((tp) << dsh)) * (unsigned)(PROJ2_W * 2))
    bf16x8 qf[4];
    { const unsigned qo = DIL_ROWB(tau0 + r32) + (unsigned)(PC_DQ + h * 64 + 8 * hi) * 2u;
#pragma unroll
      for (int ks = 0; ks < 4; ++ks) qf[ks] = *(const bf16x8*)(P2 + qo + 32 * ks); }
    f32x16 S[5];
#pragma unroll
    for (int kt = 0; kt < 5; ++kt) {
        int tj = tau0 - 64 + 32 * kt + r32; tj = tj < 0 ? 0 : (tj > Lp - 1 ? Lp - 1 : tj);
        const unsigned ko = DIL_ROWB(tj) + (unsigned)(PC_DK + h * 64 + 8 * hi) * 2u;
        f32x16 a = f32x16{};
#pragma unroll
        for (int ks = 0; ks < 4; ++ks) a = mfma32(*(const bf16x8*)(P2 + ko + 32 * ks), qf[ks], a);
        S[kt] = a;
    }
    float mx = -1e30f;
#pragma unroll
    for (int kt = 0; kt < 5; ++kt)
#pragma unroll
        for (int r = 0; r < 16; ++r) { const int dl = -64 + 32 * kt + crow(r, hi) - r32, tj = tau0 + r32 + dl;
            const bool ok = dl >= -64 && dl <= 64 && tj >= 0 && tj < Lp;
            const float s = S[kt][r] * (0.125f * 1.4426950408889634f) - slope2 * (float)(dl < 0 ? -dl : dl);
            S[kt][r] = ok ? s : -1e30f; mx = fmaxf(mx, S[kt][r]); }
    mx = fmaxf(mx, __shfl_xor(mx, 32));
    float lsum = 0.f;
#pragma unroll
    for (int kt = 0; kt < 5; ++kt)
#pragma unroll
        for (int r = 0; r < 16; ++r) { const float p = __builtin_amdgcn_exp2f(S[kt][r] - mx); S[kt][r] = p; lsum += p; }
    lsum += __shfl_xor(lsum, 32);
    f32x16 O[2]; O[0] = f32x16{}; O[1] = f32x16{};
    const unsigned vcol = (unsigned)(PC_DV + h * 64 + r32) * 2u;
#pragma unroll
    for (int kt = 0; kt < 5; ++kt)
#pragma unroll
        for (int s = 0; s < 2; ++s) {
            bf16x8 pa; bf16x8 v0, v1;
#pragma unroll
            for (int j = 0; j < 8; j += 2) { const unsigned w = pk2(S[kt][8 * s + j], S[kt][8 * s + j + 1]); pa[j] = (short)(w & 0xffff); pa[j + 1] = (short)(w >> 16); }
#pragma unroll
            for (int j = 0; j < 8; ++j) { int tj = tau0 - 64 + 32 * kt + 16 * s + 8 * (j >> 2) + 4 * hi + (j & 3); tj = tj < 0 ? 0 : (tj > Lp - 1 ? Lp - 1 : tj);
                const bf16* vp = (const bf16*)(P2 + DIL_ROWB(tj) + vcol); v0[j] = (short)vp[0]; v1[j] = (short)vp[32]; }
            O[0] = mfma32(pa, v0, O[0]); O[1] = mfma32(pa, v1, O[1]);
            asm volatile("" ::: "memory");
        }
    const float linv = 1.f / lsum;
    bf16* Og = WSP(bf16, WS_RD + RD_DILO) + (size_t)g * M * 256 + (size_t)b * SEQ * 256 + hh * 64 + r32;
#pragma unroll
    for (int r = 0; r < 16; ++r) { const int i = crow(r, hi); const float li = __shfl(linv, i);
        const unsigned ro = (unsigned)(rho + ((tau0 + i) << dsh)) * 256u;
        Og[ro] = (bf16)f2bf(O[0][r] * li); Og[ro + 32] = (bf16)f2bf(O[1][r] * li); }
    if (hi == 0) WSP(float, WS_DLSE)[((size_t)g * M + (size_t)b * SEQ + rho + ((tau0 + r32) << dsh)) * 4 + hh] = (mx + log2f(lsum)) * 0.6931471805599453f;
#undef DIL_ROWB
}

__device__ __forceinline__ void gqa_prep_row(Frame& F, const Args& args, int l, int m) {
    const int lane = F.lane, t = m & (SEQ - 1);
    const bf16* src = WSP(bf16, WS_RB + RB_PROJ2) + (size_t)m * PROJ2_W + PC_GQ;
    bf16* dst = WSP(bf16, WS_RD + RD_QKVG) + (size_t)m * 512;
    const int i = lane & 15, pos = lane < 32 ? (t >> 6) : (t & 63);
    const f32x2 cs = WSP(f32x2, WS_ROPE)[pos * 16 + i];
    const float qn = FIN(I_GQ_QN)[l * 64 + lane], kn = FIN(I_GQ_KN)[l * 64 + lane];
#pragma unroll
    for (int hs = 0; hs < 6; ++hs) {
        const float x = bf2f(src[hs * 64 + lane]);
        const float rn = 1.f / sqrtf(wave_sum(x * x) * (1.f / 64.f) + RMS_EPS);
        const float xn = x * rn * (hs < 4 ? qn : kn);
        const float pr = __shfl_xor(xn, 16);
        float o = (lane & 16) ? xn * cs.x + pr * cs.y : xn * cs.x - pr * cs.y;
        if (hs < 4) o *= 0.125f * 1.4426950408889634f;
        dst[hs * 64 + lane] = (bf16)f2bf(o);
    }
    *(unsigned*)(dst + 384 + 2 * lane) = *(const unsigned*)(src + (PC_GV - PC_GQ) + 2 * lane);
}

__device__ __forceinline__ void hy_transpose_item(Frame& F, int item) {
    LAS bf16* T = (LAS bf16*)F.lds + F.wave * (64 * 66);
    const int lane = F.lane, mb = item >> 2, cb = item & 3;
    const bf16* src = WSP(bf16, WS_RD + RD_YAT) + (size_t)(cb * 64) * M + (size_t)mb * 64;
    bf16* dst = WSP(bf16, WS_Y) + (size_t)(mb * 64) * 1024 + cb * 64;
#pragma unroll
    for (int i = 0; i < 8; ++i) { const int c = 8 * i + (lane >> 3), m0 = (lane & 7) * 8; const v4u v = *(const v4u*)(src + (size_t)c * M + m0);
        LAS unsigned* tp = (LAS unsigned*)(T + c * 66 + m0); tp[0] = v.x; tp[1] = v.y; tp[2] = v.z; tp[3] = v.w; }
    LDS_WAIT(); asm volatile("" ::: "memory");
#pragma unroll
    for (int i = 0; i < 8; ++i) { const int m = 8 * i + (lane >> 3), c0 = (lane & 7) * 8; unsigned short e[8];
#pragma unroll
        for (int j = 0; j < 8; ++j) e[j] = T[(c0 + j) * 66 + m];
        v4u o; o.x = e[0] | ((unsigned)e[1] << 16); o.y = e[2] | ((unsigned)e[3] << 16); o.z = e[4] | ((unsigned)e[5] << 16); o.w = e[6] | ((unsigned)e[7] << 16);
        *(v4u*)(dst + (size_t)m * 1024 + c0) = o; }
    LDS_WAIT(); asm volatile("" ::: "memory");
}
__device__ __forceinline__ void dil_combine_row(Frame& F, int m) {
    const int lane = F.lane, hh = lane >> 4;
    const float* ls = WSP(float, WS_DLSE);
    const float l0 = ls[((size_t)0 * M + m) * 4 + hh], l1 = ls[((size_t)1 * M + m) * 4 + hh], l2 = ls[((size_t)2 * M + m) * 4 + hh];
    const float mx = fmaxf(l0, fmaxf(l1, l2)); const float e0 = expf(l0 - mx), e1 = expf(l1 - mx), e2 = expf(l2 - mx), inv = 1.f / (e0 + e1 + e2);
    const bf16* o = WSP(bf16, WS_RD + RD_DILO) + (size_t)m * 256 + 4 * lane;
    const v2u a = *(const v2u*)o, b = *(const v2u*)(o + (size_t)M * 256), c = *(const v2u*)(o + (size_t)2 * M * 256);
    const float w0 = e0 * inv, w1 = e1 * inv, w2 = e2 * inv;
    v2u r; r.x = pk2(w0 * bflo(a.x) + w1 * bflo(b.x) + w2 * bflo(c.x), w0 * bfhi(a.x) + w1 * bfhi(b.x) + w2 * bfhi(c.x));
    r.y = pk2(w0 * bflo(a.y) + w1 * bflo(b.y) + w2 * bflo(c.y), w0 * bfhi(a.y) + w1 * bfhi(b.y) + w2 * bfhi(c.y));
    *(v2u*)(WSP(bf16, WS_Y) + (size_t)m * 1024 + 256 + 4 * lane) = r;
}

__device__ __forceinline__ void ln1_router_phase(Frame& F, const Args& args, int l) {
    LAS float* RW = (LAS float*)F.lds;
    const float* rw = FIN(I_ROUTER) + (size_t)l * 1024 * 16;
    __syncthreads();
    for (int i = F.tid; i < 1024 * 16 / 4; i += 512) ((LAS f32x4*)RW)[i] = ((const f32x4*)rw)[i];
    __syncthreads();
    const int gw = F.bid * 8 + F.wave, NGW = F.G * 8, lane = F.lane;
    const float* pre = WSP(float, WS_RB + RB_PRE);
    for (int m = gw; m < M; m += NGW) {
        f32x4 v[4];
#pragma unroll
        for (int j = 0; j < 4; ++j) v[j] = *(const f32x4*)(pre + (size_t)m * DM + 4 * lane + 256 * j);
        ln_row(v, FIN(I_LN1G) + l * DM, FIN(I_LN1B) + l * DM, lane);
        store_row_f32_bf16(v, F.out + (size_t)m * DM, WSP(bf16, WS_HB) + (size_t)m * DM, lane);
        float lg[16];
#pragma unroll
        for (int e = 0; e < 16; ++e) lg[e] = 0.f;
#pragma unroll
        for (int j = 0; j < 4; ++j)
#pragma unroll
            for (int q = 0; q < 4; ++q) { const float x = v[j][q]; const LAS f32x4* wr = (const LAS f32x4*)(RW + (size_t)(4 * lane + 256 * j + q) * 16);
#pragma unroll
                for (int e4 = 0; e4 < 4; ++e4) { const f32x4 wv = wr[e4]; lg[4 * e4] += x * wv.x; lg[4 * e4 + 1] += x * wv.y; lg[4 * e4 + 2] += x * wv.z; lg[4 * e4 + 3] += x * wv.w; }
                if (q & 1) asm volatile("" ::: "memory"); }
#pragma unroll
        for (int e = 0; e < 16; ++e) lg[e] = wave_sum(lg[e]);
        float mx = lg[0];
#pragma unroll
        for (int e = 1; e < 16; ++e) mx = fmaxf(mx, lg[e]);
        float den = 0.f, mine = 0.f;
#pragma unroll
        for (int e = 0; e < 16; ++e) { const float p = expf(lg[e] - mx); den += p; if (lane == e) mine = p; }
        if (lane < 16) WSP(float, WS_AFF)[(size_t)m * 16 + lane] = mine / den;
    }
}

__device__ __forceinline__ int wave_incl_scan(int v, int lane) {
#pragma unroll
    for (int o = 1; o < 64; o <<= 1) { const int n = __shfl_up(v, o); if (lane >= o) v += n; }
    return v;
}
__device__ __forceinline__ int block_excl_scan(Frame& F, int v, LAS int* sc) {
    const int inc = wave_incl_scan(v, F.lane);
    __syncthreads();
    if (F.lane == 63) sc[F.wave] = inc;
    __syncthreads();
    int base = 0;
#pragma unroll
    for (int w = 0; w < 8; ++w) { const int x = sc[w]; if (w < F.wave) base += x; }
    return base + inc - v;
}
__device__ __forceinline__ void topk_item(Frame& F, int e, int b) {
    LAS int* H = (LAS int*)F.lds;
    LAS int* SH = H + 256;
    LAS int* SC = SH + 4;
    LAS int* SEL = SC + 16;
    const int tid = F.tid, lane = F.lane, eb = e * 8 + b;
    const float* aff = WSP(float, WS_AFF) + (size_t)b * SEQ * 16 + e;
    unsigned key[8];
#pragma unroll
    for (int j = 0; j < 8; ++j) key[j] = __float_as_uint(aff[(size_t)(8 * tid + j) * 16]);
    unsigned prefix = 0u, pmask = 0u; int need = CAP;
    for (int pass = 3; pass >= 0; --pass) {
        __syncthreads();
        if (tid < 256) H[tid] = 0;
        __syncthreads();
#pragma unroll
        for (int j = 0; j < 8; ++j) if ((key[j] & pmask) == prefix) __hip_atomic_fetch_add(&H[(key[j] >> (8 * pass)) & 255u], 1, __ATOMIC_RELAXED, __HIP_MEMORY_SCOPE_WORKGROUP);
        __syncthreads();
        if (F.wave == 0) {
            const int c0 = H[255 - 4 * lane], c1 = H[254 - 4 * lane], c2 = H[253 - 4 * lane], c3 = H[252 - 4 * lane];
            const int s = c0 + c1 + c2 + c3, inc = wave_incl_scan(s, lane), exc = inc - s;
            if (exc < need && need <= inc) { const int r = need - exc; int bin, nn;
                if (r <= c0) { bin = 255 - 4 * lane; nn = r; } else if (r <= c0 + c1) { bin = 254 - 4 * lane; nn = r - c0; }
                else if (r <= c0 + c1 + c2) { bin = 253 - 4 * lane; nn = r - c0 - c1; } else { bin = 252 - 4 * lane; nn = r - c0 - c1 - c2; }
                SH[0] = bin; SH[1] = nn; }
        }
        __syncthreads();
        prefix |= (unsigned)SH[0] << (8 * pass); pmask |= 0xffu << (8 * pass); need = SH[1];
    }
    const unsigned thr = prefix;
    int eqc = 0;
#pragma unroll
    for (int j = 0; j < 8; ++j) eqc += (key[j] == thr) ? 1 : 0;
    int eq = block_excl_scan(F, eqc, SC);
    int selc = 0; unsigned selm = 0u;
#pragma unroll
    for (int j = 0; j < 8; ++j) { bool s = key[j] > thr; if (key[j] == thr) { s = eq < need; ++eq; } if (s) { selm |= 1u << j; ++selc; } }
    int slot = block_excl_scan(F, selc, SC);
    unsigned short* inv = WSP(unsigned short, WS_INV) + (size_t)eb * SEQ;
    float* gwp = WSP(float, WS_GW) + (size_t)eb * CAP; int* idx = WSP(int, WS_IDX) + (size_t)eb * CAP;
#pragma unroll
    for (int j = 0; j < 8; ++j) { const int t = 8 * tid + j;
        if ((selm >> j) & 1u) { inv[t] = (unsigned short)(slot + 1); SEL[slot] = t; gwp[slot] = __uint_as_float(key[j]); idx[slot] = t; ++slot; }
        else inv[t] = (unsigned short)0; }
    __syncthreads();
    const bf16* hb = WSP(bf16, WS_HB) + (size_t)b * SEQ * DM; bf16* xs = WSP(bf16, WS_RA + RA_XS) + (size_t)eb * CAP * DM;
    for (int s = F.wave; s < CAP; s += 8) { const int t = SEL[s];
        const v4u* sp = (const v4u*)(hb + (size_t)t * DM); v4u* dp = (v4u*)(xs + (size_t)s * DM);
        dp[F.lane] = sp[F.lane]; dp[F.lane + 64] = sp[F.lane + 64]; }
    __syncthreads();
}

__device__ __forceinline__ void ln2_phase(Frame& F, const Args& args, int l) {
    const int gw = F.bid * 8 + F.wave, NGW = F.G * 8, lane = F.lane;
    const unsigned short* inv = WSP(unsigned short, WS_INV);
    const bf16* eo = WSP(bf16, WS_RA + RA_EOUT);
    for (int m = gw; m < M; m += NGW) {
        const int b = m >> 12, t = m & (SEQ - 1);
        f32x4 v[4];
#pragma unroll
        for (int j = 0; j < 4; ++j) v[j] = *(const f32x4*)(F.out + (size_t)m * DM + 4 * lane + 256 * j) * DN_ALPHA;
        for (int e = 0; e < NE; ++e) {
            const int sl = (int)__builtin_amdgcn_readfirstlane((int)inv[((size_t)(e * 8 + b)) * SEQ + t]);
            if (sl) { const bf16* r = eo + ((size_t)(e * 8 + b) * CAP + (sl - 1)) * DM;
#pragma unroll
                for (int j = 0; j < 4; ++j) { const v2u w = *(const v2u*)(r + 4 * lane + 256 * j); v[j].x += bflo(w.x); v[j].y += bfhi(w.x); v[j].z += bflo(w.y); v[j].w += bfhi(w.y); } }
        }
        ln_row(v, FIN(I_LN2G) + l * DM, FIN(I_LN2B) + l * DM, lane);
        store_row_f32_bf16(v, F.out + (size_t)m * DM, WSP(bf16, WS_HB) + (size_t)m * DM, lane);
    }
}

struct SchedTiles {
    const char* A0; const char* B0; size_t a_tile, b_tile; int nM, nN, G, c;
    __device__ __forceinline__ bool next(int i, pg8::Unit& u) const {
        const int L = i * G + c; if (L >= nM * nN) return false;
        int pm, pn; pg8::tile_of(L, nM, nN, pm, pn);
        u.A = A0 + (size_t)pm * a_tile; u.B = B0 + (size_t)pn * b_tile; u.orow = pm * 256; u.ocol = pn * 256; u.z = 0; return true;
    }
};
struct SchedMerge {
    const char* Y; const char* WB; int G, c;
    __device__ __forceinline__ bool next(int i, pg8::Unit& u) const {
        const int L = (i >> 2) * G + c, z = i & 3; if (L >= 128 * 4) return false;
        int pm, pn; pg8::tile_of(L, 128, 4, pm, pn);
        u.A = Y + ((size_t)pm * 256 * 1024 + z * 256) * 2; u.B = WB + ((size_t)z * 1024 * 256 + (size_t)pn * 256 * 256) * 2; u.orow = pm * 256; u.ocol = pn * 256; u.z = z; return true;
    }
};
struct SchedMoe1 {
    const char* XS; const char* W; int G, c;
    __device__ __forceinline__ bool next(int i, pg8::Unit& u) const {
        const int L = i * G + c; if (L >= 128 * 16) return false;
        const int eb = L >> 4, sub = L & 15, pm2 = sub & 1, pn = sub >> 1, e = eb >> 3;
        u.A = XS + ((size_t)(eb * 512 + pm2 * 256) * 1024) * 2; u.B = W + ((size_t)(e * 2048 + pn * 256) * 1024) * 2; u.orow = eb * 512 + pm2 * 256; u.ocol = pn * 128; u.z = eb; return true;
    }
};
struct SchedMoe2 {
    const char* HID; const char* W; int G, c;
    __device__ __forceinline__ bool next(int i, pg8::Unit& u) const {
        const int L = i * G + c; if (L >= 128 * 8) return false;
        const int eb = L >> 3, sub = L & 7, pm2 = sub & 1, pn = sub >> 1, e = eb >> 3;
        u.A = HID + ((size_t)(eb * 512 + pm2 * 256) * 1024) * 2; u.B = W + ((size_t)(e * 1024 + pn * 256) * 1024) * 2; u.orow = eb * 512 + pm2 * 256; u.ocol = pn * 256; u.z = eb; return true;
    }
};

constexpr int NPH = 12;
__global__ void __launch_bounds__(512, 2) fwd_kernel(Args args_k) {
    const Args& args0 = args_k;
    extern __shared__ __attribute__((aligned(16))) unsigned char lds_raw[];
    Frame F;
    F.lds = (LAS unsigned char*)lds_raw;
    F.MISC = (volatile LAS unsigned*)(F.lds + MISC_OFF);
    F.tid = threadIdx.x; F.lane = F.tid & 63; F.wave = __builtin_amdgcn_readfirstlane(F.tid >> 6);
    F.G = gridDim.x; F.bid = blockIdx.x;
    F.ws = args0.ws; F.out = args0.out; F.ctl = (gu32*)(args0.ws + WS_CTL);
    for (int u = F.tid; u < (LDS_BYTES - MISC_OFF) / 4; u += 512) F.MISC[u] = 0u;
    __syncthreads();
    const bool multi = (args0.l_hi - args0.l_lo > 1) || (args0.ph_hi - args0.ph_lo > 1);
    XcdBarrier bar; bar.bar = (unsigned*)(F.ctl + CW_BAR); bar.x = 0; bar.st = F.MISC + 8;
    if (multi) bar = xcd_barrier_post((unsigned*)(F.ctl + CW_BAR), F.MISC + 8);
    const int lo = args0.ph_lo, hi = args0.ph_hi, l_lo = args0.l_lo, l_hi = args0.l_hi;
#ifndef DBG_ROT
#define DBG_ROT 0
#endif
#ifndef PHASE_MASK
#define PHASE_MASK 0xfff
#endif
#define IN(k) (((PHASE_MASK >> (k)) & 1) && lo <= (k) && (k) < hi)
#ifndef SUB_MASK
#define SUB_MASK 0xff
#endif
#define SUB(k) ((SUB_MASK >> (k)) & 1)
#define FRESH() do { int t_ = threadIdx.x; asm volatile("" : "+v"(t_)); F.tid = t_; F.lane = t_ & 63; F.wave = __builtin_amdgcn_readfirstlane(t_ >> 6); } while (0)
#define SEAM(k) do { if (((k) + 1 < hi) || (l + 1 < l_hi)) xcd_barrier(bar); } while (0)

#pragma unroll 1
    for (int l = l_lo; l < l_hi; ++l) {
        const Args& args = args_k;
        { size_t z_ = 0; asm volatile("" : "+s"(z_)); F.ws = args.ws + z_; F.out = args.out + z_; F.ctl = (gu32*)(F.ws + WS_CTL); }
        unsigned char* wb = F.ws + WS_W;
        const char* HBp = (const char*)(F.ws + WS_HB);
        const int NGW = F.G * 8;
#define gw (F.bid * 8 + F.wave)
        if (IN(0) && l == 0) { FRESH(); prologue_phase(F, args); SEAM(0); }

        if (IN(1)) { FRESH();
            const pg8::Gemm g{1024, 1024, 1024};
            if (SUB(0)) {
                SchedTiles S{(const char*)(wb + W_WIN), HBp, (size_t)256 * 1024 * 2, (size_t)256 * 1024 * 2, 3, 128, F.G, F.bid};
                pg8::EpiBf16<0> E{WSP(bf16, WS_RB + RB_HYT), M};
                pg8::gemm_phase(F.lds, g, S, E); }
            if (SUB(1)) {
                SchedTiles S{HBp, (const char*)(wb + W_WIN) + (size_t)768 * 1024 * 2, (size_t)256 * 1024 * 2, (size_t)256 * 1024 * 2, 128, 12, F.G, F.bid};
                pg8::EpiBf16<0> E{WSP(bf16, WS_RB + RB_PROJ2), PROJ2_W};
                pg8::gemm_phase(F.lds, g, S, E); }
            if (SUB(2)) {
                SchedTiles S{HBp, (const char*)(wb + W_WIN) + (size_t)3840 * 1024 * 2, (size_t)256 * 1024 * 2, (size_t)256 * 1024 * 2, 128, 16, F.G, (F.bid + DBG_ROT) % F.G};
                pg8::EpiBf16<1> E{WSP(bf16, WS_RA + RA_G), 4096};
                pg8::gemm_phase(F.lds, g, S, E); }
            SEAM(1);
        }
        if (IN(2)) { FRESH(); for (int m = gw; m < M; m += NGW) gqa_prep_row(F, args, l, m); SEAM(2); }

        if (IN(3)) { FRESH();
#if MK_STATIC_Q
            if (SUB(0)) for (int it = F.bid; it < 256; it += F.G) hyena_item(F, args, l, it);
            if (SUB(1)) {   const attn_body::bf16* Qp = (const attn_body::bf16*)(F.ws + WS_RD + RD_QKVG);
                attn_body::bf16* Op = (attn_body::bf16*)(F.ws + WS_Y) + 768;
                for (int it = F.bid; it < 512; it += F.G) { __syncthreads();
                    attn_body::attn_unit<8>(it >> 6, (it >> 4) & 3, it & 15, Qp, Qp + 256, Qp + 384, Op, (char*)lds_raw); } }
            if (SUB(2)) for (int it = F.bid; it < 128; it += F.G) s5_item(F, args, l, it >> 4, it & 15);
            __syncthreads();
            if (SUB(3)) for (int it = F.bid; it < 1536; it += F.G) dil_unit(F, args, it * 8 + F.wave);
#else
            if (SUB(0)) for (;;) { const int it = wq_grab(F, l * 8 + 0); if (it >= 256) break; hyena_item(F, args, l, it); }
            if (SUB(1)) {   const attn_body::bf16* Qp = (const attn_body::bf16*)(F.ws + WS_RD + RD_QKVG);
                attn_body::bf16* Op = (attn_body::bf16*)(F.ws + WS_Y) + 768;
                for (;;) { const int it = wq_grab(F, l * 8 + 1); if (it >= 512) break;
                    attn_body::attn_unit<8>(it >> 6, (it >> 4) & 3, it & 15, Qp, Qp + 256, Qp + 384, Op, (char*)lds_raw); } }
            if (SUB(2)) for (;;) { const int it = wq_grab(F, l * 8 + 2); if (it >= 128) break; s5_item(F, args, l, it >> 4, it & 15); }
            if (SUB(3)) for (;;) { const int it = wq_grab(F, l * 8 + 3); if (it >= 1536) break; dil_unit(F, args, it * 8 + F.wave); }
#endif
            SEAM(3);
        }
        if (IN(4)) { FRESH();
            if (SUB(0)) {   const pg8::Gemm g{256, 256, 256};
                SchedTiles S{(const char*)(F.ws + WS_RD + RD_S5Z), (const char*)(wb + W_GLU), (size_t)256 * 256 * 2, 0, 128, 1, F.G, F.bid};
                pg8::EpiGlu E{WSP(bf16, WS_RD + RD_S5Z), WSP(bf16, WS_Y), FIN(I_S5_GB) + l * 256};
                pg8::gemm_phase(F.lds, g, S, E); }
            __syncthreads();
            if (SUB(1)) for (int it = gw; it < 2048; it += NGW) hy_transpose_item(F, it);
            if (SUB(2)) for (int m = gw; m < M; m += NGW) dil_combine_row(F, m);
            SEAM(4);
        }
        if (IN(5)) { FRESH();
            const pg8::Gemm g{256, 1024, 256};
            SchedMerge S{(const char*)(F.ws + WS_Y), (const char*)(wb + W_WB), F.G, F.bid};
            pg8::EpiMerge E{WSP(bf16, WS_RA + RA_G), WSP(float, WS_RB + RB_MF32), WSP(bf16, WS_RB + RB_MB)};
            pg8::gemm_phase(F.lds, g, S, E);
            SEAM(5);
        }
        if (IN(6)) { FRESH();
            const pg8::Gemm g{1024, 1024, 1024};
            SchedTiles S{(const char*)(F.ws + WS_RB + RB_MB), (const char*)(wb + W_WO), (size_t)256 * 1024 * 2, (size_t)256 * 1024 * 2, 128, 4, F.G, F.bid};
            pg8::EpiPre E{F.out, WSP(float, WS_RB + RB_PRE), DN_ALPHA};
            pg8::gemm_phase(F.lds, g, S, E);
            SEAM(6);
        }
        if (IN(7)) { FRESH(); ln1_router_phase(F, args, l); SEAM(7); }
        if (IN(8)) { FRESH(); for (int it = F.bid; it < 128; it += F.G) topk_item(F, it >> 3, it & 7); SEAM(8); }
        if (IN(9)) { FRESH();
            const pg8::Gemm g{1024, 1024, 1024};
            SchedMoe1 S{(const char*)(F.ws + WS_RA + RA_XS), (const char*)(wb + W_GU), F.G, F.bid};
            pg8::EpiSwiglu E{WSP(bf16, WS_RB + RB_HID)};
            pg8::gemm_phase(F.lds, g, S, E);
            SEAM(9);
        }
        if (IN(10)) { FRESH();
            const pg8::Gemm g{1024, 1024, 1024};
            SchedMoe2 S{(const char*)(F.ws + WS_RB + RB_HID), (const char*)(wb + W_DN), F.G, F.bid};
            pg8::EpiRowScale E{WSP(bf16, WS_RA + RA_EOUT), WSP(float, WS_GW)};
            pg8::gemm_phase(F.lds, g, S, E);
            SEAM(10);
        }
        if (IN(11)) { FRESH();
            ln2_phase(F, args, l);
            if (l + 1 < DEPTH) convert_layer(F, args, l + 1, gw, NGW);
            SEAM(11);
        }
    }
    if (multi) {
        xcd_barrier(bar);
        if (__hip_atomic_load((unsigned*)(F.ctl + CW_BAR) + XB_TMO, RLX_AGENT) != 0u) {
            const float q = __builtin_nanf("");
            for (size_t i = (size_t)blockIdx.x * 512 + threadIdx.x; i < (size_t)M * DM; i += (size_t)gridDim.x * 512) args0.out[i] = q; }
    }
#undef IN
#undef gw
#undef SEAM
}


#ifdef DBG_STOP
__global__ void dbg_dump_kernel(const unsigned char* ws, float* out, size_t off, int isf32, int ld, int ncols) {
    const size_t n = (size_t)M * DM;
    for (size_t i = (size_t)blockIdx.x * blockDim.x + threadIdx.x; i < n; i += (size_t)gridDim.x * blockDim.x) {
        const size_t r = i / DM, c = i % DM; float v = 0.f;
        if ((int)c < ncols) { if (isf32) v = ((const float*)(ws + off))[r * ld + c]; else v = bf2f(((const bf16*)(ws + off))[r * ld + c]); }
        out[i] = v; }
}
#endif

#ifdef DBG_RACE
constexpr int CW_DBG = 65536;
__global__ void dbg_sum_kernel(const unsigned* p, size_t nwords, unsigned long long* slot) {
    unsigned long long s = 0;
    for (size_t i = (size_t)blockIdx.x * blockDim.x + threadIdx.x; i < nwords; i += (size_t)gridDim.x * blockDim.x) s += (unsigned long long)p[i] * (unsigned long long)((i & 1023u) + 1u);
    for (int o = 32; o >= 1; o >>= 1) s += __shfl_xor(s, o);
    if ((threadIdx.x & 63) == 0) atomicAdd(slot, s);
}
__global__ void dbg_final_kernel(const unsigned long long* T, float* out) {
    int V = 0;
    for (int s = 56; s <= 60; ++s) if (T[s] != T[64 + s]) V |= 1 << (s - 56);
    const float c = 10.f * (float)(V + 1);
    for (size_t i = (size_t)blockIdx.x * blockDim.x + threadIdx.x; i < (size_t)M * DM; i += (size_t)gridDim.x * blockDim.x) out[i] = c;
}
#endif

#ifdef DBG_STAT
__global__ void dbg_stat_kernel(const unsigned char* ws, size_t off, int ld, int ncols, unsigned* res) {
    unsigned mx = 0, cnt = 0;
    for (size_t i = (size_t)blockIdx.x * blockDim.x + threadIdx.x; i < (size_t)M * ncols; i += (size_t)gridDim.x * blockDim.x) {
        const size_t r = i / ncols, c = i % ncols; const float v = fabsf(bf2f(((const bf16*)(ws + off))[r * ld + c]));
        const unsigned b = __float_as_uint(v); mx = b > mx ? b : mx; cnt += (v > DBG_THR || v != v) ? 1u : 0u; }
    atomicMax(res, mx); atomicAdd(res + 1, cnt);
    for (size_t r = (size_t)blockIdx.x * blockDim.x + threadIdx.x; r < (size_t)M; r += (size_t)gridDim.x * blockDim.x) { bool bad = false; unsigned first = 0xffffffffu;
        for (int c = 0; c < ncols; ++c) { const float v = fabsf(bf2f(((const bf16*)(ws + off))[r * ld + c])); if (v > DBG_THR || v != v) { bad = true; if (first == 0xffffffffu) first = c; } }
        if (bad) { atomicAdd(res + 2, 1u); atomicMin(res + 3, (unsigned)r); atomicMin(res + 4, first); } }
}
__global__ void dbg_statout_kernel(const unsigned* res, float* out) {
    const float c = DBG_STAT == 0 ? 100.f * __uint_as_float(res[0]) : DBG_STAT == 1 ? sqrtf((float)res[1]) : DBG_STAT == 2 ? sqrtf((float)res[2]) : DBG_STAT == 3 ? (float)(res[3] / 2048u + 20u) : (float)(res[4] / 256u + 20u);
    for (size_t i = (size_t)blockIdx.x * blockDim.x + threadIdx.x; i < (size_t)M * DM; i += (size_t)gridDim.x * blockDim.x) out[i] = c;
}
#endif
extern "C" void kernel_launch(void* const* d_in, const int* in_sizes, int n_in, void* d_out, int out_size, void* d_ws, size_t ws_size, hipStream_t stream) {
    static int grid = 0;
    if (grid == 0) {
        if (n_in != N_INPUTS || out_size != M * DM || ws_size < WS_END) { fprintf(stderr, "kernel_launch: unexpected problem (n_in %d, out %d, ws %zu)\n", n_in, out_size, ws_size); grid = -1; return; }
        int dev = 0, cus = 0, per_cu = 0;
        if (hipGetDevice(&dev) != hipSuccess || hipDeviceGetAttribute(&cus, hipDeviceAttributeMultiprocessorCount, dev) != hipSuccess) { grid = -1; return; }
        if (hipFuncSetAttribute((const void*)fwd_kernel, hipFuncAttributeMaxDynamicSharedMemorySize, LDS_BYTES) != hipSuccess) { fprintf(stderr, "kernel_launch: hipFuncSetAttribute failed\n"); grid = -1; return; }
        if (hipOccupancyMaxActiveBlocksPerMultiprocessor(&per_cu, (const void*)fwd_kernel, 512, LDS_BYTES) != hipSuccess || per_cu < 1)
            fprintf(stderr, "kernel_launch: occupancy query reports %d workgroups per CU\n", per_cu);
        (void)hipGetLastError();
        grid = cus;
    }
    if (grid < 0) return;
    if (hipMemsetAsync((char*)d_ws + WS_CTL, 0, CTL_ZERO_BYTES, stream) != hipSuccess) return;
    Args a{};
    for (int i = 0; i < N_INPUTS; ++i) a.in[i] = (const float*)d_in[i];
    a.out = (float*)d_out; a.ws = (unsigned char*)d_ws;
#if MK_ONE_LAUNCH
    a.ph_lo = 0; a.ph_hi = NPH; a.l_lo = 0; a.l_hi = DEPTH;
    hipLaunchKernelGGL(fwd_kernel, dim3(grid), dim3(512), LDS_BYTES, stream, a);
#else
#ifdef DBG_RACE
    {
    unsigned char* ws = (unsigned char*)d_ws; unsigned long long* T = (unsigned long long*)(ws + WS_CTL) + CW_DBG / 2;
    auto sum = [&](size_t off, size_t bytes, int slot) { hipLaunchKernelGGL(dbg_sum_kernel, dim3(1024), dim3(256), 0, stream, (const unsigned*)(ws + off), bytes / 4, T + slot); };
    auto sumout = [&](int slot) { hipLaunchKernelGGL(dbg_sum_kernel, dim3(1024), dim3(256), 0, stream, (const unsigned*)d_out, (size_t)M * DM, T + slot); };
    for (int run = 0; run < 2; ++run) {
        if (run == 1) hipMemsetAsync((char*)d_ws + WS_CTL, 0, CW_DBG * 4, stream);
        hipMemsetAsync((char*)d_ws + 1 * MiB, run == 0 ? 0xAA : 0x55, WS_END - 1 * MiB, stream);
        for (int l = 0; l < DBG_LAYERS; ++l)
            for (int p = (l == 0 ? 0 : 1); p < DBG_NPH; ++p) { a.ph_lo = p; a.ph_hi = p + 1; a.l_lo = l; a.l_hi = l + 1;
                hipLaunchKernelGGL(fwd_kernel, dim3(grid), dim3(512), LDS_BYTES, stream, a);
                const int s = run * 64 + l * 12 + p;
                switch (p) {
                case 0: sum(WS_HB, 64 * MiB, s); sumout(s); sum(WS_W, 115 * MiB, s); sum(WS_S5W, 64 * MiB, s); sum(WS_HF2, 4 * MiB, s); sum(WS_ROPE, 8 * KiB, s); sum(WS_S5A32, 64 * KiB, s); break;
                case 1: sum(WS_RB, 240 * MiB, s); sum(WS_RA, 256 * MiB, s); break;
                case 2: sum(WS_RD + RD_QKVG, 32 * MiB, s); break;
                case 3: sum(WS_RD + RD_YAT, 16 * MiB, run * 64 + 56); sum(WS_RD + RD_HV, 32 * MiB, run * 64 + 57); sum(WS_RD + RD_DILO, 48 * MiB, run * 64 + 58); sum(WS_DLSE, 1536 * KiB, run * 64 + 59); sum(WS_RD + RD_S5Z, 16 * MiB, run * 64 + 60); break;
                case 4: sum(WS_Y, 64 * MiB, s); break;
                case 5: sum(WS_RB + RB_MB, 64 * MiB, s); sum(WS_RB, 128 * MiB, s); break;
                case 6: sum(WS_RB, 128 * MiB, s); break;
                case 7: sumout(s); sum(WS_HB, 64 * MiB, s); sum(WS_AFF, 2 * MiB, s); break;
                case 8: sum(WS_RA, 128 * MiB, s); sum(WS_IDX, 512 * KiB, s); sum(WS_INV, 1 * MiB, s); break;
                case 9: sum(WS_RB, 128 * MiB, s); break;
                case 10: sum(WS_RA + RA_EOUT, 128 * MiB, s); break;
                case 11: sumout(s); sum(WS_HB, 64 * MiB, s); break;
                } }
    }
    hipLaunchKernelGGL(dbg_final_kernel, dim3(1024), dim3(256), 0, stream, (const unsigned long long*)T, (float*)d_out);
    }
#elif defined(DBG_STOP)
    for (int l = 0; l <= DBG_STOP_L; ++l)
        for (int p = (l == 0 ? 0 : 1); p < NPH; ++p) { if (l == DBG_STOP_L && p > DBG_STOP) break; a.ph_lo = p; a.ph_hi = p + 1; a.l_lo = l; a.l_hi = l + 1;
            hipLaunchKernelGGL(fwd_kernel, dim3(grid), dim3(512), LDS_BYTES, stream, a);
#ifdef DBG_REPEAT
            if (p == DBG_REPEAT) hipLaunchKernelGGL(fwd_kernel, dim3(grid), dim3(512), LDS_BYTES, stream, a);
#endif
            }
#ifdef DBG_STAT
    { unsigned* res = (unsigned*)((char*)d_ws + WS_CTL) + 100000; hipMemsetAsync(res + 3, 0x7f, 8, stream); hipLaunchKernelGGL(dbg_stat_kernel, dim3(2048), dim3(256), 0, stream, (const unsigned char*)d_ws, (size_t)(DBG_OFF), DBG_LD, DBG_NC, res);
      hipLaunchKernelGGL(dbg_statout_kernel, dim3(2048), dim3(256), 0, stream, (const unsigned*)res, (float*)d_out); }
#elif defined(DBG_OFF)
    hipLaunchKernelGGL(dbg_dump_kernel, dim3(2048), dim3(256), 0, stream, (const unsigned char*)d_ws, (float*)d_out, (size_t)(DBG_OFF), DBG_F32, DBG_LD, DBG_NC);
#endif
#else
    for (int l = 0; l < DEPTH; ++l)
        for (int p = (l == 0 ? 0 : 1); p < NPH; ++p) { a.ph_lo = p; a.ph_hi = p + 1; a.l_lo = l; a.l_hi = l + 1;
            hipLaunchKernelGGL(fwd_kernel, dim3(grid), dim3(512), LDS_BYTES, stream, a); }
#endif
#endif
}
```

```cpp
#include <hip/hip_runtime.h>
#include <hip/hip_bf16.h>
#include <cstdio>
#include <cstdint>
#include <cmath>

#ifndef MK_STATIC_Q
#define MK_STATIC_Q 0
#endif
#ifndef MK_ONE_LAUNCH
#define MK_ONE_LAUNCH 1
#endif

constexpr int BATCH = 8, SEQ = 4096, DM = 1024, DEPTH = 4, M = BATCH * SEQ;
constexpr int NIN = 7936;
constexpr int NE = 16, CAP = 512, FFD = 1024;
constexpr float LN_EPS = 1e-5f, RMS_EPS = 1e-6f;
constexpr float DN_ALPHA = 1.6817928305074292f;
constexpr int PC_DQ = 0, PC_DK = 768, PC_DV = 1536, PC_S5 = 2304, PC_GQ = 2560, PC_GK = 2816, PC_GV = 2944, PROJ2_W = 3072;
enum { I_X = 0, I_LNIN_G, I_LNIN_B, I_WIN, I_HY_CW, I_HY_CB, I_HY_W1, I_HY_B1, I_HY_W2, I_HY_B2, I_HY_W3, I_HY_FREQ, I_HY_BIAS,
       I_S5_LRE, I_S5_LIM, I_S5_LDT, I_S5_BRE, I_S5_BIM, I_S5_CRE, I_S5_CIM, I_S5_D, I_S5_GW, I_S5_GB, I_GQ_QN, I_GQ_KN,
       I_WBR, I_WOUT, I_LN1G, I_LN1B, I_ROUTER, I_EWG, I_EWU, I_EWD, I_LN2G, I_LN2B, N_INPUTS };

constexpr size_t MiB = 1u << 20, KiB = 1u << 10;
constexpr size_t WS_CTL = 0, CTL_ZERO_BYTES = 64 * KiB;
constexpr size_t WS_AFF = 1 * MiB;
constexpr size_t WS_IDX = 3 * MiB;
constexpr size_t WS_GW = 3 * MiB + 256 * KiB;
constexpr size_t WS_INV = 4 * MiB;
constexpr size_t WS_DLSE = 5 * MiB;
constexpr size_t WS_ROPE = 7 * MiB;
constexpr size_t WS_S5A32 = 7 * MiB + 256 * KiB;
constexpr size_t WS_HF2 = 8 * MiB;
constexpr size_t WS_S5W = 12 * MiB;
constexpr size_t S5W_LAYER = 16 * MiB, S5_WST_OFF = 0, S5_WCAT_OFF = 4 * MiB;
constexpr size_t WS_W = 76 * MiB;
constexpr size_t W_WIN = 0;
constexpr size_t W_WB = W_WIN + (size_t)NIN * DM * 2;
constexpr size_t W_WO = W_WB + (size_t)4 * 1024 * 256 * 2;
constexpr size_t W_GLU = W_WO + (size_t)1024 * 1024 * 2;
constexpr size_t W_GU = W_GLU + (size_t)256 * 256 * 2;
constexpr size_t W_DN = W_GU + (size_t)16 * 2048 * 1024 * 2;
constexpr size_t W_END = W_DN + (size_t)16 * 1024 * 1024 * 2;
static_assert(W_END <= 116 * MiB, "weights region");
constexpr size_t WS_HB = 192 * MiB;
constexpr size_t WS_RA = 256 * MiB;
constexpr size_t WS_RB = 512 * MiB;
constexpr size_t RB_HYT = 0, RB_PROJ2 = 48 * MiB, RB_MF32 = 0, RB_PRE = 0, RB_HID = 0, RB_MB = 128 * MiB;
constexpr size_t RA_G = 0, RA_XS = 0, RA_EOUT = 128 * MiB;
constexpr size_t WS_Y = 768 * MiB;
constexpr size_t WS_RD = 832 * MiB;
constexpr size_t RD_YAT = 0;
constexpr size_t RD_DILO = 16 * MiB;
constexpr size_t RD_S5Z = 64 * MiB;
constexpr size_t RD_HV = 80 * MiB;
constexpr size_t RD_QKVG = 112 * MiB;
constexpr size_t WS_TT = 976 * MiB;
constexpr size_t WS_END = 992 * MiB;

constexpr int CW_BAR = 4096;
constexpr int CW_Q = 8192;

constexpr int LDS_SCRATCH = 147456;
constexpr int MISC_OFF = LDS_SCRATCH;
constexpr int LDS_BYTES = LDS_SCRATCH + 1024;

#define GAS __attribute__((address_space(1)))
#define LAS __attribute__((address_space(3)))
typedef unsigned short bf16;
typedef unsigned v4u __attribute__((ext_vector_type(4)));
typedef unsigned v2u __attribute__((ext_vector_type(2)));
typedef float f32x4 __attribute__((ext_vector_type(4)));
typedef float f32x2 __attribute__((ext_vector_type(2)));
typedef float f32x16 __attribute__((ext_vector_type(16)));
typedef short bf16x8 __attribute__((ext_vector_type(8)));
typedef short s16x4 __attribute__((ext_vector_type(4)));
typedef GAS unsigned gu32;
#define RLX_AGENT __ATOMIC_RELAXED, __HIP_MEMORY_SCOPE_AGENT
#define LDS_WAIT() asm volatile("s_waitcnt lgkmcnt(0)" ::: "memory")
#define VM_WAIT() asm volatile("s_waitcnt vmcnt(0)" ::: "memory")

__device__ __forceinline__ unsigned f2bf(float f) { unsigned u = __builtin_bit_cast(unsigned, f); return (u + 0x7fffu + ((u >> 16) & 1u)) >> 16; }
__device__ __forceinline__ unsigned pk2(float lo, float hi) { return f2bf(lo) | (f2bf(hi) << 16); }
__device__ __forceinline__ float bf2f(unsigned short b) { return __builtin_bit_cast(float, (unsigned)b << 16); }
__device__ __forceinline__ float bflo(unsigned w) { return __builtin_bit_cast(float, w << 16); }
__device__ __forceinline__ float bfhi(unsigned w) { return __builtin_bit_cast(float, w & 0xffff0000u); }
__device__ __forceinline__ float sigmoidf_(float x) { return __builtin_amdgcn_rcpf(1.0f + __builtin_amdgcn_exp2f(-1.4426950408889634f * x)); }
__device__ __forceinline__ float wave_sum(float v) {
#pragma unroll
    for (int o = 1; o < 64; o <<= 1) v += __shfl_xor(v, o);
    return v;
}
__device__ __forceinline__ float wave_max(float v) {
#pragma unroll
    for (int o = 1; o < 64; o <<= 1) v = fmaxf(v, __shfl_xor(v, o));
    return v;
}

namespace pg8 {
#define PG8_LAS __attribute__((address_space(3)))
typedef unsigned short bf16_t;
typedef unsigned u32x4 __attribute__((ext_vector_type(4)));
constexpr int BM = 256, BK = 64, HALF = 128, HTB = HALF * BK * 2  , STAGE_BYTES = 8 * HTB, NXCD = 8, WGM = 8;

__host__ __device__ __forceinline__ int lds_byte(int r, int c) { const int st = (r >> 4) * 2 + (c >> 5), rr = r & 15, cc = c & 31, ob = rr * 64 + cc * 2; return st * 1024 + (ob ^ (((ob >> 9) & 1) << 5)); }
__host__ __device__ __forceinline__ void stage_rc(int b, int& R, int& C) { const int st = b / 1024, sb = b % 1024, swz = sb ^ (((sb >> 9) & 1) << 5); R = (st >> 1) * 16 + swz / 64; C = (st & 1) * 32 + (swz % 64) / 2; }
__host__ __device__ __forceinline__ int perm32(int rho) { const int n = rho >> 4, i = rho & 15; return 8 * (i >> 2) + 4 * n + (i & 3); }

struct Unit { const char* A; const char* B; int orow, ocol, z; };
struct Gemm { int K, lda, ldb; };

__device__ __forceinline__ void tile_of(int L, int nM, int nN, int& pm, int& pn) {
    const int nwg = nM * nN; int wgid = L; { const int q = nwg / NXCD, r = nwg % NXCD, xcd = wgid % NXCD, off = wgid / NXCD; wgid = (xcd < r ? xcd * (q + 1) : r * (q + 1) + (xcd - r) * q) + off; }
    const int nig = WGM * nN, gid = wgid / nig, fm = gid * WGM, gsz = (nM - fm) < WGM ? (nM - fm) : WGM;
    pm = fm + ((wgid % nig) % gsz); pn = (wgid % nig) / gsz;
}

typedef __bf16 bf16x2_t __attribute__((ext_vector_type(2)));
__device__ __forceinline__ unsigned cvt_pk_bf16(float lo, float hi) { const f32x2 v = {lo, hi}; const bf16x2_t b = __builtin_convertvector(v, bf16x2_t); return __builtin_bit_cast(unsigned, b); }
template <int ACT  > struct EpiBf16 {
    static constexpr bool PERM = true;
    bf16_t* O; int ldc;
    __device__ __forceinline__ void operator()(const f32x4 (&acc)[2][2][4][2], const Unit& u, int wr, int wc, int fr, int fq) const {
        const int row0 = u.orow + wr * 64 + fr, col0 = u.ocol + wc * 32 + 8 * fq;
#pragma unroll
        for (int ai = 0; ai < 2; ++ai)
#pragma unroll
            for (int m = 0; m < 4; ++m) { bf16_t* rowp = O + (size_t)(row0 + ai * HALF + m * 16) * ldc + col0;
#pragma unroll
                for (int bj = 0; bj < 2; ++bj) { f32x4 v0 = acc[ai][bj][m][0], v1 = acc[ai][bj][m][1];
                    if (ACT == 1) {
#pragma unroll
                        for (int j = 0; j < 4; ++j) { v0[j] = sigmoidf_(v0[j]); v1[j] = sigmoidf_(v1[j]); }
#ifdef DBG_HALF
                        for (int j = 0; j < 4; ++j) { v0[j] = 0.5f; v1[j] = 0.5f; }
#endif
                    }
                    u32x4 w; w.x = cvt_pk_bf16(v0[0], v0[1]); w.y = cvt_pk_bf16(v0[2], v0[3]); w.z = cvt_pk_bf16(v1[0], v1[1]); w.w = cvt_pk_bf16(v1[2], v1[3]);
                    *(u32x4*)(rowp + bj * HALF) = w; } }
    }
};
struct EpiMerge {
    static constexpr bool PERM = true;
    const bf16_t* G; float* F; bf16_t* MB;
    __device__ __forceinline__ void operator()(const f32x4 (&acc)[2][2][4][2], const Unit& u, int wr, int wc, int fr, int fq) const {
        const int row0 = u.orow + wr * 64 + fr, col0 = u.ocol + wc * 32 + 8 * fq, i = u.z;
#pragma unroll
        for (int ai = 0; ai < 2; ++ai)
#pragma unroll
            for (int m = 0; m < 4; ++m) { const size_t row = (size_t)(row0 + ai * HALF + m * 16);
#pragma unroll
                for (int bj = 0; bj < 2; ++bj) { const int col = col0 + bj * HALF;
                    const u32x4 g = *(const u32x4*)(G + row * 4096 + i * 1024 + col);
                    f32x4 v0 = acc[ai][bj][m][0], v1 = acc[ai][bj][m][1];
                    v0[0] *= bflo(g.x); v0[1] *= bfhi(g.x); v0[2] *= bflo(g.y); v0[3] *= bfhi(g.y);
                    v1[0] *= bflo(g.z); v1[1] *= bfhi(g.z); v1[2] *= bflo(g.w); v1[3] *= bfhi(g.w);
                    float* fp = F + row * 1024 + col;
                    if (i > 0) { f32x4 p0, p1;
                        asm volatile("global_load_dwordx4 %0, %2, off sc0 sc1\n\tglobal_load_dwordx4 %1, %2, off offset:16 sc0 sc1\n\ts_waitcnt vmcnt(0)" : "=&v"(p0), "=&v"(p1) : "v"(fp) : "memory");
                        v0 += p0; v1 += p1; }
                    if (i < 3) { *(f32x4*)fp = v0; *(f32x4*)(fp + 4) = v1; }
                    else { u32x4 w; w.x = cvt_pk_bf16(v0[0], v0[1]); w.y = cvt_pk_bf16(v0[2], v0[3]); w.z = cvt_pk_bf16(v1[0], v1[1]); w.w = cvt_pk_bf16(v1[2], v1[3]);
                        *(u32x4*)(MB + row * 1024 + col) = w; } } }
    }
};
struct EpiPre {
    static constexpr bool PERM = true;
    const bf16_t* H; bf16_t* P; float alpha;
    __device__ __forceinline__ void operator()(const f32x4 (&acc)[2][2][4][2], const Unit& u, int wr, int wc, int fr, int fq) const {
        const int row0 = u.orow + wr * 64 + fr, col0 = u.ocol + wc * 32 + 8 * fq;
#pragma unroll
        for (int ai = 0; ai < 2; ++ai)
#pragma unroll
            for (int m = 0; m < 4; ++m) { const size_t off = (size_t)(row0 + ai * HALF + m * 16) * 1024 + col0;
#pragma unroll
                for (int bj = 0; bj < 2; ++bj) { const u32x4 h = *(const u32x4*)(H + off + bj * HALF); const f32x4 a0 = acc[ai][bj][m][0], a1 = acc[ai][bj][m][1];
                    u32x4 w; w.x = cvt_pk_bf16(bflo(h.x) * alpha + a0[0], bfhi(h.x) * alpha + a0[1]); w.y = cvt_pk_bf16(bflo(h.y) * alpha + a0[2], bfhi(h.y) * alpha + a0[3]);
                    w.z = cvt_pk_bf16(bflo(h.z) * alpha + a1[0], bfhi(h.z) * alpha + a1[1]); w.w = cvt_pk_bf16(bflo(h.w) * alpha + a1[2], bfhi(h.w) * alpha + a1[3]);
                    *(u32x4*)(P + off + bj * HALF) = w; } }
    }
};
struct EpiSwiglu {
    static constexpr bool PERM = true;
    bf16_t* O;
    __device__ __forceinline__ void operator()(const f32x4 (&acc)[2][2][4][2], const Unit& u, int wr, int wc, int fr, int fq) const {
        const int row0 = u.orow + wr * 64 + fr, col0 = u.ocol + wc * 32 + 8 * fq;
#pragma unroll
        for (int ai = 0; ai < 2; ++ai)
#pragma unroll
            for (int m = 0; m < 4; ++m) { f32x4 v[2];
#pragma unroll
                for (int n = 0; n < 2; ++n)
#pragma unroll
                    for (int j = 0; j < 4; ++j) { const float g = acc[ai][0][m][n][j]; v[n][j] = g * sigmoidf_(g) * acc[ai][1][m][n][j]; }
                u32x4 w; w.x = cvt_pk_bf16(v[0][0], v[0][1]); w.y = cvt_pk_bf16(v[0][2], v[0][3]); w.z = cvt_pk_bf16(v[1][0], v[1][1]); w.w = cvt_pk_bf16(v[1][2], v[1][3]);
                *(u32x4*)(O + (size_t)(row0 + ai * HALF + m * 16) * 1024 + col0) = w; }
    }
};
struct EpiRowScale {
    static constexpr bool PERM = true;
    bf16_t* O; const float* rs;
    __device__ __forceinline__ void operator()(const f32x4 (&acc)[2][2][4][2], const Unit& u, int wr, int wc, int fr, int fq) const {
        const int row0 = u.orow + wr * 64 + fr, col0 = u.ocol + wc * 32 + 8 * fq;
#pragma unroll
        for (int ai = 0; ai < 2; ++ai)
#pragma unroll
            for (int m = 0; m < 4; ++m) { const int row = row0 + ai * HALF + m * 16; const float s = rs[row];
#pragma unroll
                for (int bj = 0; bj < 2; ++bj) { const f32x4 v0 = acc[ai][bj][m][0] * s, v1 = acc[ai][bj][m][1] * s;
                    u32x4 w; w.x = cvt_pk_bf16(v0[0], v0[1]); w.y = cvt_pk_bf16(v0[2], v0[3]); w.z = cvt_pk_bf16(v1[0], v1[1]); w.w = cvt_pk_bf16(v1[2], v1[3]);
                    *(u32x4*)(O + (size_t)row * 1024 + col0 + bj * HALF) = w; } }
    }
};
struct EpiGlu {
    static constexpr bool PERM = true;
    const bf16_t* Z; bf16_t* O; const float* gb;
    __device__ __forceinline__ void operator()(const f32x4 (&acc)[2][2][4][2], const Unit& u, int wr, int wc, int fr, int fq) const {
        const int row0 = u.orow + wr * 64 + fr, col0 = wc * 32 + 8 * fq;
#pragma unroll
        for (int ai = 0; ai < 2; ++ai)
#pragma unroll
            for (int m = 0; m < 4; ++m) { const size_t row = (size_t)(row0 + ai * HALF + m * 16);
#pragma unroll
                for (int bj = 0; bj < 2; ++bj) { const int col = col0 + bj * HALF;
                    const u32x4 z = *(const u32x4*)(Z + row * 256 + col); const f32x4 b0 = *(const f32x4*)(gb + col), b1 = *(const f32x4*)(gb + col + 4);
                    const f32x4 a0 = acc[ai][bj][m][0] + b0, a1 = acc[ai][bj][m][1] + b1; f32x4 v0, v1;
                    v0[0] = bflo(z.x) * sigmoidf_(a0[0]); v0[1] = bfhi(z.x) * sigmoidf_(a0[1]); v0[2] = bflo(z.y) * sigmoidf_(a0[2]); v0[3] = bfhi(z.y) * sigmoidf_(a0[3]);
                    v1[0] = bflo(z.z) * sigmoidf_(a1[0]); v1[1] = bfhi(z.z) * sigmoidf_(a1[1]); v1[2] = bflo(z.w) * sigmoidf_(a1[2]); v1[3] = bfhi(z.w) * sigmoidf_(a1[3]);
                    u32x4 w; w.x = cvt_pk_bf16(v0[0], v0[1]); w.y = cvt_pk_bf16(v0[2], v0[3]); w.z = cvt_pk_bf16(v1[0], v1[1]); w.w = cvt_pk_bf16(v1[2], v1[3]);
                    *(u32x4*)(O + row * 1024 + 512 + col) = w; }
                asm volatile("" ::: "memory"); }
    }
};

#ifndef PG8_SP2
#define PG8_SP2 1
#endif
template <class Epi, class Sched>
__device__ __forceinline__ void gemm_phase(PG8_LAS unsigned char* lds, const Gemm g, const Sched& S, const Epi& E, int tid_in) {
    int tid = tid_in; asm volatile("" : "+v"(tid));
    const int wid = __builtin_amdgcn_readfirstlane(tid >> 6), lane = tid & 63, wr = wid >> 2, wc = wid & 3, fr = lane & 15, fq = lane >> 4;
    int K = g.K; asm volatile("" : "+s"(K)); const int nt = K / BK;
    unsigned voffA[2], voffB[2];
#pragma unroll
    for (int i = 0; i < 2; ++i) { int R, C; stage_rc(tid * 16 + i * 8192, R, C); const int Rb = Epi::PERM ? ((R & ~31) + perm32(R & 31)) : R;
        voffA[i] = (unsigned)(R * g.lda + C) * 2u; voffB[i] = (unsigned)(Rb * g.ldb + C) * 2u; }
    const size_t kstep = (size_t)(BK * 2);
    const size_t hstepA = (size_t)HALF * g.lda * 2, hstepB = (size_t)HALF * g.ldb * 2;
    const unsigned ldsw = (unsigned)wid * 1024u;
    const int aoff = lds_byte(wr * 64 + fr, fq * 8), boff = lds_byte(wc * 32 + fr, fq * 8);
#define PG8_SA(b, h) (((b) * 2 + (h)) * HTB)
#define PG8_SB(b, h) ((4 + (b) * 2 + (h)) * HTB)
#define PG8_STAGE(bufoff, gbase, voff) do { _Pragma("unroll") for (int _i = 0; _i < 2; ++_i) \
        __builtin_amdgcn_global_load_lds((const unsigned*)((const char*)(gbase) + (voff)[_i]), (PG8_LAS unsigned*)(lds + (bufoff) + ldsw + _i * 8192), 16, 0, 0); } while (0)
#define PG8_LDA(dst, b, h) do { _Pragma("unroll") for (int m = 0; m < 4; ++m) _Pragma("unroll") for (int k = 0; k < 2; ++k) dst[m][k] = *(const PG8_LAS bf16x8*)(lds + PG8_SA(b, h) + aoff + m * 2048 + k * 1024); } while (0)
#define PG8_LDB(dst, b, h) do { _Pragma("unroll") for (int n = 0; n < 2; ++n) _Pragma("unroll") for (int k = 0; k < 2; ++k) dst[n][k] = *(const PG8_LAS bf16x8*)(lds + PG8_SB(b, h) + boff + n * 2048 + k * 1024); } while (0)
#define PG8_MMA(ai, bj, At, Bt) do { __builtin_amdgcn_s_setprio(1); _Pragma("unroll") for (int m = 0; m < 4; ++m) _Pragma("unroll") for (int n = 0; n < 2; ++n) _Pragma("unroll") for (int k = 0; k < 2; ++k) \
        acc[ai][bj][m][n] = __builtin_amdgcn_mfma_f32_16x16x32_bf16(Bt[n][k], At[m][k], acc[ai][bj][m][n], 0, 0, 0); __builtin_amdgcn_s_setprio(0); } while (0)
#define PG8_WAIT_V(n) asm volatile("s_waitcnt vmcnt(" #n ")" ::: "memory")
#define PG8_WAIT_L(n) asm volatile("s_waitcnt lgkmcnt(" #n ")" ::: "memory")
#define PG8_BAR __builtin_amdgcn_s_barrier()
#define PG8_SCHED __builtin_amdgcn_sched_barrier(0)
    Unit cur, nxt; int ui = 0;
    if (!S.next(0, cur)) return;
    f32x4 acc[2][2][4][2];
#pragma unroll
    for (int a = 0; a < 2; ++a)
#pragma unroll
        for (int b = 0; b < 2; ++b)
#pragma unroll
            for (int m = 0; m < 4; ++m)
#pragma unroll
                for (int n = 0; n < 2; ++n) acc[a][b][m][n] = (f32x4){0.f, 0.f, 0.f, 0.f};
    bf16x8 At[4][2], B0[2][2], B1[2][2];
    const char* cA = cur.A; const char* cB = cur.B;
#if PG8_SP2
    PG8_STAGE(PG8_SB(0, 0), cB, voffB); PG8_STAGE(PG8_SB(0, 1), cB + hstepB, voffB); PG8_STAGE(PG8_SA(0, 0), cA, voffA); PG8_STAGE(PG8_SA(0, 1), cA + hstepA, voffA);
    if (wr == 1) PG8_BAR;
    PG8_WAIT_V(2); PG8_BAR;
    PG8_STAGE(PG8_SB(1, 0), cB + kstep, voffB); PG8_STAGE(PG8_SA(1, 0), cA + kstep, voffA); PG8_STAGE(PG8_SB(1, 1), cB + hstepB + kstep, voffB);
    PG8_WAIT_V(6); PG8_BAR;
#else
    PG8_STAGE(PG8_SB(0, 0), cB, voffB); PG8_STAGE(PG8_SA(0, 0), cA, voffA); PG8_STAGE(PG8_SB(0, 1), cB + hstepB, voffB); PG8_STAGE(PG8_SA(0, 1), cA + hstepA, voffA);
    if (wr == 1) PG8_BAR;
    PG8_WAIT_V(4); PG8_BAR;
    PG8_STAGE(PG8_SB(1, 0), cB + kstep, voffB); PG8_STAGE(PG8_SA(1, 0), cA + kstep, voffA); PG8_STAGE(PG8_SB(1, 1), cB + hstepB + kstep, voffB);
    PG8_WAIT_V(6); PG8_BAR;
#endif
    for (;;) {
        const bool has_next = S.next(ui + 1, nxt);
        const char* nA = has_next ? nxt.A : cA; const char* nB = has_next ? nxt.B : cB;
#pragma unroll 1
        for (int t = 0; t < nt; t += 2) {
            const bool last = (t == nt - 2);
            const char* a1 = cA + (size_t)(t + 1) * kstep;
            const char* a2 = last ? nA : cA + (size_t)(t + 2) * kstep; const char* b2 = last ? nB : cB + (size_t)(t + 2) * kstep;
            const char* a3 = a2 + kstep; const char* b3 = b2 + kstep;
#if PG8_SP2
            PG8_LDB(B0, 0, 0); PG8_LDB(B1, 0, 1); PG8_SCHED; PG8_LDA(At, 0, 0); PG8_STAGE(PG8_SA(1, 1), a1 + hstepA, voffA);
            PG8_WAIT_V(8); PG8_WAIT_L(0); PG8_BAR; PG8_MMA(0, 0, At, B0); PG8_MMA(0, 1, At, B1); PG8_BAR; PG8_SCHED;
            PG8_LDA(At, 0, 1); PG8_STAGE(PG8_SB(0, 0), b2, voffB); PG8_STAGE(PG8_SB(0, 1), b2 + hstepB, voffB); PG8_STAGE(PG8_SA(0, 0), a2, voffA);
            PG8_WAIT_V(8); PG8_WAIT_L(0); PG8_BAR; PG8_MMA(1, 0, At, B0); PG8_MMA(1, 1, At, B1); PG8_BAR; PG8_SCHED;
            PG8_LDB(B0, 1, 0); PG8_LDB(B1, 1, 1); PG8_SCHED; PG8_LDA(At, 1, 0); PG8_STAGE(PG8_SA(0, 1), a2 + hstepA, voffA);
            PG8_WAIT_V(8); PG8_WAIT_L(0); PG8_BAR; PG8_MMA(0, 0, At, B0); PG8_MMA(0, 1, At, B1); PG8_BAR; PG8_SCHED;
            PG8_LDA(At, 1, 1); PG8_STAGE(PG8_SB(1, 0), b3, voffB); PG8_STAGE(PG8_SB(1, 1), b3 + hstepB, voffB); PG8_STAGE(PG8_SA(1, 0), a3, voffA);
            PG8_WAIT_V(8); PG8_WAIT_L(0); PG8_BAR; PG8_MMA(1, 0, At, B0); PG8_MMA(1, 1, At, B1); PG8_BAR; PG8_SCHED;
#else
            PG8_LDB(B0, 0, 0); PG8_SCHED; PG8_LDA(At, 0, 0); PG8_STAGE(PG8_SA(1, 1), a1 + hstepA, voffA);
            PG8_WAIT_L(8); PG8_BAR; PG8_WAIT_L(0); PG8_MMA(0, 0, At, B0); PG8_BAR; PG8_SCHED;
            PG8_LDB(B1, 0, 1); PG8_STAGE(PG8_SB(0, 0), b2, voffB);
            PG8_BAR; PG8_WAIT_L(0); PG8_MMA(0, 1, At, B1); PG8_BAR;
            PG8_LDA(At, 0, 1); PG8_STAGE(PG8_SA(0, 0), a2, voffA);
            PG8_BAR; PG8_WAIT_L(0); PG8_MMA(1, 0, At, B0); PG8_BAR; PG8_SCHED;
            PG8_STAGE(PG8_SB(0, 1), b2 + hstepB, voffB);
            PG8_WAIT_V(6); PG8_BAR; PG8_MMA(1, 1, At, B1); PG8_BAR;
            PG8_LDB(B0, 1, 0); PG8_SCHED; PG8_LDA(At, 1, 0); PG8_STAGE(PG8_SA(0, 1), a2 + hstepA, voffA);
            PG8_WAIT_L(8); PG8_BAR; PG8_WAIT_L(0); PG8_MMA(0, 0, At, B0); PG8_BAR; PG8_SCHED;
            PG8_LDB(B1, 1, 1); PG8_STAGE(PG8_SB(1, 0), b3, voffB);
            PG8_BAR; PG8_WAIT_L(0); PG8_MMA(0, 1, At, B1); PG8_BAR;
            PG8_LDA(At, 1, 1); PG8_STAGE(PG8_SA(1, 0), a3, voffA);
            PG8_BAR; PG8_WAIT_L(0); PG8_MMA(1, 0, At, B0); PG8_BAR; PG8_SCHED;
            PG8_STAGE(PG8_SB(1, 1), b3 + hstepB, voffB);
            PG8_WAIT_V(6); PG8_BAR; PG8_MMA(1, 1, At, B1); PG8_BAR;
#endif
        }
        if (wr == 0) PG8_BAR;
        E(acc, cur, wr, wc, fr, fq);
        if (!has_next) break;
#pragma unroll
        for (int a = 0; a < 2; ++a)
#pragma unroll
            for (int b = 0; b < 2; ++b)
#pragma unroll
                for (int m = 0; m < 4; ++m)
#pragma unroll
                    for (int n = 0; n < 2; ++n) acc[a][b][m][n] = (f32x4){0.f, 0.f, 0.f, 0.f};
        cur = nxt; cA = nA; cB = nB; ++ui;
        if (wr == 1) PG8_BAR;
    }
    PG8_WAIT_V(0);
    PG8_BAR;
#undef PG8_SA
#undef PG8_SB
#undef PG8_STAGE
#undef PG8_LDA
#undef PG8_LDB
#undef PG8_MMA
#undef PG8_WAIT_V
#undef PG8_WAIT_L
#undef PG8_BAR
#undef PG8_SCHED
}

struct MergeUnit { const char* A; const char* B; int orow, ocol, z; };
template <class Sched>
__device__ __forceinline__ void gemm_merge_phase(PG8_LAS unsigned char* lds, const Gemm g, const Sched& S, const bf16_t* G, bf16_t* MB, int tid_in) {
    int tid = tid_in; asm volatile("" : "+v"(tid));
    const int wid = __builtin_amdgcn_readfirstlane(tid >> 6), lane = tid & 63, wr = wid >> 2, wc = wid & 3, fr = lane & 15, fq = lane >> 4;
    int K = g.K; asm volatile("" : "+s"(K)); const int nt = K / BK;
    unsigned voffA[2], voffB[2];
#pragma unroll
    for (int i = 0; i < 2; ++i) { int R, C; stage_rc(tid * 16 + i * 8192, R, C); const int Rb = (R & ~31) + perm32(R & 31);
        voffA[i] = (unsigned)(R * g.lda + C) * 2u; voffB[i] = (unsigned)(Rb * g.ldb + C) * 2u; }
    const size_t kstep = (size_t)(BK * 2);
    const size_t hstepA = (size_t)HALF * g.lda * 2;
    const unsigned ldsw = (unsigned)wid * 1024u;
    const int aoff = lds_byte(wr * 64 + fr, fq * 8), boff = lds_byte(wc * 32 + fr, fq * 8);
#define PG8_SA(b, h) (((b) * 2 + (h)) * HTB)
#define PG8_SB(b, h) ((4 + (b) * 2 + (h)) * HTB)
#define PG8_STAGE(bufoff, gbase, voff) do { _Pragma("unroll") for (int _i = 0; _i < 2; ++_i) \
        __builtin_amdgcn_global_load_lds((const unsigned*)((const char*)(gbase) + (voff)[_i]), (PG8_LAS unsigned*)(lds + (bufoff) + ldsw + _i * 8192), 16, 0, 0); } while (0)
#define PG8_LDA(dst, b, h) do { _Pragma("unroll") for (int m = 0; m < 4; ++m) _Pragma("unroll") for (int k = 0; k < 2; ++k) dst[m][k] = *(const PG8_LAS bf16x8*)(lds + PG8_SA(b, h) + aoff + m * 2048 + k * 1024); } while (0)
#define PG8_LDB(dst, b, h) do { _Pragma("unroll") for (int n = 0; n < 2; ++n) _Pragma("unroll") for (int k = 0; k < 2; ++k) dst[n][k] = *(const PG8_LAS bf16x8*)(lds + PG8_SB(b, h) + boff + n * 2048 + k * 1024); } while (0)
#define PG8_MMA1(ai, At, Bt) do { __builtin_amdgcn_s_setprio(1); _Pragma("unroll") for (int m = 0; m < 4; ++m) _Pragma("unroll") for (int n = 0; n < 2; ++n) _Pragma("unroll") for (int k = 0; k < 2; ++k) \
        acc[ai][m][n] = __builtin_amdgcn_mfma_f32_16x16x32_bf16(Bt[n][k], At[m][k], acc[ai][m][n], 0, 0, 0); __builtin_amdgcn_s_setprio(0); } while (0)
#define PG8_WAIT_V(n) asm volatile("s_waitcnt vmcnt(" #n ")" ::: "memory")
#define PG8_WAIT_L(n) asm volatile("s_waitcnt lgkmcnt(" #n ")" ::: "memory")
#define PG8_BAR __builtin_amdgcn_s_barrier()
#define PG8_SCHED __builtin_amdgcn_sched_barrier(0)
    MergeUnit cur, nxt; int ui = 0;
    if (!S.next(0, cur)) return;
    f32x4 acc[2][4][2], mrg[2][4][2];
#pragma unroll
    for (int a = 0; a < 2; ++a)
#pragma unroll
        for (int m = 0; m < 4; ++m)
#pragma unroll
            for (int n = 0; n < 2; ++n) { acc[a][m][n] = (f32x4){0.f, 0.f, 0.f, 0.f}; mrg[a][m][n] = (f32x4){0.f, 0.f, 0.f, 0.f}; }
    bf16x8 At[4][2], B0[2][2];
    const char* cA = cur.A; const char* cB = cur.B;
    PG8_STAGE(PG8_SB(0, 0), cB, voffB); PG8_STAGE(PG8_SA(0, 0), cA, voffA); PG8_STAGE(PG8_SA(0, 1), cA + hstepA, voffA);
    if (wr == 1) PG8_BAR;
    PG8_WAIT_V(2); PG8_BAR;
    PG8_STAGE(PG8_SB(1, 0), cB + kstep, voffB); PG8_STAGE(PG8_SA(1, 0), cA + kstep, voffA);
    PG8_WAIT_V(4); PG8_BAR;
    for (;;) {
        const bool has_next = S.next(ui + 1, nxt);
        const char* nA = has_next ? nxt.A : cA; const char* nB = has_next ? nxt.B : cB;
#pragma unroll 1
        for (int t = 0; t < nt; t += 2) {
            const bool last = (t == nt - 2);
            const char* a1 = cA + (size_t)(t + 1) * kstep;
            const char* a2 = last ? nA : cA + (size_t)(t + 2) * kstep; const char* b2 = last ? nB : cB + (size_t)(t + 2) * kstep;
            const char* a3 = a2 + kstep; const char* b3 = b2 + kstep;
            PG8_LDB(B0, 0, 0); PG8_SCHED; PG8_LDA(At, 0, 0); PG8_STAGE(PG8_SA(1, 1), a1 + hstepA, voffA);
            PG8_WAIT_V(6); PG8_WAIT_L(0); PG8_BAR; PG8_MMA1(0, At, B0); PG8_BAR; PG8_SCHED;
            PG8_LDA(At, 0, 1); PG8_STAGE(PG8_SB(0, 0), b2, voffB); PG8_STAGE(PG8_SA(0, 0), a2, voffA);
            PG8_WAIT_V(6); PG8_WAIT_L(0); PG8_BAR; PG8_MMA1(1, At, B0); PG8_BAR; PG8_SCHED;
            PG8_LDB(B0, 1, 0); PG8_SCHED; PG8_LDA(At, 1, 0); PG8_STAGE(PG8_SA(0, 1), a2 + hstepA, voffA);
            PG8_WAIT_V(6); PG8_WAIT_L(0); PG8_BAR; PG8_MMA1(0, At, B0); PG8_BAR; PG8_SCHED;
            PG8_LDA(At, 1, 1); PG8_STAGE(PG8_SB(1, 0), b3, voffB); PG8_STAGE(PG8_SA(1, 0), a3, voffA);
            PG8_WAIT_V(6); PG8_WAIT_L(0); PG8_BAR; PG8_MMA1(1, At, B0); PG8_BAR; PG8_SCHED;
        }
        if (wr == 0) PG8_BAR;
        {
            const int row0 = cur.orow + wr * 64 + fr, col0 = cur.ocol + wc * 32 + 8 * fq, z = cur.z;
            u32x4 gq[2][4];
#pragma unroll
            for (int ai = 0; ai < 2; ++ai)
#pragma unroll
                for (int m = 0; m < 4; ++m) gq[ai][m] = *(const u32x4*)(G + (size_t)(row0 + ai * HALF + m * 16) * 4096 + z * 1024 + col0);
#pragma unroll
            for (int ai = 0; ai < 2; ++ai)
#pragma unroll
                for (int m = 0; m < 4; ++m) { const size_t row = (size_t)(row0 + ai * HALF + m * 16);
                    const u32x4 gv = gq[ai][m];
                    f32x4 v0 = acc[ai][m][0], v1 = acc[ai][m][1];
                    v0[0] *= bflo(gv.x); v0[1] *= bfhi(gv.x); v0[2] *= bflo(gv.y); v0[3] *= bfhi(gv.y);
                    v1[0] *= bflo(gv.z); v1[1] *= bfhi(gv.z); v1[2] *= bflo(gv.w); v1[3] *= bfhi(gv.w);
                    if (z == 0) { mrg[ai][m][0] = v0; mrg[ai][m][1] = v1; } else { mrg[ai][m][0] += v0; mrg[ai][m][1] += v1; }
                    acc[ai][m][0] = (f32x4){0.f, 0.f, 0.f, 0.f}; acc[ai][m][1] = (f32x4){0.f, 0.f, 0.f, 0.f};
                    if (z == 3) { const f32x4 o0 = mrg[ai][m][0], o1 = mrg[ai][m][1];
                        u32x4 w; w.x = cvt_pk_bf16(o0[0], o0[1]); w.y = cvt_pk_bf16(o0[2], o0[3]); w.z = cvt_pk_bf16(o1[0], o1[1]); w.w = cvt_pk_bf16(o1[2], o1[3]);
                        *(u32x4*)(MB + row * 1024 + col0) = w; } }
        }
        if (!has_next) break;
        cur = nxt; cA = nA; cB = nB; ++ui;
        if (wr == 1) PG8_BAR;
    }
    PG8_WAIT_V(0);
    PG8_BAR;
#undef PG8_SA
#undef PG8_SB
#undef PG8_STAGE
#undef PG8_LDA
#undef PG8_LDB
#undef PG8_MMA1
#undef PG8_WAIT_V
#undef PG8_WAIT_L
#undef PG8_BAR
#undef PG8_SCHED
}
}
#define XB_TMO      128
#define XB_XCNT(j)  (256  + 64 * (j))
#define XB_XSUB(j)  (1280 + 64 * (j))
#define XB_XGEN(j)  (2304 + 64 * (j))
#define XB_TOP      3328
#define XB_TOPGEN   3392
#define XCD_BAR_WORDS 3456
#define XB_SPIN_CAP (1u << 18)

__device__ __forceinline__ unsigned xb_ld(unsigned* p)              { return __hip_atomic_load(p, __ATOMIC_RELAXED, __HIP_MEMORY_SCOPE_AGENT); }
__device__ __forceinline__ unsigned xb_add(unsigned* p, unsigned v) { return __hip_atomic_fetch_add(p, v, __ATOMIC_RELAXED, __HIP_MEMORY_SCOPE_AGENT); }
__device__ __forceinline__ unsigned xb_xcc_id() { return (unsigned)__builtin_amdgcn_s_getreg((3 << 11) | 20) & 0xFu; }
#define XB_SPIN(cond, bar) do { unsigned _sp = 0; while (cond) { __builtin_amdgcn_s_sleep(1); \
    if ((++_sp & 255u) == 0u) { if (xb_ld(&(bar)[XB_TMO])) break; if (_sp > XB_SPIN_CAP) { atomicAdd(&(bar)[XB_TMO], 1u); break; } } } } while (0)

struct XcdBarrier {
    unsigned* bar; unsigned x;
    volatile LAS unsigned* st;
};

__device__ __forceinline__ XcdBarrier xcd_barrier_post(unsigned* bar, volatile LAS unsigned* st) {
    XcdBarrier b; b.bar = bar; b.x = xb_xcc_id(); b.st = st;
    if (threadIdx.x == 0) (void)xb_add(&bar[XB_XCNT(b.x)], 1u);
    return b;
}
__device__ __forceinline__ void xcd_barrier_complete(unsigned* bar, unsigned x, unsigned& nloc, unsigned& nx) {
    const unsigned G = gridDim.x * gridDim.y * gridDim.z;
    unsigned sum, cnt, mine, sp = 0u;
    for (;;) {
        sum = 0u; cnt = 0u; mine = 0u;
#pragma unroll
        for (unsigned j = 0; j < 16; ++j) { const unsigned c = xb_ld(&bar[XB_XCNT(j)]); sum += c; cnt += (c > 0u) ? 1u : 0u; mine = (j == x) ? c : mine; }
        if (sum == G) break;
        __builtin_amdgcn_s_sleep(1);
        if ((++sp & 255u) == 0u) { if (xb_ld(&bar[XB_TMO])) break; if (sp > XB_SPIN_CAP) { atomicAdd(&bar[XB_TMO], 1u); break; } }
    }
    nloc = mine > 0u ? mine : 1u; nx = cnt > 0u ? cnt : 1u;
}

__device__ __forceinline__ void xcd_barrier(const XcdBarrier& b, int tid_now) {
    asm volatile("s_waitcnt vmcnt(0)" ::: "memory");
    __syncthreads();
    if (tid_now == 0) {
        unsigned* bar = b.bar;
        __builtin_amdgcn_s_waitcnt(0);
        unsigned nloc = b.st[0], nx = b.st[1];
        if (nloc == 0u) { xcd_barrier_complete(bar, b.x, nloc, nx); b.st[0] = nloc; b.st[1] = nx; }
        const unsigned old = xb_add(&bar[XB_XSUB(b.x)], 1u);
        const unsigned gen = old / nloc;
        if (old + 1u == (gen + 1u) * nloc) {
            __builtin_amdgcn_fence(__ATOMIC_RELEASE, "agent");
            asm volatile("s_waitcnt vmcnt(0)" ::: "memory");
            const unsigned og = xb_add(&bar[XB_TOP], 1u);
            const unsigned tg = og / nx;
            if (og + 1u == (tg + 1u) * nx) xb_add(&bar[XB_TOPGEN], 1u);
            else XB_SPIN(xb_ld(&bar[XB_TOPGEN]) == tg, bar);
            __builtin_amdgcn_fence(__ATOMIC_ACQUIRE, "agent");
            xb_add(&bar[XB_XGEN(b.x)], 1u);
            asm volatile("s_waitcnt vmcnt(0)" ::: "memory");
        } else {
            XB_SPIN(xb_ld(&bar[XB_XGEN(b.x)]) == gen, bar);
            __builtin_amdgcn_fence(__ATOMIC_ACQUIRE, "agent");
            asm volatile("s_waitcnt vmcnt(0)" ::: "memory");
        }
    }
    __syncthreads();
}

struct Args { const float* in[N_INPUTS]; float* out; unsigned char* ws; int ph_lo, ph_hi, l_lo, l_hi; };
struct Frame {
    LAS unsigned char* lds;
    volatile LAS unsigned* MISC;
    gu32* ctl;
    int tid, lane, wave, G, bid, zoff;
    unsigned char* ws;
    float* out;
};
#define FIN(k) (args.in[k])
#define WSP(T, off) ((T*)(F.ws + (off)))

__device__ __forceinline__ int wq_grab(Frame& F, int qid) {
    __syncthreads();
    if (F.tid == 0) F.MISC[16] = __hip_atomic_fetch_add((unsigned*)(F.ctl + CW_Q + qid * 64), 1u, RLX_AGENT);
    __syncthreads();
    return (int)F.MISC[16];
}
__device__ __forceinline__ float block_sum(Frame& F, float v, LAS float* red  ) {
    v = wave_sum(v);
    __syncthreads();
    if (F.lane == 0) red[F.wave] = v;
    __syncthreads();
    float s = 0.f;
#pragma unroll
    for (int w = 0; w < 8; ++w) s += red[w];
    return s;
}

__device__ __forceinline__ void ln_row(f32x4 (&v)[4], const float* g, const float* b, int lane) {
    float s = 0.f;
#pragma unroll
    for (int j = 0; j < 4; ++j) s += (v[j].x + v[j].y) + (v[j].z + v[j].w);
    const float mean = wave_sum(s) * (1.f / DM); float s2 = 0.f;
#pragma unroll
    for (int j = 0; j < 4; ++j) { v[j] = v[j] - mean; s2 += (v[j].x * v[j].x + v[j].y * v[j].y) + (v[j].z * v[j].z + v[j].w * v[j].w); }
    const float rstd = 1.f / sqrtf(wave_sum(s2) * (1.f / DM) + LN_EPS);
#pragma unroll
    for (int j = 0; j < 4; ++j) { const f32x4 gg = *(const f32x4*)(g + 4 * lane + 256 * j), bb = *(const f32x4*)(b + 4 * lane + 256 * j); v[j] = v[j] * rstd * gg + bb; }
}
__device__ __forceinline__ void store_row_bf16(const f32x4 (&v)[4], bf16* o16, int lane) {
#pragma unroll
    for (int j = 0; j < 4; ++j) { v2u w; w.x = pk2(v[j].x, v[j].y); w.y = pk2(v[j].z, v[j].w); *(v2u*)(o16 + 4 * lane + 256 * j) = w; }
}
__device__ __forceinline__ void load_row_bf16(f32x4 (&v)[4], const bf16* p, int lane, float scale) {
#pragma unroll
    for (int j = 0; j < 4; ++j) { const v2u w = *(const v2u*)(p + 4 * lane + 256 * j); v[j] = (f32x4){bflo(w.x), bfhi(w.x), bflo(w.y), bfhi(w.y)} * scale; }
}
__device__ __forceinline__ void store_row_f32_bf16(const f32x4 (&v)[4], float* o32, bf16* o16, int lane) {
#pragma unroll
    for (int j = 0; j < 4; ++j) { *(f32x4*)(o32 + 4 * lane + 256 * j) = v[j];
        v2u w; w.x = pk2(v[j].x, v[j].y); w.y = pk2(v[j].z, v[j].w); *(v2u*)(o16 + 4 * lane + 256 * j) = w; }
}

template <class RowPtr>
__device__ __forceinline__ void transpose_item(const float* W, int ldw, int k0, int n0, const RowPtr& rp, LAS float* scr, int lane) {
    const float* src = W + (size_t)k0 * ldw + n0 + lane;
#pragma unroll 16
    for (int kk = 0; kk < 64; ++kk) scr[kk * 65 + lane] = src[(size_t)kk * ldw];
    LDS_WAIT(); asm volatile("" ::: "memory");
    const int c = lane & 7;
#pragma unroll
    for (int j = 0; j < 8; ++j) { const int n = (lane >> 3) + 8 * j; const LAS float* s = scr + (8 * c) * 65 + n;
        v4u o; o.x = pk2(s[0 * 65], s[1 * 65]); o.y = pk2(s[2 * 65], s[3 * 65]); o.z = pk2(s[4 * 65], s[5 * 65]); o.w = pk2(s[6 * 65], s[7 * 65]);
        *(v4u*)(rp(n0 + n) + k0 + 8 * c) = o; }
    LDS_WAIT(); asm volatile("" ::: "memory");
}
struct RowPlain { bf16* base; int ld; __device__ __forceinline__ bf16* operator()(int n) const { return base + (size_t)n * ld; } };
struct RowGU { bf16* base; int half; __device__ __forceinline__ bf16* operator()(int f) const { return base + (size_t)((f >> 7) * 256 + half * 128 + (f & 127)) * 1024; } };

__device__ __forceinline__ void convert_layer(Frame& F, const Args& args, int l, int gw, int NGW) {
    LAS float* scr = (LAS float*)(F.lds + F.wave * 16640);
    unsigned char* wb = F.ws + WS_W;
    constexpr int I_IN = 16 * 124, I_BR = 4 * 4 * 16, I_OUT = 16 * 16, I_GLU = 4 * 4, I_EX = 16 * 256;
    constexpr int NIT = I_IN + I_BR + I_OUT + I_GLU + 3 * I_EX;
    for (int it = gw; it < NIT; it += NGW) {
        int r = it;
        if (r < I_IN) { const int kb = r / 124, nb = r % 124; transpose_item(FIN(I_WIN) + (size_t)l * DM * NIN, NIN, 64 * kb, 64 * nb, RowPlain{(bf16*)(wb + W_WIN), 1024}, scr, F.lane); continue; } r -= I_IN;
        if (r < I_BR) { const int i = r / 64, q = r % 64, kb = q / 16, nb = q % 16;
            transpose_item(FIN(I_WBR) + ((size_t)l * 4 + i) * 256 * 1024, 1024, 64 * kb, 64 * nb, RowPlain{(bf16*)(wb + W_WB) + (size_t)i * 1024 * 256, 256}, scr, F.lane); continue; } r -= I_BR;
        if (r < I_OUT) { const int kb = r / 16, nb = r % 16; transpose_item(FIN(I_WOUT) + (size_t)l * 1024 * 1024, 1024, 64 * kb, 64 * nb, RowPlain{(bf16*)(wb + W_WO), 1024}, scr, F.lane); continue; } r -= I_OUT;
        if (r < I_GLU) { const int kb = r / 4, nb = r % 4; transpose_item(FIN(I_S5_GW) + (size_t)l * 256 * 256, 256, 64 * kb, 64 * nb, RowPlain{(bf16*)(wb + W_GLU), 256}, scr, F.lane); continue; } r -= I_GLU;
        const int which = r / I_EX, q = r % I_EX, e = q / 256, q2 = q % 256, kb = q2 / 16, nb = q2 % 16;
        const size_t esz = (size_t)1024 * 1024;
        if (which == 0) transpose_item(FIN(I_EWG) + ((size_t)l * NE + e) * esz, 1024, 64 * kb, 64 * nb, RowGU{(bf16*)(wb + W_GU) + (size_t)e * 2048 * 1024, 0}, scr, F.lane);
        else if (which == 1) transpose_item(FIN(I_EWU) + ((size_t)l * NE + e) * esz, 1024, 64 * kb, 64 * nb, RowGU{(bf16*)(wb + W_GU) + (size_t)e * 2048 * 1024, 1}, scr, F.lane);
        else transpose_item(FIN(I_EWD) + ((size_t)l * NE + e) * esz, 1024, 64 * kb, 64 * nb, RowPlain{(bf16*)(wb + W_DN) + (size_t)e * esz, 1024}, scr, F.lane);
    }
}

__device__ __forceinline__ f32x2 cmul(f32x2 a, f32x2 b) { return (f32x2){a.x * b.x - a.y * b.y, a.x * b.y + a.y * b.x}; }

__device__ __forceinline__ void s5_build_item(Frame& F, const Args& args, int l, int g, int q4  ) {
    LAS f32x2* ap = (LAS f32x2*)F.lds;
    LAS f32x2* bb = ap + 2 * 64 * 33;
    LAS f32x2* cm = bb + 2 * 64 * 16;
    LAS float* kern = (LAS float*)(cm + 2 * 16 * 64);
    const int tid = F.tid;
    __syncthreads();
    if (tid < 128) {
        const int dir = tid >> 6, p = tid & 63; const size_t gi = ((size_t)(l * 2 + dir) * 16 + g);
        const float lre = FIN(I_S5_LRE)[gi * 64 + p], lim = FIN(I_S5_LIM)[gi * 64 + p], dt = expf(FIN(I_S5_LDT)[gi]);
        const float x = lre * dt, y = lim * dt;
        for (int tau = 0; tau <= 32; ++tau) { float s, c; sincosf((float)tau * y, &s, &c); const float e = expf((float)tau * x); ap[(dir * 64 + p) * 33 + tau] = (f32x2){e * c, e * s}; }
        if (q4 == 0) { float s, c; sincosf(32.f * y, &s, &c); const float e = expf(32.f * x); WSP(f32x2, WS_S5A32)[gi * 64 + p] = (f32x2){e * c, e * s}; }
        float s1, c1; sincosf(y, &s1, &c1); const float sh = sinf(0.5f * y);
        const f32x2 em1 = (f32x2){expm1f(x) * c1 - 2.f * sh * sh, expf(x) * s1};
        const float inv = 1.f / (lre * lre + lim * lim);
        const f32x2 q = (f32x2){(em1.x * lre + em1.y * lim) * inv, (em1.y * lre - em1.x * lim) * inv};
        for (int ci = 0; ci < 16; ++ci) { const f32x2 bm = (f32x2){FIN(I_S5_BRE)[(gi * 64 + p) * 16 + ci], FIN(I_S5_BIM)[(gi * 64 + p) * 16 + ci]}; bb[(dir * 64 + p) * 16 + ci] = cmul(q, bm); }
    }
    for (int i = tid; i < 2 * 16 * 64; i += 512) { const int dir = i >> 10, co = (i >> 6) & 15, p = i & 63; const size_t gi = ((size_t)(l * 2 + dir) * 16 + g);
        cm[i] = (f32x2){FIN(I_S5_CRE)[(gi * 16 + co) * 64 + p], FIN(I_S5_CIM)[(gi * 16 + co) * 64 + p]}; }
    __syncthreads();
    for (int e4 = tid; e4 < 63 * 64; e4 += 512) {
        const int ti = e4 >> 6, co = 4 * q4 + ((e4 >> 4) & 3), ci = e4 & 15, tau = ti - 31, e = ti * 256 + co * 16 + ci; float acc = 0.f;
        if (tau >= 0) for (int p = 0; p < 64; ++p) { const f32x2 w = cmul(cm[(0 * 16 + co) * 64 + p], ap[(0 * 64 + p) * 33 + tau]); const f32x2 b = bb[(0 * 64 + p) * 16 + ci]; acc += w.x * b.x - w.y * b.y; }
        if (tau <= 0) for (int p = 0; p < 64; ++p) { const f32x2 w = cmul(cm[(1 * 16 + co) * 64 + p], ap[(1 * 64 + p) * 33 - tau]); const f32x2 b = bb[(1 * 64 + p) * 16 + ci]; acc += w.x * b.x - w.y * b.y; }
        if (tau == 0 && co == ci) acc += FIN(I_S5_D)[l * 256 + g * 16 + co];
        kern[e] = acc;
    }
    __syncthreads();
    bf16* wcat = (bf16*)(F.ws + WS_S5W + (size_t)l * S5W_LAYER + S5_WCAT_OFF) + (size_t)g * 512 * 768;
    for (int ch = tid; ch < 128 * 96; ch += 512) {
        const int ml = ch / 96, k8 = ch % 96, t = ml >> 2, co = 4 * q4 + (ml & 3), m = 16 * t + co; float v[8];
        if (k8 < 64) { const int j = k8 >> 1, ci0 = (k8 & 1) * 8;
#pragma unroll
            for (int e = 0; e < 8; ++e) v[e] = kern[(t - j + 31) * 256 + co * 16 + ci0 + e]; }
        else { const int kk = (k8 - 64) * 8, dir = kk >> 7, p0 = (kk & 127) >> 1, tau = dir == 0 ? t + 1 : 32 - t;
#pragma unroll
            for (int pp = 0; pp < 4; ++pp) { const f32x2 w = cmul(cm[(dir * 16 + co) * 64 + p0 + pp], ap[(dir * 64 + p0 + pp) * 33 + tau]); v[2 * pp] = w.x; v[2 * pp + 1] = -w.y; } }
        v4u o; o.x = pk2(v[0], v[1]); o.y = pk2(v[2], v[3]); o.z = pk2(v[4], v[5]); o.w = pk2(v[6], v[7]);
        *(v4u*)(wcat + (size_t)m * 768 + k8 * 8) = o;
    }
    bf16* wst = (bf16*)(F.ws + WS_S5W + (size_t)l * S5W_LAYER + S5_WST_OFF) + (size_t)g * 2 * 128 * 512;
    if (q4 == 0) for (int ch = tid; ch < 2 * 128 * 64; ch += 512) {
        const int dir = ch >> 13, o = (ch >> 6) & 127, k8 = ch & 63, p = o >> 1, ri = o & 1, j = k8 >> 1, ci0 = (k8 & 1) * 8; float v[8];
        const f32x2 a = ap[(dir * 64 + p) * 33 + (dir == 0 ? 31 - j : j)];
#pragma unroll
        for (int e = 0; e < 8; ++e) { const f32x2 w = cmul(a, bb[(dir * 64 + p) * 16 + ci0 + e]); v[e] = ri ? w.y : w.x; }
        v4u q; q.x = pk2(v[0], v[1]); q.y = pk2(v[2], v[3]); q.z = pk2(v[4], v[5]); q.w = pk2(v[6], v[7]);
        *(v4u*)(wst + ((size_t)dir * 128 + o) * 512 + k8 * 8) = q;
    }
    __syncthreads();
}

__device__ __forceinline__ void hf2_item(Frame& F, const Args& args, int l, int t) {
    const int lane = F.lane;
    const float tn = (float)t * (1.f / 4095.f), w = 6.283185307179586f * (float)t * (1.f / 4096.f);
    float zv = 0.f;
    if (lane == 0) zv = tn;
    else if (lane <= 16) { const float f = 1e-4f + (float)(lane - 1) * ((15.f - 1e-4f) / 15.f); zv = cosf(f * w); }
    else if (lane <= 32) { const float f = 1e-4f + (float)(lane - 17) * ((15.f - 1e-4f) / 15.f); zv = -sinf(f * w); }
    float acc = FIN(I_HY_B1)[l * 64 + lane];
    const float* w1 = FIN(I_HY_W1) + (size_t)l * 33 * 64;
    for (int i = 0; i < 33; ++i) acc += __shfl(zv, i) * w1[i * 64 + lane];
    const float f1 = sinf(FIN(I_HY_FREQ)[(l * 2 + 0) * 64 + lane] * acc);
    float acc2 = FIN(I_HY_B2)[l * 64 + lane];
    const float* w2 = FIN(I_HY_W2) + (size_t)l * 64 * 64;
    for (int i = 0; i < 64; ++i) acc2 += __shfl(f1, i) * w2[i * 64 + lane];
    WSP(float, WS_HF2)[((size_t)l * 4096 + t) * 64 + lane] = sinf(FIN(I_HY_FREQ)[(l * 2 + 1) * 64 + lane] * acc2);
}

__device__ __forceinline__ void prologue_phase(Frame& F, const Args& args) {
    const int gw = F.bid * 8 + F.wave, NGW = F.G * 8;
    for (int it = F.bid; it < DEPTH * 16 * 4; it += F.G) s5_build_item(F, args, it >> 6, (it >> 2) & 15, it & 3);
    __syncthreads();
    { const int gi = F.bid * 512 + F.tid; if (gi < 1024) { const int pos = gi >> 4, i = gi & 15; const float inv = expf(-(float)(2 * i) * (1.f / 32.f) * 9.210340371976184f);
        float s, c; sincosf((float)pos * inv, &s, &c); WSP(f32x2, WS_ROPE)[gi] = (f32x2){c, s}; } }
    for (int it = gw; it < DEPTH * 4096; it += NGW) hf2_item(F, args, it >> 12, it & 4095);
    for (int m = gw; m < M; m += NGW) { f32x4 v[4];
#pragma unroll
        for (int j = 0; j < 4; ++j) v[j] = *(const f32x4*)(FIN(I_X) + (size_t)m * DM + 4 * F.lane + 256 * j);
        ln_row(v, FIN(I_LNIN_G), FIN(I_LNIN_B), F.lane);
        store_row_bf16(v, WSP(bf16, WS_HB) + (size_t)m * DM, F.lane); }
    convert_layer(F, args, 0, gw, NGW);
}
namespace attn_body {
using bf16=__hip_bfloat16;
using bf16x8=__attribute__((ext_vector_type(8)))short;
using s16x4=__attribute__((ext_vector_type(4)))short;
using f32x16=__attribute__((ext_vector_type(16)))float;
using u32x4=__attribute__((ext_vector_type(4)))unsigned;
constexpr int SEQ=4096,D=64,QP=512,KP=512,VP=512,OP=1024;
constexpr int NW=8,QBLK=32,QB=QBLK*NW,KVBLK=64,NQB=SEQ/QB;
constexpr int ATTN_UNIT_ROWS=QB;
__device__ __forceinline__ int crow(int r,int hi){return (r&3)+8*(r>>2)+4*hi;}
#define SBAR() __builtin_amdgcn_sched_barrier(0)
__device__ __forceinline__ void cmask(f32x16&p0,f32x16&p1,int jb,int qrel,int hi){
  const float NEG=-INFINITY; int kb=64*jb+4*hi;
  #pragma unroll
  for(int r=0;r<16;++r){int kv=kb+(r&3)+8*(r>>2); if(kv>qrel)p0[r]=NEG; if(kv+32>qrel)p1[r]=NEG;}
}

constexpr int NSLOT=3, SLOTB=8192;
constexpr int LDS_K=0, LDS_V=NSLOT*SLOTB, LDS_WS=2*NSLOT*SLOTB, LDS_OST=LDS_WS+NW*64*4, LDS_BYTES=LDS_OST+NW*4096;
constexpr float C2=0.125f*1.4426950408889634f;
__device__ __forceinline__ void glds16(const void*gsrc,unsigned lds_dst){unsigned keep;
  asm volatile("s_mov_b32 %0, m0\n\ts_mov_b32 m0, %2\n\ts_nop 0\n\tglobal_load_lds_dwordx4 %1, off\n\ts_mov_b32 m0, %0":"=&s"(keep):"v"(gsrc),"s"(lds_dst):"memory");}
__device__ __forceinline__ float max3f(float a,float b,float c){float r;asm("v_max3_f32 %0, %1, %2, %3":"=v"(r):"v"(a),"v"(b),"v"(c));return r;}
__device__ __forceinline__ float max2f(float a,float b){float r;asm("v_max_f32_e32 %0, %1, %2":"=v"(r):"v"(a),"v"(b));return r;}
__device__ __forceinline__ float fadd_s(float a,float b){float r;asm("v_add_f32_e32 %0, %1, %2":"=v"(r):"v"(a),"v"(b));return r;}
__device__ __forceinline__ float fsub_s(float a,float b){float r;asm("v_sub_f32_e32 %0, %1, %2":"=v"(r):"v"(a),"v"(b));return r;}
typedef float f32x2_t __attribute__((ext_vector_type(2))); typedef __bf16 bf16x2_t __attribute__((ext_vector_type(2)));
__device__ __forceinline__ unsigned cvtpk_s(float lo,float hi){f32x2_t v={lo,hi};bf16x2_t b=__builtin_convertvector(v,bf16x2_t);return __builtin_bit_cast(unsigned,b);}
#define WAIT_BAR(N) asm volatile("s_waitcnt vmcnt(" #N ") lgkmcnt(0)\n\ts_barrier":::"memory")

__device__ __forceinline__ void qkt(f32x16&p0,f32x16&p1,const char*Kslot,const bf16x8*qr,const f32x16&negm,int r32,int hi){
  const char*kb=Kslot+hi*1024+r32*16;
  #pragma unroll
  for(int d0=0;d0<4;++d0){
    const bf16x8 b0=*reinterpret_cast<const bf16x8*>(kb+d0*2048);
    const bf16x8 b1=*reinterpret_cast<const bf16x8*>(kb+d0*2048+512);
    if(d0==0){p0=__builtin_amdgcn_mfma_f32_32x32x16_bf16(b0,qr[0],negm,0,0,0);p1=__builtin_amdgcn_mfma_f32_32x32x16_bf16(b1,qr[0],negm,0,0,0);}
    else{p0=__builtin_amdgcn_mfma_f32_32x32x16_bf16(b0,qr[d0],p0,0,0,0);p1=__builtin_amdgcn_mfma_f32_32x32x16_bf16(b1,qr[d0],p1,0,0,0);}}
}
typedef __attribute__((address_space(3))) const char* lds_cptr;
typedef short v4i16_t __attribute__((ext_vector_type(4)));
__device__ __forceinline__ void kload8(bf16x8*kf,lds_cptr kp){
  kf[0]=*(const __attribute__((address_space(3))) bf16x8*)(kp);      kf[1]=*(const __attribute__((address_space(3))) bf16x8*)(kp+512);
  kf[2]=*(const __attribute__((address_space(3))) bf16x8*)(kp+2048); kf[3]=*(const __attribute__((address_space(3))) bf16x8*)(kp+2560);
  kf[4]=*(const __attribute__((address_space(3))) bf16x8*)(kp+4096); kf[5]=*(const __attribute__((address_space(3))) bf16x8*)(kp+4608);
  kf[6]=*(const __attribute__((address_space(3))) bf16x8*)(kp+6144); kf[7]=*(const __attribute__((address_space(3))) bf16x8*)(kp+6656);
}
__device__ __forceinline__ void kload2(bf16x8*kf,lds_cptr kp,int j){ kf[2*j]=*(const __attribute__((address_space(3))) bf16x8*)(kp+j*2048); kf[2*j+1]=*(const __attribute__((address_space(3))) bf16x8*)(kp+j*2048+512); }
__device__ __forceinline__ s16x4 vtr(lds_cptr p){ return __builtin_bit_cast(s16x4,__builtin_amdgcn_ds_read_tr16_b64_v4i16((__attribute__((address_space(3))) v4i16_t*)p)); }
__device__ __forceinline__ float rowmax(const f32x16&p0,const f32x16&p1){
  float a=max3f(p0[0],p0[1],p1[0]),b=max3f(p0[2],p0[3],p1[1]);a=max3f(a,p1[2],p1[3]);
  #pragma unroll
  for(int r=4;r<16;r+=4){a=max3f(a,p0[r],p0[r+1]);b=max3f(b,p0[r+2],p0[r+3]);a=max3f(a,p1[r],p1[r+1]);b=max3f(b,p1[r+2],p1[r+3]);}
  const float m=max2f(a,b);
  auto rr=__builtin_amdgcn_permlane32_swap(__float_as_uint(m),__float_as_uint(m),false,false);
  return max2f(__uint_as_float(rr[0]),__uint_as_float(rr[1]));
}
__device__ __forceinline__ void pv(f32x16*o,int vb,bf16x8 pa0,bf16x8 pa1,bf16x8 pa2,bf16x8 pa3){
  #pragma unroll
  for(int d0=0;d0<2;++d0){s16x4 lo[4],hi[4];
    #pragma unroll
    for(int ks=0;ks<4;++ks){
      asm volatile("ds_read_b64_tr_b16 %0,%1 offset:%c2":"=&v"(lo[ks]):"v"(vb),"i"(d0*4096+ks*1024):"memory");
      asm volatile("ds_read_b64_tr_b16 %0,%1 offset:%c2":"=&v"(hi[ks]):"v"(vb),"i"(d0*4096+ks*1024+512):"memory");}
    asm volatile("s_waitcnt lgkmcnt(0)":::"memory");SBAR();
    #define PK(k) (bf16x8){lo[k][0],lo[k][1],lo[k][2],lo[k][3],hi[k][0],hi[k][1],hi[k][2],hi[k][3]}
    o[d0]=__builtin_amdgcn_mfma_f32_32x32x16_bf16(pa0,PK(0),o[d0],0,0,0);
    o[d0]=__builtin_amdgcn_mfma_f32_32x32x16_bf16(pa1,PK(1),o[d0],0,0,0);
    o[d0]=__builtin_amdgcn_mfma_f32_32x32x16_bf16(pa2,PK(2),o[d0],0,0,0);
    o[d0]=__builtin_amdgcn_mfma_f32_32x32x16_bf16(pa3,PK(3),o[d0],0,0,0);
    #undef PK
  }
}

#ifndef ATTN_STORE16
#define ATTN_STORE16(p,v) (*(u32x4*)(p)=(v))
#endif
template<int THRL> __device__ __forceinline__ void attn_unit(int b,int h,int qb,const bf16*Q,const bf16*__restrict__ K,const bf16*__restrict__ V,bf16*O,char*shm,int tid_in){
  int tid=tid_in; asm volatile("":"+v"(tid)); const int lane=tid&63,r32=lane&31,hi=lane>>5; const int wid=__builtin_amdgcn_readfirstlane(tid>>6);
  const long rowbase=(long)b*SEQ; const int q0=qb*QB;
  const bf16*Qw=Q+(rowbase+q0+wid*QBLK)*QP+h*D;
  const bf16*Kh=K+rowbase*KP+(h>>1)*D,*Vh=V+rowbase*VP+(h>>1)*D;
  const unsigned lds0=(unsigned)(uintptr_t)shm;
  float*wsf=(float*)(shm+LDS_WS)+wid*64;
  const bf16*ksrc=Kh+(long)lane*KP+wid*8;
  const bf16*vsrc=Vh+(long)(16*(wid&3)+(lane>>2))*VP+(wid>>2)*32+(lane&3)*8;
  const unsigned kdst=lds0+LDS_K+wid*1024, vdst=lds0+LDS_V+wid*1024;
  #define DMA_K(t,slot) glds16(ksrc+(long)(t)*KVBLK*KP,(unsigned)__builtin_amdgcn_readfirstlane(kdst+(slot)))
  #define DMA_V(t,slot) glds16(vsrc+(long)(t)*KVBLK*VP,(unsigned)__builtin_amdgcn_readfirstlane(vdst+(slot)))
  const int vb0=(int)(lds0+LDS_V)+((lane>>4)&1)*32+(lane&3)*8+(4*hi+((lane&15)>>2))*64;
  const char*Kbase=shm+LDS_K; bf16x8 kf[8];
  const lds_cptr shm3=(lds_cptr)shm; const lds_cptr kp0=shm3+LDS_K+hi*1024+r32*16; const lds_cptr vp0=shm3+LDS_V+((lane>>4)&1)*32+(lane&3)*8+(4*hi+((lane&15)>>2))*64;
  const int NT=SEQ/KVBLK;
  DMA_K(0,0);DMA_V(0,0);DMA_K(1,SLOTB);
  bf16x8 qr[4];
  #pragma unroll
  for(int d0=0;d0<4;++d0)qr[d0]=*reinterpret_cast<const bf16x8*>(&Qw[(long)r32*QP+d0*16+hi*8]);
  float mhat=0.f,l_reg=0.f;f32x16 o[2];o[0]=f32x16{};o[1]=f32x16{};f32x16 negm=f32x16{};asm volatile("":"+v"(negm));
  #define CMASK(P0,P1,t) do{}while(0)
  bool resc=false;
  #define START(P0,P1) do{ const float rm=rowmax(P0,P1); resc=false; \
    { const float dl=rm; mhat=fadd_s(mhat,dl); \
      _Pragma("unroll") for(int r=0;r<16;++r){P0[r]=fsub_s(P0[r],dl);P1[r]=fsub_s(P1[r],dl);} \
      _Pragma("unroll") for(int r=0;r<16;++r)negm[r]=-mhat; asm volatile("":"+v"(negm)); } \
    _Pragma("unroll") for(int r=0;r<16;++r)P0[r]=__builtin_amdgcn_exp2f(P0[r]); }while(0)
  #define RESC() do{ if(resc){ asm volatile("s_waitcnt lgkmcnt(0)":::"memory"); \
      _Pragma("unroll") for(int d_=0;d_<2;++d_) _Pragma("unroll") for(int r=0;r<16;++r)o[d_][r]*=wsf[crow(r,hi)]; } }while(0)
  f32x16 pA0,pA1,pB0,pB1;
  int sl_prev=0,sl_cur=0,sl_next=SLOTB;
  #define ROT() do{sl_prev=sl_cur;sl_cur=sl_next;sl_next=(sl_next==(NSLOT-1)*SLOTB)?0:sl_next+SLOTB;}while(0)
  DMA_K(2,2*SLOTB);
  WAIT_BAR(3);
  qkt(pA0,pA1,Kbase,qr,negm,r32,hi);asm volatile("s_nop 15\n\ts_nop 7":"+v"(pA0),"+v"(pA1));CMASK(pA0,pA1,0);
  START(pA0,pA1);
  _Pragma("unroll") for(int r=0;r<16;++r)pA1[r]=__builtin_amdgcn_exp2f(pA1[r]);
  WAIT_BAR(0);
  DMA_K(3,0);DMA_V(1,SLOTB);
  ROT();
  kload8(kf,kp0+sl_cur);
  WAIT_BAR(2);
  s16x4 vlo[8],vhi[8]; u32x4 pw0,pw1,pw2,pw3;
  #define PKW(P,B) cvtpk_s(P[B],P[B+1])
  #define PAF(k) __builtin_bit_cast(bf16x8,pw##k)
  #define VFR(i) (bf16x8){vlo[i][0],vlo[i][1],vlo[i][2],vlo[i][3],vhi[i][0],vhi[i][1],vhi[i][2],vhi[i][3]}
  #define PIN(x) asm volatile("":"+v"(x))
  #define MX3(a,b,c) __builtin_fmaxf(__builtin_fmaxf((a),(b)),(c))
  #define GAPA(MF,A0,A1,A2,A3,W0,W1,PW) do{ MF; sacc+=A0; sacc+=A1; sacc+=A2; sacc+=A3; PIN(sacc); W0; W1; PIN(PW); SBAR(); }while(0)
  #define EX(v) __builtin_amdgcn_exp2f(v)
  #define GAPB(MF,X,B) do{ MF; X[B]=EX(X[B]); X[B+1]=EX(X[B+1]); X[B+2]=EX(X[B+2]); X[B+3]=EX(X[B+3]); PIN(X); SBAR(); }while(0)
  #define VRD(i) do{ vlo[i]=vtr(vp_+(((i)>>2)*4096+((i)&3)*1024)); vhi[i]=vtr(vp_+(((i)>>2)*4096+((i)&3)*1024+512)); }while(0)
  #define KRD(G,j) do{ if(G){ kload2(kf,kp0+sl_next,j); SBAR(); } }while(0)
  #define STEP(C0,C1,P0,P1,t,GK,GV,GL) do{ SBAR(); \
    const lds_cptr vp_=vp0+sl_prev; \
    VRD(0); SBAR(); float sacc=(P0[0]+P0[1]); \
    GAPA(C0=__builtin_amdgcn_mfma_f32_32x32x16_bf16(kf[0],qr[0],negm,0,0,0), P0[2],P0[3],P0[4],P0[5],     pw0[0]=PKW(P0,0), pw0[1]=PKW(P0,2), pw0); \
    VRD(4); SBAR(); GAPA(C1=__builtin_amdgcn_mfma_f32_32x32x16_bf16(kf[1],qr[0],negm,0,0,0), P0[6],P0[7],P0[8],P0[9],     pw0[2]=PKW(P0,4), pw0[3]=PKW(P0,6), pw0); \
    VRD(1); SBAR(); GAPA(C0=__builtin_amdgcn_mfma_f32_32x32x16_bf16(kf[2],qr[1],C0,0,0,0),   P0[10],P0[11],P0[12],P0[13], pw1[0]=PKW(P0,8), pw1[1]=PKW(P0,10), pw1); \
    VRD(5); SBAR(); GAPA(C1=__builtin_amdgcn_mfma_f32_32x32x16_bf16(kf[3],qr[1],C1,0,0,0),   P0[14],P0[15],P1[0],P1[1],   pw1[2]=PKW(P0,12),pw1[3]=PKW(P0,14), pw1); \
    VRD(2); SBAR(); GAPA(C0=__builtin_amdgcn_mfma_f32_32x32x16_bf16(kf[4],qr[2],C0,0,0,0),   P1[2],P1[3],P1[4],P1[5],     pw2[0]=PKW(P1,0), pw2[1]=PKW(P1,2), pw2); \
    VRD(6); SBAR(); GAPA(C1=__builtin_amdgcn_mfma_f32_32x32x16_bf16(kf[5],qr[2],C1,0,0,0),   P1[6],P1[7],P1[8],P1[9],     pw2[2]=PKW(P1,4), pw2[3]=PKW(P1,6), pw2); \
    VRD(3); SBAR(); GAPA(C0=__builtin_amdgcn_mfma_f32_32x32x16_bf16(kf[6],qr[3],C0,0,0,0),   P1[10],P1[11],P1[12],P1[13], pw3[0]=PKW(P1,8), pw3[1]=PKW(P1,10), pw3); \
    VRD(7); SBAR(); GAPA(C1=__builtin_amdgcn_mfma_f32_32x32x16_bf16(kf[7],qr[3],C1,0,0,0),   P1[14],P1[15],0.f,0.f,       pw3[2]=PKW(P1,12),pw3[3]=PKW(P1,14), pw3); \
    l_reg+=sacc; \
    if(GK){DMA_K((t)+3,sl_cur);} if(GV){DMA_V((t)+1,sl_next);} \
    CMASK(C0,C1,t); \
    { float a=MX3(C0[0],C0[1],C1[0]),b=MX3(C0[2],C0[3],C1[1]); a=MX3(a,C1[2],C1[3]); \
      _Pragma("unroll") for(int r=4;r<16;r+=4){a=MX3(a,C0[r],C0[r+1]);b=MX3(b,C0[r+2],C0[r+3]);a=MX3(a,C1[r],C1[r+1]);b=MX3(b,C1[r+2],C1[r+3]);} \
      float rm=__builtin_fmaxf(a,b); { auto rr=__builtin_amdgcn_permlane32_swap(__float_as_uint(rm),__float_as_uint(rm),false,false); rm=__builtin_fmaxf(__uint_as_float(rr[0]),__uint_as_float(rr[1])); } \
      resc=false; \
      if(__builtin_expect(__any(rm>(float)THRL),0)){ const float dl=__builtin_fmaxf(rm,0.f); mhat+=dl; \
        _Pragma("unroll") for(int r=0;r<16;++r){C0[r]-=dl;C1[r]-=dl;} \
        _Pragma("unroll") for(int r=0;r<16;++r)negm[r]=-mhat; asm volatile("":"+v"(negm)); \
        const float f=__builtin_amdgcn_exp2f(-dl); l_reg*=f; if(hi==0)wsf[r32]=f; resc=true; } } \
    SBAR(); \
    GAPB(o[0]=__builtin_amdgcn_mfma_f32_32x32x16_bf16(PAF(0),VFR(0),o[0],0,0,0), C0,0); \
    GAPB(o[1]=__builtin_amdgcn_mfma_f32_32x32x16_bf16(PAF(0),VFR(4),o[1],0,0,0), C0,4); \
    KRD(GL,0); GAPB(o[0]=__builtin_amdgcn_mfma_f32_32x32x16_bf16(PAF(1),VFR(1),o[0],0,0,0), C0,8); \
    KRD(GL,1); GAPB(o[1]=__builtin_amdgcn_mfma_f32_32x32x16_bf16(PAF(1),VFR(5),o[1],0,0,0), C0,12); \
    KRD(GL,2); GAPB(o[0]=__builtin_amdgcn_mfma_f32_32x32x16_bf16(PAF(2),VFR(2),o[0],0,0,0), C1,0); \
    KRD(GL,3); GAPB(o[1]=__builtin_amdgcn_mfma_f32_32x32x16_bf16(PAF(2),VFR(6),o[1],0,0,0), C1,4); \
    GAPB(o[0]=__builtin_amdgcn_mfma_f32_32x32x16_bf16(PAF(3),VFR(3),o[0],0,0,0), C1,8); \
    GAPB(o[1]=__builtin_amdgcn_mfma_f32_32x32x16_bf16(PAF(3),VFR(7),o[1],0,0,0), C1,12); \
    }while(0)
  int t=1;
  #undef CMASK
  #define CMASK(P0,P1,t) do{}while(0)
  for(;t+5<NT;t+=2){
    STEP(pB0,pB1,pA0,pA1,t,true,true,true);     WAIT_BAR(2); RESC(); ROT();
    STEP(pA0,pA1,pB0,pB1,t+1,true,true,true);   WAIT_BAR(2); RESC(); ROT();
  }
  #undef CMASK
  #define CMASK(P0,P1,t) do{}while(0)
  #define ENDW(tt) do{ if((tt)+3<NT){WAIT_BAR(2);} else if((tt)+2<NT){WAIT_BAR(1);} else {WAIT_BAR(0);} }while(0)
  for(;t+1<NT;t+=2){
    STEP(pB0,pB1,pA0,pA1,t,(t+3<NT),(t+1<NT),(t+1<NT));       ENDW(t);   RESC(); ROT();
    STEP(pA0,pA1,pB0,pB1,t+1,(t+4<NT),(t+2<NT),(t+2<NT));     ENDW(t+1); RESC(); ROT();
  }
  STEP(pB0,pB1,pA0,pA1,NT-1,false,false,false); RESC();
  { float sacc=pB0[0]+pB0[1]; _Pragma("unroll") for(int r=2;r<16;++r)sacc+=pB0[r]; _Pragma("unroll") for(int r=0;r<16;++r)sacc+=pB1[r]; l_reg+=sacc;
    pw0=(u32x4){PKW(pB0,0),PKW(pB0,2),PKW(pB0,4),PKW(pB0,6)};pw1=(u32x4){PKW(pB0,8),PKW(pB0,10),PKW(pB0,12),PKW(pB0,14)};pw2=(u32x4){PKW(pB1,0),PKW(pB1,2),PKW(pB1,4),PKW(pB1,6)};pw3=(u32x4){PKW(pB1,8),PKW(pB1,10),PKW(pB1,12),PKW(pB1,14)};
    SBAR(); pv(o,vb0+sl_cur,PAF(0),PAF(1),PAF(2),PAF(3)); }
  #undef PKW
  #undef PAF
  #undef VFR
  #undef PIN
  #undef MX3
  #undef GAPA
  #undef GAPB
  #undef EX
  #undef VRD
  #undef KRD
  #undef STEP
  #undef ENDW
  {auto rr=__builtin_amdgcn_permlane32_swap(__float_as_uint(l_reg),__float_as_uint(l_reg),false,false);l_reg=__uint_as_float(rr[0])+__uint_as_float(rr[1]);}
  if(hi==0)wsf[32+r32]=l_reg;asm volatile("s_waitcnt lgkmcnt(0)":::"memory");
  float rli[16];
  #pragma unroll
  for(int r=0;r<16;++r)rli[r]=__builtin_amdgcn_rcpf(wsf[32+crow(r,hi)]);
  bf16*Ow=O+(rowbase+q0+wid*QBLK)*OP+h*D;
  { bf16*stg=(bf16*)(shm+LDS_OST)+wid*2048;
    #pragma unroll
    for(int r=0;r<16;++r){const int orow=crow(r,hi);
      #pragma unroll
      for(int d0=0;d0<2;++d0)stg[orow*64+d0*32+r32]=__float2bfloat16(o[d0][r]*rli[r]);}
    asm volatile("s_waitcnt lgkmcnt(0)":::"memory");
    #pragma unroll
    for(int i=0;i<4;++i){const int row=i*8+(lane>>3),ch=lane&7; const u32x4 v=*(const u32x4*)(stg+row*64+ch*8); ATTN_STORE16(Ow+(long)row*OP+ch*8,v);} }
  asm volatile("s_waitcnt lgkmcnt(0)\n\ts_barrier":::"memory");
  #undef DMA_K
  #undef DMA_V
  #undef CMASK
  #undef START
  #undef RESC
  #undef ROT
}
constexpr int ATTN_LDS_BYTES=LDS_BYTES;
#undef SBAR
#undef WAIT_BAR
}

constexpr int FBUF = 8720;
__device__ __forceinline__ int fpad(int i) { return i + (i >> 5) + 18 * (i >> 9); }
constexpr float kTwC[16] = {1.000000000e+00f, 9.807852804e-01f, 9.238795325e-01f, 8.314696123e-01f, 7.071067812e-01f, 5.555702330e-01f, 3.826834324e-01f, 1.950903220e-01f,
                            0.0f, -1.950903220e-01f, -3.826834324e-01f, -5.555702330e-01f, -7.071067812e-01f, -8.314696123e-01f, -9.238795325e-01f, -9.807852804e-01f};
constexpr float kTwS[16] = {0.000000000e+00f, 1.950903220e-01f, 3.826834324e-01f, 5.555702330e-01f, 7.071067812e-01f, 8.314696123e-01f, 9.238795325e-01f, 9.807852804e-01f,
                            1.000000000e+00f, 9.807852804e-01f, 9.238795325e-01f, 8.314696123e-01f, 7.071067812e-01f, 5.555702330e-01f, 3.826834324e-01f, 1.950903220e-01f};
template <int N> __device__ __forceinline__ void dft_dif(f32x2 (&v)[N]) {
#pragma unroll
    for (int len = N; len >= 2; len >>= 1) {
        const int half = len / 2;
#pragma unroll
        for (int base = 0; base < N; base += len)
#pragma unroll
            for (int j = 0; j < half; ++j) {
                const f32x2 a = v[base + j], b = v[base + j + half];
                v[base + j] = a + b;
                const f32x2 d = a - b;
                const int ti = j * (32 / len);
                v[base + j + half] = (ti == 0) ? d : (f32x2){d.x * kTwC[ti] + d.y * kTwS[ti], d.y * kTwC[ti] - d.x * kTwS[ti]};
            }
    }
}
__host__ __device__ constexpr int brev(int i, int bits) { int r = 0; for (int b = 0; b < bits; ++b) r |= ((i >> b) & 1) << (bits - 1 - b); return r; }

#define FFT_BAR() asm volatile("s_waitcnt lgkmcnt(0)\n\ts_barrier" ::: "memory")
__device__ __forceinline__ void fft8192(LAS f32x2* buf, int tid_in) {
    int tid = tid_in; asm volatile("" : "+v"(tid));
    {
        const int n2 = tid; f32x2 v[16];
        LAS f32x2* p = buf + n2 + (n2 >> 5);
#pragma unroll
        for (int n1 = 0; n1 < 16; ++n1) v[n1] = p[546 * n1];
        dft_dif<16>(v);
        const float rv1 = (float)n2 * (1.f / 8192.f); const float c = __builtin_amdgcn_cosf(rv1), s = -__builtin_amdgcn_sinf(rv1);
        f32x2 pw[16]; pw[0] = (f32x2){1.f, 0.f}; pw[1] = (f32x2){c, s};
#pragma unroll
        for (int k = 2; k < 16; ++k) pw[k] = cmul(pw[k - 1], pw[1]);
#pragma unroll
        for (int i = 0; i < 16; ++i) { const int k1 = brev(i, 4); p[546 * k1] = cmul(v[i], pw[k1]); }
    }
    FFT_BAR();
    {
        const int k1 = tid >> 5, b = tid & 31; f32x2 v[16];
        LAS f32x2* p = buf + 546 * k1 + b;
#pragma unroll
        for (int a = 0; a < 16; ++a) v[a] = p[33 * a];
        dft_dif<16>(v);
        const float rv2 = (float)b * (1.f / 512.f); const float c = __builtin_amdgcn_cosf(rv2), s = -__builtin_amdgcn_sinf(rv2);
        f32x2 pw[16]; pw[0] = (f32x2){1.f, 0.f}; pw[1] = (f32x2){c, s};
#pragma unroll
        for (int k = 2; k < 16; ++k) pw[k] = cmul(pw[k - 1], pw[1]);
#pragma unroll
        for (int i = 0; i < 16; ++i) { const int ka = brev(i, 4); p[33 * ka] = cmul(v[i], pw[ka]); }
    }
    FFT_BAR();
    {
        const int ka = (tid >> 4) & 15, k1 = tid & 15; f32x2 v[32];
        if (tid < 256) {
            const LAS f32x2* p = buf + 546 * k1 + 33 * ka;
#pragma unroll
            for (int b = 0; b < 32; ++b) v[b] = p[b];
            dft_dif<32>(v);
        }
        FFT_BAR();
        if (tid < 256) {
            LAS f32x2* q = buf + k1 + 16 * ka + (ka >> 1);
#pragma unroll
            for (int i = 0; i < 32; ++i) { const int kb = brev(i, 5); q[264 * kb + 18 * (kb >> 1)] = v[i]; }
        }
    }
    FFT_BAR();
}

__device__ __forceinline__ float hy_sconv(const bf16* xrow, unsigned t, float w0, float w1, float w2, float bias) {
    const unsigned tm = t > 0u ? t - 1u : 0u, tp = t < (unsigned)(SEQ - 1) ? t + 1u : (unsigned)(SEQ - 1);
    const float xm = t > 0u ? bf2f(xrow[tm]) : 0.f, x0 = bf2f(xrow[t]), xp = t < (unsigned)(SEQ - 1) ? bf2f(xrow[tp]) : 0.f;
    return xm * w0 + x0 * w1 + xp * w2 + bias;
}

__device__ __forceinline__ void hy_sconv_row(Frame& F, const Args& args, int l, int row  ) {
    const int lane = F.lane, ch = row >> 3;
    bf16* x = WSP(bf16, WS_RB + RB_HYT) + (size_t)ch * M + (size_t)(row & 7) * SEQ;
    const float* cw = FIN(I_HY_CW) + (size_t)l * 3 * 768; const float w0 = cw[ch], w1 = cw[768 + ch], w2 = cw[1536 + ch], bias = FIN(I_HY_CB)[(size_t)l * 768 + ch];
    v4u raw[8];
#pragma unroll
    for (int k = 0; k < 8; ++k) raw[k] = *(const v4u*)(x + 8 * lane + 512 * k);
    float first[8], lastv[8];
#pragma unroll
    for (int k = 0; k < 8; ++k) { first[k] = bflo(raw[k].x); lastv[k] = bfhi(raw[k].w); }
#pragma unroll
    for (int k = 0; k < 8; ++k) {
        float v[10];
        v[1] = bflo(raw[k].x); v[2] = bfhi(raw[k].x); v[3] = bflo(raw[k].y); v[4] = bfhi(raw[k].y); v[5] = bflo(raw[k].z); v[6] = bfhi(raw[k].z); v[7] = bflo(raw[k].w); v[8] = bfhi(raw[k].w);
        const float lft = __shfl_up(lastv[k], 1), lft0 = k > 0 ? __shfl(lastv[k > 0 ? k - 1 : 0], 63) : 0.f;
        const float rgt = __shfl_down(first[k], 1), rgt63 = k < 7 ? __shfl(first[k < 7 ? k + 1 : 7], 0) : 0.f;
        v[0] = lane == 0 ? lft0 : lft; v[9] = lane == 63 ? rgt63 : rgt;
        float o[8];
#pragma unroll
        for (int e = 0; e < 8; ++e) o[e] = v[e] * w0 + v[e + 1] * w1 + v[e + 2] * w2 + bias;
        v4u w; w.x = pk2(o[0], o[1]); w.y = pk2(o[2], o[3]); w.z = pk2(o[4], o[5]); w.w = pk2(o[6], o[7]);
        *(v4u*)(x + 8 * lane + 512 * k) = w;
    }
}
__device__ __forceinline__ void hy_taps_block(Frame& F, const Args& args, int l, int tb) {
    LAS float* F2 = (LAS float*)F.lds;
    const int tid = F.tid, t0 = tb * 16;
    const float* f2 = WSP(float, WS_HF2) + ((size_t)l * 4096 + t0) * 64;
    __syncthreads();
    for (int i = tid; i < 16 * 64; i += 512) F2[i] = f2[i];
    __syncthreads();
    const float* w3 = FIN(I_HY_W3) + (size_t)l * 64 * 1024;
    float acc0[16], acc1[16];
#pragma unroll
    for (int j = 0; j < 16; ++j) { acc0[j] = 0.f; acc1[j] = 0.f; }
#pragma unroll 4
    for (int i = 0; i < 64; ++i) { const float wa = w3[i * 1024 + tid], wb = w3[i * 1024 + 512 + tid];
#pragma unroll
        for (int j = 0; j < 16; ++j) { const float x = F2[j * 64 + i]; acc0[j] += x * wa; acc1[j] += x * wb; } }
    const int c = tid & 255;
    const float delta = fabsf(-3.0701134573253945f + (float)c * ((-15.350567286626973f + 3.0701134573253945f) / 255.f));
    float* tt = WSP(float, WS_TT);
#pragma unroll
    for (int j = 0; j < 16; j += 4) { f32x4 o0, o1;
#pragma unroll
        for (int q = 0; q < 4; ++q) { const float dec = expf(-(float)(t0 + j + q) * (1.f / 4095.f) * delta); o0[q] = acc0[j + q] * dec; o1[q] = acc1[j + q] * dec; }
        *(f32x4*)(tt + (size_t)tid * SEQ + t0 + j) = o0; *(f32x4*)(tt + (size_t)(512 + tid) * SEQ + t0 + j) = o1; }
}

__device__ __forceinline__ void hyena_item(Frame& F, const Args& args, int l, int c) {
    LAS f32x2* A = (LAS f32x2*)F.lds;
    LAS f32x2* B = A + FBUF;
    LAS float* W3L = (LAS float*)(B + FBUF);
    LAS float* red = W3L + 256;
    const bf16* hyT = WSP(bf16, WS_RB + RB_HYT);
    float* HV = WSP(float, WS_RD + RD_HV) + (size_t)c * 8 * SEQ;
    bf16* yaT = WSP(bf16, WS_RD + RD_YAT) + (size_t)c * M;
    const float* f2 = WSP(float, WS_HF2) + (size_t)l * 4096 * 64;
    __syncthreads();
    __syncthreads();
#pragma unroll 1
    for (int n = 0; n < 2; ++n) {
        int tid = F.tid; asm volatile("" : "+v"(tid));
        float ss = 0.f;
        {   const float* tf = WSP(float, WS_TT) + ((size_t)(0 * 2 + n) * 256 + c) * SEQ; const float* tbk = WSP(float, WS_TT) + ((size_t)(1 * 2 + n) * 256 + c) * SEQ;
#pragma unroll
            for (int j = 0; j < 8; ++j) { const int t = tid + 512 * j; const float fw = tf[t], bw = tbk[t];
                A[tid + (tid >> 5) + 546 * j] = (f32x2){fw, 0.f}; ss += fw * fw;
                if (t >= 1) { A[fpad(8192 - t)] = (f32x2){bw, 0.f}; ss += bw * bw; } } }
        if (tid == 0) A[fpad(4096)] = (f32x2){0.f, 0.f};
        ss = block_sum(F, ss, red);
        const float scale = (1.f / sqrtf(ss)) * (1.f / 8192.f);
        const float biasN = FIN(I_HY_BIAS)[((size_t)l * 2 + n) * 256 + c] * (1.f / 8192.f);
        fft8192(A, tid);
#pragma unroll
        for (int j = 0; j < 16; ++j) { LAS f32x2* p = A + tid + (tid >> 5) + 546 * j; f32x2 a = *p * scale; a.x += biasN; *p = a; }
#pragma unroll 1
        for (int pb = 0; pb < 4; ++pb) {
            int tq = tid; asm volatile("" : "+v"(tq));
            const bf16* zr0 = hyT + (size_t)c * M + (size_t)(2 * pb) * SEQ; const bf16* zr1 = zr0 + SEQ;
            const bf16* gr0 = hyT + (size_t)((n + 1) * 256 + c) * M + (size_t)(2 * pb) * SEQ; const bf16* gr1 = gr0 + SEQ;
            float* hv0 = HV + (size_t)(2 * pb) * SEQ; float* hv1 = hv0 + SEQ;
            __syncthreads();
#pragma unroll
            for (int j = 0; j < 8; ++j) { const unsigned t = (unsigned)tq + 512u * j; float z0, z1;
                if (n == 0) { z0 = bf2f(zr0[t]); z1 = bf2f(zr1[t]); }
                else { z0 = hv0[t]; z1 = hv1[t]; }
                B[tq + (tq >> 5) + 546 * j] = (f32x2){z0, z1}; B[tq + (tq >> 5) + 546 * (j + 8)] = (f32x2){0.f, 0.f}; }
            float g0[8], g1[8];
#pragma unroll
            for (int j = 0; j < 8; ++j) { const unsigned t = (unsigned)tq + 512u * j; g0[j] = bf2f(gr0[t]); g1[j] = bf2f(gr1[t]); }
            FFT_BAR();
            fft8192(B, tq);
#pragma unroll
            for (int j = 0; j < 16; ++j) { const int p = tq + (tq >> 5) + 546 * j; const f32x2 y = cmul(B[p], A[p]); B[p] = (f32x2){y.x, -y.y}; }
            FFT_BAR();
            fft8192(B, tq);
#pragma unroll
            for (int j = 0; j < 8; ++j) { const unsigned t = (unsigned)tq + 512u * j; const f32x2 y = B[tq + (tq >> 5) + 546 * j];
                const float o0 = g0[j] * y.x, o1 = g1[j] * -y.y;
                if (n == 0) { hv0[t] = o0; hv1[t] = o1; }
                else { yaT[(size_t)(2 * pb) * SEQ + t] = (bf16)f2bf(o0); yaT[(size_t)(2 * pb + 1) * SEQ + t] = (bf16)f2bf(o1); } }
        }
        __syncthreads();
    }
}

__device__ __forceinline__ f32x16 mfma32(bf16x8 a, bf16x8 b, f32x16 c) { return __builtin_amdgcn_mfma_f32_32x32x16_bf16(a, b, c, 0, 0, 0); }
__device__ __forceinline__ int crow(int r, int hi) { return (r & 3) + 8 * (r >> 2) + 4 * hi; }
__device__ __forceinline__ float gelu_tanh(float x) {
    const float u = 0.7978845608028654f * (x + 0.044715f * x * x * x);
    const float e = __builtin_amdgcn_exp2f(2.885390081777927f * u);
    const float th = 1.f - 2.f * __builtin_amdgcn_rcpf(e + 1.f);
    return 0.5f * x * (1.f + th);
}
__device__ __forceinline__ void s5_item(Frame& F, const Args& args, int l, int b, int g) {
    constexpr int SP = 129, XP = 136;
    LAS float* S = (LAS float*)F.lds;
    LAS bf16* XB = (LAS bf16*)(F.lds + 128 * SP * 4);
    const int tid = F.tid, lane = F.lane, w = F.wave, r32 = lane & 31, hi = lane >> 5;
    const bf16* U = WSP(bf16, WS_RB + RB_PROJ2) + (size_t)b * SEQ * PROJ2_W + PC_S5 + g * 16;
    const bf16* wst = WSP(bf16, WS_S5W + (size_t)l * S5W_LAYER + S5_WST_OFF) + (size_t)g * 2 * 128 * 512;
    const bf16* wcat = WSP(bf16, WS_S5W + (size_t)l * S5W_LAYER + S5_WCAT_OFF) + (size_t)g * 512 * 768;
    bf16* Z = WSP(bf16, WS_RD + RD_S5Z) + (size_t)b * SEQ * 256 + g * 16;
    __syncthreads();
    for (int dir = 0; dir < 2; ++dir) {
        {
            const int rt = w >> 1, ct0 = 2 * (w & 1);
            f32x16 acc[2]; acc[0] = f32x16{}; acc[1] = f32x16{};
            const bf16* ap = wst + ((size_t)dir * 128 + rt * 32 + r32) * 512 + 8 * hi;
            const bf16* bp0 = U + (size_t)(32 * (ct0 * 32 + r32)) * PROJ2_W + 8 * hi;
            const bf16* bp1 = bp0 + (size_t)(32 * 32) * PROJ2_W;
#pragma unroll 4
            for (int ks = 0; ks < 32; ++ks) {
                const bf16x8 a = *(const bf16x8*)(ap + 16 * ks);
                const bf16x8 b0 = *(const bf16x8*)(bp0 + (size_t)ks * PROJ2_W), b1 = *(const bf16x8*)(bp1 + (size_t)ks * PROJ2_W);
                acc[0] = mfma32(a, b0, acc[0]); acc[1] = mfma32(a, b1, acc[1]);
            }
#pragma unroll
            for (int q = 0; q < 2; ++q)
#pragma unroll
                for (int r = 0; r < 16; ++r) S[((ct0 + q) * 32 + r32) * SP + rt * 32 + crow(r, hi)] = acc[q][r];
        }
        __syncthreads();
        if (tid < 64) {
            const f32x2 a32 = WSP(f32x2, WS_S5A32)[((size_t)(l * 2 + dir) * 16 + g) * 64 + tid];
            f32x2 X = (f32x2){0.f, 0.f};
#pragma unroll 8
            for (int cc = 0; cc < 128; ++cc) { const int c = dir == 0 ? cc : 127 - cc;
                const f32x2 s = (f32x2){S[c * SP + 2 * tid], S[c * SP + 2 * tid + 1]};
                X = cmul(a32, X) + s;
                *(LAS unsigned*)(XB + ((size_t)dir * 128 + c) * XP + 2 * tid) = pk2(X.x, X.y); }
        }
        __syncthreads();
    }
    {
        f32x16 acc[2][4];
#pragma unroll
        for (int i = 0; i < 2; ++i)
#pragma unroll
            for (int j = 0; j < 4; ++j) acc[i][j] = f32x16{};
        const bf16* ap = wcat + (size_t)(2 * w * 32 + r32) * 768 + 8 * hi;
        const bf16* bp = U + (size_t)(32 * r32) * PROJ2_W + 8 * hi;
#pragma unroll 2
        for (int ks = 0; ks < 32; ++ks) {
            const bf16x8 a0 = *(const bf16x8*)(ap + 16 * ks), a1 = *(const bf16x8*)(ap + 32 * 768 + 16 * ks);
#pragma unroll
            for (int ct = 0; ct < 4; ++ct) { const bf16x8 bv = *(const bf16x8*)(bp + (size_t)(32 * 32 * ct + ks) * PROJ2_W);
                acc[0][ct] = mfma32(a0, bv, acc[0][ct]); acc[1][ct] = mfma32(a1, bv, acc[1][ct]); }
        }
#pragma unroll 2
        for (int ks = 0; ks < 16; ++ks) {
            const int dir = ks >> 3, kk = ks & 7;
            const bf16x8 a0 = *(const bf16x8*)(ap + 512 + 16 * ks), a1 = *(const bf16x8*)(ap + 32 * 768 + 512 + 16 * ks);
#pragma unroll
            for (int ct = 0; ct < 4; ++ct) { const int c = ct * 32 + r32, cs = dir == 0 ? c - 1 : c + 1;
                bf16x8 bv = (bf16x8){0, 0, 0, 0, 0, 0, 0, 0};
                if (cs >= 0 && cs < 128) bv = *(const LAS bf16x8*)(XB + ((size_t)dir * 128 + cs) * XP + 16 * kk + 8 * hi);
                acc[0][ct] = mfma32(a0, bv, acc[0][ct]); acc[1][ct] = mfma32(a1, bv, acc[1][ct]); }
        }
#pragma unroll
        for (int i = 0; i < 2; ++i)
#pragma unroll
            for (int ct = 0; ct < 4; ++ct)
#pragma unroll
                for (int q = 0; q < 4; ++q) {
                    const int tl = (2 * w + i) * 2 + (q >> 1), co = 8 * (q & 1) + 4 * hi, c = ct * 32 + r32;
                    v2u o; o.x = pk2(gelu_tanh(acc[i][ct][4 * q]), gelu_tanh(acc[i][ct][4 * q + 1])); o.y = pk2(gelu_tanh(acc[i][ct][4 * q + 2]), gelu_tanh(acc[i][ct][4 * q + 3]));
                    *(v2u*)(Z + (size_t)(32 * c + tl) * 256 + co) = o; }
    }
    __syncthreads();
}

__device__ __forceinline__ void dil_item(Frame& F, const Args& args, int it) {
    constexpr int RS = 144;
    LAS unsigned char* Ks = F.lds; LAS unsigned char* Vs = F.lds + 384 * RS;
    int lane = F.lane; asm volatile("" : "+v"(lane));
    const int r32 = lane & 31, hi = lane >> 5, w = F.wave;
    const int u0 = it * 8, g = u0 >> 12, b = (u0 >> 9) & 7, hh = (u0 >> 7) & 3, tile0 = u0 & 127;
    const int dsh = 2 * g, Lp = SEQ >> dsh, tpr = Lp >> 5, rho = tile0 / tpr, q0 = (tile0 % tpr) * 32, h = g * 4 + hh;
    const float slope2 = exp2f(-8.f * (float)(h + 1) * (1.f / 12.f)) * (float)(1 << dsh) * 1.4426950408889634f;
    const char* P2 = (const char*)(WSP(bf16, WS_RB + RB_PROJ2) + (size_t)b * SEQ * PROJ2_W);
#define DIL_ROWB(tp) ((unsigned)(rho + ((tp) << dsh)) * (unsigned)(PROJ2_W * 2))
    __syncthreads();
    {   int tq = F.tid; asm volatile("" : "+v"(tq));
#pragma unroll
        for (int k = 0; k < 6; ++k) { const int id = tq + 512 * k, row = id >> 3, ch = id & 7;
            int tj = q0 - 64 + row; tj = tj < 0 ? 0 : (tj > Lp - 1 ? Lp - 1 : tj);
            const unsigned ro = DIL_ROWB(tj) + (unsigned)(h * 64 + ch * 8) * 2u;
            const v4u kv = *(const v4u*)(P2 + ro + PC_DK * 2), vv = *(const v4u*)(P2 + ro + PC_DV * 2);
            *(LAS v4u*)(Ks + row * RS + ch * 16) = kv; *(LAS v4u*)(Vs + row * RS + ch * 16) = vv; } }
    const int tau0 = q0 + 32 * w;
    bf16x8 qf[4];
    { const unsigned qo = DIL_ROWB(tau0 + r32) + (unsigned)(PC_DQ + h * 64 + 8 * hi) * 2u;
#pragma unroll
      for (int ks = 0; ks < 4; ++ks) qf[ks] = *(const bf16x8*)(P2 + qo + 32 * ks); }
    __syncthreads();
    f32x16 S[5];
#pragma unroll
    for (int kt = 0; kt < 5; ++kt) {
        const LAS unsigned char* kp = Ks + (32 * w + 32 * kt + r32) * RS + 16 * hi;
        f32x16 a = f32x16{};
#pragma unroll
        for (int ks = 0; ks < 4; ++ks) a = mfma32(*(const LAS bf16x8*)(kp + 32 * ks), qf[ks], a);
        S[kt] = a;
    }
    float mx = -1e30f;
#pragma unroll
    for (int kt = 0; kt < 5; ++kt)
#pragma unroll
        for (int r = 0; r < 16; ++r) { const int dl = -64 + 32 * kt + crow(r, hi) - r32, tj = tau0 + r32 + dl;
            const bool ok = dl >= -64 && dl <= 64 && tj >= 0 && tj < Lp;
            const float sc = S[kt][r] * (0.125f * 1.4426950408889634f) - slope2 * (float)(dl < 0 ? -dl : dl);
            S[kt][r] = ok ? sc : -1e30f; mx = fmaxf(mx, S[kt][r]); }
    mx = fmaxf(mx, __shfl_xor(mx, 32));
    float lsum = 0.f;
#pragma unroll
    for (int kt = 0; kt < 5; ++kt)
#pragma unroll
        for (int r = 0; r < 16; ++r) { const float p = __builtin_amdgcn_exp2f(S[kt][r] - mx); S[kt][r] = p; lsum += p; }
    lsum += __shfl_xor(lsum, 32);
    f32x16 O[2]; O[0] = f32x16{}; O[1] = f32x16{};
    const LAS unsigned short* vb = (const LAS unsigned short*)(Vs + (32 * w + 4 * hi) * RS) + r32;
#pragma unroll
    for (int kt = 0; kt < 5; ++kt)
#pragma unroll
        for (int s = 0; s < 2; ++s) {
            bf16x8 pa; bf16x8 v0, v1;
#pragma unroll
            for (int j = 0; j < 8; j += 2) { const unsigned pw = pk2(S[kt][8 * s + j], S[kt][8 * s + j + 1]); pa[j] = (short)(pw & 0xffff); pa[j + 1] = (short)(pw >> 16); }
#pragma unroll
            for (int j = 0; j < 8; ++j) { const LAS unsigned short* vp = vb + (32 * kt + 16 * s + 8 * (j >> 2) + (j & 3)) * (RS / 2); v0[j] = (short)vp[0]; v1[j] = (short)vp[32]; }
            O[0] = mfma32(pa, v0, O[0]); O[1] = mfma32(pa, v1, O[1]);
        }
    const float linv = 1.f / lsum;
    bf16* Og = WSP(bf16, WS_RD + RD_DILO) + (size_t)g * M * 256 + (size_t)b * SEQ * 256 + hh * 64 + r32;
#pragma unroll
    for (int r = 0; r < 16; ++r) { const int i = crow(r, hi); const float li = __shfl(linv, i);
        const unsigned ro = (unsigned)(rho + ((tau0 + i) << dsh)) * 256u;
        Og[ro] = (bf16)f2bf(O[0][r] * li); Og[ro + 32] = (bf16)f2bf(O[1][r] * li); }
    if (hi == 0) WSP(float, WS_DLSE)[((size_t)g * M + (size_t)b * SEQ + rho + ((tau0 + r32) << dsh)) * 4 + hh] = (mx + log2f(lsum)) * 0.6931471805599453f;
#undef DIL_ROWB
}

__device__ __forceinline__ void gqa_prep_rows(Frame& F, const Args& args, int l, int m0) {
    const int lane = F.lane, grp = lane >> 4, li = lane & 15;
    const bf16* P2 = WSP(bf16, WS_RB + RB_PROJ2); bf16* QK = WSP(bf16, WS_RD + RD_QKVG);
    const f32x4 qn = *(const f32x4*)(FIN(I_GQ_QN) + l * 64 + 4 * li), kn = *(const f32x4*)(FIN(I_GQ_KN) + l * 64 + 4 * li);
#pragma unroll
    for (int p = 0; p < 3; ++p) {
        const int s = 4 * p + grp, rsel = s >= 6 ? 1 : 0, hs = s - 6 * rsel, m = m0 + rsel, t = m & (SEQ - 1);
        const v2u raw = *(const v2u*)(P2 + (size_t)m * PROJ2_W + PC_GQ + hs * 64 + 4 * li);
        f32x4 x = (f32x4){bflo(raw.x), bfhi(raw.x), bflo(raw.y), bfhi(raw.y)};
        float ss = (x[0] * x[0] + x[1] * x[1]) + (x[2] * x[2] + x[3] * x[3]);
        ss += __shfl_xor(ss, 1); ss += __shfl_xor(ss, 2); ss += __shfl_xor(ss, 4); ss += __shfl_xor(ss, 8);
        const float rn = 1.f / sqrtf(ss * (1.f / 64.f) + RMS_EPS);
        x = x * rn * (hs < 4 ? qn : kn);
        f32x4 pr; pr[0] = __shfl_xor(x[0], 4); pr[1] = __shfl_xor(x[1], 4); pr[2] = __shfl_xor(x[2], 4); pr[3] = __shfl_xor(x[3], 4);
        const int pos = li >= 8 ? (t & 63) : (t >> 6);
        const f32x4* cs = (const f32x4*)(WSP(f32x2, WS_ROPE) + pos * 16 + 4 * (li & 3));
        const f32x4 cs0 = cs[0], cs1 = cs[1];
        const float sg = (li & 4) ? 1.f : -1.f, sc = hs < 4 ? 0.125f * 1.4426950408889634f : 1.f;
        f32x4 o; o[0] = (x[0] * cs0[0] + sg * pr[0] * cs0[1]) * sc; o[1] = (x[1] * cs0[2] + sg * pr[1] * cs0[3]) * sc; o[2] = (x[2] * cs1[0] + sg * pr[2] * cs1[1]) * sc; o[3] = (x[3] * cs1[2] + sg * pr[3] * cs1[3]) * sc;
        v2u w; w.x = pk2(o[0], o[1]); w.y = pk2(o[2], o[3]);
        *(v2u*)(QK + (size_t)m * 512 + hs * 64 + 4 * li) = w;
    }
    { const int m = m0 + (lane >> 5), c4 = 4 * (lane & 31);
      *(v2u*)(QK + (size_t)m * 512 + 384 + c4) = *(const v2u*)(P2 + (size_t)m * PROJ2_W + PC_GV + c4); }
}

__device__ __forceinline__ void hy_transpose_item(Frame& F, int item) {
    LAS bf16* T = (LAS bf16*)F.lds + F.wave * (64 * 66);
    const int lane = F.lane, mb = item >> 2, cb = item & 3;
    const bf16* src = WSP(bf16, WS_RD + RD_YAT) + (size_t)(cb * 64) * M + (size_t)mb * 64;
    bf16* dst = WSP(bf16, WS_Y) + (size_t)(mb * 64) * 1024 + cb * 64;
#pragma unroll
    for (int i = 0; i < 8; ++i) { const int c = 8 * i + (lane >> 3), m0 = (lane & 7) * 8; const v4u v = *(const v4u*)(src + (size_t)c * M + m0);
        LAS unsigned* tp = (LAS unsigned*)(T + c * 66 + m0); tp[0] = v.x; tp[1] = v.y; tp[2] = v.z; tp[3] = v.w; }
    LDS_WAIT(); asm volatile("" ::: "memory");
#pragma unroll
    for (int i = 0; i < 8; ++i) { const int m = 8 * i + (lane >> 3), c0 = (lane & 7) * 8; unsigned short e[8];
#pragma unroll
        for (int j = 0; j < 8; ++j) e[j] = T[(c0 + j) * 66 + m];
        v4u o; o.x = e[0] | ((unsigned)e[1] << 16); o.y = e[2] | ((unsigned)e[3] << 16); o.z = e[4] | ((unsigned)e[5] << 16); o.w = e[6] | ((unsigned)e[7] << 16);
        *(v4u*)(dst + (size_t)m * 1024 + c0) = o; }
    LDS_WAIT(); asm volatile("" ::: "memory");
}
__device__ __forceinline__ void dil_combine_row(Frame& F, int m) {
    const int lane = F.lane, hh = lane >> 4;
    const float* ls = WSP(float, WS_DLSE);
    const float l0 = ls[((size_t)0 * M + m) * 4 + hh], l1 = ls[((size_t)1 * M + m) * 4 + hh], l2 = ls[((size_t)2 * M + m) * 4 + hh];
    const float mx = fmaxf(l0, fmaxf(l1, l2)); const float e0 = expf(l0 - mx), e1 = expf(l1 - mx), e2 = expf(l2 - mx), inv = 1.f / (e0 + e1 + e2);
    const bf16* o = WSP(bf16, WS_RD + RD_DILO) + (size_t)m * 256 + 4 * lane;
    const v2u a = *(const v2u*)o, b = *(const v2u*)(o + (size_t)M * 256), c = *(const v2u*)(o + (size_t)2 * M * 256);
    const float w0 = e0 * inv, w1 = e1 * inv, w2 = e2 * inv;
    v2u r; r.x = pk2(w0 * bflo(a.x) + w1 * bflo(b.x) + w2 * bflo(c.x), w0 * bfhi(a.x) + w1 * bfhi(b.x) + w2 * bfhi(c.x));
    r.y = pk2(w0 * bflo(a.y) + w1 * bflo(b.y) + w2 * bflo(c.y), w0 * bfhi(a.y) + w1 * bfhi(b.y) + w2 * bfhi(c.y));
    *(v2u*)(WSP(bf16, WS_Y) + (size_t)m * 1024 + 256 + 4 * lane) = r;
}

__device__ __forceinline__ void ln1_router_phase(Frame& F, const Args& args, int l) {
    LAS float* RT = (LAS float*)F.lds;
    const float* rw = FIN(I_ROUTER) + (size_t)l * 1024 * 16;
    __syncthreads();
    for (int i = F.tid; i < 1024 * 16; i += 512) { const int col = i >> 4, e = i & 15; RT[e * 1024 + col] = rw[i]; }
    __syncthreads();
    const int gw = F.bid * 8 + F.wave, NGW = F.G * 8, lane = F.lane;
    const bf16* pre = WSP(bf16, WS_RB + RB_PRE);
    v2u nx[4];
#pragma unroll
    for (int j = 0; j < 4; ++j) nx[j] = *(const v2u*)(pre + (size_t)gw * DM + 4 * lane + 256 * j);
    for (int m = gw; m < M; m += NGW) {
        f32x4 v[4];
#pragma unroll
        for (int j = 0; j < 4; ++j) v[j] = (f32x4){bflo(nx[j].x), bfhi(nx[j].x), bflo(nx[j].y), bfhi(nx[j].y)};
        if (m + NGW < M) {
#pragma unroll
            for (int j = 0; j < 4; ++j) nx[j] = *(const v2u*)(pre + (size_t)(m + NGW) * DM + 4 * lane + 256 * j); }
        ln_row(v, FIN(I_LN1G) + l * DM, FIN(I_LN1B) + l * DM, lane);
        store_row_bf16(v, WSP(bf16, WS_HB) + (size_t)m * DM, lane);
        float lg[16];
#pragma unroll
        for (int e = 0; e < 16; ++e) { float a = 0.f;
#pragma unroll
            for (int j = 0; j < 4; ++j) { const f32x4 w = *(const LAS f32x4*)(RT + e * 1024 + 4 * lane + 256 * j); a += v[j].x * w.x + v[j].y * w.y + v[j].z * w.z + v[j].w * w.w; }
            lg[e] = a; if (e & 1) asm volatile("" ::: "memory"); }
#pragma unroll
        for (int e = 0; e < 8; ++e) { const bool up = (lane & 32) != 0; const float keep = up ? lg[e + 8] : lg[e], give = up ? lg[e] : lg[e + 8]; lg[e] = keep + __shfl_xor(give, 32); }
#pragma unroll
        for (int e = 0; e < 4; ++e) { const bool up = (lane & 16) != 0; const float keep = up ? lg[e + 4] : lg[e], give = up ? lg[e] : lg[e + 4]; lg[e] = keep + __shfl_xor(give, 16); }
#pragma unroll
        for (int e = 0; e < 2; ++e) { const bool up = (lane & 8) != 0; const float keep = up ? lg[e + 2] : lg[e], give = up ? lg[e] : lg[e + 2]; lg[e] = keep + __shfl_xor(give, 8); }
        { const bool up = (lane & 4) != 0; const float keep = up ? lg[1] : lg[0], give = up ? lg[0] : lg[1]; lg[0] = keep + __shfl_xor(give, 4); }
        float z = lg[0]; z += __shfl_xor(z, 2); z += __shfl_xor(z, 1);
        float mx = z; mx = fmaxf(mx, __shfl_xor(mx, 4)); mx = fmaxf(mx, __shfl_xor(mx, 8)); mx = fmaxf(mx, __shfl_xor(mx, 16)); mx = fmaxf(mx, __shfl_xor(mx, 32));
        const float p = expf(z - mx); float den = p; den += __shfl_xor(den, 4); den += __shfl_xor(den, 8); den += __shfl_xor(den, 16); den += __shfl_xor(den, 32);
        if ((lane & 3) == 0) { const int e = ((lane >> 5) & 1) * 8 + ((lane >> 4) & 1) * 4 + ((lane >> 3) & 1) * 2 + ((lane >> 2) & 1); WSP(float, WS_AFF)[(size_t)m * 16 + e] = p / den; }
    }
}

__device__ __forceinline__ int wave_incl_scan(int v, int lane) {
#pragma unroll
    for (int o = 1; o < 64; o <<= 1) { const int n = __shfl_up(v, o); if (lane >= o) v += n; }
    return v;
}
__device__ __forceinline__ int block_excl_scan(Frame& F, int v, LAS int* sc) {
    const int inc = wave_incl_scan(v, F.lane);
    __syncthreads();
    if (F.lane == 63) sc[F.wave] = inc;
    __syncthreads();
    int base = 0;
#pragma unroll
    for (int w = 0; w < 8; ++w) { const int x = sc[w]; if (w < F.wave) base += x; }
    return base + inc - v;
}
__device__ __forceinline__ void topk_item(Frame& F, int e, int b) {
    LAS int* H = (LAS int*)F.lds;
    LAS int* SH = H + 256;
    LAS int* SC = SH + 4;
    LAS int* SEL = SC + 16;
    const int tid = F.tid, lane = F.lane, eb = e * 8 + b;
    const float* aff = WSP(float, WS_AFF) + (size_t)b * SEQ * 16 + e;
    unsigned key[8];
#pragma unroll
    for (int j = 0; j < 8; ++j) key[j] = __float_as_uint(aff[(size_t)(8 * tid + j) * 16]);
    unsigned prefix = 0u, pmask = 0u; int need = CAP;
    for (int pass = 3; pass >= 0; --pass) {
        __syncthreads();
        if (tid < 256) H[tid] = 0;
        __syncthreads();
#pragma unroll
        for (int j = 0; j < 8; ++j) if ((key[j] & pmask) == prefix) __hip_atomic_fetch_add(&H[(key[j] >> (8 * pass)) & 255u], 1, __ATOMIC_RELAXED, __HIP_MEMORY_SCOPE_WORKGROUP);
        __syncthreads();
        if (F.wave == 0) {
            const int c0 = H[255 - 4 * lane], c1 = H[254 - 4 * lane], c2 = H[253 - 4 * lane], c3 = H[252 - 4 * lane];
            const int s = c0 + c1 + c2 + c3, inc = wave_incl_scan(s, lane), exc = inc - s;
            if (exc < need && need <= inc) { const int r = need - exc; int bin, nn;
                if (r <= c0) { bin = 255 - 4 * lane; nn = r; } else if (r <= c0 + c1) { bin = 254 - 4 * lane; nn = r - c0; }
                else if (r <= c0 + c1 + c2) { bin = 253 - 4 * lane; nn = r - c0 - c1; } else { bin = 252 - 4 * lane; nn = r - c0 - c1 - c2; }
                SH[0] = bin; SH[1] = nn; }
        }
        __syncthreads();
        prefix |= (unsigned)SH[0] << (8 * pass); pmask |= 0xffu << (8 * pass); need = SH[1];
    }
    const unsigned thr = prefix;
    int eqc = 0;
#pragma unroll
    for (int j = 0; j < 8; ++j) eqc += (key[j] == thr) ? 1 : 0;
    int eq = block_excl_scan(F, eqc, SC);
    int selc = 0; unsigned selm = 0u;
#pragma unroll
    for (int j = 0; j < 8; ++j) { bool s = key[j] > thr; if (key[j] == thr) { s = eq < need; ++eq; } if (s) { selm |= 1u << j; ++selc; } }
    int slot = block_excl_scan(F, selc, SC);
    unsigned short* inv = WSP(unsigned short, WS_INV) + (size_t)eb * SEQ;
    float* gwp = WSP(float, WS_GW) + (size_t)eb * CAP; int* idx = WSP(int, WS_IDX) + (size_t)eb * CAP;
#pragma unroll
    for (int j = 0; j < 8; ++j) { const int t = 8 * tid + j;
        if ((selm >> j) & 1u) { inv[t] = (unsigned short)(slot + 1); SEL[slot] = t; gwp[slot] = __uint_as_float(key[j]); idx[slot] = t; ++slot; }
        else inv[t] = (unsigned short)0; }
    __syncthreads();
    const bf16* hb = WSP(bf16, WS_HB) + (size_t)b * SEQ * DM; bf16* xs = WSP(bf16, WS_RA + RA_XS) + (size_t)eb * CAP * DM;
    for (int s = F.wave; s < CAP; s += 8) { const int t = SEL[s];
        const v4u* sp = (const v4u*)(hb + (size_t)t * DM); v4u* dp = (v4u*)(xs + (size_t)s * DM);
        dp[F.lane] = sp[F.lane]; dp[F.lane + 64] = sp[F.lane + 64]; }
    __syncthreads();
}

__device__ __forceinline__ void ln2_phase(Frame& F, const Args& args, int l) {
    const int gw = F.bid * 8 + F.wave, NGW = F.G * 8, lane = F.lane;
    const unsigned short* inv = WSP(unsigned short, WS_INV);
    const bf16* eo = WSP(bf16, WS_RA + RA_EOUT);
    v2u nx[4]; unsigned nslv = 0u;
    { const int b = gw >> 12, t = gw & (SEQ - 1); if (lane < NE) nslv = inv[((size_t)(lane * 8 + b)) * SEQ + t];
#pragma unroll
      for (int j = 0; j < 4; ++j) nx[j] = *(const v2u*)(WSP(bf16, WS_HB) + (size_t)gw * DM + 4 * lane + 256 * j); }
    for (int m = gw; m < M; m += NGW) {
        const int b = m >> 12;
        const unsigned slv = nslv;
        f32x4 v[4];
#pragma unroll
        for (int j = 0; j < 4; ++j) v[j] = (f32x4){bflo(nx[j].x), bfhi(nx[j].x), bflo(nx[j].y), bfhi(nx[j].y)} * DN_ALPHA;
        if (m + NGW < M) { const int m2 = m + NGW, b2 = m2 >> 12, t2 = m2 & (SEQ - 1); nslv = 0u; if (lane < NE) nslv = inv[((size_t)(lane * 8 + b2)) * SEQ + t2];
#pragma unroll
            for (int j = 0; j < 4; ++j) nx[j] = *(const v2u*)(WSP(bf16, WS_HB) + (size_t)m2 * DM + 4 * lane + 256 * j); }
        unsigned mask = (unsigned)__ballot(slv != 0u);
        while (mask) {
            int e[4]; float wgt[4];
#pragma unroll
            for (int k = 0; k < 4; ++k) { if (mask) { e[k] = __builtin_ctz(mask); mask &= mask - 1u; wgt[k] = 1.f; } else { e[k] = e[0]; wgt[k] = 0.f; } }
            v2u w[4][4];
#pragma unroll
            for (int k = 0; k < 4; ++k) { const int ek = __builtin_amdgcn_readfirstlane(e[k]); const unsigned sl = (unsigned)__builtin_amdgcn_readlane((int)slv, ek);
                const bf16* r = eo + ((size_t)(ek * 8 + b) * CAP + (sl - 1u)) * DM + 4 * lane;
#pragma unroll
                for (int j = 0; j < 4; ++j) w[k][j] = *(const v2u*)(r + 256 * j); }
#pragma unroll
            for (int k = 0; k < 4; ++k)
#pragma unroll
                for (int j = 0; j < 4; ++j) { v[j].x += wgt[k] * bflo(w[k][j].x); v[j].y += wgt[k] * bfhi(w[k][j].x); v[j].z += wgt[k] * bflo(w[k][j].y); v[j].w += wgt[k] * bfhi(w[k][j].y); }
        }
        ln_row(v, FIN(I_LN2G) + l * DM, FIN(I_LN2B) + l * DM, lane);
        if (l == DEPTH - 1) {
#pragma unroll
            for (int j = 0; j < 4; ++j) *(f32x4*)(F.out + (size_t)m * DM + 4 * lane + 256 * j) = v[j]; }
        else store_row_bf16(v, WSP(bf16, WS_HB) + (size_t)m * DM, lane);
    }
}

struct SchedTiles {
    const char* A0; const char* B0; size_t a_tile, b_tile; int nM, nN, G, c;
    __device__ __forceinline__ bool next(int i, pg8::Unit& u) const {
        const int L = i * G + c; if (L >= nM * nN) return false;
        int pm, pn; pg8::tile_of(L, nM, nN, pm, pn);
        u.A = A0 + (size_t)pm * a_tile; u.B = B0 + (size_t)pn * b_tile; u.orow = pm * 256; u.ocol = pn * 256; u.z = 0; return true;
    }
};
struct SchedMerge {
    const char* Y; const char* WB; int G, c;
    __device__ __forceinline__ bool next(int i, pg8::MergeUnit& u) const {
        const int L = (i >> 2) * G + c, z = i & 3; if (L >= 128 * 8) return false;
        int pm, pn; pg8::tile_of(L, 128, 8, pm, pn);
        u.A = Y + ((size_t)pm * 256 * 1024 + z * 256) * 2; u.B = WB + ((size_t)z * 1024 * 256 + (size_t)pn * 128 * 256) * 2; u.orow = pm * 256; u.ocol = pn * 128; u.z = z; return true;
    }
};
struct SchedMoe1 {
    const char* XS; const char* W; int G, c;
    __device__ __forceinline__ bool next(int i, pg8::Unit& u) const {
        const int L = i * G + c; if (L >= 128 * 16) return false;
        const int eb = L >> 4, sub = L & 15, pm2 = sub & 1, pn = sub >> 1, e = eb >> 3;
        u.A = XS + ((size_t)(eb * 512 + pm2 * 256) * 1024) * 2; u.B = W + ((size_t)(e * 2048 + pn * 256) * 1024) * 2; u.orow = eb * 512 + pm2 * 256; u.ocol = pn * 128; u.z = eb; return true;
    }
};
struct SchedMoe2 {
    const char* HID; const char* W; int G, c;
    __device__ __forceinline__ bool next(int i, pg8::Unit& u) const {
        const int L = i * G + c; if (L >= 128 * 8) return false;
        const int eb = L >> 3, sub = L & 7, pm2 = sub & 1, pn = sub >> 1, e = eb >> 3;
        u.A = HID + ((size_t)(eb * 512 + pm2 * 256) * 1024) * 2; u.B = W + ((size_t)(e * 1024 + pn * 256) * 1024) * 2; u.orow = eb * 512 + pm2 * 256; u.ocol = pn * 256; u.z = eb; return true;
    }
};

static_assert((size_t)(CW_Q + (DEPTH * 8 + 8) * 64) * 4 <= CTL_ZERO_BYTES && (size_t)(CW_BAR + 3456) * 4 <= (size_t)CW_Q * 4, "control words inside the per-call memset");
constexpr int NPH = 12;
__global__ void __launch_bounds__(512, 2) fwd_kernel(Args args_k) {
    const Args& args0 = args_k;
    extern __shared__ __attribute__((aligned(16))) unsigned char lds_raw[];
    Frame F;
    F.lds = (LAS unsigned char*)lds_raw;
    F.MISC = (volatile LAS unsigned*)(F.lds + MISC_OFF);
    F.tid = threadIdx.x; F.lane = F.tid & 63; F.wave = __builtin_amdgcn_readfirstlane(F.tid >> 6);
    F.G = gridDim.x; F.bid = blockIdx.x; F.zoff = 0;
    const int wave0 = __builtin_amdgcn_readfirstlane(threadIdx.x >> 6);
    F.ws = args0.ws; F.out = args0.out; F.ctl = (gu32*)(args0.ws + WS_CTL);
    for (int u = F.tid; u < (LDS_BYTES - MISC_OFF) / 4; u += 512) F.MISC[u] = 0u;
    __syncthreads();
#ifdef DBG_PROF
    if (blockIdx.x == 0 && threadIdx.x == 0) ((unsigned long long*)(args0.ws + WS_CTL))[50000 + 15] = __builtin_amdgcn_s_memrealtime();
#endif
    const bool multi = (args0.l_hi - args0.l_lo > 1) || (args0.ph_hi - args0.ph_lo > 1);
    XcdBarrier bar; bar.bar = (unsigned*)(F.ctl + CW_BAR); bar.x = 0; bar.st = F.MISC + 8;
    if (multi) bar = xcd_barrier_post((unsigned*)(F.ctl + CW_BAR), F.MISC + 8);
    const int lo = args0.ph_lo, hi = args0.ph_hi, l_lo = args0.l_lo, l_hi = args0.l_hi;
#ifndef DBL_MASK
#define DBL_MASK 0
#endif
#define NREP(k) (((DBL_MASK >> (k)) & 1) ? 2 : 1)
#ifndef DBG_ROT
#define DBG_ROT 0
#endif
#ifndef PHASE_MASK
#define PHASE_MASK 0xfff
#endif
#define IN(k) (((PHASE_MASK >> (k)) & 1) && lo <= (k) && (k) < hi)
#ifndef SUB_MASK
#define SUB_MASK 0xff
#endif
#define SUB(k) ((SUB_MASK >> (k)) & 1)
#define FRESH() do { { int b_ = blockIdx.x, g_ = gridDim.x; asm volatile("" : "+s"(b_)); asm volatile("" : "+s"(g_)); F.bid = b_; F.G = g_; } int ln_ = __builtin_amdgcn_mbcnt_hi(~0u, __builtin_amdgcn_mbcnt_lo(~0u, 0u)); asm volatile("" : "+v"(ln_)); int wv_ = wave0; asm volatile("" : "+s"(wv_)); F.lane = ln_; F.wave = wv_; F.tid = wv_ * 64 + ln_; } while (0)
#ifdef DBG_PROF
#define STAMP(k) do { if (blockIdx.x == 0 && threadIdx.x == 0) ((unsigned long long*)(F.ws + WS_CTL))[50000 + l * 16 + (k)] = __builtin_amdgcn_s_memrealtime(); } while (0)
#else
#define STAMP(k) do {} while (0)
#endif
#define SEAM(k) do { if (((k) + 1 < hi) || (l + 1 < l_hi)) { XcdBarrier b2_ = bar; asm volatile("" : "+s"(b2_.x)); asm volatile("" : "+s"(b2_.bar)); xcd_barrier(b2_, F.tid); } STAMP(k); } while (0)

#pragma unroll 1
    for (int l = l_lo; l < l_hi; ++l) {
        const Args& args = args_k;
        { size_t z_ = 0; asm volatile("" : "+s"(z_)); F.ws = args.ws + z_; F.out = args.out + z_; F.ctl = (gu32*)(F.ws + WS_CTL); }
        unsigned char* wb = F.ws + WS_W;
        const char* HBp = (const char*)(F.ws + WS_HB);
#define NGW (F.G * 8)
#define gw (F.bid * 8 + F.wave)
        if (IN(0) && l == 0) { FRESH(); prologue_phase(F, args); SEAM(0); }

        if (IN(1)) _Pragma("unroll 1") for (int rep_ = 0; rep_ < NREP(1); ++rep_) { FRESH();
            const pg8::Gemm g{1024, 1024, 1024};
            if (SUB(0)) {
                SchedTiles S{(const char*)(wb + W_WIN), HBp, (size_t)256 * 1024 * 2, (size_t)256 * 1024 * 2, 3, 128, F.G, F.bid};
                pg8::EpiBf16<0> E{WSP(bf16, WS_RB + RB_HYT), M};
                pg8::gemm_phase(F.lds, g, S, E, F.tid); }
            if (SUB(1)) {
                SchedTiles S{HBp, (const char*)(wb + W_WIN) + (size_t)768 * 1024 * 2, (size_t)256 * 1024 * 2, (size_t)256 * 1024 * 2, 128, 12, F.G, F.bid};
                pg8::EpiBf16<0> E{WSP(bf16, WS_RB + RB_PROJ2), PROJ2_W};
                pg8::gemm_phase(F.lds, g, S, E, F.tid); }
            if (SUB(2)) {
                SchedTiles S{HBp, (const char*)(wb + W_WIN) + (size_t)3840 * 1024 * 2, (size_t)256 * 1024 * 2, (size_t)256 * 1024 * 2, 128, 16, F.G, (F.bid + DBG_ROT) % F.G};
                pg8::EpiBf16<1> E{WSP(bf16, WS_RA + RA_G), 4096};
                pg8::gemm_phase(F.lds, g, S, E, F.tid); }
            SEAM(1);
        }
        if (IN(2)) _Pragma("unroll 1") for (int rep_ = 0; rep_ < NREP(2); ++rep_) { FRESH();
            if (l == 0) { for (int tb = F.bid; tb < 256; tb += F.G) hy_taps_block(F, args, 0, tb); __syncthreads(); }
            _Pragma("unroll 2") for (int m = 2 * gw; m < M; m += 2 * NGW) gqa_prep_rows(F, args, l, m);
            for (int r = gw; r < 768 * 8; r += NGW) hy_sconv_row(F, args, l, r);
            SEAM(2); }

        if (IN(3)) _Pragma("unroll 1") for (int rep_ = 0; rep_ < NREP(3); ++rep_) { FRESH();
#if MK_STATIC_Q
            if (SUB(0)) for (int it = F.bid; it < 256; it += F.G) hyena_item(F, args, l, it);
            if (SUB(1)) {   const attn_body::bf16* Qp = (const attn_body::bf16*)(F.ws + WS_RD + RD_QKVG);
                attn_body::bf16* Op = (attn_body::bf16*)(F.ws + WS_Y) + 768;
                for (int it = F.bid; it < 512; it += F.G) { __syncthreads();
                    attn_body::attn_unit<8>(it >> 6, (it >> 4) & 3, it & 15, Qp, Qp + 256, Qp + 384, Op, (char*)lds_raw, F.tid); } }
            if (SUB(2)) for (int it = F.bid; it < 128; it += F.G) s5_item(F, args, l, it >> 4, it & 15);
            __syncthreads();
            if (SUB(3)) for (int it = F.bid; it < 1536; it += F.G) dil_item(F, args, it);
#else
#ifndef DBL_SUB
#define DBL_SUB 0
#endif
#define NREPS(t) (((DBL_SUB >> (t)) & 1) ? 2 : 1)
            _Pragma("unroll 1") for (int r2 = 0; r2 < NREPS(2); ++r2) for (;;) { const int it = wq_grab(F, l * 8 + r2 * 4 + 2); if (it >= 128) break; s5_item(F, args, l, it >> 4, it & 15); }
            _Pragma("unroll 1") for (int r2 = 0; r2 < NREPS(0); ++r2) for (;;) { const int it = wq_grab(F, l * 8 + r2 * 4 + 0); if (it >= 256) break; hyena_item(F, args, l, it); }
            {   const attn_body::bf16* Qp = (const attn_body::bf16*)(F.ws + WS_RD + RD_QKVG);
                attn_body::bf16* Op = (attn_body::bf16*)(F.ws + WS_Y) + 768;
                _Pragma("unroll 1") for (int r2 = 0; r2 < NREPS(1); ++r2) for (;;) { const int it = wq_grab(F, l * 8 + r2 * 4 + 1); if (it >= 512) break;
                    attn_body::attn_unit<8>(it >> 6, (it >> 4) & 3, it & 15, Qp, Qp + 256, Qp + 384, Op, (char*)lds_raw, F.tid); } }
            _Pragma("unroll 1") for (int r2 = 0; r2 < NREPS(3); ++r2) for (;;) { const int it = wq_grab(F, l * 8 + r2 * 4 + 3); if (it >= 1536) break; dil_item(F, args, it); }
#endif
            SEAM(3);
        }
        if (IN(4)) _Pragma("unroll 1") for (int rep_ = 0; rep_ < NREP(4); ++rep_) { FRESH();
            if (SUB(0)) {   const pg8::Gemm g{256, 256, 256};
                SchedTiles S{(const char*)(F.ws + WS_RD + RD_S5Z), (const char*)(wb + W_GLU), (size_t)256 * 256 * 2, 0, 128, 1, F.G, F.bid};
                pg8::EpiGlu E{WSP(bf16, WS_RD + RD_S5Z), WSP(bf16, WS_Y), FIN(I_S5_GB) + l * 256};
                pg8::gemm_phase(F.lds, g, S, E, F.tid); }
            __syncthreads();
            if (SUB(1)) for (int it = gw; it < 2048; it += NGW) hy_transpose_item(F, it);
            if (SUB(2)) for (int m = gw; m < M; m += NGW) dil_combine_row(F, m);
            SEAM(4);
        }
        if (IN(5)) _Pragma("unroll 1") for (int rep_ = 0; rep_ < NREP(5); ++rep_) { FRESH();
            const pg8::Gemm g{256, 1024, 256};
            SchedMerge S{(const char*)(F.ws + WS_Y), (const char*)(wb + W_WB), F.G, F.bid};
            pg8::gemm_merge_phase(F.lds, g, S, WSP(bf16, WS_RA + RA_G), WSP(bf16, WS_RB + RB_MB), F.tid);
            SEAM(5);
        }
        if (IN(6)) _Pragma("unroll 1") for (int rep_ = 0; rep_ < NREP(6); ++rep_) { FRESH();
            const pg8::Gemm g{1024, 1024, 1024};
            SchedTiles S{(const char*)(F.ws + WS_RB + RB_MB), (const char*)(wb + W_WO), (size_t)256 * 1024 * 2, (size_t)256 * 1024 * 2, 128, 4, F.G, F.bid};
            pg8::EpiPre E{WSP(bf16, WS_HB), WSP(bf16, WS_RB + RB_PRE), DN_ALPHA};
            pg8::gemm_phase(F.lds, g, S, E, F.tid);
            SEAM(6);
        }
        if (IN(7)) _Pragma("unroll 1") for (int rep_ = 0; rep_ < NREP(7); ++rep_) { FRESH(); ln1_router_phase(F, args, l); SEAM(7); }
        if (IN(8)) _Pragma("unroll 1") for (int rep_ = 0; rep_ < NREP(8); ++rep_) { FRESH(); for (int it = F.bid; it < 128; it += F.G) topk_item(F, it >> 3, it & 7);
            if (l + 1 < DEPTH && F.G > 128) { __syncthreads(); for (int tb = F.bid - 128; tb >= 0 && tb < 256; tb += F.G - 128) hy_taps_block(F, args, l + 1, tb); }
            else if (l + 1 < DEPTH) { __syncthreads(); for (int tb = F.bid; tb < 256; tb += F.G) hy_taps_block(F, args, l + 1, tb); }
            SEAM(8); }
        if (IN(9)) _Pragma("unroll 1") for (int rep_ = 0; rep_ < NREP(9); ++rep_) { FRESH();
            const pg8::Gemm g{1024, 1024, 1024};
            SchedMoe1 S{(const char*)(F.ws + WS_RA + RA_XS), (const char*)(wb + W_GU), F.G, F.bid};
            pg8::EpiSwiglu E{WSP(bf16, WS_RB + RB_HID)};
            pg8::gemm_phase(F.lds, g, S, E, F.tid);
            SEAM(9);
        }
        if (IN(10)) _Pragma("unroll 1") for (int rep_ = 0; rep_ < NREP(10); ++rep_) { FRESH();
            const pg8::Gemm g{1024, 1024, 1024};
            SchedMoe2 S{(const char*)(F.ws + WS_RB + RB_HID), (const char*)(wb + W_DN), F.G, F.bid};
            pg8::EpiRowScale E{WSP(bf16, WS_RA + RA_EOUT), WSP(float, WS_GW)};
            pg8::gemm_phase(F.lds, g, S, E, F.tid);
            SEAM(10);
        }
        if (IN(11)) { FRESH();
            ln2_phase(F, args, l);
            if (l + 1 < DEPTH) convert_layer(F, args, l + 1, gw, NGW);
#ifdef DBG_CONV2
            if (l + 1 < DEPTH) convert_layer(F, args, l + 1, gw, NGW);
#endif
            SEAM(11);
        }
    }
    if (multi) {
        { XcdBarrier b2_ = bar; asm volatile("" : "+s"(b2_.x)); asm volatile("" : "+s"(b2_.bar)); xcd_barrier(b2_, F.tid); }
        if (__hip_atomic_load((unsigned*)(F.ctl + CW_BAR) + XB_TMO, RLX_AGENT) != 0u) {
            const float q = __builtin_nanf("");
            for (size_t i = (size_t)F.bid * 512 + F.tid; i < (size_t)M * DM; i += (size_t)F.G * 512) args0.out[i] = q; }
    }
#undef IN
#undef gw
#undef NGW
#undef SEAM
}


#ifdef DBG_STOP
__global__ void dbg_dump_kernel(const unsigned char* ws, float* out, size_t off, int isf32, int ld, int ncols) {
    const size_t n = (size_t)M * DM;
    for (size_t i = (size_t)blockIdx.x * blockDim.x + threadIdx.x; i < n; i += (size_t)gridDim.x * blockDim.x) {
        const size_t r = i / DM, c = i % DM; float v = 0.f;
        if ((int)c < ncols) { if (isf32) v = ((const float*)(ws + off))[r * ld + c]; else v = bf2f(((const bf16*)(ws + off))[r * ld + c]); }
        out[i] = v; }
}
#endif

#ifdef DBG_RACE
constexpr int CW_DBG = 65536;
__global__ void dbg_sum_kernel(const unsigned* p, size_t nwords, unsigned long long* slot) {
    unsigned long long s = 0;
    for (size_t i = (size_t)blockIdx.x * blockDim.x + threadIdx.x; i < nwords; i += (size_t)gridDim.x * blockDim.x) s += (unsigned long long)p[i] * (unsigned long long)((i & 1023u) + 1u);
    for (int o = 32; o >= 1; o >>= 1) s += __shfl_xor(s, o);
    if ((threadIdx.x & 63) == 0) atomicAdd(slot, s);
}
__global__ void dbg_final_kernel(const unsigned long long* T, float* out) {
    int V = 0;
    for (int s = 56; s <= 60; ++s) if (T[s] != T[64 + s]) V |= 1 << (s - 56);
    const float c = 10.f * (float)(V + 1);
    for (size_t i = (size_t)blockIdx.x * blockDim.x + threadIdx.x; i < (size_t)M * DM; i += (size_t)gridDim.x * blockDim.x) out[i] = c;
}
#endif

#ifdef DBG_STAT
__global__ void dbg_stat_kernel(const unsigned char* ws, size_t off, int ld, int ncols, unsigned* res) {
    unsigned mx = 0, cnt = 0;
    for (size_t i = (size_t)blockIdx.x * blockDim.x + threadIdx.x; i < (size_t)M * ncols; i += (size_t)gridDim.x * blockDim.x) {
        const size_t r = i / ncols, c = i % ncols; const float v = fabsf(bf2f(((const bf16*)(ws + off))[r * ld + c]));
        const unsigned b = __float_as_uint(v); mx = b > mx ? b : mx; cnt += (v > DBG_THR || v != v) ? 1u : 0u; }
    atomicMax(res, mx); atomicAdd(res + 1, cnt);
    for (size_t r = (size_t)blockIdx.x * blockDim.x + threadIdx.x; r < (size_t)M; r += (size_t)gridDim.x * blockDim.x) { bool bad = false; unsigned first = 0xffffffffu;
        for (int c = 0; c < ncols; ++c) { const float v = fabsf(bf2f(((const bf16*)(ws + off))[r * ld + c])); if (v > DBG_THR || v != v) { bad = true; if (first == 0xffffffffu) first = c; } }
        if (bad) { atomicAdd(res + 2, 1u); atomicMin(res + 3, (unsigned)r); atomicMin(res + 4, first); } }
}
__global__ void dbg_statout_kernel(const unsigned* res, float* out) {
    const float c = DBG_STAT == 0 ? 100.f * __uint_as_float(res[0]) : DBG_STAT == 1 ? sqrtf((float)res[1]) : DBG_STAT == 2 ? sqrtf((float)res[2]) : DBG_STAT == 3 ? (float)(res[3] / 2048u + 20u) : (float)(res[4] / 256u + 20u);
    for (size_t i = (size_t)blockIdx.x * blockDim.x + threadIdx.x; i < (size_t)M * DM; i += (size_t)gridDim.x * blockDim.x) out[i] = c;
}
#endif

#ifdef DBG_PROF
__global__ void dbg_prof_kernel(const unsigned long long* ts, float* out) {
    float tp[12];
    for (int p = 0; p < 12; ++p) { double s = 0; for (int l = 0; l < DEPTH; ++l) { if (p == 0 && l > 0) continue;
        const unsigned long long e = ts[l * 16 + p]; unsigned long long b;
        if (p == 0) b = ts[15]; else if (p == 1 && l > 0) b = ts[(l - 1) * 16 + 11]; else b = ts[l * 16 + p - 1];
        if (p == 11 && l == DEPTH - 1) continue;
        s += (double)(e - b) * 0.01; } tp[p] = (float)s; }
    const float c = tp[DBG_PA], d = 1000.f * tp[DBG_PB];
    for (size_t i = (size_t)blockIdx.x * blockDim.x + threadIdx.x; i < (size_t)M * DM; i += (size_t)gridDim.x * blockDim.x) out[i] = (i == 0) ? d : c;
}
#endif
extern "C" void kernel_launch(void* const* d_in, const int* in_sizes, int n_in, void* d_out, int out_size, void* d_ws, size_t ws_size, hipStream_t stream) {
    static int grid = 0;
    if (grid == 0) {
        if (n_in != N_INPUTS || out_size != M * DM || ws_size < WS_END) { fprintf(stderr, "kernel_launch: unexpected problem (n_in %d, out %d, ws %zu)\n", n_in, out_size, ws_size); grid = -1; return; }
        int dev = 0, cus = 0, per_cu = 0;
        if (hipGetDevice(&dev) != hipSuccess || hipDeviceGetAttribute(&cus, hipDeviceAttributeMultiprocessorCount, dev) != hipSuccess) { grid = -1; return; }
        if (hipFuncSetAttribute((const void*)fwd_kernel, hipFuncAttributeMaxDynamicSharedMemorySize, LDS_BYTES) != hipSuccess) { fprintf(stderr, "kernel_launch: hipFuncSetAttribute failed\n"); grid = -1; return; }
        if (hipOccupancyMaxActiveBlocksPerMultiprocessor(&per_cu, (const void*)fwd_kernel, 512, LDS_BYTES) != hipSuccess || per_cu < 1)
            fprintf(stderr, "kernel_launch: occupancy query reports %d workgroups per CU\n", per_cu);
        (void)hipGetLastError();
        grid = cus;
    }
    if (grid < 0) return;
    if (hipMemsetAsync((char*)d_ws + WS_CTL, 0, CTL_ZERO_BYTES, stream) != hipSuccess) return;
    Args a{};
    for (int i = 0; i < N_INPUTS; ++i) a.in[i] = (const float*)d_in[i];
    a.out = (float*)d_out; a.ws = (unsigned char*)d_ws;
#if MK_ONE_LAUNCH
    a.ph_lo = 0; a.ph_hi = NPH; a.l_lo = 0; a.l_hi = DEPTH;
    hipLaunchKernelGGL(fwd_kernel, dim3(grid), dim3(512), LDS_BYTES, stream, a);
#ifdef DBG_PROF
    hipLaunchKernelGGL(dbg_prof_kernel, dim3(1024), dim3(256), 0, stream, (const unsigned long long*)((char*)d_ws + WS_CTL) + 50000, (float*)d_out);
#endif
#else
#ifdef DBG_RACE
    {
    unsigned char* ws = (unsigned char*)d_ws; unsigned long long* T = (unsigned long long*)(ws + WS_CTL) + CW_DBG / 2;
    auto sum = [&](size_t off, size_t bytes, int slot) { hipLaunchKernelGGL(dbg_sum_kernel, dim3(1024), dim3(256), 0, stream, (const unsigned*)(ws + off), bytes / 4, T + slot); };
    auto sumout = [&](int slot) { hipLaunchKernelGGL(dbg_sum_kernel, dim3(1024), dim3(256), 0, stream, (const unsigned*)d_out, (size_t)M * DM, T + slot); };
    for (int run = 0; run < 2; ++run) {
        if (run == 1) hipMemsetAsync((char*)d_ws + WS_CTL, 0, CW_DBG * 4, stream);
        hipMemsetAsync((char*)d_ws + 1 * MiB, run == 0 ? 0xAA : 0x55, WS_END - 1 * MiB, stream);
        for (int l = 0; l < DBG_LAYERS; ++l)
            for (int p = (l == 0 ? 0 : 1); p < DBG_NPH; ++p) { a.ph_lo = p; a.ph_hi = p + 1; a.l_lo = l; a.l_hi = l + 1;
                hipLaunchKernelGGL(fwd_kernel, dim3(grid), dim3(512), LDS_BYTES, stream, a);
                const int s = run * 64 + l * 12 + p;
                switch (p) {
                case 0: sum(WS_HB, 64 * MiB, s); sumout(s); sum(WS_W, 115 * MiB, s); sum(WS_S5W, 64 * MiB, s); sum(WS_HF2, 4 * MiB, s); sum(WS_ROPE, 8 * KiB, s); sum(WS_S5A32, 64 * KiB, s); break;
                case 1: sum(WS_RB, 240 * MiB, s); sum(WS_RA, 256 * MiB, s); break;
                case 2: sum(WS_RD + RD_QKVG, 32 * MiB, s); break;
                case 3: sum(WS_RD + RD_YAT, 16 * MiB, run * 64 + 56); sum(WS_RD + RD_HV, 32 * MiB, run * 64 + 57); sum(WS_RD + RD_DILO, 48 * MiB, run * 64 + 58); sum(WS_DLSE, 1536 * KiB, run * 64 + 59); sum(WS_RD + RD_S5Z, 16 * MiB, run * 64 + 60); break;
                case 4: sum(WS_Y, 64 * MiB, s); break;
                case 5: sum(WS_RB + RB_MB, 64 * MiB, s); sum(WS_RB, 128 * MiB, s); break;
                case 6: sum(WS_RB, 128 * MiB, s); break;
                case 7: sumout(s); sum(WS_HB, 64 * MiB, s); sum(WS_AFF, 2 * MiB, s); break;
                case 8: sum(WS_RA, 128 * MiB, s); sum(WS_IDX, 512 * KiB, s); sum(WS_INV, 1 * MiB, s); break;
                case 9: sum(WS_RB, 128 * MiB, s); break;
                case 10: sum(WS_RA + RA_EOUT, 128 * MiB, s); break;
                case 11: sumout(s); sum(WS_HB, 64 * MiB, s); break;
                } }
    }
    hipLaunchKernelGGL(dbg_final_kernel, dim3(1024), dim3(256), 0, stream, (const unsigned long long*)T, (float*)d_out);
    }
#elif defined(DBG_STOP)
    for (int l = 0; l <= DBG_STOP_L; ++l)
        for (int p = (l == 0 ? 0 : 1); p < NPH; ++p) { if (l == DBG_STOP_L && p > DBG_STOP) break; a.ph_lo = p; a.ph_hi = p + 1; a.l_lo = l; a.l_hi = l + 1;
            hipLaunchKernelGGL(fwd_kernel, dim3(grid), dim3(512), LDS_BYTES, stream, a);
#ifdef DBG_REPEAT
            if (p == DBG_REPEAT) hipLaunchKernelGGL(fwd_kernel, dim3(grid), dim3(512), LDS_BYTES, stream, a);
#endif
            }
#ifdef DBG_STAT
    { unsigned* res = (unsigned*)((char*)d_ws + WS_CTL) + 100000; hipMemsetAsync(res + 3, 0x7f, 8, stream); hipLaunchKernelGGL(dbg_stat_kernel, dim3(2048), dim3(256), 0, stream, (const unsigned char*)d_ws, (size_t)(DBG_OFF), DBG_LD, DBG_NC, res);
      hipLaunchKernelGGL(dbg_statout_kernel, dim3(2048), dim3(256), 0, stream, (const unsigned*)res, (float*)d_out); }
#elif defined(DBG_OFF)
    hipLaunchKernelGGL(dbg_dump_kernel, dim3(2048), dim3(256), 0, stream, (const unsigned char*)d_ws, (float*)d_out, (size_t)(DBG_OFF), DBG_F32, DBG_LD, DBG_NC);
#endif
#else
    for (int l = 0; l < DEPTH; ++l)
        for (int p = (l == 0 ? 0 : 1); p < NPH; ++p) { a.ph_lo = p; a.ph_hi = p + 1; a.l_lo = l; a.l_hi = l + 1;
            hipLaunchKernelGGL(fwd_kernel, dim3(grid), dim3(512), LDS_BYTES, stream, a); }
#endif
#endif
}
```

```cpp
#include <hip/hip_runtime.h>
#include <hip/hip_bf16.h>
#include <cstdio>
#include <cstdint>
#include <cmath>

#ifndef MK_STATIC_Q
#define MK_STATIC_Q 0
#endif
#ifndef MK_ONE_LAUNCH
#define MK_ONE_LAUNCH 1
#endif

constexpr int BATCH = 8, SEQ = 4096, DM = 1024, DEPTH = 4, M = BATCH * SEQ;
constexpr int NIN = 7936;
constexpr int NE = 16, CAP = 512, FFD = 1024;
constexpr float LN_EPS = 1e-5f, RMS_EPS = 1e-6f;
constexpr float DN_ALPHA = 1.6817928305074292f;
constexpr int PC_DQ = 0, PC_DK = 768, PC_DV = 1536, PC_S5 = 2304, PC_GQ = 2560, PC_GK = 2816, PC_GV = 2944, PROJ2_W = 3072;
enum { I_X = 0, I_LNIN_G, I_LNIN_B, I_WIN, I_HY_CW, I_HY_CB, I_HY_W1, I_HY_B1, I_HY_W2, I_HY_B2, I_HY_W3, I_HY_FREQ, I_HY_BIAS,
       I_S5_LRE, I_S5_LIM, I_S5_LDT, I_S5_BRE, I_S5_BIM, I_S5_CRE, I_S5_CIM, I_S5_D, I_S5_GW, I_S5_GB, I_GQ_QN, I_GQ_KN,
       I_WBR, I_WOUT, I_LN1G, I_LN1B, I_ROUTER, I_EWG, I_EWU, I_EWD, I_LN2G, I_LN2B, N_INPUTS };

constexpr size_t MiB = 1u << 20, KiB = 1u << 10;
constexpr size_t WS_CTL = 0, CTL_ZERO_BYTES = 64 * KiB;
constexpr size_t WS_AFF = 1 * MiB;
constexpr size_t WS_IDX = 3 * MiB;
constexpr size_t WS_GW = 3 * MiB + 256 * KiB;
constexpr size_t WS_INV = 4 * MiB;
constexpr size_t WS_DLSE = 5 * MiB;
constexpr size_t WS_ROPE = 7 * MiB;
constexpr size_t WS_S5A32 = 7 * MiB + 256 * KiB;
constexpr size_t WS_HF2 = 8 * MiB;
constexpr size_t WS_S5W = 12 * MiB;
constexpr size_t S5W_LAYER = 16 * MiB, S5_WST_OFF = 0, S5_WCAT_OFF = 4 * MiB;
constexpr size_t WS_W = 76 * MiB;
constexpr size_t W_WIN = 0;
constexpr size_t W_WB = W_WIN + (size_t)NIN * DM * 2;
constexpr size_t W_WO = W_WB + (size_t)4 * 1024 * 256 * 2;
constexpr size_t W_GLU = W_WO + (size_t)1024 * 1024 * 2;
constexpr size_t W_GU = W_GLU + (size_t)256 * 256 * 2;
constexpr size_t W_DN = W_GU + (size_t)16 * 2048 * 1024 * 2;
constexpr size_t W_END = W_DN + (size_t)16 * 1024 * 1024 * 2;
static_assert(W_END <= 116 * MiB, "weights region");
constexpr size_t WS_HB = 192 * MiB;
constexpr size_t WS_RA = 256 * MiB;
constexpr size_t WS_RB = 512 * MiB;
constexpr size_t RB_HYT = 0, RB_PROJ2 = 48 * MiB, RB_MF32 = 0, RB_PRE = 0, RB_HID = 0, RB_MB = 128 * MiB;
constexpr size_t RA_G = 0, RA_XS = 0, RA_EOUT = 128 * MiB;
constexpr size_t WS_Y = 768 * MiB;
constexpr size_t WS_RD = 832 * MiB;
constexpr size_t RD_YAT = 0;
constexpr size_t RD_DILO = 16 * MiB;
constexpr size_t RD_S5Z = 64 * MiB;
constexpr size_t RD_HV = 80 * MiB;
constexpr size_t RD_QKVG = 112 * MiB;
constexpr size_t WS_TT = 976 * MiB;
constexpr size_t WS_END = 992 * MiB;

constexpr int CW_BAR = 4096;
constexpr int CW_Q = 8192;

constexpr int LDS_SCRATCH = 147456;
constexpr int MISC_OFF = LDS_SCRATCH;
constexpr int LDS_BYTES = LDS_SCRATCH + 1024;

#define GAS __attribute__((address_space(1)))
#define LAS __attribute__((address_space(3)))
typedef unsigned short bf16;
typedef unsigned v4u __attribute__((ext_vector_type(4)));
typedef unsigned v2u __attribute__((ext_vector_type(2)));
typedef float f32x4 __attribute__((ext_vector_type(4)));
typedef float f32x2 __attribute__((ext_vector_type(2)));
typedef float f32x16 __attribute__((ext_vector_type(16)));
typedef short bf16x8 __attribute__((ext_vector_type(8)));
typedef short s16x4 __attribute__((ext_vector_type(4)));
typedef GAS unsigned gu32;
#define RLX_AGENT __ATOMIC_RELAXED, __HIP_MEMORY_SCOPE_AGENT
#define LDS_WAIT() asm volatile("s_waitcnt lgkmcnt(0)" ::: "memory")
#define VM_WAIT() asm volatile("s_waitcnt vmcnt(0)" ::: "memory")

__device__ __forceinline__ unsigned f2bf(float f) { unsigned u = __builtin_bit_cast(unsigned, f); return (u + 0x7fffu + ((u >> 16) & 1u)) >> 16; }
__device__ __forceinline__ unsigned pk2(float lo, float hi) { return f2bf(lo) | (f2bf(hi) << 16); }
__device__ __forceinline__ float bf2f(unsigned short b) { return __builtin_bit_cast(float, (unsigned)b << 16); }
__device__ __forceinline__ float bflo(unsigned w) { return __builtin_bit_cast(float, w << 16); }
__device__ __forceinline__ float bfhi(unsigned w) { return __builtin_bit_cast(float, w & 0xffff0000u); }
__device__ __forceinline__ float sigmoidf_(float x) { return __builtin_amdgcn_rcpf(1.0f + __builtin_amdgcn_exp2f(-1.4426950408889634f * x)); }
__device__ __forceinline__ float wave_sum(float v) {
#pragma unroll
    for (int o = 1; o < 64; o <<= 1) v += __shfl_xor(v, o);
    return v;
}
__device__ __forceinline__ float wave_max(float v) {
#pragma unroll
    for (int o = 1; o < 64; o <<= 1) v = fmaxf(v, __shfl_xor(v, o));
    return v;
}

namespace pg8 {
#define PG8_LAS __attribute__((address_space(3)))
typedef unsigned short bf16_t;
typedef unsigned u32x4 __attribute__((ext_vector_type(4)));
constexpr int BM = 256, BK = 64, HALF = 128, HTB = HALF * BK * 2  , STAGE_BYTES = 8 * HTB, NXCD = 8, WGM = 8;

__host__ __device__ __forceinline__ int lds_byte(int r, int c) { const int st = (r >> 4) * 2 + (c >> 5), rr = r & 15, cc = c & 31, ob = rr * 64 + cc * 2; return st * 1024 + (ob ^ (((ob >> 9) & 1) << 5)); }
__host__ __device__ __forceinline__ void stage_rc(int b, int& R, int& C) { const int st = b / 1024, sb = b % 1024, swz = sb ^ (((sb >> 9) & 1) << 5); R = (st >> 1) * 16 + swz / 64; C = (st & 1) * 32 + (swz % 64) / 2; }
__host__ __device__ __forceinline__ int perm32(int rho) { const int n = rho >> 4, i = rho & 15; return 8 * (i >> 2) + 4 * n + (i & 3); }

struct Unit { const char* A; const char* B; int orow, ocol, z; };
struct Gemm { int K, lda, ldb; };

__device__ __forceinline__ void tile_of(int L, int nM, int nN, int& pm, int& pn) {
    const int nwg = nM * nN; int wgid = L; { const int q = nwg / NXCD, r = nwg % NXCD, xcd = wgid % NXCD, off = wgid / NXCD; wgid = (xcd < r ? xcd * (q + 1) : r * (q + 1) + (xcd - r) * q) + off; }
    const int nig = WGM * nN, gid = wgid / nig, fm = gid * WGM, gsz = (nM - fm) < WGM ? (nM - fm) : WGM;
    pm = fm + ((wgid % nig) % gsz); pn = (wgid % nig) / gsz;
}

typedef __bf16 bf16x2_t __attribute__((ext_vector_type(2)));
__device__ __forceinline__ unsigned cvt_pk_bf16(float lo, float hi) { const f32x2 v = {lo, hi}; const bf16x2_t b = __builtin_convertvector(v, bf16x2_t); return __builtin_bit_cast(unsigned, b); }
template <int ACT  > struct EpiBf16 {
    static constexpr bool PERM = true;
    bf16_t* O; int ldc;
    __device__ __forceinline__ void operator()(const f32x4 (&acc)[2][2][4][2], const Unit& u, int wr, int wc, int fr, int fq) const {
        const int row0 = u.orow + wr * 64 + fr, col0 = u.ocol + wc * 32 + 8 * fq;
#pragma unroll
        for (int ai = 0; ai < 2; ++ai)
#pragma unroll
            for (int m = 0; m < 4; ++m) { bf16_t* rowp = O + (size_t)(row0 + ai * HALF + m * 16) * ldc + col0;
#pragma unroll
                for (int bj = 0; bj < 2; ++bj) { f32x4 v0 = acc[ai][bj][m][0], v1 = acc[ai][bj][m][1];
                    if (ACT == 1) {
#pragma unroll
                        for (int j = 0; j < 4; ++j) { v0[j] = sigmoidf_(v0[j]); v1[j] = sigmoidf_(v1[j]); }
#ifdef DBG_HALF
                        for (int j = 0; j < 4; ++j) { v0[j] = 0.5f; v1[j] = 0.5f; }
#endif
                    }
                    u32x4 w; w.x = cvt_pk_bf16(v0[0], v0[1]); w.y = cvt_pk_bf16(v0[2], v0[3]); w.z = cvt_pk_bf16(v1[0], v1[1]); w.w = cvt_pk_bf16(v1[2], v1[3]);
                    *(u32x4*)(rowp + bj * HALF) = w; } }
    }
};
struct EpiMerge {
    static constexpr bool PERM = true;
    const bf16_t* G; float* F; bf16_t* MB;
    __device__ __forceinline__ void operator()(const f32x4 (&acc)[2][2][4][2], const Unit& u, int wr, int wc, int fr, int fq) const {
        const int row0 = u.orow + wr * 64 + fr, col0 = u.ocol + wc * 32 + 8 * fq, i = u.z;
#pragma unroll
        for (int ai = 0; ai < 2; ++ai)
#pragma unroll
            for (int m = 0; m < 4; ++m) { const size_t row = (size_t)(row0 + ai * HALF + m * 16);
#pragma unroll
                for (int bj = 0; bj < 2; ++bj) { const int col = col0 + bj * HALF;
                    const u32x4 g = *(const u32x4*)(G + row * 4096 + i * 1024 + col);
                    f32x4 v0 = acc[ai][bj][m][0], v1 = acc[ai][bj][m][1];
                    v0[0] *= bflo(g.x); v0[1] *= bfhi(g.x); v0[2] *= bflo(g.y); v0[3] *= bfhi(g.y);
                    v1[0] *= bflo(g.z); v1[1] *= bfhi(g.z); v1[2] *= bflo(g.w); v1[3] *= bfhi(g.w);
                    float* fp = F + row * 1024 + col;
                    if (i > 0) { f32x4 p0, p1;
                        asm volatile("global_load_dwordx4 %0, %2, off sc0 sc1\n\tglobal_load_dwordx4 %1, %2, off offset:16 sc0 sc1\n\ts_waitcnt vmcnt(0)" : "=&v"(p0), "=&v"(p1) : "v"(fp) : "memory");
                        v0 += p0; v1 += p1; }
                    if (i < 3) { *(f32x4*)fp = v0; *(f32x4*)(fp + 4) = v1; }
                    else { u32x4 w; w.x = cvt_pk_bf16(v0[0], v0[1]); w.y = cvt_pk_bf16(v0[2], v0[3]); w.z = cvt_pk_bf16(v1[0], v1[1]); w.w = cvt_pk_bf16(v1[2], v1[3]);
                        *(u32x4*)(MB + row * 1024 + col) = w; } } }
    }
};
struct EpiPre {
    static constexpr bool PERM = true;
    const bf16_t* H; bf16_t* P; float alpha;
    __device__ __forceinline__ void operator()(const f32x4 (&acc)[2][2][4][2], const Unit& u, int wr, int wc, int fr, int fq) const {
        const int row0 = u.orow + wr * 64 + fr, col0 = u.ocol + wc * 32 + 8 * fq;
#pragma unroll
        for (int ai = 0; ai < 2; ++ai)
#pragma unroll
            for (int m = 0; m < 4; ++m) { const size_t off = (size_t)(row0 + ai * HALF + m * 16) * 1024 + col0;
#pragma unroll
                for (int bj = 0; bj < 2; ++bj) { const u32x4 h = *(const u32x4*)(H + off + bj * HALF); const f32x4 a0 = acc[ai][bj][m][0], a1 = acc[ai][bj][m][1];
                    u32x4 w; w.x = cvt_pk_bf16(bflo(h.x) * alpha + a0[0], bfhi(h.x) * alpha + a0[1]); w.y = cvt_pk_bf16(bflo(h.y) * alpha + a0[2], bfhi(h.y) * alpha + a0[3]);
                    w.z = cvt_pk_bf16(bflo(h.z) * alpha + a1[0], bfhi(h.z) * alpha + a1[1]); w.w = cvt_pk_bf16(bflo(h.w) * alpha + a1[2], bfhi(h.w) * alpha + a1[3]);
                    *(u32x4*)(P + off + bj * HALF) = w; } }
    }
};
struct EpiSwiglu {
    static constexpr bool PERM = true;
    bf16_t* O;
    __device__ __forceinline__ void operator()(const f32x4 (&acc)[2][2][4][2], const Unit& u, int wr, int wc, int fr, int fq) const {
        const int row0 = u.orow + wr * 64 + fr, col0 = u.ocol + wc * 32 + 8 * fq;
#pragma unroll
        for (int ai = 0; ai < 2; ++ai)
#pragma unroll
            for (int m = 0; m < 4; ++m) { f32x4 v[2];
#pragma unroll
                for (int n = 0; n < 2; ++n)
#pragma unroll
                    for (int j = 0; j < 4; ++j) { const float g = acc[ai][0][m][n][j]; v[n][j] = g * sigmoidf_(g) * acc[ai][1][m][n][j]; }
                u32x4 w; w.x = cvt_pk_bf16(v[0][0], v[0][1]); w.y = cvt_pk_bf16(v[0][2], v[0][3]); w.z = cvt_pk_bf16(v[1][0], v[1][1]); w.w = cvt_pk_bf16(v[1][2], v[1][3]);
                *(u32x4*)(O + (size_t)(row0 + ai * HALF + m * 16) * 1024 + col0) = w; }
    }
};
struct EpiRowScale {
    static constexpr bool PERM = true;
    bf16_t* O; const float* rs;
    __device__ __forceinline__ void operator()(const f32x4 (&acc)[2][2][4][2], const Unit& u, int wr, int wc, int fr, int fq) const {
        const int row0 = u.orow + wr * 64 + fr, col0 = u.ocol + wc * 32 + 8 * fq;
#pragma unroll
        for (int ai = 0; ai < 2; ++ai)
#pragma unroll
            for (int m = 0; m < 4; ++m) { const int row = row0 + ai * HALF + m * 16; const float s = rs[row];
#pragma unroll
                for (int bj = 0; bj < 2; ++bj) { const f32x4 v0 = acc[ai][bj][m][0] * s, v1 = acc[ai][bj][m][1] * s;
                    u32x4 w; w.x = cvt_pk_bf16(v0[0], v0[1]); w.y = cvt_pk_bf16(v0[2], v0[3]); w.z = cvt_pk_bf16(v1[0], v1[1]); w.w = cvt_pk_bf16(v1[2], v1[3]);
                    *(u32x4*)(O + (size_t)row * 1024 + col0 + bj * HALF) = w; } }
    }
};
struct EpiGlu {
    static constexpr bool PERM = true;
    const bf16_t* Z; bf16_t* O; const float* gb;
    __device__ __forceinline__ void operator()(const f32x4 (&acc)[2][2][4][2], const Unit& u, int wr, int wc, int fr, int fq) const {
        const int row0 = u.orow + wr * 64 + fr, col0 = wc * 32 + 8 * fq;
#pragma unroll
        for (int ai = 0; ai < 2; ++ai)
#pragma unroll
            for (int m = 0; m < 4; ++m) { const size_t row = (size_t)(row0 + ai * HALF + m * 16);
#pragma unroll
                for (int bj = 0; bj < 2; ++bj) { const int col = col0 + bj * HALF;
                    const u32x4 z = *(const u32x4*)(Z + row * 256 + col); const f32x4 b0 = *(const f32x4*)(gb + col), b1 = *(const f32x4*)(gb + col + 4);
                    const f32x4 a0 = acc[ai][bj][m][0] + b0, a1 = acc[ai][bj][m][1] + b1; f32x4 v0, v1;
                    v0[0] = bflo(z.x) * sigmoidf_(a0[0]); v0[1] = bfhi(z.x) * sigmoidf_(a0[1]); v0[2] = bflo(z.y) * sigmoidf_(a0[2]); v0[3] = bfhi(z.y) * sigmoidf_(a0[3]);
                    v1[0] = bflo(z.z) * sigmoidf_(a1[0]); v1[1] = bfhi(z.z) * sigmoidf_(a1[1]); v1[2] = bflo(z.w) * sigmoidf_(a1[2]); v1[3] = bfhi(z.w) * sigmoidf_(a1[3]);
                    u32x4 w; w.x = cvt_pk_bf16(v0[0], v0[1]); w.y = cvt_pk_bf16(v0[2], v0[3]); w.z = cvt_pk_bf16(v1[0], v1[1]); w.w = cvt_pk_bf16(v1[2], v1[3]);
                    *(u32x4*)(O + row * 1024 + 512 + col) = w; }
                asm volatile("" ::: "memory"); }
    }
};

#ifndef PG8_SP2
#define PG8_SP2 1
#endif
template <class Epi, class Sched>
__device__ __forceinline__ void gemm_phase(PG8_LAS unsigned char* lds, const Gemm g, const Sched& S, const Epi& E, int tid_in) {
    int tid = tid_in; asm volatile("" : "+v"(tid));
    const int wid = __builtin_amdgcn_readfirstlane(tid >> 6), lane = tid & 63, wr = wid >> 2, wc = wid & 3, fr = lane & 15, fq = lane >> 4;
    int K = g.K; asm volatile("" : "+s"(K)); const int nt = K / BK;
    unsigned voffA[2], voffB[2];
#pragma unroll
    for (int i = 0; i < 2; ++i) { int R, C; stage_rc(tid * 16 + i * 8192, R, C); const int Rb = Epi::PERM ? ((R & ~31) + perm32(R & 31)) : R;
        voffA[i] = (unsigned)(R * g.lda + C) * 2u; voffB[i] = (unsigned)(Rb * g.ldb + C) * 2u; }
    const size_t kstep = (size_t)(BK * 2);
    const size_t hstepA = (size_t)HALF * g.lda * 2, hstepB = (size_t)HALF * g.ldb * 2;
    const unsigned ldsw = (unsigned)wid * 1024u;
    const int aoff = lds_byte(wr * 64 + fr, fq * 8), boff = lds_byte(wc * 32 + fr, fq * 8);
#define PG8_SA(b, h) (((b) * 2 + (h)) * HTB)
#define PG8_SB(b, h) ((4 + (b) * 2 + (h)) * HTB)
#define PG8_STAGE(bufoff, gbase, voff) do { _Pragma("unroll") for (int _i = 0; _i < 2; ++_i) \
        __builtin_amdgcn_global_load_lds((const unsigned*)((const char*)(gbase) + (voff)[_i]), (PG8_LAS unsigned*)(lds + (bufoff) + ldsw + _i * 8192), 16, 0, 0); } while (0)
#define PG8_LDA(dst, b, h) do { _Pragma("unroll") for (int m = 0; m < 4; ++m) _Pragma("unroll") for (int k = 0; k < 2; ++k) dst[m][k] = *(const PG8_LAS bf16x8*)(lds + PG8_SA(b, h) + aoff + m * 2048 + k * 1024); } while (0)
#define PG8_LDB(dst, b, h) do { _Pragma("unroll") for (int n = 0; n < 2; ++n) _Pragma("unroll") for (int k = 0; k < 2; ++k) dst[n][k] = *(const PG8_LAS bf16x8*)(lds + PG8_SB(b, h) + boff + n * 2048 + k * 1024); } while (0)
#define PG8_MMA(ai, bj, At, Bt) do { __builtin_amdgcn_s_setprio(1); _Pragma("unroll") for (int m = 0; m < 4; ++m) _Pragma("unroll") for (int n = 0; n < 2; ++n) _Pragma("unroll") for (int k = 0; k < 2; ++k) \
        acc[ai][bj][m][n] = __builtin_amdgcn_mfma_f32_16x16x32_bf16(Bt[n][k], At[m][k], acc[ai][bj][m][n], 0, 0, 0); __builtin_amdgcn_s_setprio(0); } while (0)
#define PG8_WAIT_V(n) asm volatile("s_waitcnt vmcnt(" #n ")" ::: "memory")
#define PG8_WAIT_L(n) asm volatile("s_waitcnt lgkmcnt(" #n ")" ::: "memory")
#define PG8_BAR __builtin_amdgcn_s_barrier()
#define PG8_SCHED __builtin_amdgcn_sched_barrier(0)
    Unit cur, nxt; int ui = 0;
    if (!S.next(0, cur)) return;
    f32x4 acc[2][2][4][2];
#pragma unroll
    for (int a = 0; a < 2; ++a)
#pragma unroll
        for (int b = 0; b < 2; ++b)
#pragma unroll
            for (int m = 0; m < 4; ++m)
#pragma unroll
                for (int n = 0; n < 2; ++n) acc[a][b][m][n] = (f32x4){0.f, 0.f, 0.f, 0.f};
    bf16x8 At[4][2], B0[2][2], B1[2][2];
    const char* cA = cur.A; const char* cB = cur.B;
#if PG8_SP2
    PG8_STAGE(PG8_SB(0, 0), cB, voffB); PG8_STAGE(PG8_SB(0, 1), cB + hstepB, voffB); PG8_STAGE(PG8_SA(0, 0), cA, voffA); PG8_STAGE(PG8_SA(0, 1), cA + hstepA, voffA);
    if (wr == 1) PG8_BAR;
    PG8_WAIT_V(2); PG8_BAR;
    PG8_STAGE(PG8_SB(1, 0), cB + kstep, voffB); PG8_STAGE(PG8_SA(1, 0), cA + kstep, voffA); PG8_STAGE(PG8_SB(1, 1), cB + hstepB + kstep, voffB);
    PG8_WAIT_V(6); PG8_BAR;
#else
    PG8_STAGE(PG8_SB(0, 0), cB, voffB); PG8_STAGE(PG8_SA(0, 0), cA, voffA); PG8_STAGE(PG8_SB(0, 1), cB + hstepB, voffB); PG8_STAGE(PG8_SA(0, 1), cA + hstepA, voffA);
    if (wr == 1) PG8_BAR;
    PG8_WAIT_V(4); PG8_BAR;
    PG8_STAGE(PG8_SB(1, 0), cB + kstep, voffB); PG8_STAGE(PG8_SA(1, 0), cA + kstep, voffA); PG8_STAGE(PG8_SB(1, 1), cB + hstepB + kstep, voffB);
    PG8_WAIT_V(6); PG8_BAR;
#endif
    for (;;) {
        const bool has_next = S.next(ui + 1, nxt);
        const char* nA = has_next ? nxt.A : cA; const char* nB = has_next ? nxt.B : cB;
#pragma unroll 1
        for (int t = 0; t < nt; t += 2) {
            const bool last = (t == nt - 2);
            const char* a1 = cA + (size_t)(t + 1) * kstep;
            const char* a2 = last ? nA : cA + (size_t)(t + 2) * kstep; const char* b2 = last ? nB : cB + (size_t)(t + 2) * kstep;
            const char* a3 = a2 + kstep; const char* b3 = b2 + kstep;
#if PG8_SP2
            PG8_LDB(B0, 0, 0); PG8_LDB(B1, 0, 1); PG8_SCHED; PG8_LDA(At, 0, 0); PG8_STAGE(PG8_SA(1, 1), a1 + hstepA, voffA);
            PG8_WAIT_V(8); PG8_WAIT_L(0); PG8_BAR; PG8_MMA(0, 0, At, B0); PG8_MMA(0, 1, At, B1); PG8_BAR; PG8_SCHED;
            PG8_LDA(At, 0, 1); PG8_STAGE(PG8_SB(0, 0), b2, voffB); PG8_STAGE(PG8_SB(0, 1), b2 + hstepB, voffB); PG8_STAGE(PG8_SA(0, 0), a2, voffA);
            PG8_WAIT_V(8); PG8_WAIT_L(0); PG8_BAR; PG8_MMA(1, 0, At, B0); PG8_MMA(1, 1, At, B1); PG8_BAR; PG8_SCHED;
            PG8_LDB(B0, 1, 0); PG8_LDB(B1, 1, 1); PG8_SCHED; PG8_LDA(At, 1, 0); PG8_STAGE(PG8_SA(0, 1), a2 + hstepA, voffA);
            PG8_WAIT_V(8); PG8_WAIT_L(0); PG8_BAR; PG8_MMA(0, 0, At, B0); PG8_MMA(0, 1, At, B1); PG8_BAR; PG8_SCHED;
            PG8_LDA(At, 1, 1); PG8_STAGE(PG8_SB(1, 0), b3, voffB); PG8_STAGE(PG8_SB(1, 1), b3 + hstepB, voffB); PG8_STAGE(PG8_SA(1, 0), a3, voffA);
            PG8_WAIT_V(8); PG8_WAIT_L(0); PG8_BAR; PG8_MMA(1, 0, At, B0); PG8_MMA(1, 1, At, B1); PG8_BAR; PG8_SCHED;
#else
            PG8_LDB(B0, 0, 0); PG8_SCHED; PG8_LDA(At, 0, 0); PG8_STAGE(PG8_SA(1, 1), a1 + hstepA, voffA);
            PG8_WAIT_L(8); PG8_BAR; PG8_WAIT_L(0); PG8_MMA(0, 0, At, B0); PG8_BAR; PG8_SCHED;
            PG8_LDB(B1, 0, 1); PG8_STAGE(PG8_SB(0, 0), b2, voffB);
            PG8_BAR; PG8_WAIT_L(0); PG8_MMA(0, 1, At, B1); PG8_BAR;
            PG8_LDA(At, 0, 1); PG8_STAGE(PG8_SA(0, 0), a2, voffA);
            PG8_BAR; PG8_WAIT_L(0); PG8_MMA(1, 0, At, B0); PG8_BAR; PG8_SCHED;
            PG8_STAGE(PG8_SB(0, 1), b2 + hstepB, voffB);
            PG8_WAIT_V(6); PG8_BAR; PG8_MMA(1, 1, At, B1); PG8_BAR;
            PG8_LDB(B0, 1, 0); PG8_SCHED; PG8_LDA(At, 1, 0); PG8_STAGE(PG8_SA(0, 1), a2 + hstepA, voffA);
            PG8_WAIT_L(8); PG8_BAR; PG8_WAIT_L(0); PG8_MMA(0, 0, At, B0); PG8_BAR; PG8_SCHED;
            PG8_LDB(B1, 1, 1); PG8_STAGE(PG8_SB(1, 0), b3, voffB);
            PG8_BAR; PG8_WAIT_L(0); PG8_MMA(0, 1, At, B1); PG8_BAR;
            PG8_LDA(At, 1, 1); PG8_STAGE(PG8_SA(1, 0), a3, voffA);
            PG8_BAR; PG8_WAIT_L(0); PG8_MMA(1, 0, At, B0); PG8_BAR; PG8_SCHED;
            PG8_STAGE(PG8_SB(1, 1), b3 + hstepB, voffB);
            PG8_WAIT_V(6); PG8_BAR; PG8_MMA(1, 1, At, B1); PG8_BAR;
#endif
        }
        if (wr == 0) PG8_BAR;
        E(acc, cur, wr, wc, fr, fq);
        if (!has_next) break;
#pragma unroll
        for (int a = 0; a < 2; ++a)
#pragma unroll
            for (int b = 0; b < 2; ++b)
#pragma unroll
                for (int m = 0; m < 4; ++m)
#pragma unroll
                    for (int n = 0; n < 2; ++n) acc[a][b][m][n] = (f32x4){0.f, 0.f, 0.f, 0.f};
        cur = nxt; cA = nA; cB = nB; ++ui;
        if (wr == 1) PG8_BAR;
    }
    PG8_WAIT_V(0);
    PG8_BAR;
#undef PG8_SA
#undef PG8_SB
#undef PG8_STAGE
#undef PG8_LDA
#undef PG8_LDB
#undef PG8_MMA
#undef PG8_WAIT_V
#undef PG8_WAIT_L
#undef PG8_BAR
#undef PG8_SCHED
}

struct MergeUnit { const char* A; const char* B; int orow, ocol, z; };
template <class Sched>
__device__ __forceinline__ void gemm_merge_phase(PG8_LAS unsigned char* lds, const Gemm g, const Sched& S, const bf16_t* G, bf16_t* MB, int tid_in) {
    int tid = tid_in; asm volatile("" : "+v"(tid));
    const int wid = __builtin_amdgcn_readfirstlane(tid >> 6), lane = tid & 63, wr = wid >> 2, wc = wid & 3, fr = lane & 15, fq = lane >> 4;
    int K = g.K; asm volatile("" : "+s"(K)); const int nt = K / BK;
    unsigned voffA[2], voffB[2];
#pragma unroll
    for (int i = 0; i < 2; ++i) { int R, C; stage_rc(tid * 16 + i * 8192, R, C); const int Rb = (R & ~31) + perm32(R & 31);
        voffA[i] = (unsigned)(R * g.lda + C) * 2u; voffB[i] = (unsigned)(Rb * g.ldb + C) * 2u; }
    const size_t kstep = (size_t)(BK * 2);
    const size_t hstepA = (size_t)HALF * g.lda * 2;
    const unsigned ldsw = (unsigned)wid * 1024u;
    const int aoff = lds_byte(wr * 64 + fr, fq * 8), boff = lds_byte(wc * 32 + fr, fq * 8);
#define PG8_SA(b, h) (((b) * 2 + (h)) * HTB)
#define PG8_SB(b, h) ((4 + (b) * 2 + (h)) * HTB)
#define PG8_STAGE(bufoff, gbase, voff) do { _Pragma("unroll") for (int _i = 0; _i < 2; ++_i) \
        __builtin_amdgcn_global_load_lds((const unsigned*)((const char*)(gbase) + (voff)[_i]), (PG8_LAS unsigned*)(lds + (bufoff) + ldsw + _i * 8192), 16, 0, 0); } while (0)
#define PG8_LDA(dst, b, h) do { _Pragma("unroll") for (int m = 0; m < 4; ++m) _Pragma("unroll") for (int k = 0; k < 2; ++k) dst[m][k] = *(const PG8_LAS bf16x8*)(lds + PG8_SA(b, h) + aoff + m * 2048 + k * 1024); } while (0)
#define PG8_LDB(dst, b, h) do { _Pragma("unroll") for (int n = 0; n < 2; ++n) _Pragma("unroll") for (int k = 0; k < 2; ++k) dst[n][k] = *(const PG8_LAS bf16x8*)(lds + PG8_SB(b, h) + boff + n * 2048 + k * 1024); } while (0)
#define PG8_MMA1(ai, At, Bt) do { __builtin_amdgcn_s_setprio(1); _Pragma("unroll") for (int m = 0; m < 4; ++m) _Pragma("unroll") for (int n = 0; n < 2; ++n) _Pragma("unroll") for (int k = 0; k < 2; ++k) \
        acc[ai][m][n] = __builtin_amdgcn_mfma_f32_16x16x32_bf16(Bt[n][k], At[m][k], acc[ai][m][n], 0, 0, 0); __builtin_amdgcn_s_setprio(0); } while (0)
#define PG8_WAIT_V(n) asm volatile("s_waitcnt vmcnt(" #n ")" ::: "memory")
#define PG8_WAIT_L(n) asm volatile("s_waitcnt lgkmcnt(" #n ")" ::: "memory")
#define PG8_BAR __builtin_amdgcn_s_barrier()
#define PG8_SCHED __builtin_amdgcn_sched_barrier(0)
    MergeUnit cur, nxt; int ui = 0;
    if (!S.next(0, cur)) return;
    f32x4 acc[2][4][2], mrg[2][4][2];
#pragma unroll
    for (int a = 0; a < 2; ++a)
#pragma unroll
        for (int m = 0; m < 4; ++m)
#pragma unroll
            for (int n = 0; n < 2; ++n) { acc[a][m][n] = (f32x4){0.f, 0.f, 0.f, 0.f}; mrg[a][m][n] = (f32x4){0.f, 0.f, 0.f, 0.f}; }
    bf16x8 At[4][2], B0[2][2];
    const char* cA = cur.A; const char* cB = cur.B;
    PG8_STAGE(PG8_SB(0, 0), cB, voffB); PG8_STAGE(PG8_SA(0, 0), cA, voffA); PG8_STAGE(PG8_SA(0, 1), cA + hstepA, voffA);
    if (wr == 1) PG8_BAR;
    PG8_WAIT_V(2); PG8_BAR;
    PG8_STAGE(PG8_SB(1, 0), cB + kstep, voffB); PG8_STAGE(PG8_SA(1, 0), cA + kstep, voffA);
    PG8_WAIT_V(4); PG8_BAR;
    for (;;) {
        const bool has_next = S.next(ui + 1, nxt);
        const char* nA = has_next ? nxt.A : cA; const char* nB = has_next ? nxt.B : cB;
#pragma unroll 1
        for (int t = 0; t < nt; t += 2) {
            const bool last = (t == nt - 2);
            const char* a1 = cA + (size_t)(t + 1) * kstep;
            const char* a2 = last ? nA : cA + (size_t)(t + 2) * kstep; const char* b2 = last ? nB : cB + (size_t)(t + 2) * kstep;
            const char* a3 = a2 + kstep; const char* b3 = b2 + kstep;
            PG8_LDB(B0, 0, 0); PG8_SCHED; PG8_LDA(At, 0, 0); PG8_STAGE(PG8_SA(1, 1), a1 + hstepA, voffA);
            PG8_WAIT_V(6); PG8_WAIT_L(0); PG8_BAR; PG8_MMA1(0, At, B0); PG8_BAR; PG8_SCHED;
            PG8_LDA(At, 0, 1); PG8_STAGE(PG8_SB(0, 0), b2, voffB); PG8_STAGE(PG8_SA(0, 0), a2, voffA);
            PG8_WAIT_V(6); PG8_WAIT_L(0); PG8_BAR; PG8_MMA1(1, At, B0); PG8_BAR; PG8_SCHED;
            PG8_LDB(B0, 1, 0); PG8_SCHED; PG8_LDA(At, 1, 0); PG8_STAGE(PG8_SA(0, 1), a2 + hstepA, voffA);
            PG8_WAIT_V(6); PG8_WAIT_L(0); PG8_BAR; PG8_MMA1(0, At, B0); PG8_BAR; PG8_SCHED;
            PG8_LDA(At, 1, 1); PG8_STAGE(PG8_SB(1, 0), b3, voffB); PG8_STAGE(PG8_SA(1, 0), a3, voffA);
            PG8_WAIT_V(6); PG8_WAIT_L(0); PG8_BAR; PG8_MMA1(1, At, B0); PG8_BAR; PG8_SCHED;
        }
        if (wr == 0) PG8_BAR;
        {
            const int row0 = cur.orow + wr * 64 + fr, col0 = cur.ocol + wc * 32 + 8 * fq, z = cur.z;
            u32x4 gq[2][4];
#pragma unroll
            for (int ai = 0; ai < 2; ++ai)
#pragma unroll
                for (int m = 0; m < 4; ++m) gq[ai][m] = *(const u32x4*)(G + (size_t)(row0 + ai * HALF + m * 16) * 4096 + z * 1024 + col0);
#pragma unroll
            for (int ai = 0; ai < 2; ++ai)
#pragma unroll
                for (int m = 0; m < 4; ++m) { const size_t row = (size_t)(row0 + ai * HALF + m * 16);
                    const u32x4 gv = gq[ai][m];
                    f32x4 v0 = acc[ai][m][0], v1 = acc[ai][m][1];
                    v0[0] *= bflo(gv.x); v0[1] *= bfhi(gv.x); v0[2] *= bflo(gv.y); v0[3] *= bfhi(gv.y);
                    v1[0] *= bflo(gv.z); v1[1] *= bfhi(gv.z); v1[2] *= bflo(gv.w); v1[3] *= bfhi(gv.w);
                    if (z == 0) { mrg[ai][m][0] = v0; mrg[ai][m][1] = v1; } else { mrg[ai][m][0] += v0; mrg[ai][m][1] += v1; }
                    acc[ai][m][0] = (f32x4){0.f, 0.f, 0.f, 0.f}; acc[ai][m][1] = (f32x4){0.f, 0.f, 0.f, 0.f};
                    if (z == 3) { const f32x4 o0 = mrg[ai][m][0], o1 = mrg[ai][m][1];
                        u32x4 w; w.x = cvt_pk_bf16(o0[0], o0[1]); w.y = cvt_pk_bf16(o0[2], o0[3]); w.z = cvt_pk_bf16(o1[0], o1[1]); w.w = cvt_pk_bf16(o1[2], o1[3]);
                        *(u32x4*)(MB + row * 1024 + col0) = w; } }
        }
        if (!has_next) break;
        cur = nxt; cA = nA; cB = nB; ++ui;
        if (wr == 1) PG8_BAR;
    }
    PG8_WAIT_V(0);
    PG8_BAR;
#undef PG8_SA
#undef PG8_SB
#undef PG8_STAGE
#undef PG8_LDA
#undef PG8_LDB
#undef PG8_MMA1
#undef PG8_WAIT_V
#undef PG8_WAIT_L
#undef PG8_BAR
#undef PG8_SCHED
}
}
#define XB_TMO      128
#define XB_XCNT(j)  (256  + 64 * (j))
#define XB_XSUB(j)  (1280 + 64 * (j))
#define XB_XGEN(j)  (2304 + 64 * (j))
#define XB_TOP      3328
#define XB_TOPGEN   3392
#define XCD_BAR_WORDS 3456
#define XB_SPIN_CAP (1u << 18)

__device__ __forceinline__ unsigned xb_ld(unsigned* p)              { return __hip_atomic_load(p, __ATOMIC_RELAXED, __HIP_MEMORY_SCOPE_AGENT); }
__device__ __forceinline__ unsigned xb_add(unsigned* p, unsigned v) { return __hip_atomic_fetch_add(p, v, __ATOMIC_RELAXED, __HIP_MEMORY_SCOPE_AGENT); }
__device__ __forceinline__ unsigned xb_xcc_id() { return (unsigned)__builtin_amdgcn_s_getreg((3 << 11) | 20) & 0xFu; }
#define XB_SPIN(cond, bar) do { unsigned _sp = 0; while (cond) { __builtin_amdgcn_s_sleep(1); \
    if ((++_sp & 255u) == 0u) { if (xb_ld(&(bar)[XB_TMO])) break; if (_sp > XB_SPIN_CAP) { atomicAdd(&(bar)[XB_TMO], 1u); break; } } } } while (0)

struct XcdBarrier {
    unsigned* bar; unsigned x;
    volatile LAS unsigned* st;
};

__device__ __forceinline__ XcdBarrier xcd_barrier_post(unsigned* bar, volatile LAS unsigned* st) {
    XcdBarrier b; b.bar = bar; b.x = xb_xcc_id(); b.st = st;
    if (threadIdx.x == 0) (void)xb_add(&bar[XB_XCNT(b.x)], 1u);
    return b;
}
__device__ __forceinline__ void xcd_barrier_complete(unsigned* bar, unsigned x, unsigned& nloc, unsigned& nx) {
    const unsigned G = gridDim.x * gridDim.y * gridDim.z;
    unsigned sum, cnt, mine, sp = 0u;
    for (;;) {
        sum = 0u; cnt = 0u; mine = 0u;
#pragma unroll
        for (unsigned j = 0; j < 16; ++j) { const unsigned c = xb_ld(&bar[XB_XCNT(j)]); sum += c; cnt += (c > 0u) ? 1u : 0u; mine = (j == x) ? c : mine; }
        if (sum == G) break;
        __builtin_amdgcn_s_sleep(1);
        if ((++sp & 255u) == 0u) { if (xb_ld(&bar[XB_TMO])) break; if (sp > XB_SPIN_CAP) { atomicAdd(&bar[XB_TMO], 1u); break; } }
    }
    nloc = mine > 0u ? mine : 1u; nx = cnt > 0u ? cnt : 1u;
}

__device__ __forceinline__ void xcd_barrier(const XcdBarrier& b, int tid_now) {
    asm volatile("s_waitcnt vmcnt(0)" ::: "memory");
    __syncthreads();
    if (tid_now == 0) {
        unsigned* bar = b.bar;
        __builtin_amdgcn_s_waitcnt(0);
        unsigned nloc = b.st[0], nx = b.st[1];
        if (nloc == 0u) { xcd_barrier_complete(bar, b.x, nloc, nx); b.st[0] = nloc; b.st[1] = nx; }
        const unsigned old = xb_add(&bar[XB_XSUB(b.x)], 1u);
        const unsigned gen = old / nloc;
        if (old + 1u == (gen + 1u) * nloc) {
            __builtin_amdgcn_fence(__ATOMIC_RELEASE, "agent");
            asm volatile("s_waitcnt vmcnt(0)" ::: "memory");
            const unsigned og = xb_add(&bar[XB_TOP], 1u);
            const unsigned tg = og / nx;
            if (og + 1u == (tg + 1u) * nx) xb_add(&bar[XB_TOPGEN], 1u);
            else XB_SPIN(xb_ld(&bar[XB_TOPGEN]) == tg, bar);
            __builtin_amdgcn_fence(__ATOMIC_ACQUIRE, "agent");
            xb_add(&bar[XB_XGEN(b.x)], 1u);
            asm volatile("s_waitcnt vmcnt(0)" ::: "memory");
        } else {
            XB_SPIN(xb_ld(&bar[XB_XGEN(b.x)]) == gen, bar);
            __builtin_amdgcn_fence(__ATOMIC_ACQUIRE, "agent");
            asm volatile("s_waitcnt vmcnt(0)" ::: "memory");
        }
    }
    __syncthreads();
}

struct Args { const float* in[N_INPUTS]; float* out; unsigned char* ws; int ph_lo, ph_hi, l_lo, l_hi; };
struct Frame {
    LAS unsigned char* lds;
    volatile LAS unsigned* MISC;
    gu32* ctl;
    int tid, lane, wave, G, bid, zoff;
    unsigned char* ws;
    float* out;
};
#define FIN(k) (args.in[k])
#define WSP(T, off) ((T*)(F.ws + (off)))

__device__ __forceinline__ int wq_grab(Frame& F, int qid) {
    __syncthreads();
    if (F.tid == 0) F.MISC[16] = __hip_atomic_fetch_add((unsigned*)(F.ctl + CW_Q + qid * 64), 1u, RLX_AGENT);
    __syncthreads();
    return (int)F.MISC[16];
}
__device__ __forceinline__ float block_sum(Frame& F, float v, LAS float* red  ) {
    v = wave_sum(v);
    __syncthreads();
    if (F.lane == 0) red[F.wave] = v;
    __syncthreads();
    float s = 0.f;
#pragma unroll
    for (int w = 0; w < 8; ++w) s += red[w];
    return s;
}

__device__ __forceinline__ void ln_row(f32x4 (&v)[4], const float* g, const float* b, int lane) {
    float s = 0.f;
#pragma unroll
    for (int j = 0; j < 4; ++j) s += (v[j].x + v[j].y) + (v[j].z + v[j].w);
    const float mean = wave_sum(s) * (1.f / DM); float s2 = 0.f;
#pragma unroll
    for (int j = 0; j < 4; ++j) { v[j] = v[j] - mean; s2 += (v[j].x * v[j].x + v[j].y * v[j].y) + (v[j].z * v[j].z + v[j].w * v[j].w); }
    const float rstd = 1.f / sqrtf(wave_sum(s2) * (1.f / DM) + LN_EPS);
#pragma unroll
    for (int j = 0; j < 4; ++j) { const f32x4 gg = *(const f32x4*)(g + 4 * lane + 256 * j), bb = *(const f32x4*)(b + 4 * lane + 256 * j); v[j] = v[j] * rstd * gg + bb; }
}
__device__ __forceinline__ void store_row_bf16(const f32x4 (&v)[4], bf16* o16, int lane) {
#pragma unroll
    for (int j = 0; j < 4; ++j) { v2u w; w.x = pk2(v[j].x, v[j].y); w.y = pk2(v[j].z, v[j].w); *(v2u*)(o16 + 4 * lane + 256 * j) = w; }
}
__device__ __forceinline__ void load_row_bf16(f32x4 (&v)[4], const bf16* p, int lane, float scale) {
#pragma unroll
    for (int j = 0; j < 4; ++j) { const v2u w = *(const v2u*)(p + 4 * lane + 256 * j); v[j] = (f32x4){bflo(w.x), bfhi(w.x), bflo(w.y), bfhi(w.y)} * scale; }
}
__device__ __forceinline__ void store_row_f32_bf16(const f32x4 (&v)[4], float* o32, bf16* o16, int lane) {
#pragma unroll
    for (int j = 0; j < 4; ++j) { *(f32x4*)(o32 + 4 * lane + 256 * j) = v[j];
        v2u w; w.x = pk2(v[j].x, v[j].y); w.y = pk2(v[j].z, v[j].w); *(v2u*)(o16 + 4 * lane + 256 * j) = w; }
}

template <class RowPtr>
__device__ __forceinline__ void transpose_item(const float* W, int ldw, int k0, int n0, const RowPtr& rp, LAS float* scr, int lane) {
    const float* src = W + (size_t)k0 * ldw + n0 + lane;
#pragma unroll 16
    for (int kk = 0; kk < 64; ++kk) scr[kk * 65 + lane] = src[(size_t)kk * ldw];
    LDS_WAIT(); asm volatile("" ::: "memory");
    const int c = lane & 7;
#pragma unroll
    for (int j = 0; j < 8; ++j) { const int n = (lane >> 3) + 8 * j; const LAS float* s = scr + (8 * c) * 65 + n;
        v4u o; o.x = pk2(s[0 * 65], s[1 * 65]); o.y = pk2(s[2 * 65], s[3 * 65]); o.z = pk2(s[4 * 65], s[5 * 65]); o.w = pk2(s[6 * 65], s[7 * 65]);
        *(v4u*)(rp(n0 + n) + k0 + 8 * c) = o; }
    LDS_WAIT(); asm volatile("" ::: "memory");
}
struct RowPlain { bf16* base; int ld; __device__ __forceinline__ bf16* operator()(int n) const { return base + (size_t)n * ld; } };
struct RowGU { bf16* base; int half; __device__ __forceinline__ bf16* operator()(int f) const { return base + (size_t)((f >> 7) * 256 + half * 128 + (f & 127)) * 1024; } };

__device__ __forceinline__ void convert_layer(Frame& F, const Args& args, int l, int gw, int NGW) {
    LAS float* scr = (LAS float*)(F.lds + F.wave * 16640);
    unsigned char* wb = F.ws + WS_W;
    constexpr int I_IN = 16 * 124, I_BR = 4 * 4 * 16, I_OUT = 16 * 16, I_GLU = 4 * 4, I_EX = 16 * 256;
    constexpr int NIT = I_IN + I_BR + I_OUT + I_GLU + 3 * I_EX;
    for (int it = gw; it < NIT; it += NGW) {
        int r = it;
        if (r < I_IN) { const int kb = r / 124, nb = r % 124; transpose_item(FIN(I_WIN) + (size_t)l * DM * NIN, NIN, 64 * kb, 64 * nb, RowPlain{(bf16*)(wb + W_WIN), 1024}, scr, F.lane); continue; } r -= I_IN;
        if (r < I_BR) { const int i = r / 64, q = r % 64, kb = q / 16, nb = q % 16;
            transpose_item(FIN(I_WBR) + ((size_t)l * 4 + i) * 256 * 1024, 1024, 64 * kb, 64 * nb, RowPlain{(bf16*)(wb + W_WB) + (size_t)i * 1024 * 256, 256}, scr, F.lane); continue; } r -= I_BR;
        if (r < I_OUT) { const int kb = r / 16, nb = r % 16; transpose_item(FIN(I_WOUT) + (size_t)l * 1024 * 1024, 1024, 64 * kb, 64 * nb, RowPlain{(bf16*)(wb + W_WO), 1024}, scr, F.lane); continue; } r -= I_OUT;
        if (r < I_GLU) { const int kb = r / 4, nb = r % 4; transpose_item(FIN(I_S5_GW) + (size_t)l * 256 * 256, 256, 64 * kb, 64 * nb, RowPlain{(bf16*)(wb + W_GLU), 256}, scr, F.lane); continue; } r -= I_GLU;
        const int which = r / I_EX, q = r % I_EX, e = q / 256, q2 = q % 256, kb = q2 / 16, nb = q2 % 16;
        const size_t esz = (size_t)1024 * 1024;
        if (which == 0) transpose_item(FIN(I_EWG) + ((size_t)l * NE + e) * esz, 1024, 64 * kb, 64 * nb, RowGU{(bf16*)(wb + W_GU) + (size_t)e * 2048 * 1024, 0}, scr, F.lane);
        else if (which == 1) transpose_item(FIN(I_EWU) + ((size_t)l * NE + e) * esz, 1024, 64 * kb, 64 * nb, RowGU{(bf16*)(wb + W_GU) + (size_t)e * 2048 * 1024, 1}, scr, F.lane);
        else transpose_item(FIN(I_EWD) + ((size_t)l * NE + e) * esz, 1024, 64 * kb, 64 * nb, RowPlain{(bf16*)(wb + W_DN) + (size_t)e * esz, 1024}, scr, F.lane);
    }
}

__device__ __forceinline__ f32x2 cmul(f32x2 a, f32x2 b) { return (f32x2){a.x * b.x - a.y * b.y, a.x * b.y + a.y * b.x}; }

__device__ __forceinline__ void s5_build_item(Frame& F, const Args& args, int l, int g, int q4  ) {
    LAS f32x2* ap = (LAS f32x2*)F.lds;
    LAS f32x2* bb = ap + 2 * 64 * 33;
    LAS f32x2* cm = bb + 2 * 64 * 16;
    LAS float* kern = (LAS float*)(cm + 2 * 16 * 64);
    const int tid = F.tid;
    __syncthreads();
    if (tid < 128) {
        const int dir = tid >> 6, p = tid & 63; const size_t gi = ((size_t)(l * 2 + dir) * 16 + g);
        const float lre = FIN(I_S5_LRE)[gi * 64 + p], lim = FIN(I_S5_LIM)[gi * 64 + p], dt = expf(FIN(I_S5_LDT)[gi]);
        const float x = lre * dt, y = lim * dt;
        for (int tau = 0; tau <= 32; ++tau) { float s, c; sincosf((float)tau * y, &s, &c); const float e = expf((float)tau * x); ap[(dir * 64 + p) * 33 + tau] = (f32x2){e * c, e * s}; }
        if (q4 == 0) { float s, c; sincosf(32.f * y, &s, &c); const float e = expf(32.f * x); WSP(f32x2, WS_S5A32)[gi * 64 + p] = (f32x2){e * c, e * s}; }
        float s1, c1; sincosf(y, &s1, &c1); const float sh = sinf(0.5f * y);
        const f32x2 em1 = (f32x2){expm1f(x) * c1 - 2.f * sh * sh, expf(x) * s1};
        const float inv = 1.f / (lre * lre + lim * lim);
        const f32x2 q = (f32x2){(em1.x * lre + em1.y * lim) * inv, (em1.y * lre - em1.x * lim) * inv};
        for (int ci = 0; ci < 16; ++ci) { const f32x2 bm = (f32x2){FIN(I_S5_BRE)[(gi * 64 + p) * 16 + ci], FIN(I_S5_BIM)[(gi * 64 + p) * 16 + ci]}; bb[(dir * 64 + p) * 16 + ci] = cmul(q, bm); }
    }
    for (int i = tid; i < 2 * 16 * 64; i += 512) { const int dir = i >> 10, co = (i >> 6) & 15, p = i & 63; const size_t gi = ((size_t)(l * 2 + dir) * 16 + g);
        cm[i] = (f32x2){FIN(I_S5_CRE)[(gi * 16 + co) * 64 + p], FIN(I_S5_CIM)[(gi * 16 + co) * 64 + p]}; }
    __syncthreads();
    for (int e4 = tid; e4 < 63 * 64; e4 += 512) {
        const int ti = e4 >> 6, co = 4 * q4 + ((e4 >> 4) & 3), ci = e4 & 15, tau = ti - 31, e = ti * 256 + co * 16 + ci; float acc = 0.f;
        if (tau >= 0) for (int p = 0; p < 64; ++p) { const f32x2 w = cmul(cm[(0 * 16 + co) * 64 + p], ap[(0 * 64 + p) * 33 + tau]); const f32x2 b = bb[(0 * 64 + p) * 16 + ci]; acc += w.x * b.x - w.y * b.y; }
        if (tau <= 0) for (int p = 0; p < 64; ++p) { const f32x2 w = cmul(cm[(1 * 16 + co) * 64 + p], ap[(1 * 64 + p) * 33 - tau]); const f32x2 b = bb[(1 * 64 + p) * 16 + ci]; acc += w.x * b.x - w.y * b.y; }
        if (tau == 0 && co == ci) acc += FIN(I_S5_D)[l * 256 + g * 16 + co];
        kern[e] = acc;
    }
    __syncthreads();
    bf16* wcat = (bf16*)(F.ws + WS_S5W + (size_t)l * S5W_LAYER + S5_WCAT_OFF) + (size_t)g * 512 * 768;
    for (int ch = tid; ch < 128 * 96; ch += 512) {
        const int ml = ch / 96, k8 = ch % 96, t = ml >> 2, co = 4 * q4 + (ml & 3), m = 16 * t + co; float v[8];
        if (k8 < 64) { const int j = k8 >> 1, ci0 = (k8 & 1) * 8;
#pragma unroll
            for (int e = 0; e < 8; ++e) v[e] = kern[(t - j + 31) * 256 + co * 16 + ci0 + e]; }
        else { const int kk = (k8 - 64) * 8, dir = kk >> 7, p0 = (kk & 127) >> 1, tau = dir == 0 ? t + 1 : 32 - t;
#pragma unroll
            for (int pp = 0; pp < 4; ++pp) { const f32x2 w = cmul(cm[(dir * 16 + co) * 64 + p0 + pp], ap[(dir * 64 + p0 + pp) * 33 + tau]); v[2 * pp] = w.x; v[2 * pp + 1] = -w.y; } }
        v4u o; o.x = pk2(v[0], v[1]); o.y = pk2(v[2], v[3]); o.z = pk2(v[4], v[5]); o.w = pk2(v[6], v[7]);
        *(v4u*)(wcat + (size_t)m * 768 + k8 * 8) = o;
    }
    bf16* wst = (bf16*)(F.ws + WS_S5W + (size_t)l * S5W_LAYER + S5_WST_OFF) + (size_t)g * 2 * 128 * 512;
    if (q4 == 0) for (int ch = tid; ch < 2 * 128 * 64; ch += 512) {
        const int dir = ch >> 13, o = (ch >> 6) & 127, k8 = ch & 63, p = o >> 1, ri = o & 1, j = k8 >> 1, ci0 = (k8 & 1) * 8; float v[8];
        const f32x2 a = ap[(dir * 64 + p) * 33 + (dir == 0 ? 31 - j : j)];
#pragma unroll
        for (int e = 0; e < 8; ++e) { const f32x2 w = cmul(a, bb[(dir * 64 + p) * 16 + ci0 + e]); v[e] = ri ? w.y : w.x; }
        v4u q; q.x = pk2(v[0], v[1]); q.y = pk2(v[2], v[3]); q.z = pk2(v[4], v[5]); q.w = pk2(v[6], v[7]);
        *(v4u*)(wst + ((size_t)dir * 128 + o) * 512 + k8 * 8) = q;
    }
    __syncthreads();
}

__device__ __forceinline__ void hf2_item(Frame& F, const Args& args, int l, int t) {
    const int lane = F.lane;
    const float tn = (float)t * (1.f / 4095.f), w = 6.283185307179586f * (float)t * (1.f / 4096.f);
    float zv = 0.f;
    if (lane == 0) zv = tn;
    else if (lane <= 16) { const float f = 1e-4f + (float)(lane - 1) * ((15.f - 1e-4f) / 15.f); zv = cosf(f * w); }
    else if (lane <= 32) { const float f = 1e-4f + (float)(lane - 17) * ((15.f - 1e-4f) / 15.f); zv = -sinf(f * w); }
    float acc = FIN(I_HY_B1)[l * 64 + lane];
    const float* w1 = FIN(I_HY_W1) + (size_t)l * 33 * 64;
    for (int i = 0; i < 33; ++i) acc += __shfl(zv, i) * w1[i * 64 + lane];
    const float f1 = sinf(FIN(I_HY_FREQ)[(l * 2 + 0) * 64 + lane] * acc);
    float acc2 = FIN(I_HY_B2)[l * 64 + lane];
    const float* w2 = FIN(I_HY_W2) + (size_t)l * 64 * 64;
    for (int i = 0; i < 64; ++i) acc2 += __shfl(f1, i) * w2[i * 64 + lane];
    WSP(float, WS_HF2)[((size_t)l * 4096 + t) * 64 + lane] = sinf(FIN(I_HY_FREQ)[(l * 2 + 1) * 64 + lane] * acc2);
}

__device__ __forceinline__ void prologue_phase(Frame& F, const Args& args) {
    const int gw = F.bid * 8 + F.wave, NGW = F.G * 8;
    for (int it = F.bid; it < DEPTH * 16 * 4; it += F.G) s5_build_item(F, args, it >> 6, (it >> 2) & 15, it & 3);
    __syncthreads();
    { const int gi = F.bid * 512 + F.tid; if (gi < 1024) { const int pos = gi >> 4, i = gi & 15; const float inv = expf(-(float)(2 * i) * (1.f / 32.f) * 9.210340371976184f);
        float s, c; sincosf((float)pos * inv, &s, &c); WSP(f32x2, WS_ROPE)[gi] = (f32x2){c, s}; } }
    for (int it = gw; it < DEPTH * 4096; it += NGW) hf2_item(F, args, it >> 12, it & 4095);
    for (int m = gw; m < M; m += NGW) { f32x4 v[4];
#pragma unroll
        for (int j = 0; j < 4; ++j) v[j] = *(const f32x4*)(FIN(I_X) + (size_t)m * DM + 4 * F.lane + 256 * j);
        ln_row(v, FIN(I_LNIN_G), FIN(I_LNIN_B), F.lane);
        store_row_bf16(v, WSP(bf16, WS_HB) + (size_t)m * DM, F.lane); }
    convert_layer(F, args, 0, gw, NGW);
}
namespace attn_body {
using bf16=__hip_bfloat16;
using bf16x8=__attribute__((ext_vector_type(8)))short;
using s16x4=__attribute__((ext_vector_type(4)))short;
using f32x16=__attribute__((ext_vector_type(16)))float;
using u32x4=__attribute__((ext_vector_type(4)))unsigned;
constexpr int SEQ=4096,D=64,QP=512,KP=512,VP=512,OP=1024;
constexpr int NW=8,QBLK=32,QB=QBLK*NW,KVBLK=64,NQB=SEQ/QB;
constexpr int ATTN_UNIT_ROWS=QB;
__device__ __forceinline__ int crow(int r,int hi){return (r&3)+8*(r>>2)+4*hi;}
#define SBAR() __builtin_amdgcn_sched_barrier(0)
__device__ __forceinline__ void cmask(f32x16&p0,f32x16&p1,int jb,int qrel,int hi){
  const float NEG=-INFINITY; int kb=64*jb+4*hi;
  #pragma unroll
  for(int r=0;r<16;++r){int kv=kb+(r&3)+8*(r>>2); if(kv>qrel)p0[r]=NEG; if(kv+32>qrel)p1[r]=NEG;}
}

constexpr int NSLOT=3, SLOTB=8192;
constexpr int LDS_K=0, LDS_V=NSLOT*SLOTB, LDS_WS=2*NSLOT*SLOTB, LDS_OST=LDS_WS+NW*64*4, LDS_BYTES=LDS_OST+NW*4096;
constexpr float C2=0.125f*1.4426950408889634f;
__device__ __forceinline__ void glds16(const void*gsrc,unsigned lds_dst){unsigned keep;
  asm volatile("s_mov_b32 %0, m0\n\ts_mov_b32 m0, %2\n\ts_nop 0\n\tglobal_load_lds_dwordx4 %1, off\n\ts_mov_b32 m0, %0":"=&s"(keep):"v"(gsrc),"s"(lds_dst):"memory");}
__device__ __forceinline__ float max3f(float a,float b,float c){float r;asm("v_max3_f32 %0, %1, %2, %3":"=v"(r):"v"(a),"v"(b),"v"(c));return r;}
__device__ __forceinline__ float max2f(float a,float b){float r;asm("v_max_f32_e32 %0, %1, %2":"=v"(r):"v"(a),"v"(b));return r;}
__device__ __forceinline__ float fadd_s(float a,float b){float r;asm("v_add_f32_e32 %0, %1, %2":"=v"(r):"v"(a),"v"(b));return r;}
__device__ __forceinline__ float fsub_s(float a,float b){float r;asm("v_sub_f32_e32 %0, %1, %2":"=v"(r):"v"(a),"v"(b));return r;}
typedef float f32x2_t __attribute__((ext_vector_type(2))); typedef __bf16 bf16x2_t __attribute__((ext_vector_type(2)));
__device__ __forceinline__ unsigned cvtpk_s(float lo,float hi){f32x2_t v={lo,hi};bf16x2_t b=__builtin_convertvector(v,bf16x2_t);return __builtin_bit_cast(unsigned,b);}
#define WAIT_BAR(N) asm volatile("s_waitcnt vmcnt(" #N ") lgkmcnt(0)\n\ts_barrier":::"memory")

__device__ __forceinline__ void qkt(f32x16&p0,f32x16&p1,const char*Kslot,const bf16x8*qr,const f32x16&negm,int r32,int hi){
  const char*kb=Kslot+hi*1024+r32*16;
  #pragma unroll
  for(int d0=0;d0<4;++d0){
    const bf16x8 b0=*reinterpret_cast<const bf16x8*>(kb+d0*2048);
    const bf16x8 b1=*reinterpret_cast<const bf16x8*>(kb+d0*2048+512);
    if(d0==0){p0=__builtin_amdgcn_mfma_f32_32x32x16_bf16(b0,qr[0],negm,0,0,0);p1=__builtin_amdgcn_mfma_f32_32x32x16_bf16(b1,qr[0],negm,0,0,0);}
    else{p0=__builtin_amdgcn_mfma_f32_32x32x16_bf16(b0,qr[d0],p0,0,0,0);p1=__builtin_amdgcn_mfma_f32_32x32x16_bf16(b1,qr[d0],p1,0,0,0);}}
}
typedef __attribute__((address_space(3))) const char* lds_cptr;
typedef short v4i16_t __attribute__((ext_vector_type(4)));
__device__ __forceinline__ void kload8(bf16x8*kf,lds_cptr kp){
  kf[0]=*(const __attribute__((address_space(3))) bf16x8*)(kp);      kf[1]=*(const __attribute__((address_space(3))) bf16x8*)(kp+512);
  kf[2]=*(const __attribute__((address_space(3))) bf16x8*)(kp+2048); kf[3]=*(const __attribute__((address_space(3))) bf16x8*)(kp+2560);
  kf[4]=*(const __attribute__((address_space(3))) bf16x8*)(kp+4096); kf[5]=*(const __attribute__((address_space(3))) bf16x8*)(kp+4608);
  kf[6]=*(const __attribute__((address_space(3))) bf16x8*)(kp+6144); kf[7]=*(const __attribute__((address_space(3))) bf16x8*)(kp+6656);
}
__device__ __forceinline__ void kload2(bf16x8*kf,lds_cptr kp,int j){ kf[2*j]=*(const __attribute__((address_space(3))) bf16x8*)(kp+j*2048); kf[2*j+1]=*(const __attribute__((address_space(3))) bf16x8*)(kp+j*2048+512); }
__device__ __forceinline__ s16x4 vtr(lds_cptr p){ return __builtin_bit_cast(s16x4,__builtin_amdgcn_ds_read_tr16_b64_v4i16((__attribute__((address_space(3))) v4i16_t*)p)); }
__device__ __forceinline__ float rowmax(const f32x16&p0,const f32x16&p1){
  float a=max3f(p0[0],p0[1],p1[0]),b=max3f(p0[2],p0[3],p1[1]);a=max3f(a,p1[2],p1[3]);
  #pragma unroll
  for(int r=4;r<16;r+=4){a=max3f(a,p0[r],p0[r+1]);b=max3f(b,p0[r+2],p0[r+3]);a=max3f(a,p1[r],p1[r+1]);b=max3f(b,p1[r+2],p1[r+3]);}
  const float m=max2f(a,b);
  auto rr=__builtin_amdgcn_permlane32_swap(__float_as_uint(m),__float_as_uint(m),false,false);
  return max2f(__uint_as_float(rr[0]),__uint_as_float(rr[1]));
}
__device__ __forceinline__ void pv(f32x16*o,int vb,bf16x8 pa0,bf16x8 pa1,bf16x8 pa2,bf16x8 pa3){
  #pragma unroll
  for(int d0=0;d0<2;++d0){s16x4 lo[4],hi[4];
    #pragma unroll
    for(int ks=0;ks<4;++ks){
      asm volatile("ds_read_b64_tr_b16 %0,%1 offset:%c2":"=&v"(lo[ks]):"v"(vb),"i"(d0*4096+ks*1024):"memory");
      asm volatile("ds_read_b64_tr_b16 %0,%1 offset:%c2":"=&v"(hi[ks]):"v"(vb),"i"(d0*4096+ks*1024+512):"memory");}
    asm volatile("s_waitcnt lgkmcnt(0)":::"memory");SBAR();
    #define PK(k) (bf16x8){lo[k][0],lo[k][1],lo[k][2],lo[k][3],hi[k][0],hi[k][1],hi[k][2],hi[k][3]}
    o[d0]=__builtin_amdgcn_mfma_f32_32x32x16_bf16(pa0,PK(0),o[d0],0,0,0);
    o[d0]=__builtin_amdgcn_mfma_f32_32x32x16_bf16(pa1,PK(1),o[d0],0,0,0);
    o[d0]=__builtin_amdgcn_mfma_f32_32x32x16_bf16(pa2,PK(2),o[d0],0,0,0);
    o[d0]=__builtin_amdgcn_mfma_f32_32x32x16_bf16(pa3,PK(3),o[d0],0,0,0);
    #undef PK
  }
}

#ifndef ATTN_STORE16
#define ATTN_STORE16(p,v) (*(u32x4*)(p)=(v))
#endif
template<int THRL> __device__ __forceinline__ void attn_unit(int b,int h,int qb,const bf16*Q,const bf16*__restrict__ K,const bf16*__restrict__ V,bf16*O,char*shm,int tid_in){
  int tid=tid_in; asm volatile("":"+v"(tid)); const int lane=tid&63,r32=lane&31,hi=lane>>5; const int wid=__builtin_amdgcn_readfirstlane(tid>>6);
  const long rowbase=(long)b*SEQ; const int q0=qb*QB;
  const bf16*Qw=Q+(rowbase+q0+wid*QBLK)*QP+h*D;
  const bf16*Kh=K+rowbase*KP+(h>>1)*D,*Vh=V+rowbase*VP+(h>>1)*D;
  const unsigned lds0=(unsigned)(uintptr_t)shm;
  float*wsf=(float*)(shm+LDS_WS)+wid*64;
  const bf16*ksrc=Kh+(long)lane*KP+wid*8;
  const bf16*vsrc=Vh+(long)(16*(wid&3)+(lane>>2))*VP+(wid>>2)*32+(lane&3)*8;
  const unsigned kdst=lds0+LDS_K+wid*1024, vdst=lds0+LDS_V+wid*1024;
  #define DMA_K(t,slot) glds16(ksrc+(long)(t)*KVBLK*KP,(unsigned)__builtin_amdgcn_readfirstlane(kdst+(slot)))
  #define DMA_V(t,slot) glds16(vsrc+(long)(t)*KVBLK*VP,(unsigned)__builtin_amdgcn_readfirstlane(vdst+(slot)))
  const int vb0=(int)(lds0+LDS_V)+((lane>>4)&1)*32+(lane&3)*8+(4*hi+((lane&15)>>2))*64;
  const char*Kbase=shm+LDS_K; bf16x8 kf[8];
  const lds_cptr shm3=(lds_cptr)shm; const lds_cptr kp0=shm3+LDS_K+hi*1024+r32*16; const lds_cptr vp0=shm3+LDS_V+((lane>>4)&1)*32+(lane&3)*8+(4*hi+((lane&15)>>2))*64;
  const int NT=SEQ/KVBLK;
  DMA_K(0,0);DMA_V(0,0);DMA_K(1,SLOTB);
  bf16x8 qr[4];
  #pragma unroll
  for(int d0=0;d0<4;++d0)qr[d0]=*reinterpret_cast<const bf16x8*>(&Qw[(long)r32*QP+d0*16+hi*8]);
  float mhat=0.f,l_reg=0.f;f32x16 o[2];o[0]=f32x16{};o[1]=f32x16{};f32x16 negm=f32x16{};asm volatile("":"+v"(negm));
  #define CMASK(P0,P1,t) do{}while(0)
  bool resc=false;
  #define START(P0,P1) do{ const float rm=rowmax(P0,P1); resc=false; \
    { const float dl=rm; mhat=fadd_s(mhat,dl); \
      _Pragma("unroll") for(int r=0;r<16;++r){P0[r]=fsub_s(P0[r],dl);P1[r]=fsub_s(P1[r],dl);} \
      _Pragma("unroll") for(int r=0;r<16;++r)negm[r]=-mhat; asm volatile("":"+v"(negm)); } \
    _Pragma("unroll") for(int r=0;r<16;++r)P0[r]=__builtin_amdgcn_exp2f(P0[r]); }while(0)
  #define RESC() do{ if(resc){ asm volatile("s_waitcnt lgkmcnt(0)":::"memory"); \
      _Pragma("unroll") for(int d_=0;d_<2;++d_) _Pragma("unroll") for(int r=0;r<16;++r)o[d_][r]*=wsf[crow(r,hi)]; } }while(0)
  f32x16 pA0,pA1,pB0,pB1;
  int sl_prev=0,sl_cur=0,sl_next=SLOTB;
  #define ROT() do{sl_prev=sl_cur;sl_cur=sl_next;sl_next=(sl_next==(NSLOT-1)*SLOTB)?0:sl_next+SLOTB;}while(0)
  DMA_K(2,2*SLOTB);
  WAIT_BAR(3);
  qkt(pA0,pA1,Kbase,qr,negm,r32,hi);asm volatile("s_nop 15\n\ts_nop 7":"+v"(pA0),"+v"(pA1));CMASK(pA0,pA1,0);
  START(pA0,pA1);
  _Pragma("unroll") for(int r=0;r<16;++r)pA1[r]=__builtin_amdgcn_exp2f(pA1[r]);
  WAIT_BAR(0);
  DMA_K(3,0);DMA_V(1,SLOTB);
  ROT();
  kload8(kf,kp0+sl_cur);
  WAIT_BAR(2);
  s16x4 vlo[8],vhi[8]; u32x4 pw0,pw1,pw2,pw3;
  #define PKW(P,B) cvtpk_s(P[B],P[B+1])
  #define PAF(k) __builtin_bit_cast(bf16x8,pw##k)
  #define VFR(i) (bf16x8){vlo[i][0],vlo[i][1],vlo[i][2],vlo[i][3],vhi[i][0],vhi[i][1],vhi[i][2],vhi[i][3]}
  #define PIN(x) asm volatile("":"+v"(x))
  #define MX3(a,b,c) __builtin_fmaxf(__builtin_fmaxf((a),(b)),(c))
  #define GAPA(MF,A0,A1,A2,A3,W0,W1,PW) do{ MF; sacc+=A0; sacc+=A1; sacc+=A2; sacc+=A3; PIN(sacc); W0; W1; PIN(PW); SBAR(); }while(0)
  #define EX(v) __builtin_amdgcn_exp2f(v)
  #define GAPB(MF,X,B) do{ MF; X[B]=EX(X[B]); X[B+1]=EX(X[B+1]); X[B+2]=EX(X[B+2]); X[B+3]=EX(X[B+3]); PIN(X); SBAR(); }while(0)
  #define VRD(i) do{ vlo[i]=vtr(vp_+(((i)>>2)*4096+((i)&3)*1024)); vhi[i]=vtr(vp_+(((i)>>2)*4096+((i)&3)*1024+512)); }while(0)
  #define KRD(G,j) do{ if(G){ kload2(kf,kp0+sl_next,j); SBAR(); } }while(0)
  #define STEP(C0,C1,P0,P1,t,GK,GV,GL) do{ SBAR(); \
    const lds_cptr vp_=vp0+sl_prev; \
    VRD(0); SBAR(); float sacc=(P0[0]+P0[1]); \
    GAPA(C0=__builtin_amdgcn_mfma_f32_32x32x16_bf16(kf[0],qr[0],negm,0,0,0), P0[2],P0[3],P0[4],P0[5],     pw0[0]=PKW(P0,0), pw0[1]=PKW(P0,2), pw0); \
    VRD(4); SBAR(); GAPA(C1=__builtin_amdgcn_mfma_f32_32x32x16_bf16(kf[1],qr[0],negm,0,0,0), P0[6],P0[7],P0[8],P0[9],     pw0[2]=PKW(P0,4), pw0[3]=PKW(P0,6), pw0); \
    VRD(1); SBAR(); GAPA(C0=__builtin_amdgcn_mfma_f32_32x32x16_bf16(kf[2],qr[1],C0,0,0,0),   P0[10],P0[11],P0[12],P0[13], pw1[0]=PKW(P0,8), pw1[1]=PKW(P0,10), pw1); \
    VRD(5); SBAR(); GAPA(C1=__builtin_amdgcn_mfma_f32_32x32x16_bf16(kf[3],qr[1],C1,0,0,0),   P0[14],P0[15],P1[0],P1[1],   pw1[2]=PKW(P0,12),pw1[3]=PKW(P0,14), pw1); \
    VRD(2); SBAR(); GAPA(C0=__builtin_amdgcn_mfma_f32_32x32x16_bf16(kf[4],qr[2],C0,0,0,0),   P1[2],P1[3],P1[4],P1[5],     pw2[0]=PKW(P1,0), pw2[1]=PKW(P1,2), pw2); \
    VRD(6); SBAR(); GAPA(C1=__builtin_amdgcn_mfma_f32_32x32x16_bf16(kf[5],qr[2],C1,0,0,0),   P1[6],P1[7],P1[8],P1[9],     pw2[2]=PKW(P1,4), pw2[3]=PKW(P1,6), pw2); \
    VRD(3); SBAR(); GAPA(C0=__builtin_amdgcn_mfma_f32_32x32x16_bf16(kf[6],qr[3],C0,0,0,0),   P1[10],P1[11],P1[12],P1[13], pw3[0]=PKW(P1,8), pw3[1]=PKW(P1,10), pw3); \
    VRD(7); SBAR(); GAPA(C1=__builtin_amdgcn_mfma_f32_32x32x16_bf16(kf[7],qr[3],C1,0,0,0),   P1[14],P1[15],0.f,0.f,       pw3[2]=PKW(P1,12),pw3[3]=PKW(P1,14), pw3); \
    l_reg+=sacc; \
    if(GK){DMA_K((t)+3,sl_cur);} if(GV){DMA_V((t)+1,sl_next);} \
    CMASK(C0,C1,t); \
    { float a=MX3(C0[0],C0[1],C1[0]),b=MX3(C0[2],C0[3],C1[1]); a=MX3(a,C1[2],C1[3]); \
      _Pragma("unroll") for(int r=4;r<16;r+=4){a=MX3(a,C0[r],C0[r+1]);b=MX3(b,C0[r+2],C0[r+3]);a=MX3(a,C1[r],C1[r+1]);b=MX3(b,C1[r+2],C1[r+3]);} \
      float rm=__builtin_fmaxf(a,b); { auto rr=__builtin_amdgcn_permlane32_swap(__float_as_uint(rm),__float_as_uint(rm),false,false); rm=__builtin_fmaxf(__uint_as_float(rr[0]),__uint_as_float(rr[1])); } \
      resc=false; \
      if(__builtin_expect(__any(rm>(float)THRL),0)){ const float dl=__builtin_fmaxf(rm,0.f); mhat+=dl; \
        _Pragma("unroll") for(int r=0;r<16;++r){C0[r]-=dl;C1[r]-=dl;} \
        _Pragma("unroll") for(int r=0;r<16;++r)negm[r]=-mhat; asm volatile("":"+v"(negm)); \
        const float f=__builtin_amdgcn_exp2f(-dl); l_reg*=f; if(hi==0)wsf[r32]=f; resc=true; } } \
    SBAR(); \
    GAPB(o[0]=__builtin_amdgcn_mfma_f32_32x32x16_bf16(PAF(0),VFR(0),o[0],0,0,0), C0,0); \
    GAPB(o[1]=__builtin_amdgcn_mfma_f32_32x32x16_bf16(PAF(0),VFR(4),o[1],0,0,0), C0,4); \
    KRD(GL,0); GAPB(o[0]=__builtin_amdgcn_mfma_f32_32x32x16_bf16(PAF(1),VFR(1),o[0],0,0,0), C0,8); \
    KRD(GL,1); GAPB(o[1]=__builtin_amdgcn_mfma_f32_32x32x16_bf16(PAF(1),VFR(5),o[1],0,0,0), C0,12); \
    KRD(GL,2); GAPB(o[0]=__builtin_amdgcn_mfma_f32_32x32x16_bf16(PAF(2),VFR(2),o[0],0,0,0), C1,0); \
    KRD(GL,3); GAPB(o[1]=__builtin_amdgcn_mfma_f32_32x32x16_bf16(PAF(2),VFR(6),o[1],0,0,0), C1,4); \
    GAPB(o[0]=__builtin_amdgcn_mfma_f32_32x32x16_bf16(PAF(3),VFR(3),o[0],0,0,0), C1,8); \
    GAPB(o[1]=__builtin_amdgcn_mfma_f32_32x32x16_bf16(PAF(3),VFR(7),o[1],0,0,0), C1,12); \
    }while(0)
  int t=1;
  #undef CMASK
  #define CMASK(P0,P1,t) do{}while(0)
  for(;t+5<NT;t+=2){
    STEP(pB0,pB1,pA0,pA1,t,true,true,true);     WAIT_BAR(2); RESC(); ROT();
    STEP(pA0,pA1,pB0,pB1,t+1,true,true,true);   WAIT_BAR(2); RESC(); ROT();
  }
  #undef CMASK
  #define CMASK(P0,P1,t) do{}while(0)
  #define ENDW(tt) do{ if((tt)+3<NT){WAIT_BAR(2);} else if((tt)+2<NT){WAIT_BAR(1);} else {WAIT_BAR(0);} }while(0)
  for(;t+1<NT;t+=2){
    STEP(pB0,pB1,pA0,pA1,t,(t+3<NT),(t+1<NT),(t+1<NT));       ENDW(t);   RESC(); ROT();
    STEP(pA0,pA1,pB0,pB1,t+1,(t+4<NT),(t+2<NT),(t+2<NT));     ENDW(t+1); RESC(); ROT();
  }
  STEP(pB0,pB1,pA0,pA1,NT-1,false,false,false); RESC();
  { float sacc=pB0[0]+pB0[1]; _Pragma("unroll") for(int r=2;r<16;++r)sacc+=pB0[r]; _Pragma("unroll") for(int r=0;r<16;++r)sacc+=pB1[r]; l_reg+=sacc;
    pw0=(u32x4){PKW(pB0,0),PKW(pB0,2),PKW(pB0,4),PKW(pB0,6)};pw1=(u32x4){PKW(pB0,8),PKW(pB0,10),PKW(pB0,12),PKW(pB0,14)};pw2=(u32x4){PKW(pB1,0),PKW(pB1,2),PKW(pB1,4),PKW(pB1,6)};pw3=(u32x4){PKW(pB1,8),PKW(pB1,10),PKW(pB1,12),PKW(pB1,14)};
    SBAR(); pv(o,vb0+sl_cur,PAF(0),PAF(1),PAF(2),PAF(3)); }
  #undef PKW
  #undef PAF
  #undef VFR
  #undef PIN
  #undef MX3
  #undef GAPA
  #undef GAPB
  #undef EX
  #undef VRD
  #undef KRD
  #undef STEP
  #undef ENDW
  {auto rr=__builtin_amdgcn_permlane32_swap(__float_as_uint(l_reg),__float_as_uint(l_reg),false,false);l_reg=__uint_as_float(rr[0])+__uint_as_float(rr[1]);}
  if(hi==0)wsf[32+r32]=l_reg;asm volatile("s_waitcnt lgkmcnt(0)":::"memory");
  float rli[16];
  #pragma unroll
  for(int r=0;r<16;++r)rli[r]=__builtin_amdgcn_rcpf(wsf[32+crow(r,hi)]);
  bf16*Ow=O+(rowbase+q0+wid*QBLK)*OP+h*D;
  { bf16*stg=(bf16*)(shm+LDS_OST)+wid*2048;
    #pragma unroll
    for(int r=0;r<16;++r){const int orow=crow(r,hi);
      #pragma unroll
      for(int d0=0;d0<2;++d0)stg[orow*64+d0*32+r32]=__float2bfloat16(o[d0][r]*rli[r]);}
    asm volatile("s_waitcnt lgkmcnt(0)":::"memory");
    #pragma unroll
    for(int i=0;i<4;++i){const int row=i*8+(lane>>3),ch=lane&7; const u32x4 v=*(const u32x4*)(stg+row*64+ch*8); ATTN_STORE16(Ow+(long)row*OP+ch*8,v);} }
  asm volatile("s_waitcnt lgkmcnt(0)\n\ts_barrier":::"memory");
  #undef DMA_K
  #undef DMA_V
  #undef CMASK
  #undef START
  #undef RESC
  #undef ROT
}
constexpr int ATTN_LDS_BYTES=LDS_BYTES;
#undef SBAR
#undef WAIT_BAR
}

constexpr int FBUF = 8720;
__device__ __forceinline__ int fpad(int i) { return i + (i >> 5) + 18 * (i >> 9); }
constexpr float kTwC[16] = {1.000000000e+00f, 9.807852804e-01f, 9.238795325e-01f, 8.314696123e-01f, 7.071067812e-01f, 5.555702330e-01f, 3.826834324e-01f, 1.950903220e-01f,
                            0.0f, -1.950903220e-01f, -3.826834324e-01f, -5.555702330e-01f, -7.071067812e-01f, -8.314696123e-01f, -9.238795325e-01f, -9.807852804e-01f};
constexpr float kTwS[16] = {0.000000000e+00f, 1.950903220e-01f, 3.826834324e-01f, 5.555702330e-01f, 7.071067812e-01f, 8.314696123e-01f, 9.238795325e-01f, 9.807852804e-01f,
                            1.000000000e+00f, 9.807852804e-01f, 9.238795325e-01f, 8.314696123e-01f, 7.071067812e-01f, 5.555702330e-01f, 3.826834324e-01f, 1.950903220e-01f};
template <int N> __device__ __forceinline__ void dft_dif(f32x2 (&v)[N]) {
#pragma unroll
    for (int len = N; len >= 2; len >>= 1) {
        const int half = len / 2;
#pragma unroll
        for (int base = 0; base < N; base += len)
#pragma unroll
            for (int j = 0; j < half; ++j) {
                const f32x2 a = v[base + j], b = v[base + j + half];
                v[base + j] = a + b;
                const f32x2 d = a - b;
                const int ti = j * (32 / len);
                v[base + j + half] = (ti == 0) ? d : (f32x2){d.x * kTwC[ti] + d.y * kTwS[ti], d.y * kTwC[ti] - d.x * kTwS[ti]};
            }
    }
}
__host__ __device__ constexpr int brev(int i, int bits) { int r = 0; for (int b = 0; b < bits; ++b) r |= ((i >> b) & 1) << (bits - 1 - b); return r; }

#define FFT_BAR() asm volatile("s_waitcnt lgkmcnt(0)\n\ts_barrier" ::: "memory")
__device__ __forceinline__ void fft8192(LAS f32x2* buf, int tid_in) {
    int tid = tid_in; asm volatile("" : "+v"(tid));
    {
        const int n2 = tid; f32x2 v[16];
        LAS f32x2* p = buf + n2 + (n2 >> 5);
#pragma unroll
        for (int n1 = 0; n1 < 16; ++n1) v[n1] = p[546 * n1];
        dft_dif<16>(v);
        const float rv1 = (float)n2 * (1.f / 8192.f); const float c = __builtin_amdgcn_cosf(rv1), s = -__builtin_amdgcn_sinf(rv1);
        f32x2 pw[16]; pw[0] = (f32x2){1.f, 0.f}; pw[1] = (f32x2){c, s};
#pragma unroll
        for (int k = 2; k < 16; ++k) pw[k] = cmul(pw[k - 1], pw[1]);
#pragma unroll
        for (int i = 0; i < 16; ++i) { const int k1 = brev(i, 4); p[546 * k1] = cmul(v[i], pw[k1]); }
    }
    FFT_BAR();
    {
        const int k1 = tid >> 5, b = tid & 31; f32x2 v[16];
        LAS f32x2* p = buf + 546 * k1 + b;
#pragma unroll
        for (int a = 0; a < 16; ++a) v[a] = p[33 * a];
        dft_dif<16>(v);
        const float rv2 = (float)b * (1.f / 512.f); const float c = __builtin_amdgcn_cosf(rv2), s = -__builtin_amdgcn_sinf(rv2);
        f32x2 pw[16]; pw[0] = (f32x2){1.f, 0.f}; pw[1] = (f32x2){c, s};
#pragma unroll
        for (int k = 2; k < 16; ++k) pw[k] = cmul(pw[k - 1], pw[1]);
#pragma unroll
        for (int i = 0; i < 16; ++i) { const int ka = brev(i, 4); p[33 * ka] = cmul(v[i], pw[ka]); }
    }
    FFT_BAR();
    {
        const int ka = (tid >> 4) & 15, k1 = tid & 15; f32x2 v[32];
        if (tid < 256) {
            const LAS f32x2* p = buf + 546 * k1 + 33 * ka;
#pragma unroll
            for (int b = 0; b < 32; ++b) v[b] = p[b];
            dft_dif<32>(v);
        }
        FFT_BAR();
        if (tid < 256) {
            LAS f32x2* q = buf + k1 + 16 * ka + (ka >> 1);
#pragma unroll
            for (int i = 0; i < 32; ++i) { const int kb = brev(i, 5); q[264 * kb + 18 * (kb >> 1)] = v[i]; }
        }
    }
    FFT_BAR();
}

__device__ __forceinline__ float hy_sconv(const bf16* xrow, unsigned t, float w0, float w1, float w2, float bias) {
    const unsigned tm = t > 0u ? t - 1u : 0u, tp = t < (unsigned)(SEQ - 1) ? t + 1u : (unsigned)(SEQ - 1);
    const float xm = t > 0u ? bf2f(xrow[tm]) : 0.f, x0 = bf2f(xrow[t]), xp = t < (unsigned)(SEQ - 1) ? bf2f(xrow[tp]) : 0.f;
    return xm * w0 + x0 * w1 + xp * w2 + bias;
}

__device__ __forceinline__ void hy_sconv_row(Frame& F, const Args& args, int l, int row  ) {
    const int lane = F.lane, ch = row >> 3;
    bf16* x = WSP(bf16, WS_RB + RB_HYT) + (size_t)ch * M + (size_t)(row & 7) * SEQ;
    const float* cw = FIN(I_HY_CW) + (size_t)l * 3 * 768; const float w0 = cw[ch], w1 = cw[768 + ch], w2 = cw[1536 + ch], bias = FIN(I_HY_CB)[(size_t)l * 768 + ch];
    v4u raw[8];
#pragma unroll
    for (int k = 0; k < 8; ++k) raw[k] = *(const v4u*)(x + 8 * lane + 512 * k);
    float first[8], lastv[8];
#pragma unroll
    for (int k = 0; k < 8; ++k) { first[k] = bflo(raw[k].x); lastv[k] = bfhi(raw[k].w); }
#pragma unroll
    for (int k = 0; k < 8; ++k) {
        float v[10];
        v[1] = bflo(raw[k].x); v[2] = bfhi(raw[k].x); v[3] = bflo(raw[k].y); v[4] = bfhi(raw[k].y); v[5] = bflo(raw[k].z); v[6] = bfhi(raw[k].z); v[7] = bflo(raw[k].w); v[8] = bfhi(raw[k].w);
        const float lft = __shfl_up(lastv[k], 1), lft0 = k > 0 ? __shfl(lastv[k > 0 ? k - 1 : 0], 63) : 0.f;
        const float rgt = __shfl_down(first[k], 1), rgt63 = k < 7 ? __shfl(first[k < 7 ? k + 1 : 7], 0) : 0.f;
        v[0] = lane == 0 ? lft0 : lft; v[9] = lane == 63 ? rgt63 : rgt;
        float o[8];
#pragma unroll
        for (int e = 0; e < 8; ++e) o[e] = v[e] * w0 + v[e + 1] * w1 + v[e + 2] * w2 + bias;
        v4u w; w.x = pk2(o[0], o[1]); w.y = pk2(o[2], o[3]); w.z = pk2(o[4], o[5]); w.w = pk2(o[6], o[7]);
        *(v4u*)(x + 8 * lane + 512 * k) = w;
    }
}
__device__ __forceinline__ void hy_taps_block(Frame& F, const Args& args, int l, int tb) {
    LAS float* F2 = (LAS float*)F.lds;
    const int tid = F.tid, t0 = tb * 16;
    const float* f2 = WSP(float, WS_HF2) + ((size_t)l * 4096 + t0) * 64;
    __syncthreads();
    for (int i = tid; i < 16 * 64; i += 512) F2[i] = f2[i];
    __syncthreads();
    const float* w3 = FIN(I_HY_W3) + (size_t)l * 64 * 1024;
    float acc0[16], acc1[16];
#pragma unroll
    for (int j = 0; j < 16; ++j) { acc0[j] = 0.f; acc1[j] = 0.f; }
#pragma unroll 4
    for (int i = 0; i < 64; ++i) { const float wa = w3[i * 1024 + tid], wb = w3[i * 1024 + 512 + tid];
#pragma unroll
        for (int j = 0; j < 16; ++j) { const float x = F2[j * 64 + i]; acc0[j] += x * wa; acc1[j] += x * wb; } }
    const int c = tid & 255;
    const float delta = fabsf(-3.0701134573253945f + (float)c * ((-15.350567286626973f + 3.0701134573253945f) / 255.f));
    float* tt = WSP(float, WS_TT);
#pragma unroll
    for (int j = 0; j < 16; j += 4) { f32x4 o0, o1;
#pragma unroll
        for (int q = 0; q < 4; ++q) { const float dec = expf(-(float)(t0 + j + q) * (1.f / 4095.f) * delta); o0[q] = acc0[j + q] * dec; o1[q] = acc1[j + q] * dec; }
        *(f32x4*)(tt + (size_t)tid * SEQ + t0 + j) = o0; *(f32x4*)(tt + (size_t)(512 + tid) * SEQ + t0 + j) = o1; }
}

__device__ __forceinline__ void hyena_item(Frame& F, const Args& args, int l, int c) {
    LAS f32x2* A = (LAS f32x2*)F.lds;
    LAS f32x2* B = A + FBUF;
    LAS float* W3L = (LAS float*)(B + FBUF);
    LAS float* red = W3L + 256;
    const bf16* hyT = WSP(bf16, WS_RB + RB_HYT);
    float* HV = WSP(float, WS_RD + RD_HV) + (size_t)c * 8 * SEQ;
    bf16* yaT = WSP(bf16, WS_RD + RD_YAT) + (size_t)c * M;
    const float* f2 = WSP(float, WS_HF2) + (size_t)l * 4096 * 64;
    __syncthreads();
    __syncthreads();
#pragma unroll 1
    for (int n = 0; n < 2; ++n) {
        int tid = F.tid; asm volatile("" : "+v"(tid));
        float ss = 0.f;
        {   const float* tf = WSP(float, WS_TT) + ((size_t)(0 * 2 + n) * 256 + c) * SEQ; const float* tbk = WSP(float, WS_TT) + ((size_t)(1 * 2 + n) * 256 + c) * SEQ;
#pragma unroll
            for (int j = 0; j < 8; ++j) { const int t = tid + 512 * j; const float fw = tf[t], bw = tbk[t];
                A[tid + (tid >> 5) + 546 * j] = (f32x2){fw, 0.f}; ss += fw * fw;
                if (t >= 1) { A[fpad(8192 - t)] = (f32x2){bw, 0.f}; ss += bw * bw; } } }
        if (tid == 0) A[fpad(4096)] = (f32x2){0.f, 0.f};
        ss = block_sum(F, ss, red);
        const float scale = (1.f / sqrtf(ss)) * (1.f / 8192.f);
        const float biasN = FIN(I_HY_BIAS)[((size_t)l * 2 + n) * 256 + c] * (1.f / 8192.f);
        fft8192(A, tid);
#pragma unroll
        for (int j = 0; j < 16; ++j) { LAS f32x2* p = A + tid + (tid >> 5) + 546 * j; f32x2 a = *p * scale; a.x += biasN; *p = a; }
#pragma unroll 1
        for (int pb = 0; pb < 4; ++pb) {
            int tq = tid; asm volatile("" : "+v"(tq));
            const bf16* zr0 = hyT + (size_t)c * M + (size_t)(2 * pb) * SEQ; const bf16* zr1 = zr0 + SEQ;
            const bf16* gr0 = hyT + (size_t)((n + 1) * 256 + c) * M + (size_t)(2 * pb) * SEQ; const bf16* gr1 = gr0 + SEQ;
            float* hv0 = HV + (size_t)(2 * pb) * SEQ; float* hv1 = hv0 + SEQ;
            __syncthreads();
#pragma unroll
            for (int j = 0; j < 8; ++j) { const unsigned t = (unsigned)tq + 512u * j; float z0, z1;
                if (n == 0) { z0 = bf2f(zr0[t]); z1 = bf2f(zr1[t]); }
                else { z0 = hv0[t]; z1 = hv1[t]; }
                B[tq + (tq >> 5) + 546 * j] = (f32x2){z0, z1}; B[tq + (tq >> 5) + 546 * (j + 8)] = (f32x2){0.f, 0.f}; }
            float g0[8], g1[8];
#pragma unroll
            for (int j = 0; j < 8; ++j) { const unsigned t = (unsigned)tq + 512u * j; g0[j] = bf2f(gr0[t]); g1[j] = bf2f(gr1[t]); }
            FFT_BAR();
            fft8192(B, tq);
#pragma unroll
            for (int j = 0; j < 16; ++j) { const int p = tq + (tq >> 5) + 546 * j; const f32x2 y = cmul(B[p], A[p]); B[p] = (f32x2){y.x, -y.y}; }
            FFT_BAR();
            fft8192(B, tq);
#pragma unroll
            for (int j = 0; j < 8; ++j) { const unsigned t = (unsigned)tq + 512u * j; const f32x2 y = B[tq + (tq >> 5) + 546 * j];
                const float o0 = g0[j] * y.x, o1 = g1[j] * -y.y;
                if (n == 0) { hv0[t] = o0; hv1[t] = o1; }
                else { yaT[(size_t)(2 * pb) * SEQ + t] = (bf16)f2bf(o0); yaT[(size_t)(2 * pb + 1) * SEQ + t] = (bf16)f2bf(o1); } }
        }
        __syncthreads();
    }
}

__device__ __forceinline__ f32x16 mfma32(bf16x8 a, bf16x8 b, f32x16 c) { return __builtin_amdgcn_mfma_f32_32x32x16_bf16(a, b, c, 0, 0, 0); }
__device__ __forceinline__ int crow(int r, int hi) { return (r & 3) + 8 * (r >> 2) + 4 * hi; }
__device__ __forceinline__ float gelu_tanh(float x) {
    const float u = 0.7978845608028654f * (x + 0.044715f * x * x * x);
    const float e = __builtin_amdgcn_exp2f(2.885390081777927f * u);
    const float th = 1.f - 2.f * __builtin_amdgcn_rcpf(e + 1.f);
    return 0.5f * x * (1.f + th);
}
__device__ __forceinline__ void s5_item(Frame& F, const Args& args, int l, int b, int g) {
    constexpr int SP = 129, XP = 136;
    LAS float* S = (LAS float*)F.lds;
    LAS bf16* XB = (LAS bf16*)(F.lds + 128 * SP * 4);
    const int tid = F.tid, lane = F.lane, w = F.wave, r32 = lane & 31, hi = lane >> 5;
    const bf16* U = WSP(bf16, WS_RB + RB_PROJ2) + (size_t)b * SEQ * PROJ2_W + PC_S5 + g * 16;
    const bf16* wst = WSP(bf16, WS_S5W + (size_t)l * S5W_LAYER + S5_WST_OFF) + (size_t)g * 2 * 128 * 512;
    const bf16* wcat = WSP(bf16, WS_S5W + (size_t)l * S5W_LAYER + S5_WCAT_OFF) + (size_t)g * 512 * 768;
    bf16* Z = WSP(bf16, WS_RD + RD_S5Z) + (size_t)b * SEQ * 256 + g * 16;
    __syncthreads();
    for (int dir = 0; dir < 2; ++dir) {
        {
            const int rt = w >> 1, ct0 = 2 * (w & 1);
            f32x16 acc[2]; acc[0] = f32x16{}; acc[1] = f32x16{};
            const bf16* ap = wst + ((size_t)dir * 128 + rt * 32 + r32) * 512 + 8 * hi;
            const bf16* bp0 = U + (size_t)(32 * (ct0 * 32 + r32)) * PROJ2_W + 8 * hi;
            const bf16* bp1 = bp0 + (size_t)(32 * 32) * PROJ2_W;
#pragma unroll 4
            for (int ks = 0; ks < 32; ++ks) {
                const bf16x8 a = *(const bf16x8*)(ap + 16 * ks);
                const bf16x8 b0 = *(const bf16x8*)(bp0 + (size_t)ks * PROJ2_W), b1 = *(const bf16x8*)(bp1 + (size_t)ks * PROJ2_W);
                acc[0] = mfma32(a, b0, acc[0]); acc[1] = mfma32(a, b1, acc[1]);
            }
#pragma unroll
            for (int q = 0; q < 2; ++q)
#pragma unroll
                for (int r = 0; r < 16; ++r) S[((ct0 + q) * 32 + r32) * SP + rt * 32 + crow(r, hi)] = acc[q][r];
        }
        __syncthreads();
        if (tid < 64) {
            const f32x2 a32 = WSP(f32x2, WS_S5A32)[((size_t)(l * 2 + dir) * 16 + g) * 64 + tid];
            f32x2 X = (f32x2){0.f, 0.f};
#pragma unroll 8
            for (int cc = 0; cc < 128; ++cc) { const int c = dir == 0 ? cc : 127 - cc;
                const f32x2 s = (f32x2){S[c * SP + 2 * tid], S[c * SP + 2 * tid + 1]};
                X = cmul(a32, X) + s;
                *(LAS unsigned*)(XB + ((size_t)dir * 128 + c) * XP + 2 * tid) = pk2(X.x, X.y); }
        }
        __syncthreads();
    }
    {
        f32x16 acc[2][4];
#pragma unroll
        for (int i = 0; i < 2; ++i)
#pragma unroll
            for (int j = 0; j < 4; ++j) acc[i][j] = f32x16{};
        const bf16* ap = wcat + (size_t)(2 * w * 32 + r32) * 768 + 8 * hi;
        const bf16* bp = U + (size_t)(32 * r32) * PROJ2_W + 8 * hi;
#pragma unroll 2
        for (int ks = 0; ks < 32; ++ks) {
            const bf16x8 a0 = *(const bf16x8*)(ap + 16 * ks), a1 = *(const bf16x8*)(ap + 32 * 768 + 16 * ks);
#pragma unroll
            for (int ct = 0; ct < 4; ++ct) { const bf16x8 bv = *(const bf16x8*)(bp + (size_t)(32 * 32 * ct + ks) * PROJ2_W);
                acc[0][ct] = mfma32(a0, bv, acc[0][ct]); acc[1][ct] = mfma32(a1, bv, acc[1][ct]); }
        }
#pragma unroll 2
        for (int ks = 0; ks < 16; ++ks) {
            const int dir = ks >> 3, kk = ks & 7;
            const bf16x8 a0 = *(const bf16x8*)(ap + 512 + 16 * ks), a1 = *(const bf16x8*)(ap + 32 * 768 + 512 + 16 * ks);
#pragma unroll
            for (int ct = 0; ct < 4; ++ct) { const int c = ct * 32 + r32, cs = dir == 0 ? c - 1 : c + 1;
                bf16x8 bv = (bf16x8){0, 0, 0, 0, 0, 0, 0, 0};
                if (cs >= 0 && cs < 128) bv = *(const LAS bf16x8*)(XB + ((size_t)dir * 128 + cs) * XP + 16 * kk + 8 * hi);
                acc[0][ct] = mfma32(a0, bv, acc[0][ct]); acc[1][ct] = mfma32(a1, bv, acc[1][ct]); }
        }
#pragma unroll
        for (int i = 0; i < 2; ++i)
#pragma unroll
            for (int ct = 0; ct < 4; ++ct)
#pragma unroll
                for (int q = 0; q < 4; ++q) {
                    const int tl = (2 * w + i) * 2 + (q >> 1), co = 8 * (q & 1) + 4 * hi, c = ct * 32 + r32;
                    v2u o; o.x = pk2(gelu_tanh(acc[i][ct][4 * q]), gelu_tanh(acc[i][ct][4 * q + 1])); o.y = pk2(gelu_tanh(acc[i][ct][4 * q + 2]), gelu_tanh(acc[i][ct][4 * q + 3]));
                    *(v2u*)(Z + (size_t)(32 * c + tl) * 256 + co) = o; }
    }
    __syncthreads();
}

__device__ __forceinline__ void dil_item(Frame& F, const Args& args, int it) {
    constexpr int RS = 144;
    LAS unsigned char* Ks = F.lds; LAS unsigned char* Vs = F.lds + 384 * RS;
    int lane = F.lane; asm volatile("" : "+v"(lane));
    const int r32 = lane & 31, hi = lane >> 5, w = F.wave;
    const int u0 = it * 8, g = u0 >> 12, b = (u0 >> 9) & 7, hh = (u0 >> 7) & 3, tile0 = u0 & 127;
    const int dsh = 2 * g, Lp = SEQ >> dsh, tpr = Lp >> 5, rho = tile0 / tpr, q0 = (tile0 % tpr) * 32, h = g * 4 + hh;
    const float slope2 = exp2f(-8.f * (float)(h + 1) * (1.f / 12.f)) * (float)(1 << dsh) * 1.4426950408889634f;
    const char* P2 = (const char*)(WSP(bf16, WS_RB + RB_PROJ2) + (size_t)b * SEQ * PROJ2_W);
#define DIL_ROWB(tp) ((unsigned)(rho + ((tp) << dsh)) * (unsigned)(PROJ2_W * 2))
    __syncthreads();
    {   int tq = F.tid; asm volatile("" : "+v"(tq));
#pragma unroll
        for (int k = 0; k < 6; ++k) { const int id = tq + 512 * k, row = id >> 3, ch = id & 7;
            int tj = q0 - 64 + row; tj = tj < 0 ? 0 : (tj > Lp - 1 ? Lp - 1 : tj);
            const unsigned ro = DIL_ROWB(tj) + (unsigned)(h * 64 + ch * 8) * 2u;
            const v4u kv = *(const v4u*)(P2 + ro + PC_DK * 2), vv = *(const v4u*)(P2 + ro + PC_DV * 2);
            *(LAS v4u*)(Ks + row * RS + ch * 16) = kv; *(LAS v4u*)(Vs + row * RS + ch * 16) = vv; } }
    const int tau0 = q0 + 32 * w;
    bf16x8 qf[4];
    { const unsigned qo = DIL_ROWB(tau0 + r32) + (unsigned)(PC_DQ + h * 64 + 8 * hi) * 2u;
#pragma unroll
      for (int ks = 0; ks < 4; ++ks) qf[ks] = *(const bf16x8*)(P2 + qo + 32 * ks); }
    __syncthreads();
    f32x16 S[5];
#pragma unroll
    for (int kt = 0; kt < 5; ++kt) {
        const LAS unsigned char* kp = Ks + (32 * w + 32 * kt + r32) * RS + 16 * hi;
        f32x16 a = f32x16{};
#pragma unroll
        for (int ks = 0; ks < 4; ++ks) a = mfma32(*(const LAS bf16x8*)(kp + 32 * ks), qf[ks], a);
        S[kt] = a;
    }
    float mx = -1e30f;
    const float cr32 = (float)r32;
    if (tau0 >= 64 && tau0 + 96 <= Lp) {
#pragma unroll
        for (int kt = 0; kt < 5; ++kt)
#pragma unroll
            for (int r = 0; r < 16; ++r) { const float dlf = (float)(-64 + 32 * kt + crow(r, 0)) + (float)(4 * hi) - cr32;
                float sc = S[kt][r] * (0.125f * 1.4426950408889634f) - slope2 * fabsf(dlf);
                if (kt == 0) sc = dlf >= -64.f ? sc : -1e30f;
                if (kt == 4) sc = dlf <= 64.f ? sc : -1e30f;
                S[kt][r] = sc; mx = fmaxf(mx, sc); }
    } else {
#pragma unroll
        for (int kt = 0; kt < 5; ++kt)
#pragma unroll
            for (int r = 0; r < 16; ++r) { const int dl = -64 + 32 * kt + crow(r, hi) - r32, tj = tau0 + r32 + dl;
                const bool ok = dl >= -64 && dl <= 64 && tj >= 0 && tj < Lp;
                const float sc = S[kt][r] * (0.125f * 1.4426950408889634f) - slope2 * (float)(dl < 0 ? -dl : dl);
                S[kt][r] = ok ? sc : -1e30f; mx = fmaxf(mx, S[kt][r]); }
    }
    mx = fmaxf(mx, __shfl_xor(mx, 32));
    float lsum = 0.f;
#pragma unroll
    for (int kt = 0; kt < 5; ++kt)
#pragma unroll
        for (int r = 0; r < 16; ++r) { const float p = __builtin_amdgcn_exp2f(S[kt][r] - mx); S[kt][r] = p; lsum += p; }
    lsum += __shfl_xor(lsum, 32);
    f32x16 O[2]; O[0] = f32x16{}; O[1] = f32x16{};
    const LAS unsigned short* vb = (const LAS unsigned short*)(Vs + (32 * w + 4 * hi) * RS) + r32;
#pragma unroll
    for (int kt = 0; kt < 5; ++kt)
#pragma unroll
        for (int s = 0; s < 2; ++s) {
            bf16x8 pa; bf16x8 v0, v1;
#pragma unroll
            for (int j = 0; j < 8; j += 2) { const unsigned pw = pk2(S[kt][8 * s + j], S[kt][8 * s + j + 1]); pa[j] = (short)(pw & 0xffff); pa[j + 1] = (short)(pw >> 16); }
#pragma unroll
            for (int j = 0; j < 8; ++j) { const LAS unsigned short* vp = vb + (32 * kt + 16 * s + 8 * (j >> 2) + (j & 3)) * (RS / 2); v0[j] = (short)vp[0]; v1[j] = (short)vp[32]; }
            O[0] = mfma32(pa, v0, O[0]); O[1] = mfma32(pa, v1, O[1]);
        }
    const float linv = 1.f / lsum;
    bf16* Og = WSP(bf16, WS_RD + RD_DILO) + (size_t)g * M * 256 + (size_t)b * SEQ * 256 + hh * 64 + r32;
#pragma unroll
    for (int r = 0; r < 16; ++r) { const int i = crow(r, hi); const float li = __shfl(linv, i);
        const unsigned ro = (unsigned)(rho + ((tau0 + i) << dsh)) * 256u;
        Og[ro] = (bf16)f2bf(O[0][r] * li); Og[ro + 32] = (bf16)f2bf(O[1][r] * li); }
    if (hi == 0) WSP(float, WS_DLSE)[((size_t)g * M + (size_t)b * SEQ + rho + ((tau0 + r32) << dsh)) * 4 + hh] = (mx + log2f(lsum)) * 0.6931471805599453f;
#undef DIL_ROWB
}

__device__ __forceinline__ void gqa_prep_rows(Frame& F, const Args& args, int l, int m0) {
    const int lane = F.lane, grp = lane >> 4, li = lane & 15;
    const bf16* P2 = WSP(bf16, WS_RB + RB_PROJ2); bf16* QK = WSP(bf16, WS_RD + RD_QKVG);
    const f32x4 qn = *(const f32x4*)(FIN(I_GQ_QN) + l * 64 + 4 * li), kn = *(const f32x4*)(FIN(I_GQ_KN) + l * 64 + 4 * li);
#pragma unroll
    for (int p = 0; p < 3; ++p) {
        const int s = 4 * p + grp, rsel = s >= 6 ? 1 : 0, hs = s - 6 * rsel, m = m0 + rsel, t = m & (SEQ - 1);
        const v2u raw = *(const v2u*)(P2 + (size_t)m * PROJ2_W + PC_GQ + hs * 64 + 4 * li);
        f32x4 x = (f32x4){bflo(raw.x), bfhi(raw.x), bflo(raw.y), bfhi(raw.y)};
        float ss = (x[0] * x[0] + x[1] * x[1]) + (x[2] * x[2] + x[3] * x[3]);
        ss += __shfl_xor(ss, 1); ss += __shfl_xor(ss, 2); ss += __shfl_xor(ss, 4); ss += __shfl_xor(ss, 8);
        const float rn = 1.f / sqrtf(ss * (1.f / 64.f) + RMS_EPS);
        x = x * rn * (hs < 4 ? qn : kn);
        f32x4 pr; pr[0] = __shfl_xor(x[0], 4); pr[1] = __shfl_xor(x[1], 4); pr[2] = __shfl_xor(x[2], 4); pr[3] = __shfl_xor(x[3], 4);
        const int pos = li >= 8 ? (t & 63) : (t >> 6);
        const f32x4* cs = (const f32x4*)(WSP(f32x2, WS_ROPE) + pos * 16 + 4 * (li & 3));
        const f32x4 cs0 = cs[0], cs1 = cs[1];
        const float sg = (li & 4) ? 1.f : -1.f, sc = hs < 4 ? 0.125f * 1.4426950408889634f : 1.f;
        f32x4 o; o[0] = (x[0] * cs0[0] + sg * pr[0] * cs0[1]) * sc; o[1] = (x[1] * cs0[2] + sg * pr[1] * cs0[3]) * sc; o[2] = (x[2] * cs1[0] + sg * pr[2] * cs1[1]) * sc; o[3] = (x[3] * cs1[2] + sg * pr[3] * cs1[3]) * sc;
        v2u w; w.x = pk2(o[0], o[1]); w.y = pk2(o[2], o[3]);
        *(v2u*)(QK + (size_t)m * 512 + hs * 64 + 4 * li) = w;
    }
    { const int m = m0 + (lane >> 5), c4 = 4 * (lane & 31);
      *(v2u*)(QK + (size_t)m * 512 + 384 + c4) = *(const v2u*)(P2 + (size_t)m * PROJ2_W + PC_GV + c4); }
}

__device__ __forceinline__ void hy_transpose_item(Frame& F, int item) {
    LAS bf16* T = (LAS bf16*)F.lds + F.wave * (64 * 66);
    const int lane = F.lane, mb = item >> 2, cb = item & 3;
    const bf16* src = WSP(bf16, WS_RD + RD_YAT) + (size_t)(cb * 64) * M + (size_t)mb * 64;
    bf16* dst = WSP(bf16, WS_Y) + (size_t)(mb * 64) * 1024 + cb * 64;
#pragma unroll
    for (int i = 0; i < 8; ++i) { const int c = 8 * i + (lane >> 3), m0 = (lane & 7) * 8; const v4u v = *(const v4u*)(src + (size_t)c * M + m0);
        LAS unsigned* tp = (LAS unsigned*)(T + c * 66 + m0); tp[0] = v.x; tp[1] = v.y; tp[2] = v.z; tp[3] = v.w; }
    LDS_WAIT(); asm volatile("" ::: "memory");
#pragma unroll
    for (int i = 0; i < 8; ++i) { const int m = 8 * i + (lane >> 3), c0 = (lane & 7) * 8; unsigned short e[8];
#pragma unroll
        for (int j = 0; j < 8; ++j) e[j] = T[(c0 + j) * 66 + m];
        v4u o; o.x = e[0] | ((unsigned)e[1] << 16); o.y = e[2] | ((unsigned)e[3] << 16); o.z = e[4] | ((unsigned)e[5] << 16); o.w = e[6] | ((unsigned)e[7] << 16);
        *(v4u*)(dst + (size_t)m * 1024 + c0) = o; }
    LDS_WAIT(); asm volatile("" ::: "memory");
}
__device__ __forceinline__ void dil_combine_row(Frame& F, int m) {
    const int lane = F.lane, hh = lane >> 4;
    const float* ls = WSP(float, WS_DLSE);
    const float l0 = ls[((size_t)0 * M + m) * 4 + hh], l1 = ls[((size_t)1 * M + m) * 4 + hh], l2 = ls[((size_t)2 * M + m) * 4 + hh];
    const float mx = fmaxf(l0, fmaxf(l1, l2)); const float e0 = expf(l0 - mx), e1 = expf(l1 - mx), e2 = expf(l2 - mx), inv = 1.f / (e0 + e1 + e2);
    const bf16* o = WSP(bf16, WS_RD + RD_DILO) + (size_t)m * 256 + 4 * lane;
    const v2u a = *(const v2u*)o, b = *(const v2u*)(o + (size_t)M * 256), c = *(const v2u*)(o + (size_t)2 * M * 256);
    const float w0 = e0 * inv, w1 = e1 * inv, w2 = e2 * inv;
    v2u r; r.x = pk2(w0 * bflo(a.x) + w1 * bflo(b.x) + w2 * bflo(c.x), w0 * bfhi(a.x) + w1 * bfhi(b.x) + w2 * bfhi(c.x));
    r.y = pk2(w0 * bflo(a.y) + w1 * bflo(b.y) + w2 * bflo(c.y), w0 * bfhi(a.y) + w1 * bfhi(b.y) + w2 * bfhi(c.y));
    *(v2u*)(WSP(bf16, WS_Y) + (size_t)m * 1024 + 256 + 4 * lane) = r;
}

__device__ __forceinline__ void ln1_router_phase(Frame& F, const Args& args, int l) {
    LAS float* RT = (LAS float*)F.lds;
    const float* rw = FIN(I_ROUTER) + (size_t)l * 1024 * 16;
    __syncthreads();
    for (int i = F.tid; i < 1024 * 16; i += 512) { const int col = i >> 4, e = i & 15; RT[e * 1024 + col] = rw[i]; }
    __syncthreads();
    const int gw = F.bid * 8 + F.wave, NGW = F.G * 8, lane = F.lane;
    const bf16* pre = WSP(bf16, WS_RB + RB_PRE);
    v2u nx[4];
#pragma unroll
    for (int j = 0; j < 4; ++j) nx[j] = *(const v2u*)(pre + (size_t)gw * DM + 4 * lane + 256 * j);
    for (int m = gw; m < M; m += NGW) {
        f32x4 v[4];
#pragma unroll
        for (int j = 0; j < 4; ++j) v[j] = (f32x4){bflo(nx[j].x), bfhi(nx[j].x), bflo(nx[j].y), bfhi(nx[j].y)};
        if (m + NGW < M) {
#pragma unroll
            for (int j = 0; j < 4; ++j) nx[j] = *(const v2u*)(pre + (size_t)(m + NGW) * DM + 4 * lane + 256 * j); }
        ln_row(v, FIN(I_LN1G) + l * DM, FIN(I_LN1B) + l * DM, lane);
        store_row_bf16(v, WSP(bf16, WS_HB) + (size_t)m * DM, lane);
        float lg[16];
#pragma unroll
        for (int e = 0; e < 16; ++e) { float a = 0.f;
#pragma unroll
            for (int j = 0; j < 4; ++j) { const f32x4 w = *(const LAS f32x4*)(RT + e * 1024 + 4 * lane + 256 * j); a += v[j].x * w.x + v[j].y * w.y + v[j].z * w.z + v[j].w * w.w; }
            lg[e] = a; if (e & 1) asm volatile("" ::: "memory"); }
#pragma unroll
        for (int e = 0; e < 8; ++e) { const bool up = (lane & 32) != 0; const float keep = up ? lg[e + 8] : lg[e], give = up ? lg[e] : lg[e + 8]; lg[e] = keep + __shfl_xor(give, 32); }
#pragma unroll
        for (int e = 0; e < 4; ++e) { const bool up = (lane & 16) != 0; const float keep = up ? lg[e + 4] : lg[e], give = up ? lg[e] : lg[e + 4]; lg[e] = keep + __shfl_xor(give, 16); }
#pragma unroll
        for (int e = 0; e < 2; ++e) { const bool up = (lane & 8) != 0; const float keep = up ? lg[e + 2] : lg[e], give = up ? lg[e] : lg[e + 2]; lg[e] = keep + __shfl_xor(give, 8); }
        { const bool up = (lane & 4) != 0; const float keep = up ? lg[1] : lg[0], give = up ? lg[0] : lg[1]; lg[0] = keep + __shfl_xor(give, 4); }
        float z = lg[0]; z += __shfl_xor(z, 2); z += __shfl_xor(z, 1);
        float mx = z; mx = fmaxf(mx, __shfl_xor(mx, 4)); mx = fmaxf(mx, __shfl_xor(mx, 8)); mx = fmaxf(mx, __shfl_xor(mx, 16)); mx = fmaxf(mx, __shfl_xor(mx, 32));
        const float p = expf(z - mx); float den = p; den += __shfl_xor(den, 4); den += __shfl_xor(den, 8); den += __shfl_xor(den, 16); den += __shfl_xor(den, 32);
        if ((lane & 3) == 0) { const int e = ((lane >> 5) & 1) * 8 + ((lane >> 4) & 1) * 4 + ((lane >> 3) & 1) * 2 + ((lane >> 2) & 1); WSP(float, WS_AFF)[(size_t)m * 16 + e] = p / den; }
    }
}

__device__ __forceinline__ int wave_incl_scan(int v, int lane) {
#pragma unroll
    for (int o = 1; o < 64; o <<= 1) { const int n = __shfl_up(v, o); if (lane >= o) v += n; }
    return v;
}
__device__ __forceinline__ int block_excl_scan(Frame& F, int v, LAS int* sc) {
    const int inc = wave_incl_scan(v, F.lane);
    __syncthreads();
    if (F.lane == 63) sc[F.wave] = inc;
    __syncthreads();
    int base = 0;
#pragma unroll
    for (int w = 0; w < 8; ++w) { const int x = sc[w]; if (w < F.wave) base += x; }
    return base + inc - v;
}
__device__ __forceinline__ void topk_item(Frame& F, int e, int b, int half, int nhalf) {
    LAS int* H = (LAS int*)F.lds;
    LAS int* SH = H + 256;
    LAS int* SC = SH + 4;
    LAS int* SEL = SC + 16;
    const int tid = F.tid, lane = F.lane, eb = e * 8 + b;
    const float* aff = WSP(float, WS_AFF) + (size_t)b * SEQ * 16 + e;
    unsigned key[8];
#pragma unroll
    for (int j = 0; j < 8; ++j) key[j] = __float_as_uint(aff[(size_t)(8 * tid + j) * 16]);
    unsigned prefix = 0u, pmask = 0u; int need = CAP;
    for (int pass = 3; pass >= 0; --pass) {
        __syncthreads();
        if (tid < 256) H[tid] = 0;
        __syncthreads();
#pragma unroll
        for (int j = 0; j < 8; ++j) if ((key[j] & pmask) == prefix) __hip_atomic_fetch_add(&H[(key[j] >> (8 * pass)) & 255u], 1, __ATOMIC_RELAXED, __HIP_MEMORY_SCOPE_WORKGROUP);
        __syncthreads();
        if (F.wave == 0) {
            const int c0 = H[255 - 4 * lane], c1 = H[254 - 4 * lane], c2 = H[253 - 4 * lane], c3 = H[252 - 4 * lane];
            const int s = c0 + c1 + c2 + c3, inc = wave_incl_scan(s, lane), exc = inc - s;
            if (exc < need && need <= inc) { const int r = need - exc; int bin, nn;
                if (r <= c0) { bin = 255 - 4 * lane; nn = r; } else if (r <= c0 + c1) { bin = 254 - 4 * lane; nn = r - c0; }
                else if (r <= c0 + c1 + c2) { bin = 253 - 4 * lane; nn = r - c0 - c1; } else { bin = 252 - 4 * lane; nn = r - c0 - c1 - c2; }
                SH[0] = bin; SH[1] = nn; }
        }
        __syncthreads();
        prefix |= (unsigned)SH[0] << (8 * pass); pmask |= 0xffu << (8 * pass); need = SH[1];
    }
    const unsigned thr = prefix;
    int eqc = 0;
#pragma unroll
    for (int j = 0; j < 8; ++j) eqc += (key[j] == thr) ? 1 : 0;
    int eq = block_excl_scan(F, eqc, SC);
    int selc = 0; unsigned selm = 0u;
#pragma unroll
    for (int j = 0; j < 8; ++j) { bool s = key[j] > thr; if (key[j] == thr) { s = eq < need; ++eq; } if (s) { selm |= 1u << j; ++selc; } }
    int slot = block_excl_scan(F, selc, SC);
    unsigned short* inv = WSP(unsigned short, WS_INV) + (size_t)eb * SEQ;
    float* gwp = WSP(float, WS_GW) + (size_t)eb * CAP; int* idx = WSP(int, WS_IDX) + (size_t)eb * CAP;
#pragma unroll
    for (int j = 0; j < 8; ++j) { const int t = 8 * tid + j;
        if ((selm >> j) & 1u) { SEL[slot] = t; if (half == 0) { inv[t] = (unsigned short)(slot + 1); gwp[slot] = __uint_as_float(key[j]); idx[slot] = t; } ++slot; }
        else if (half == 0) inv[t] = (unsigned short)0; }
    __syncthreads();
    const bf16* hb = WSP(bf16, WS_HB) + (size_t)b * SEQ * DM; bf16* xs = WSP(bf16, WS_RA + RA_XS) + (size_t)eb * CAP * DM;
    for (int s = half * (CAP / nhalf) + F.wave; s < (half + 1) * (CAP / nhalf); s += 8) { const int t = SEL[s];
        const v4u* sp = (const v4u*)(hb + (size_t)t * DM); v4u* dp = (v4u*)(xs + (size_t)s * DM);
        dp[F.lane] = sp[F.lane]; dp[F.lane + 64] = sp[F.lane + 64]; }
    __syncthreads();
}

__device__ __forceinline__ void ln2_phase(Frame& F, const Args& args, int l) {
    const int gw = F.bid * 8 + F.wave, NGW = F.G * 8, lane = F.lane;
    const unsigned short* inv = WSP(unsigned short, WS_INV);
    const bf16* eo = WSP(bf16, WS_RA + RA_EOUT);
    v2u nx[4]; unsigned nslv = 0u;
    { const int b = gw >> 12, t = gw & (SEQ - 1); if (lane < NE) nslv = inv[((size_t)(lane * 8 + b)) * SEQ + t];
#pragma unroll
      for (int j = 0; j < 4; ++j) nx[j] = *(const v2u*)(WSP(bf16, WS_HB) + (size_t)gw * DM + 4 * lane + 256 * j); }
    for (int m = gw; m < M; m += NGW) {
        const int b = m >> 12;
        const unsigned slv = nslv;
        f32x4 v[4];
#pragma unroll
        for (int j = 0; j < 4; ++j) v[j] = (f32x4){bflo(nx[j].x), bfhi(nx[j].x), bflo(nx[j].y), bfhi(nx[j].y)} * DN_ALPHA;
        if (m + NGW < M) { const int m2 = m + NGW, b2 = m2 >> 12, t2 = m2 & (SEQ - 1); nslv = 0u; if (lane < NE) nslv = inv[((size_t)(lane * 8 + b2)) * SEQ + t2];
#pragma unroll
            for (int j = 0; j < 4; ++j) nx[j] = *(const v2u*)(WSP(bf16, WS_HB) + (size_t)m2 * DM + 4 * lane + 256 * j); }
        unsigned mask = (unsigned)__ballot(slv != 0u);
        while (mask) {
            int e[4]; float wgt[4];
#pragma unroll
            for (int k = 0; k < 4; ++k) { if (mask) { e[k] = __builtin_ctz(mask); mask &= mask - 1u; wgt[k] = 1.f; } else { e[k] = e[0]; wgt[k] = 0.f; } }
            v2u w[4][4];
#pragma unroll
            for (int k = 0; k < 4; ++k) { const int ek = __builtin_amdgcn_readfirstlane(e[k]); const unsigned sl = (unsigned)__builtin_amdgcn_readlane((int)slv, ek);
                const bf16* r = eo + ((size_t)(ek * 8 + b) * CAP + (sl - 1u)) * DM + 4 * lane;
#pragma unroll
                for (int j = 0; j < 4; ++j) w[k][j] = *(const v2u*)(r + 256 * j); }
#pragma unroll
            for (int k = 0; k < 4; ++k)
#pragma unroll
                for (int j = 0; j < 4; ++j) { v[j].x += wgt[k] * bflo(w[k][j].x); v[j].y += wgt[k] * bfhi(w[k][j].x); v[j].z += wgt[k] * bflo(w[k][j].y); v[j].w += wgt[k] * bfhi(w[k][j].y); }
        }
        ln_row(v, FIN(I_LN2G) + l * DM, FIN(I_LN2B) + l * DM, lane);
        if (l == DEPTH - 1) {
#pragma unroll
            for (int j = 0; j < 4; ++j) *(f32x4*)(F.out + (size_t)m * DM + 4 * lane + 256 * j) = v[j]; }
        else store_row_bf16(v, WSP(bf16, WS_HB) + (size_t)m * DM, lane);
    }
}

struct SchedTiles {
    const char* A0; const char* B0; size_t a_tile, b_tile; int nM, nN, G, c;
    __device__ __forceinline__ bool next(int i, pg8::Unit& u) const {
        const int L = i * G + c; if (L >= nM * nN) return false;
        int pm, pn; pg8::tile_of(L, nM, nN, pm, pn);
        u.A = A0 + (size_t)pm * a_tile; u.B = B0 + (size_t)pn * b_tile; u.orow = pm * 256; u.ocol = pn * 256; u.z = 0; return true;
    }
};
struct SchedMerge {
    const char* Y; const char* WB; int G, c;
    __device__ __forceinline__ bool next(int i, pg8::MergeUnit& u) const {
        const int L = (i >> 2) * G + c, z = i & 3; if (L >= 128 * 8) return false;
        int pm, pn; pg8::tile_of(L, 128, 8, pm, pn);
        u.A = Y + ((size_t)pm * 256 * 1024 + z * 256) * 2; u.B = WB + ((size_t)z * 1024 * 256 + (size_t)pn * 128 * 256) * 2; u.orow = pm * 256; u.ocol = pn * 128; u.z = z; return true;
    }
};
struct SchedMoe1 {
    const char* XS; const char* W; int G, c;
    __device__ __forceinline__ bool next(int i, pg8::Unit& u) const {
        const int L = i * G + c; if (L >= 128 * 16) return false;
        const int eb = L >> 4, sub = L & 15, pm2 = sub & 1, pn = sub >> 1, e = eb >> 3;
        u.A = XS + ((size_t)(eb * 512 + pm2 * 256) * 1024) * 2; u.B = W + ((size_t)(e * 2048 + pn * 256) * 1024) * 2; u.orow = eb * 512 + pm2 * 256; u.ocol = pn * 128; u.z = eb; return true;
    }
};
struct SchedMoe2 {
    const char* HID; const char* W; int G, c;
    __device__ __forceinline__ bool next(int i, pg8::Unit& u) const {
        const int L = i * G + c; if (L >= 128 * 8) return false;
        const int eb = L >> 3, sub = L & 7, pm2 = sub & 1, pn = sub >> 1, e = eb >> 3;
        u.A = HID + ((size_t)(eb * 512 + pm2 * 256) * 1024) * 2; u.B = W + ((size_t)(e * 1024 + pn * 256) * 1024) * 2; u.orow = eb * 512 + pm2 * 256; u.ocol = pn * 256; u.z = eb; return true;
    }
};

static_assert((size_t)(CW_Q + (DEPTH * 8 + 8) * 64) * 4 <= CTL_ZERO_BYTES && (size_t)(CW_BAR + 3456) * 4 <= (size_t)CW_Q * 4, "control words inside the per-call memset");
constexpr int NPH = 12;
__global__ void __launch_bounds__(512, 2) fwd_kernel(Args args_k) {
    const Args& args0 = args_k;
    extern __shared__ __attribute__((aligned(16))) unsigned char lds_raw[];
    Frame F;
    F.lds = (LAS unsigned char*)lds_raw;
    F.MISC = (volatile LAS unsigned*)(F.lds + MISC_OFF);
    F.tid = threadIdx.x; F.lane = F.tid & 63; F.wave = __builtin_amdgcn_readfirstlane(F.tid >> 6);
    F.G = gridDim.x; F.bid = blockIdx.x; F.zoff = 0;
    const int wave0 = __builtin_amdgcn_readfirstlane(threadIdx.x >> 6);
    F.ws = args0.ws; F.out = args0.out; F.ctl = (gu32*)(args0.ws + WS_CTL);
    for (int u = F.tid; u < (LDS_BYTES - MISC_OFF) / 4; u += 512) F.MISC[u] = 0u;
    __syncthreads();
#ifdef DBG_PROF
    if (blockIdx.x == 0 && threadIdx.x == 0) ((unsigned long long*)(args0.ws + WS_CTL))[50000 + 15] = __builtin_amdgcn_s_memrealtime();
#endif
    const bool multi = (args0.l_hi - args0.l_lo > 1) || (args0.ph_hi - args0.ph_lo > 1);
    XcdBarrier bar; bar.bar = (unsigned*)(F.ctl + CW_BAR); bar.x = 0; bar.st = F.MISC + 8;
    if (multi) bar = xcd_barrier_post((unsigned*)(F.ctl + CW_BAR), F.MISC + 8);
    const int lo = args0.ph_lo, hi = args0.ph_hi, l_lo = args0.l_lo, l_hi = args0.l_hi;
#ifndef DBL_MASK
#define DBL_MASK 0
#endif
#define NREP(k) (((DBL_MASK >> (k)) & 1) ? 2 : 1)
#ifndef DBG_ROT
#define DBG_ROT 0
#endif
#ifndef PHASE_MASK
#define PHASE_MASK 0xfff
#endif
#define IN(k) (((PHASE_MASK >> (k)) & 1) && lo <= (k) && (k) < hi)
#ifndef SUB_MASK
#define SUB_MASK 0xff
#endif
#define SUB(k) ((SUB_MASK >> (k)) & 1)
#define FRESH() do { { int b_ = blockIdx.x, g_ = gridDim.x; asm volatile("" : "+s"(b_)); asm volatile("" : "+s"(g_)); F.bid = b_; F.G = g_; } int ln_ = __builtin_amdgcn_mbcnt_hi(~0u, __builtin_amdgcn_mbcnt_lo(~0u, 0u)); asm volatile("" : "+v"(ln_)); int wv_ = wave0; asm volatile("" : "+s"(wv_)); F.lane = ln_; F.wave = wv_; F.tid = wv_ * 64 + ln_; } while (0)
#ifdef DBG_PROF
#define STAMP(k) do { if (blockIdx.x == 0 && threadIdx.x == 0) ((unsigned long long*)(F.ws + WS_CTL))[50000 + l * 16 + (k)] = __builtin_amdgcn_s_memrealtime(); } while (0)
#else
#define STAMP(k) do {} while (0)
#endif
#define SEAM(k) do { if (((k) + 1 < hi) || (l + 1 < l_hi)) { XcdBarrier b2_ = bar; asm volatile("" : "+s"(b2_.x)); asm volatile("" : "+s"(b2_.bar)); xcd_barrier(b2_, F.tid); } STAMP(k); } while (0)

#pragma unroll 1
    for (int l = l_lo; l < l_hi; ++l) {
        const Args& args = args_k;
        { size_t z_ = 0; asm volatile("" : "+s"(z_)); F.ws = args.ws + z_; F.out = args.out + z_; F.ctl = (gu32*)(F.ws + WS_CTL); }
        unsigned char* wb = F.ws + WS_W;
        const char* HBp = (const char*)(F.ws + WS_HB);
#define NGW (F.G * 8)
#define gw (F.bid * 8 + F.wave)
        if (IN(0) && l == 0) { FRESH(); prologue_phase(F, args); SEAM(0); }

        if (IN(1)) _Pragma("unroll 1") for (int rep_ = 0; rep_ < NREP(1); ++rep_) { FRESH();
            const pg8::Gemm g{1024, 1024, 1024};
            if (SUB(0)) {
                SchedTiles S{(const char*)(wb + W_WIN), HBp, (size_t)256 * 1024 * 2, (size_t)256 * 1024 * 2, 3, 128, F.G, F.bid};
                pg8::EpiBf16<0> E{WSP(bf16, WS_RB + RB_HYT), M};
                pg8::gemm_phase(F.lds, g, S, E, F.tid); }
            if (SUB(1)) {
                SchedTiles S{HBp, (const char*)(wb + W_WIN) + (size_t)768 * 1024 * 2, (size_t)256 * 1024 * 2, (size_t)256 * 1024 * 2, 128, 12, F.G, F.bid};
                pg8::EpiBf16<0> E{WSP(bf16, WS_RB + RB_PROJ2), PROJ2_W};
                pg8::gemm_phase(F.lds, g, S, E, F.tid); }
            if (SUB(2)) {
                SchedTiles S{HBp, (const char*)(wb + W_WIN) + (size_t)3840 * 1024 * 2, (size_t)256 * 1024 * 2, (size_t)256 * 1024 * 2, 128, 16, F.G, (F.bid + DBG_ROT) % F.G};
                pg8::EpiBf16<1> E{WSP(bf16, WS_RA + RA_G), 4096};
                pg8::gemm_phase(F.lds, g, S, E, F.tid); }
            SEAM(1);
        }
        if (IN(2)) _Pragma("unroll 1") for (int rep_ = 0; rep_ < NREP(2); ++rep_) { FRESH();
            if (l == 0) { for (int tb = F.bid; tb < 256; tb += F.G) hy_taps_block(F, args, 0, tb); __syncthreads(); }
            _Pragma("unroll 2") for (int m = 2 * gw; m < M; m += 2 * NGW) gqa_prep_rows(F, args, l, m);
            for (int r = gw; r < 768 * 8; r += NGW) hy_sconv_row(F, args, l, r);
            SEAM(2); }

        if (IN(3)) _Pragma("unroll 1") for (int rep_ = 0; rep_ < NREP(3); ++rep_) { FRESH();
#if MK_STATIC_Q
            if (SUB(0)) for (int it = F.bid; it < 256; it += F.G) hyena_item(F, args, l, it);
            if (SUB(1)) {   const attn_body::bf16* Qp = (const attn_body::bf16*)(F.ws + WS_RD + RD_QKVG);
                attn_body::bf16* Op = (attn_body::bf16*)(F.ws + WS_Y) + 768;
                for (int it = F.bid; it < 512; it += F.G) { __syncthreads();
                    attn_body::attn_unit<8>(it >> 6, (it >> 4) & 3, it & 15, Qp, Qp + 256, Qp + 384, Op, (char*)lds_raw, F.tid); } }
            if (SUB(2)) for (int it = F.bid; it < 128; it += F.G) s5_item(F, args, l, it >> 4, it & 15);
            __syncthreads();
            if (SUB(3)) for (int it = F.bid; it < 1536; it += F.G) dil_item(F, args, it);
#else
#ifndef DBL_SUB
#define DBL_SUB 0
#endif
#define NREPS(t) (((DBL_SUB >> (t)) & 1) ? 2 : 1)
            _Pragma("unroll 1") for (int r2 = 0; r2 < NREPS(2); ++r2) for (;;) { const int it = wq_grab(F, l * 8 + r2 * 4 + 2); if (it >= 128) break; s5_item(F, args, l, it >> 4, it & 15); }
            _Pragma("unroll 1") for (int r2 = 0; r2 < NREPS(0); ++r2) for (;;) { const int it = wq_grab(F, l * 8 + r2 * 4 + 0); if (it >= 256) break; hyena_item(F, args, l, it); }
            {   const attn_body::bf16* Qp = (const attn_body::bf16*)(F.ws + WS_RD + RD_QKVG);
                attn_body::bf16* Op = (attn_body::bf16*)(F.ws + WS_Y) + 768;
                _Pragma("unroll 1") for (int r2 = 0; r2 < NREPS(1); ++r2) for (;;) { const int it = wq_grab(F, l * 8 + r2 * 4 + 1); if (it >= 512) break;
                    attn_body::attn_unit<8>(it >> 6, (it >> 4) & 3, it & 15, Qp, Qp + 256, Qp + 384, Op, (char*)lds_raw, F.tid); } }
            _Pragma("unroll 1") for (int r2 = 0; r2 < NREPS(3); ++r2) for (;;) { const int it = wq_grab(F, l * 8 + r2 * 4 + 3); if (it >= 1536) break; dil_item(F, args, it); }
#endif
            SEAM(3);
        }
        if (IN(4)) _Pragma("unroll 1") for (int rep_ = 0; rep_ < NREP(4); ++rep_) { FRESH();
            if (SUB(0)) {   const pg8::Gemm g{256, 256, 256};
                SchedTiles S{(const char*)(F.ws + WS_RD + RD_S5Z), (const char*)(wb + W_GLU), (size_t)256 * 256 * 2, 0, 128, 1, F.G, F.bid};
                pg8::EpiGlu E{WSP(bf16, WS_RD + RD_S5Z), WSP(bf16, WS_Y), FIN(I_S5_GB) + l * 256};
                pg8::gemm_phase(F.lds, g, S, E, F.tid); }
            __syncthreads();
            if (SUB(1)) for (int it = gw; it < 2048; it += NGW) hy_transpose_item(F, it);
            if (SUB(2)) for (int m = gw; m < M; m += NGW) dil_combine_row(F, m);
            SEAM(4);
        }
        if (IN(5)) _Pragma("unroll 1") for (int rep_ = 0; rep_ < NREP(5); ++rep_) { FRESH();
            const pg8::Gemm g{256, 1024, 256};
            SchedMerge S{(const char*)(F.ws + WS_Y), (const char*)(wb + W_WB), F.G, F.bid};
            pg8::gemm_merge_phase(F.lds, g, S, WSP(bf16, WS_RA + RA_G), WSP(bf16, WS_RB + RB_MB), F.tid);
            SEAM(5);
        }
        if (IN(6)) _Pragma("unroll 1") for (int rep_ = 0; rep_ < NREP(6); ++rep_) { FRESH();
            const pg8::Gemm g{1024, 1024, 1024};
            SchedTiles S{(const char*)(F.ws + WS_RB + RB_MB), (const char*)(wb + W_WO), (size_t)256 * 1024 * 2, (size_t)256 * 1024 * 2, 128, 4, F.G, F.bid};
            pg8::EpiPre E{WSP(bf16, WS_HB), WSP(bf16, WS_RB + RB_PRE), DN_ALPHA};
            pg8::gemm_phase(F.lds, g, S, E, F.tid);
            SEAM(6);
        }
        if (IN(7)) _Pragma("unroll 1") for (int rep_ = 0; rep_ < NREP(7); ++rep_) { FRESH(); ln1_router_phase(F, args, l); SEAM(7); }
        if (IN(8)) _Pragma("unroll 1") for (int rep_ = 0; rep_ < NREP(8); ++rep_) { FRESH(); if (F.G >= 256) { if (F.bid < 256) topk_item(F, (F.bid & 127) >> 3, F.bid & 7, F.bid >> 7, 2); } else for (int it = F.bid; it < 128; it += F.G) topk_item(F, it >> 3, it & 7, 0, 1);
            if (l + 1 < DEPTH) { __syncthreads(); for (int tb = F.bid; tb < 256; tb += F.G) hy_taps_block(F, args, l + 1, tb); }
            SEAM(8); }
        if (IN(9)) _Pragma("unroll 1") for (int rep_ = 0; rep_ < NREP(9); ++rep_) { FRESH();
            const pg8::Gemm g{1024, 1024, 1024};
            SchedMoe1 S{(const char*)(F.ws + WS_RA + RA_XS), (const char*)(wb + W_GU), F.G, F.bid};
            pg8::EpiSwiglu E{WSP(bf16, WS_RB + RB_HID)};
            pg8::gemm_phase(F.lds, g, S, E, F.tid);
            SEAM(9);
        }
        if (IN(10)) _Pragma("unroll 1") for (int rep_ = 0; rep_ < NREP(10); ++rep_) { FRESH();
            const pg8::Gemm g{1024, 1024, 1024};
            SchedMoe2 S{(const char*)(F.ws + WS_RB + RB_HID), (const char*)(wb + W_DN), F.G, F.bid};
            pg8::EpiRowScale E{WSP(bf16, WS_RA + RA_EOUT), WSP(float, WS_GW)};
            pg8::gemm_phase(F.lds, g, S, E, F.tid);
            SEAM(10);
        }
        if (IN(11)) { FRESH();
            ln2_phase(F, args, l);
            if (l + 1 < DEPTH) convert_layer(F, args, l + 1, gw, NGW);
#ifdef DBG_CONV2
            if (l + 1 < DEPTH) convert_layer(F, args, l + 1, gw, NGW);
#endif
            SEAM(11);
        }
    }
    if (multi) {
        { XcdBarrier b2_ = bar; asm volatile("" : "+s"(b2_.x)); asm volatile("" : "+s"(b2_.bar)); xcd_barrier(b2_, F.tid); }
        if (__hip_atomic_load((unsigned*)(F.ctl + CW_BAR) + XB_TMO, RLX_AGENT) != 0u) {
            const float q = __builtin_nanf("");
            for (size_t i = (size_t)F.bid * 512 + F.tid; i < (size_t)M * DM; i += (size_t)F.G * 512) args0.out[i] = q; }
    }
#undef IN
#undef gw
#undef NGW
#undef SEAM
}


#ifdef DBG_STOP
__global__ void dbg_dump_kernel(const unsigned char* ws, float* out, size_t off, int isf32, int ld, int ncols) {
    const size_t n = (size_t)M * DM;
    for (size_t i = (size_t)blockIdx.x * blockDim.x + threadIdx.x; i < n; i += (size_t)gridDim.x * blockDim.x) {
        const size_t r = i / DM, c = i % DM; float v = 0.f;
        if ((int)c < ncols) { if (isf32) v = ((const float*)(ws + off))[r * ld + c]; else v = bf2f(((const bf16*)(ws + off))[r * ld + c]); }
        out[i] = v; }
}
#endif

#ifdef DBG_RACE
constexpr int CW_DBG = 65536;
__global__ void dbg_sum_kernel(const unsigned* p, size_t nwords, unsigned long long* slot) {
    unsigned long long s = 0;
    for (size_t i = (size_t)blockIdx.x * blockDim.x + threadIdx.x; i < nwords; i += (size_t)gridDim.x * blockDim.x) s += (unsigned long long)p[i] * (unsigned long long)((i & 1023u) + 1u);
    for (int o = 32; o >= 1; o >>= 1) s += __shfl_xor(s, o);
    if ((threadIdx.x & 63) == 0) atomicAdd(slot, s);
}
__global__ void dbg_final_kernel(const unsigned long long* T, float* out) {
    int V = 0;
    for (int s = 56; s <= 60; ++s) if (T[s] != T[64 + s]) V |= 1 << (s - 56);
    const float c = 10.f * (float)(V + 1);
    for (size_t i = (size_t)blockIdx.x * blockDim.x + threadIdx.x; i < (size_t)M * DM; i += (size_t)gridDim.x * blockDim.x) out[i] = c;
}
#endif

#ifdef DBG_STAT
__global__ void dbg_stat_kernel(const unsigned char* ws, size_t off, int ld, int ncols, unsigned* res) {
    unsigned mx = 0, cnt = 0;
    for (size_t i = (size_t)blockIdx.x * blockDim.x + threadIdx.x; i < (size_t)M * ncols; i += (size_t)gridDim.x * blockDim.x) {
        const size_t r = i / ncols, c = i % ncols; const float v = fabsf(bf2f(((const bf16*)(ws + off))[r * ld + c]));
        const unsigned b = __float_as_uint(v); mx = b > mx ? b : mx; cnt += (v > DBG_THR || v != v) ? 1u : 0u; }
    atomicMax(res, mx); atomicAdd(res + 1, cnt);
    for (size_t r = (size_t)blockIdx.x * blockDim.x + threadIdx.x; r < (size_t)M; r += (size_t)gridDim.x * blockDim.x) { bool bad = false; unsigned first = 0xffffffffu;
        for (int c = 0; c < ncols; ++c) { const float v = fabsf(bf2f(((const bf16*)(ws + off))[r * ld + c])); if (v > DBG_THR || v != v) { bad = true; if (first == 0xffffffffu) first = c; } }
        if (bad) { atomicAdd(res + 2, 1u); atomicMin(res + 3, (unsigned)r); atomicMin(res + 4, first); } }
}
__global__ void dbg_statout_kernel(const unsigned* res, float* out) {
    const float c = DBG_STAT == 0 ? 100.f * __uint_as_float(res[0]) : DBG_STAT == 1 ? sqrtf((float)res[1]) : DBG_STAT == 2 ? sqrtf((float)res[2]) : DBG_STAT == 3 ? (float)(res[3] / 2048u + 20u) : (float)(res[4] / 256u + 20u);
    for (size_t i = (size_t)blockIdx.x * blockDim.x + threadIdx.x; i < (size_t)M * DM; i += (size_t)gridDim.x * blockDim.x) out[i] = c;
}
#endif

#ifdef DBG_PROF
__global__ void dbg_prof_kernel(const unsigned long long* ts, float* out) {
    float tp[12];
    for (int p = 0; p < 12; ++p) { double s = 0; for (int l = 0; l < DEPTH; ++l) { if (p == 0 && l > 0) continue;
        const unsigned long long e = ts[l * 16 + p]; unsigned long long b;
        if (p == 0) b = ts[15]; else if (p == 1 && l > 0) b = ts[(l - 1) * 16 + 11]; else b = ts[l * 16 + p - 1];
        if (p == 11 && l == DEPTH - 1) continue;
        s += (double)(e - b) * 0.01; } tp[p] = (float)s; }
    const float c = tp[DBG_PA], d = 1000.f * tp[DBG_PB];
    for (size_t i = (size_t)blockIdx.x * blockDim.x + threadIdx.x; i < (size_t)M * DM; i += (size_t)gridDim.x * blockDim.x) out[i] = (i == 0) ? d : c;
}
#endif
extern "C" void kernel_launch(void* const* d_in, const int* in_sizes, int n_in, void* d_out, int out_size, void* d_ws, size_t ws_size, hipStream_t stream) {
    static int grid = 0;
    if (grid == 0) {
        if (n_in != N_INPUTS || out_size != M * DM || ws_size < WS_END) { fprintf(stderr, "kernel_launch: unexpected problem (n_in %d, out %d, ws %zu)\n", n_in, out_size, ws_size); grid = -1; return; }
        int dev = 0, cus = 0, per_cu = 0;
        if (hipGetDevice(&dev) != hipSuccess || hipDeviceGetAttribute(&cus, hipDeviceAttributeMultiprocessorCount, dev) != hipSuccess) { grid = -1; return; }
        if (hipFuncSetAttribute((const void*)fwd_kernel, hipFuncAttributeMaxDynamicSharedMemorySize, LDS_BYTES) != hipSuccess) { fprintf(stderr, "kernel_launch: hipFuncSetAttribute failed\n"); grid = -1; return; }
        if (hipOccupancyMaxActiveBlocksPerMultiprocessor(&per_cu, (const void*)fwd_kernel, 512, LDS_BYTES) != hipSuccess || per_cu < 1)
            fprintf(stderr, "kernel_launch: occupancy query reports %d workgroups per CU\n", per_cu);
        (void)hipGetLastError();
        grid = cus;
    }
    if (grid < 0) return;
    if (hipMemsetAsync((char*)d_ws + WS_CTL, 0, CTL_ZERO_BYTES, stream) != hipSuccess) return;
    Args a{};
    for (int i = 0; i < N_INPUTS; ++i) a.in[i] = (const float*)d_in[i];
    a.out = (float*)d_out; a.ws = (unsigned char*)d_ws;
#if MK_ONE_LAUNCH
    a.ph_lo = 0; a.ph_hi = NPH; a.l_lo = 0; a.l_hi = DEPTH;
    hipLaunchKernelGGL(fwd_kernel, dim3(grid), dim3(512), LDS_BYTES, stream, a);
#ifdef DBG_PROF
    hipLaunchKernelGGL(dbg_prof_kernel, dim3(1024), dim3(256), 0, stream, (const unsigned long long*)((char*)d_ws + WS_CTL) + 50000, (float*)d_out);
#endif
#else
#ifdef DBG_RACE
    {
    unsigned char* ws = (unsigned char*)d_ws; unsigned long long* T = (unsigned long long*)(ws + WS_CTL) + CW_DBG / 2;
    auto sum = [&](size_t off, size_t bytes, int slot) { hipLaunchKernelGGL(dbg_sum_kernel, dim3(1024), dim3(256), 0, stream, (const unsigned*)(ws + off), bytes / 4, T + slot); };
    auto sumout = [&](int slot) { hipLaunchKernelGGL(dbg_sum_kernel, dim3(1024), dim3(256), 0, stream, (const unsigned*)d_out, (size_t)M * DM, T + slot); };
    for (int run = 0; run < 2; ++run) {
        if (run == 1) hipMemsetAsync((char*)d_ws + WS_CTL, 0, CW_DBG * 4, stream);
        hipMemsetAsync((char*)d_ws + 1 * MiB, run == 0 ? 0xAA : 0x55, WS_END - 1 * MiB, stream);
        for (int l = 0; l < DBG_LAYERS; ++l)
            for (int p = (l == 0 ? 0 : 1); p < DBG_NPH; ++p) { a.ph_lo = p; a.ph_hi = p + 1; a.l_lo = l; a.l_hi = l + 1;
                hipLaunchKernelGGL(fwd_kernel, dim3(grid), dim3(512), LDS_BYTES, stream, a);
                const int s = run * 64 + l * 12 + p;
                switch (p) {
                case 0: sum(WS_HB, 64 * MiB, s); sumout(s); sum(WS_W, 115 * MiB, s); sum(WS_S5W, 64 * MiB, s); sum(WS_HF2, 4 * MiB, s); sum(WS_ROPE, 8 * KiB, s); sum(WS_S5A32, 64 * KiB, s); break;
                case 1: sum(WS_RB, 240 * MiB, s); sum(WS_RA, 256 * MiB, s); break;
                case 2: sum(WS_RD + RD_QKVG, 32 * MiB, s); break;
                case 3: sum(WS_RD + RD_YAT, 16 * MiB, run * 64 + 56); sum(WS_RD + RD_HV, 32 * MiB, run * 64 + 57); sum(WS_RD + RD_DILO, 48 * MiB, run * 64 + 58); sum(WS_DLSE, 1536 * KiB, run * 64 + 59); sum(WS_RD + RD_S5Z, 16 * MiB, run * 64 + 60); break;
                case 4: sum(WS_Y, 64 * MiB, s); break;
                case 5: sum(WS_RB + RB_MB, 64 * MiB, s); sum(WS_RB, 128 * MiB, s); break;
                case 6: sum(WS_RB, 128 * MiB, s); break;
                case 7: sumout(s); sum(WS_HB, 64 * MiB, s); sum(WS_AFF, 2 * MiB, s); break;
                case 8: sum(WS_RA, 128 * MiB, s); sum(WS_IDX, 512 * KiB, s); sum(WS_INV, 1 * MiB, s); break;
                case 9: sum(WS_RB, 128 * MiB, s); break;
                case 10: sum(WS_RA + RA_EOUT, 128 * MiB, s); break;
                case 11: sumout(s); sum(WS_HB, 64 * MiB, s); break;
                } }
    }
    hipLaunchKernelGGL(dbg_final_kernel, dim3(1024), dim3(256), 0, stream, (const unsigned long long*)T, (float*)d_out);
    }
#elif defined(DBG_STOP)
    for (int l = 0; l <= DBG_STOP_L; ++l)
        for (int p = (l == 0 ? 0 : 1); p < NPH; ++p) { if (l == DBG_STOP_L && p > DBG_STOP) break; a.ph_lo = p; a.ph_hi = p + 1; a.l_lo = l; a.l_hi = l + 1;
            hipLaunchKernelGGL(fwd_kernel, dim3(grid), dim3(512), LDS_BYTES, stream, a);
#ifdef DBG_REPEAT
            if (p == DBG_REPEAT) hipLaunchKernelGGL(fwd_kernel, dim3(grid), dim3(512), LDS_BYTES, stream, a);
#endif
            }
#ifdef DBG_STAT
    { unsigned* res = (unsigned*)((char*)d_ws + WS_CTL) + 100000; hipMemsetAsync(res + 3, 0x7f, 8, stream); hipLaunchKernelGGL(dbg_stat_kernel, dim3(2048), dim3(256), 0, stream, (const unsigned char*)d_ws, (size_t)(DBG_OFF), DBG_LD, DBG_NC, res);
      hipLaunchKernelGGL(dbg_statout_kernel, dim3(2048), dim3(256), 0, stream, (const unsigned*)res, (float*)d_out); }
#elif defined(DBG_OFF)
    hipLaunchKernelGGL(dbg_dump_kernel, dim3(2048), dim3(256), 0, stream, (const unsigned char*)d_ws, (float*)d_out, (size_t)(DBG_OFF), DBG_F32, DBG_LD, DBG_NC);
#endif
#else
    for (int l = 0; l < DEPTH; ++l)
        for (int p = (l == 0 ? 0 : 1); p < NPH; ++p) { a.ph_lo = p; a.ph_hi = p + 1; a.l_lo = l; a.l_hi = l + 1;
            hipLaunchKernelGGL(fwd_kernel, dim3(grid), dim3(512), LDS_BYTES, stream, a); }
#endif
#endif
}
```

```cpp
#include <hip/hip_runtime.h>
#include <hip/hip_bf16.h>
#include <cstdio>
#include <cstdint>
#include <cmath>

#ifndef MK_STATIC_Q
#define MK_STATIC_Q 0
#endif
#ifndef MK_ONE_LAUNCH
#define MK_ONE_LAUNCH 1
#endif

constexpr int BATCH = 8, SEQ = 4096, DM = 1024, DEPTH = 4, M = BATCH * SEQ;
constexpr int NIN = 7936;
constexpr int NE = 16, CAP = 512, FFD = 1024;
constexpr float LN_EPS = 1e-5f, RMS_EPS = 1e-6f;
constexpr float DN_ALPHA = 1.6817928305074292f;
constexpr int PC_DQ = 0, PC_DK = 768, PC_DV = 1536, PC_S5 = 2304, PC_GQ = 2560, PC_GK = 2816, PC_GV = 2944, PROJ2_W = 3072;
enum { I_X = 0, I_LNIN_G, I_LNIN_B, I_WIN, I_HY_CW, I_HY_CB, I_HY_W1, I_HY_B1, I_HY_W2, I_HY_B2, I_HY_W3, I_HY_FREQ, I_HY_BIAS,
       I_S5_LRE, I_S5_LIM, I_S5_LDT, I_S5_BRE, I_S5_BIM, I_S5_CRE, I_S5_CIM, I_S5_D, I_S5_GW, I_S5_GB, I_GQ_QN, I_GQ_KN,
       I_WBR, I_WOUT, I_LN1G, I_LN1B, I_ROUTER, I_EWG, I_EWU, I_EWD, I_LN2G, I_LN2B, N_INPUTS };

constexpr size_t MiB = 1u << 20, KiB = 1u << 10;
constexpr size_t WS_CTL = 0, CTL_ZERO_BYTES = 64 * KiB;
constexpr size_t WS_AFF = 1 * MiB;
constexpr size_t WS_IDX = 3 * MiB;
constexpr size_t WS_GW = 3 * MiB + 256 * KiB;
constexpr size_t WS_INV = 4 * MiB;
constexpr size_t WS_DLSE = 5 * MiB;
constexpr size_t WS_ROPE = 7 * MiB;
constexpr size_t WS_S5A32 = 7 * MiB + 256 * KiB;
constexpr size_t WS_HF2 = 8 * MiB;
constexpr size_t WS_S5W = 12 * MiB;
constexpr size_t S5W_LAYER = 16 * MiB, S5_WST_OFF = 0, S5_WCAT_OFF = 4 * MiB;
constexpr size_t WS_W = 76 * MiB;
constexpr size_t W_WIN = 0;
constexpr size_t W_WB = W_WIN + (size_t)NIN * DM * 2;
constexpr size_t W_WO = W_WB + (size_t)4 * 1024 * 256 * 2;
constexpr size_t W_GLU = W_WO + (size_t)1024 * 1024 * 2;
constexpr size_t W_GU = W_GLU + (size_t)256 * 256 * 2;
constexpr size_t W_DN = W_GU + (size_t)16 * 2048 * 1024 * 2;
constexpr size_t W_END = W_DN + (size_t)16 * 1024 * 1024 * 2;
static_assert(W_END <= 116 * MiB, "weights region");
constexpr size_t WS_HB = 192 * MiB;
constexpr size_t WS_RA = 256 * MiB;
constexpr size_t WS_RB = 512 * MiB;
constexpr size_t RB_HYT = 0, RB_PROJ2 = 48 * MiB, RB_MF32 = 0, RB_PRE = 0, RB_HID = 0, RB_MB = 128 * MiB;
constexpr size_t RA_G = 0, RA_XS = 0, RA_EOUT = 128 * MiB;
constexpr size_t WS_Y = 768 * MiB;
constexpr size_t WS_RD = 832 * MiB;
constexpr size_t RD_YAT = 0;
constexpr size_t RD_DILO = 16 * MiB;
constexpr size_t RD_S5Z = 64 * MiB;
constexpr size_t RD_HV = 80 * MiB;
constexpr size_t RD_QKVG = 112 * MiB;
constexpr size_t WS_TT = 976 * MiB;
constexpr size_t WS_END = 992 * MiB;

constexpr int CW_BAR = 4096;
constexpr int CW_Q = 8192;

constexpr int LDS_SCRATCH = 147456;
constexpr int MISC_OFF = LDS_SCRATCH;
constexpr int LDS_BYTES = LDS_SCRATCH + 1024;

#define GAS __attribute__((address_space(1)))
#define LAS __attribute__((address_space(3)))
typedef unsigned short bf16;
typedef unsigned v4u __attribute__((ext_vector_type(4)));
typedef unsigned v2u __attribute__((ext_vector_type(2)));
typedef float f32x4 __attribute__((ext_vector_type(4)));
typedef float f32x2 __attribute__((ext_vector_type(2)));
typedef float f32x16 __attribute__((ext_vector_type(16)));
typedef short bf16x8 __attribute__((ext_vector_type(8)));
typedef short s16x4 __attribute__((ext_vector_type(4)));
typedef GAS unsigned gu32;
#define RLX_AGENT __ATOMIC_RELAXED, __HIP_MEMORY_SCOPE_AGENT
#define LDS_WAIT() asm volatile("s_waitcnt lgkmcnt(0)" ::: "memory")
#define VM_WAIT() asm volatile("s_waitcnt vmcnt(0)" ::: "memory")

__device__ __forceinline__ unsigned f2bf(float f) { unsigned u = __builtin_bit_cast(unsigned, f); return (u + 0x7fffu + ((u >> 16) & 1u)) >> 16; }
__device__ __forceinline__ unsigned pk2(float lo, float hi) { return f2bf(lo) | (f2bf(hi) << 16); }
__device__ __forceinline__ float bf2f(unsigned short b) { return __builtin_bit_cast(float, (unsigned)b << 16); }
__device__ __forceinline__ float bflo(unsigned w) { return __builtin_bit_cast(float, w << 16); }
__device__ __forceinline__ float bfhi(unsigned w) { return __builtin_bit_cast(float, w & 0xffff0000u); }
__device__ __forceinline__ float sigmoidf_(float x) { return __builtin_amdgcn_rcpf(1.0f + __builtin_amdgcn_exp2f(-1.4426950408889634f * x)); }
__device__ __forceinline__ float wave_sum(float v) {
#pragma unroll
    for (int o = 1; o < 64; o <<= 1) v += __shfl_xor(v, o);
    return v;
}
__device__ __forceinline__ float wave_max(float v) {
#pragma unroll
    for (int o = 1; o < 64; o <<= 1) v = fmaxf(v, __shfl_xor(v, o));
    return v;
}

namespace pg8 {
#define PG8_LAS __attribute__((address_space(3)))
typedef unsigned short bf16_t;
typedef unsigned u32x4 __attribute__((ext_vector_type(4)));
constexpr int BM = 256, BK = 64, HALF = 128, HTB = HALF * BK * 2  , STAGE_BYTES = 8 * HTB, NXCD = 8, WGM = 8;

__host__ __device__ __forceinline__ int lds_byte(int r, int c) { const int st = (r >> 4) * 2 + (c >> 5), rr = r & 15, cc = c & 31, ob = rr * 64 + cc * 2; return st * 1024 + (ob ^ (((ob >> 9) & 1) << 5)); }
__host__ __device__ __forceinline__ void stage_rc(int b, int& R, int& C) { const int st = b / 1024, sb = b % 1024, swz = sb ^ (((sb >> 9) & 1) << 5); R = (st >> 1) * 16 + swz / 64; C = (st & 1) * 32 + (swz % 64) / 2; }
__host__ __device__ __forceinline__ int perm32(int rho) { const int n = rho >> 4, i = rho & 15; return 8 * (i >> 2) + 4 * n + (i & 3); }

struct Unit { const char* A; const char* B; int orow, ocol, z; };
struct Gemm { int K, lda, ldb; };

__device__ __forceinline__ void tile_of(int L, int nM, int nN, int& pm, int& pn) {
    const int nwg = nM * nN; int wgid = L; { const int q = nwg / NXCD, r = nwg % NXCD, xcd = wgid % NXCD, off = wgid / NXCD; wgid = (xcd < r ? xcd * (q + 1) : r * (q + 1) + (xcd - r) * q) + off; }
    const int nig = WGM * nN, gid = wgid / nig, fm = gid * WGM, gsz = (nM - fm) < WGM ? (nM - fm) : WGM;
    pm = fm + ((wgid % nig) % gsz); pn = (wgid % nig) / gsz;
}

typedef __bf16 bf16x2_t __attribute__((ext_vector_type(2)));
__device__ __forceinline__ unsigned cvt_pk_bf16(float lo, float hi) { const f32x2 v = {lo, hi}; const bf16x2_t b = __builtin_convertvector(v, bf16x2_t); return __builtin_bit_cast(unsigned, b); }
template <int ACT  > struct EpiBf16 {
    static constexpr bool PERM = true;
    bf16_t* O; int ldc;
    __device__ __forceinline__ void operator()(const f32x4 (&acc)[2][2][4][2], const Unit& u, int wr, int wc, int fr, int fq) const {
        const int row0 = u.orow + wr * 64 + fr, col0 = u.ocol + wc * 32 + 8 * fq;
#pragma unroll
        for (int ai = 0; ai < 2; ++ai)
#pragma unroll
            for (int m = 0; m < 4; ++m) { bf16_t* rowp = O + (size_t)(row0 + ai * HALF + m * 16) * ldc + col0;
#pragma unroll
                for (int bj = 0; bj < 2; ++bj) { f32x4 v0 = acc[ai][bj][m][0], v1 = acc[ai][bj][m][1];
                    if (ACT == 1) {
#pragma unroll
                        for (int j = 0; j < 4; ++j) { v0[j] = sigmoidf_(v0[j]); v1[j] = sigmoidf_(v1[j]); }
#ifdef DBG_HALF
                        for (int j = 0; j < 4; ++j) { v0[j] = 0.5f; v1[j] = 0.5f; }
#endif
                    }
                    u32x4 w; w.x = cvt_pk_bf16(v0[0], v0[1]); w.y = cvt_pk_bf16(v0[2], v0[3]); w.z = cvt_pk_bf16(v1[0], v1[1]); w.w = cvt_pk_bf16(v1[2], v1[3]);
                    *(u32x4*)(rowp + bj * HALF) = w; } }
    }
};
struct EpiMerge {
    static constexpr bool PERM = true;
    const bf16_t* G; float* F; bf16_t* MB;
    __device__ __forceinline__ void operator()(const f32x4 (&acc)[2][2][4][2], const Unit& u, int wr, int wc, int fr, int fq) const {
        const int row0 = u.orow + wr * 64 + fr, col0 = u.ocol + wc * 32 + 8 * fq, i = u.z;
#pragma unroll
        for (int ai = 0; ai < 2; ++ai)
#pragma unroll
            for (int m = 0; m < 4; ++m) { const size_t row = (size_t)(row0 + ai * HALF + m * 16);
#pragma unroll
                for (int bj = 0; bj < 2; ++bj) { const int col = col0 + bj * HALF;
                    const u32x4 g = *(const u32x4*)(G + row * 4096 + i * 1024 + col);
                    f32x4 v0 = acc[ai][bj][m][0], v1 = acc[ai][bj][m][1];
                    v0[0] *= bflo(g.x); v0[1] *= bfhi(g.x); v0[2] *= bflo(g.y); v0[3] *= bfhi(g.y);
                    v1[0] *= bflo(g.z); v1[1] *= bfhi(g.z); v1[2] *= bflo(g.w); v1[3] *= bfhi(g.w);
                    float* fp = F + row * 1024 + col;
                    if (i > 0) { f32x4 p0, p1;
                        asm volatile("global_load_dwordx4 %0, %2, off sc0 sc1\n\tglobal_load_dwordx4 %1, %2, off offset:16 sc0 sc1\n\ts_waitcnt vmcnt(0)" : "=&v"(p0), "=&v"(p1) : "v"(fp) : "memory");
                        v0 += p0; v1 += p1; }
                    if (i < 3) { *(f32x4*)fp = v0; *(f32x4*)(fp + 4) = v1; }
                    else { u32x4 w; w.x = cvt_pk_bf16(v0[0], v0[1]); w.y = cvt_pk_bf16(v0[2], v0[3]); w.z = cvt_pk_bf16(v1[0], v1[1]); w.w = cvt_pk_bf16(v1[2], v1[3]);
                        *(u32x4*)(MB + row * 1024 + col) = w; } } }
    }
};
struct EpiPre {
    static constexpr bool PERM = true;
    const bf16_t* H; bf16_t* P; float alpha;
    __device__ __forceinline__ void operator()(const f32x4 (&acc)[2][2][4][2], const Unit& u, int wr, int wc, int fr, int fq) const {
        const int row0 = u.orow + wr * 64 + fr, col0 = u.ocol + wc * 32 + 8 * fq;
#pragma unroll
        for (int ai = 0; ai < 2; ++ai)
#pragma unroll
            for (int m = 0; m < 4; ++m) { const size_t off = (size_t)(row0 + ai * HALF + m * 16) * 1024 + col0;
#pragma unroll
                for (int bj = 0; bj < 2; ++bj) { const u32x4 h = *(const u32x4*)(H + off + bj * HALF); const f32x4 a0 = acc[ai][bj][m][0], a1 = acc[ai][bj][m][1];
                    u32x4 w; w.x = cvt_pk_bf16(bflo(h.x) * alpha + a0[0], bfhi(h.x) * alpha + a0[1]); w.y = cvt_pk_bf16(bflo(h.y) * alpha + a0[2], bfhi(h.y) * alpha + a0[3]);
                    w.z = cvt_pk_bf16(bflo(h.z) * alpha + a1[0], bfhi(h.z) * alpha + a1[1]); w.w = cvt_pk_bf16(bflo(h.w) * alpha + a1[2], bfhi(h.w) * alpha + a1[3]);
                    *(u32x4*)(P + off + bj * HALF) = w; } }
    }
};
struct EpiSwiglu {
    static constexpr bool PERM = true;
    bf16_t* O;
    __device__ __forceinline__ void operator()(const f32x4 (&acc)[2][2][4][2], const Unit& u, int wr, int wc, int fr, int fq) const {
        const int row0 = u.orow + wr * 64 + fr, col0 = u.ocol + wc * 32 + 8 * fq;
#pragma unroll
        for (int ai = 0; ai < 2; ++ai)
#pragma unroll
            for (int m = 0; m < 4; ++m) { f32x4 v[2];
#pragma unroll
                for (int n = 0; n < 2; ++n)
#pragma unroll
                    for (int j = 0; j < 4; ++j) { const float g = acc[ai][0][m][n][j]; v[n][j] = g * sigmoidf_(g) * acc[ai][1][m][n][j]; }
                u32x4 w; w.x = cvt_pk_bf16(v[0][0], v[0][1]); w.y = cvt_pk_bf16(v[0][2], v[0][3]); w.z = cvt_pk_bf16(v[1][0], v[1][1]); w.w = cvt_pk_bf16(v[1][2], v[1][3]);
                *(u32x4*)(O + (size_t)(row0 + ai * HALF + m * 16) * 1024 + col0) = w; }
    }
};
struct EpiRowScale {
    static constexpr bool PERM = true;
    bf16_t* O; const float* rs;
    __device__ __forceinline__ void operator()(const f32x4 (&acc)[2][2][4][2], const Unit& u, int wr, int wc, int fr, int fq) const {
        const int row0 = u.orow + wr * 64 + fr, col0 = u.ocol + wc * 32 + 8 * fq;
#pragma unroll
        for (int ai = 0; ai < 2; ++ai)
#pragma unroll
            for (int m = 0; m < 4; ++m) { const int row = row0 + ai * HALF + m * 16; const float s = rs[row];
#pragma unroll
                for (int bj = 0; bj < 2; ++bj) { const f32x4 v0 = acc[ai][bj][m][0] * s, v1 = acc[ai][bj][m][1] * s;
                    u32x4 w; w.x = cvt_pk_bf16(v0[0], v0[1]); w.y = cvt_pk_bf16(v0[2], v0[3]); w.z = cvt_pk_bf16(v1[0], v1[1]); w.w = cvt_pk_bf16(v1[2], v1[3]);
                    *(u32x4*)(O + (size_t)row * 1024 + col0 + bj * HALF) = w; } }
    }
};
struct EpiGlu {
    static constexpr bool PERM = true;
    const bf16_t* Z; bf16_t* O; const float* gb;
    __device__ __forceinline__ void operator()(const f32x4 (&acc)[2][2][4][2], const Unit& u, int wr, int wc, int fr, int fq) const {
        const int row0 = u.orow + wr * 64 + fr, col0 = wc * 32 + 8 * fq;
#pragma unroll
        for (int ai = 0; ai < 2; ++ai)
#pragma unroll
            for (int m = 0; m < 4; ++m) { const size_t row = (size_t)(row0 + ai * HALF + m * 16);
#pragma unroll
                for (int bj = 0; bj < 2; ++bj) { const int col = col0 + bj * HALF;
                    const u32x4 z = *(const u32x4*)(Z + row * 256 + col); const f32x4 b0 = *(const f32x4*)(gb + col), b1 = *(const f32x4*)(gb + col + 4);
                    const f32x4 a0 = acc[ai][bj][m][0] + b0, a1 = acc[ai][bj][m][1] + b1; f32x4 v0, v1;
                    v0[0] = bflo(z.x) * sigmoidf_(a0[0]); v0[1] = bfhi(z.x) * sigmoidf_(a0[1]); v0[2] = bflo(z.y) * sigmoidf_(a0[2]); v0[3] = bfhi(z.y) * sigmoidf_(a0[3]);
                    v1[0] = bflo(z.z) * sigmoidf_(a1[0]); v1[1] = bfhi(z.z) * sigmoidf_(a1[1]); v1[2] = bflo(z.w) * sigmoidf_(a1[2]); v1[3] = bfhi(z.w) * sigmoidf_(a1[3]);
                    u32x4 w; w.x = cvt_pk_bf16(v0[0], v0[1]); w.y = cvt_pk_bf16(v0[2], v0[3]); w.z = cvt_pk_bf16(v1[0], v1[1]); w.w = cvt_pk_bf16(v1[2], v1[3]);
                    *(u32x4*)(O + row * 1024 + 512 + col) = w; }
                asm volatile("" ::: "memory"); }
    }
};

#ifndef PG8_SP2
#define PG8_SP2 1
#endif
template <class Epi, class Sched>
__device__ __forceinline__ void gemm_phase(PG8_LAS unsigned char* lds, const Gemm g, const Sched& S, const Epi& E, int tid_in) {
    int tid = tid_in; asm volatile("" : "+v"(tid));
    const int wid = __builtin_amdgcn_readfirstlane(tid >> 6), lane = tid & 63, wr = wid >> 2, wc = wid & 3, fr = lane & 15, fq = lane >> 4;
    int K = g.K; asm volatile("" : "+s"(K)); const int nt = K / BK;
    unsigned voffA[2], voffB[2];
#pragma unroll
    for (int i = 0; i < 2; ++i) { int R, C; stage_rc(tid * 16 + i * 8192, R, C); const int Rb = Epi::PERM ? ((R & ~31) + perm32(R & 31)) : R;
        voffA[i] = (unsigned)(R * g.lda + C) * 2u; voffB[i] = (unsigned)(Rb * g.ldb + C) * 2u; }
    const size_t kstep = (size_t)(BK * 2);
    const size_t hstepA = (size_t)HALF * g.lda * 2, hstepB = (size_t)HALF * g.ldb * 2;
    const unsigned ldsw = (unsigned)wid * 1024u;
    const int aoff = lds_byte(wr * 64 + fr, fq * 8), boff = lds_byte(wc * 32 + fr, fq * 8);
#define PG8_SA(b, h) (((b) * 2 + (h)) * HTB)
#define PG8_SB(b, h) ((4 + (b) * 2 + (h)) * HTB)
#define PG8_STAGE(bufoff, gbase, voff) do { _Pragma("unroll") for (int _i = 0; _i < 2; ++_i) \
        __builtin_amdgcn_global_load_lds((const unsigned*)((const char*)(gbase) + (voff)[_i]), (PG8_LAS unsigned*)(lds + (bufoff) + ldsw + _i * 8192), 16, 0, 0); } while (0)
#define PG8_LDA(dst, b, h) do { _Pragma("unroll") for (int m = 0; m < 4; ++m) _Pragma("unroll") for (int k = 0; k < 2; ++k) dst[m][k] = *(const PG8_LAS bf16x8*)(lds + PG8_SA(b, h) + aoff + m * 2048 + k * 1024); } while (0)
#define PG8_LDB(dst, b, h) do { _Pragma("unroll") for (int n = 0; n < 2; ++n) _Pragma("unroll") for (int k = 0; k < 2; ++k) dst[n][k] = *(const PG8_LAS bf16x8*)(lds + PG8_SB(b, h) + boff + n * 2048 + k * 1024); } while (0)
#define PG8_MMA(ai, bj, At, Bt) do { __builtin_amdgcn_s_setprio(1); _Pragma("unroll") for (int m = 0; m < 4; ++m) _Pragma("unroll") for (int n = 0; n < 2; ++n) _Pragma("unroll") for (int k = 0; k < 2; ++k) \
        acc[ai][bj][m][n] = __builtin_amdgcn_mfma_f32_16x16x32_bf16(Bt[n][k], At[m][k], acc[ai][bj][m][n], 0, 0, 0); __builtin_amdgcn_s_setprio(0); } while (0)
#define PG8_WAIT_V(n) asm volatile("s_waitcnt vmcnt(" #n ")" ::: "memory")
#define PG8_WAIT_L(n) asm volatile("s_waitcnt lgkmcnt(" #n ")" ::: "memory")
#define PG8_BAR __builtin_amdgcn_s_barrier()
#define PG8_SCHED __builtin_amdgcn_sched_barrier(0)
    Unit cur, nxt; int ui = 0;
    if (!S.next(0, cur)) return;
    f32x4 acc[2][2][4][2];
#pragma unroll
    for (int a = 0; a < 2; ++a)
#pragma unroll
        for (int b = 0; b < 2; ++b)
#pragma unroll
            for (int m = 0; m < 4; ++m)
#pragma unroll
                for (int n = 0; n < 2; ++n) acc[a][b][m][n] = (f32x4){0.f, 0.f, 0.f, 0.f};
    bf16x8 At[4][2], B0[2][2], B1[2][2];
    const char* cA = cur.A; const char* cB = cur.B;
#if PG8_SP2
    PG8_STAGE(PG8_SB(0, 0), cB, voffB); PG8_STAGE(PG8_SB(0, 1), cB + hstepB, voffB); PG8_STAGE(PG8_SA(0, 0), cA, voffA); PG8_STAGE(PG8_SA(0, 1), cA + hstepA, voffA);
    if (wr == 1) PG8_BAR;
    PG8_WAIT_V(2); PG8_BAR;
    PG8_STAGE(PG8_SB(1, 0), cB + kstep, voffB); PG8_STAGE(PG8_SA(1, 0), cA + kstep, voffA); PG8_STAGE(PG8_SB(1, 1), cB + hstepB + kstep, voffB);
    PG8_WAIT_V(6); PG8_BAR;
#else
    PG8_STAGE(PG8_SB(0, 0), cB, voffB); PG8_STAGE(PG8_SA(0, 0), cA, voffA); PG8_STAGE(PG8_SB(0, 1), cB + hstepB, voffB); PG8_STAGE(PG8_SA(0, 1), cA + hstepA, voffA);
    if (wr == 1) PG8_BAR;
    PG8_WAIT_V(4); PG8_BAR;
    PG8_STAGE(PG8_SB(1, 0), cB + kstep, voffB); PG8_STAGE(PG8_SA(1, 0), cA + kstep, voffA); PG8_STAGE(PG8_SB(1, 1), cB + hstepB + kstep, voffB);
    PG8_WAIT_V(6); PG8_BAR;
#endif
    for (;;) {
        const bool has_next = S.next(ui + 1, nxt);
        const char* nA = has_next ? nxt.A : cA; const char* nB = has_next ? nxt.B : cB;
#pragma unroll 1
        for (int t = 0; t < nt; t += 2) {
            const bool last = (t == nt - 2);
            const char* a1 = cA + (size_t)(t + 1) * kstep;
            const char* a2 = last ? nA : cA + (size_t)(t + 2) * kstep; const char* b2 = last ? nB : cB + (size_t)(t + 2) * kstep;
            const char* a3 = a2 + kstep; const char* b3 = b2 + kstep;
#if PG8_SP2
            PG8_LDB(B0, 0, 0); PG8_LDB(B1, 0, 1); PG8_SCHED; PG8_LDA(At, 0, 0); PG8_STAGE(PG8_SA(1, 1), a1 + hstepA, voffA);
            PG8_WAIT_V(8); PG8_WAIT_L(0); PG8_BAR; PG8_MMA(0, 0, At, B0); PG8_MMA(0, 1, At, B1); PG8_BAR; PG8_SCHED;
            PG8_LDA(At, 0, 1); PG8_STAGE(PG8_SB(0, 0), b2, voffB); PG8_STAGE(PG8_SB(0, 1), b2 + hstepB, voffB); PG8_STAGE(PG8_SA(0, 0), a2, voffA);
            PG8_WAIT_V(8); PG8_WAIT_L(0); PG8_BAR; PG8_MMA(1, 0, At, B0); PG8_MMA(1, 1, At, B1); PG8_BAR; PG8_SCHED;
            PG8_LDB(B0, 1, 0); PG8_LDB(B1, 1, 1); PG8_SCHED; PG8_LDA(At, 1, 0); PG8_STAGE(PG8_SA(0, 1), a2 + hstepA, voffA);
            PG8_WAIT_V(8); PG8_WAIT_L(0); PG8_BAR; PG8_MMA(0, 0, At, B0); PG8_MMA(0, 1, At, B1); PG8_BAR; PG8_SCHED;
            PG8_LDA(At, 1, 1); PG8_STAGE(PG8_SB(1, 0), b3, voffB); PG8_STAGE(PG8_SB(1, 1), b3 + hstepB, voffB); PG8_STAGE(PG8_SA(1, 0), a3, voffA);
            PG8_WAIT_V(8); PG8_WAIT_L(0); PG8_BAR; PG8_MMA(1, 0, At, B0); PG8_MMA(1, 1, At, B1); PG8_BAR; PG8_SCHED;
#else
            PG8_LDB(B0, 0, 0); PG8_SCHED; PG8_LDA(At, 0, 0); PG8_STAGE(PG8_SA(1, 1), a1 + hstepA, voffA);
            PG8_WAIT_L(8); PG8_BAR; PG8_WAIT_L(0); PG8_MMA(0, 0, At, B0); PG8_BAR; PG8_SCHED;
            PG8_LDB(B1, 0, 1); PG8_STAGE(PG8_SB(0, 0), b2, voffB);
            PG8_BAR; PG8_WAIT_L(0); PG8_MMA(0, 1, At, B1); PG8_BAR;
            PG8_LDA(At, 0, 1); PG8_STAGE(PG8_SA(0, 0), a2, voffA);
            PG8_BAR; PG8_WAIT_L(0); PG8_MMA(1, 0, At, B0); PG8_BAR; PG8_SCHED;
            PG8_STAGE(PG8_SB(0, 1), b2 + hstepB, voffB);
            PG8_WAIT_V(6); PG8_BAR; PG8_MMA(1, 1, At, B1); PG8_BAR;
            PG8_LDB(B0, 1, 0); PG8_SCHED; PG8_LDA(At, 1, 0); PG8_STAGE(PG8_SA(0, 1), a2 + hstepA, voffA);
            PG8_WAIT_L(8); PG8_BAR; PG8_WAIT_L(0); PG8_MMA(0, 0, At, B0); PG8_BAR; PG8_SCHED;
            PG8_LDB(B1, 1, 1); PG8_STAGE(PG8_SB(1, 0), b3, voffB);
            PG8_BAR; PG8_WAIT_L(0); PG8_MMA(0, 1, At, B1); PG8_BAR;
            PG8_LDA(At, 1, 1); PG8_STAGE(PG8_SA(1, 0), a3, voffA);
            PG8_BAR; PG8_WAIT_L(0); PG8_MMA(1, 0, At, B0); PG8_BAR; PG8_SCHED;
            PG8_STAGE(PG8_SB(1, 1), b3 + hstepB, voffB);
            PG8_WAIT_V(6); PG8_BAR; PG8_MMA(1, 1, At, B1); PG8_BAR;
#endif
        }
        if (wr == 0) PG8_BAR;
        E(acc, cur, wr, wc, fr, fq);
        if (!has_next) break;
#pragma unroll
        for (int a = 0; a < 2; ++a)
#pragma unroll
            for (int b = 0; b < 2; ++b)
#pragma unroll
                for (int m = 0; m < 4; ++m)
#pragma unroll
                    for (int n = 0; n < 2; ++n) acc[a][b][m][n] = (f32x4){0.f, 0.f, 0.f, 0.f};
        cur = nxt; cA = nA; cB = nB; ++ui;
        if (wr == 1) PG8_BAR;
    }
    PG8_WAIT_V(0);
    PG8_BAR;
#undef PG8_SA
#undef PG8_SB
#undef PG8_STAGE
#undef PG8_LDA
#undef PG8_LDB
#undef PG8_MMA
#undef PG8_WAIT_V
#undef PG8_WAIT_L
#undef PG8_BAR
#undef PG8_SCHED
}

struct MergeUnit { const char* A; const char* B; int orow, ocol, z; };
template <class Sched>
__device__ __forceinline__ void gemm_merge_phase(PG8_LAS unsigned char* lds, const Gemm g, const Sched& S, const bf16_t* G, bf16_t* MB, int tid_in) {
    int tid = tid_in; asm volatile("" : "+v"(tid));
    const int wid = __builtin_amdgcn_readfirstlane(tid >> 6), lane = tid & 63, wr = wid >> 2, wc = wid & 3, fr = lane & 15, fq = lane >> 4;
    int K = g.K; asm volatile("" : "+s"(K)); const int nt = K / BK;
    unsigned voffA[2], voffB[2];
#pragma unroll
    for (int i = 0; i < 2; ++i) { int R, C; stage_rc(tid * 16 + i * 8192, R, C); const int Rb = (R & ~31) + perm32(R & 31);
        voffA[i] = (unsigned)(R * g.lda + C) * 2u; voffB[i] = (unsigned)(Rb * g.ldb + C) * 2u; }
    const size_t kstep = (size_t)(BK * 2);
    const size_t hstepA = (size_t)HALF * g.lda * 2;
    const unsigned ldsw = (unsigned)wid * 1024u;
    const int aoff = lds_byte(wr * 64 + fr, fq * 8), boff = lds_byte(wc * 32 + fr, fq * 8);
#define PG8_SA(b, h) (((b) * 2 + (h)) * HTB)
#define PG8_SB(b, h) ((4 + (b) * 2 + (h)) * HTB)
#define PG8_STAGE(bufoff, gbase, voff) do { _Pragma("unroll") for (int _i = 0; _i < 2; ++_i) \
        __builtin_amdgcn_global_load_lds((const unsigned*)((const char*)(gbase) + (voff)[_i]), (PG8_LAS unsigned*)(lds + (bufoff) + ldsw + _i * 8192), 16, 0, 0); } while (0)
#define PG8_LDA(dst, b, h) do { _Pragma("unroll") for (int m = 0; m < 4; ++m) _Pragma("unroll") for (int k = 0; k < 2; ++k) dst[m][k] = *(const PG8_LAS bf16x8*)(lds + PG8_SA(b, h) + aoff + m * 2048 + k * 1024); } while (0)
#define PG8_LDB(dst, b, h) do { _Pragma("unroll") for (int n = 0; n < 2; ++n) _Pragma("unroll") for (int k = 0; k < 2; ++k) dst[n][k] = *(const PG8_LAS bf16x8*)(lds + PG8_SB(b, h) + boff + n * 2048 + k * 1024); } while (0)
#define PG8_MMA1(ai, At, Bt) do { __builtin_amdgcn_s_setprio(1); _Pragma("unroll") for (int m = 0; m < 4; ++m) _Pragma("unroll") for (int n = 0; n < 2; ++n) _Pragma("unroll") for (int k = 0; k < 2; ++k) \
        acc[ai][m][n] = __builtin_amdgcn_mfma_f32_16x16x32_bf16(Bt[n][k], At[m][k], acc[ai][m][n], 0, 0, 0); __builtin_amdgcn_s_setprio(0); } while (0)
#define PG8_WAIT_V(n) asm volatile("s_waitcnt vmcnt(" #n ")" ::: "memory")
#define PG8_WAIT_L(n) asm volatile("s_waitcnt lgkmcnt(" #n ")" ::: "memory")
#define PG8_BAR __builtin_amdgcn_s_barrier()
#define PG8_SCHED __builtin_amdgcn_sched_barrier(0)
    MergeUnit cur, nxt; int ui = 0;
    if (!S.next(0, cur)) return;
    f32x4 acc[2][4][2], mrg[2][4][2];
#pragma unroll
    for (int a = 0; a < 2; ++a)
#pragma unroll
        for (int m = 0; m < 4; ++m)
#pragma unroll
            for (int n = 0; n < 2; ++n) { acc[a][m][n] = (f32x4){0.f, 0.f, 0.f, 0.f}; mrg[a][m][n] = (f32x4){0.f, 0.f, 0.f, 0.f}; }
    bf16x8 At[4][2], B0[2][2];
    const char* cA = cur.A; const char* cB = cur.B;
    PG8_STAGE(PG8_SB(0, 0), cB, voffB); PG8_STAGE(PG8_SA(0, 0), cA, voffA); PG8_STAGE(PG8_SA(0, 1), cA + hstepA, voffA);
    if (wr == 1) PG8_BAR;
    PG8_WAIT_V(2); PG8_BAR;
    PG8_STAGE(PG8_SB(1, 0), cB + kstep, voffB); PG8_STAGE(PG8_SA(1, 0), cA + kstep, voffA);
    PG8_WAIT_V(4); PG8_BAR;
    for (;;) {
        const bool has_next = S.next(ui + 1, nxt);
        const char* nA = has_next ? nxt.A : cA; const char* nB = has_next ? nxt.B : cB;
#pragma unroll 1
        for (int t = 0; t < nt; t += 2) {
            const bool last = (t == nt - 2);
            const char* a1 = cA + (size_t)(t + 1) * kstep;
            const char* a2 = last ? nA : cA + (size_t)(t + 2) * kstep; const char* b2 = last ? nB : cB + (size_t)(t + 2) * kstep;
            const char* a3 = a2 + kstep; const char* b3 = b2 + kstep;
            PG8_LDB(B0, 0, 0); PG8_SCHED; PG8_LDA(At, 0, 0); PG8_STAGE(PG8_SA(1, 1), a1 + hstepA, voffA);
            PG8_WAIT_V(6); PG8_WAIT_L(0); PG8_BAR; PG8_MMA1(0, At, B0); PG8_BAR; PG8_SCHED;
            PG8_LDA(At, 0, 1); PG8_STAGE(PG8_SB(0, 0), b2, voffB); PG8_STAGE(PG8_SA(0, 0), a2, voffA);
            PG8_WAIT_V(6); PG8_WAIT_L(0); PG8_BAR; PG8_MMA1(1, At, B0); PG8_BAR; PG8_SCHED;
            PG8_LDB(B0, 1, 0); PG8_SCHED; PG8_LDA(At, 1, 0); PG8_STAGE(PG8_SA(0, 1), a2 + hstepA, voffA);
            PG8_WAIT_V(6); PG8_WAIT_L(0); PG8_BAR; PG8_MMA1(0, At, B0); PG8_BAR; PG8_SCHED;
            PG8_LDA(At, 1, 1); PG8_STAGE(PG8_SB(1, 0), b3, voffB); PG8_STAGE(PG8_SA(1, 0), a3, voffA);
            PG8_WAIT_V(6); PG8_WAIT_L(0); PG8_BAR; PG8_MMA1(1, At, B0); PG8_BAR; PG8_SCHED;
        }
        if (wr == 0) PG8_BAR;
        {
            const int row0 = cur.orow + wr * 64 + fr, col0 = cur.ocol + wc * 32 + 8 * fq, z = cur.z;
            u32x4 gq[2][4];
#pragma unroll
            for (int ai = 0; ai < 2; ++ai)
#pragma unroll
                for (int m = 0; m < 4; ++m) gq[ai][m] = *(const u32x4*)(G + (size_t)(row0 + ai * HALF + m * 16) * 4096 + z * 1024 + col0);
#pragma unroll
            for (int ai = 0; ai < 2; ++ai)
#pragma unroll
                for (int m = 0; m < 4; ++m) { const size_t row = (size_t)(row0 + ai * HALF + m * 16);
                    const u32x4 gv = gq[ai][m];
                    f32x4 v0 = acc[ai][m][0], v1 = acc[ai][m][1];
                    v0[0] *= bflo(gv.x); v0[1] *= bfhi(gv.x); v0[2] *= bflo(gv.y); v0[3] *= bfhi(gv.y);
                    v1[0] *= bflo(gv.z); v1[1] *= bfhi(gv.z); v1[2] *= bflo(gv.w); v1[3] *= bfhi(gv.w);
                    if (z == 0) { mrg[ai][m][0] = v0; mrg[ai][m][1] = v1; } else { mrg[ai][m][0] += v0; mrg[ai][m][1] += v1; }
                    acc[ai][m][0] = (f32x4){0.f, 0.f, 0.f, 0.f}; acc[ai][m][1] = (f32x4){0.f, 0.f, 0.f, 0.f};
                    if (z == 3) { const f32x4 o0 = mrg[ai][m][0], o1 = mrg[ai][m][1];
                        u32x4 w; w.x = cvt_pk_bf16(o0[0], o0[1]); w.y = cvt_pk_bf16(o0[2], o0[3]); w.z = cvt_pk_bf16(o1[0], o1[1]); w.w = cvt_pk_bf16(o1[2], o1[3]);
                        *(u32x4*)(MB + row * 1024 + col0) = w; } }
        }
        if (!has_next) break;
        cur = nxt; cA = nA; cB = nB; ++ui;
        if (wr == 1) PG8_BAR;
    }
    PG8_WAIT_V(0);
    PG8_BAR;
#undef PG8_SA
#undef PG8_SB
#undef PG8_STAGE
#undef PG8_LDA
#undef PG8_LDB
#undef PG8_MMA1
#undef PG8_WAIT_V
#undef PG8_WAIT_L
#undef PG8_BAR
#undef PG8_SCHED
}
}
#define XB_TMO      128
#define XB_XCNT(j)  (256  + 64 * (j))
#define XB_XSUB(j)  (1280 + 64 * (j))
#define XB_XGEN(j)  (2304 + 64 * (j))
#define XB_TOP      3328
#define XB_TOPGEN   3392
#define XCD_BAR_WORDS 3456
#define XB_SPIN_CAP (1u << 18)

__device__ __forceinline__ unsigned xb_ld(unsigned* p)              { return __hip_atomic_load(p, __ATOMIC_RELAXED, __HIP_MEMORY_SCOPE_AGENT); }
__device__ __forceinline__ unsigned xb_add(unsigned* p, unsigned v) { return __hip_atomic_fetch_add(p, v, __ATOMIC_RELAXED, __HIP_MEMORY_SCOPE_AGENT); }
__device__ __forceinline__ unsigned xb_xcc_id() { return (unsigned)__builtin_amdgcn_s_getreg((3 << 11) | 20) & 0xFu; }
#define XB_SPIN(cond, bar) do { unsigned _sp = 0; while (cond) { __builtin_amdgcn_s_sleep(1); \
    if ((++_sp & 255u) == 0u) { if (xb_ld(&(bar)[XB_TMO])) break; if (_sp > XB_SPIN_CAP) { atomicAdd(&(bar)[XB_TMO], 1u); break; } } } } while (0)

struct XcdBarrier {
    unsigned* bar; unsigned x;
    volatile LAS unsigned* st;
};

__device__ __forceinline__ XcdBarrier xcd_barrier_post(unsigned* bar, volatile LAS unsigned* st) {
    XcdBarrier b; b.bar = bar; b.x = xb_xcc_id(); b.st = st;
    if (threadIdx.x == 0) (void)xb_add(&bar[XB_XCNT(b.x)], 1u);
    return b;
}
__device__ __forceinline__ void xcd_barrier_complete(unsigned* bar, unsigned x, unsigned& nloc, unsigned& nx) {
    const unsigned G = gridDim.x * gridDim.y * gridDim.z;
    unsigned sum, cnt, mine, sp = 0u;
    for (;;) {
        sum = 0u; cnt = 0u; mine = 0u;
#pragma unroll
        for (unsigned j = 0; j < 16; ++j) { const unsigned c = xb_ld(&bar[XB_XCNT(j)]); sum += c; cnt += (c > 0u) ? 1u : 0u; mine = (j == x) ? c : mine; }
        if (sum == G) break;
        __builtin_amdgcn_s_sleep(1);
        if ((++sp & 255u) == 0u) { if (xb_ld(&bar[XB_TMO])) break; if (sp > XB_SPIN_CAP) { atomicAdd(&bar[XB_TMO], 1u); break; } }
    }
    nloc = mine > 0u ? mine : 1u; nx = cnt > 0u ? cnt : 1u;
}

__device__ __forceinline__ void xcd_barrier(const XcdBarrier& b, int tid_now) {
    asm volatile("s_waitcnt vmcnt(0)" ::: "memory");
    __syncthreads();
    if (tid_now == 0) {
        unsigned* bar = b.bar;
        __builtin_amdgcn_s_waitcnt(0);
        unsigned nloc = b.st[0], nx = b.st[1];
        if (nloc == 0u) { xcd_barrier_complete(bar, b.x, nloc, nx); b.st[0] = nloc; b.st[1] = nx; }
        const unsigned old = xb_add(&bar[XB_XSUB(b.x)], 1u);
        const unsigned gen = old / nloc;
        if (old + 1u == (gen + 1u) * nloc) {
            __builtin_amdgcn_fence(__ATOMIC_RELEASE, "agent");
            asm volatile("s_waitcnt vmcnt(0)" ::: "memory");
            const unsigned og = xb_add(&bar[XB_TOP], 1u);
            const unsigned tg = og / nx;
            if (og + 1u == (tg + 1u) * nx) xb_add(&bar[XB_TOPGEN], 1u);
            else XB_SPIN(xb_ld(&bar[XB_TOPGEN]) == tg, bar);
            __builtin_amdgcn_fence(__ATOMIC_ACQUIRE, "agent");
            xb_add(&bar[XB_XGEN(b.x)], 1u);
            asm volatile("s_waitcnt vmcnt(0)" ::: "memory");
        } else {
            XB_SPIN(xb_ld(&bar[XB_XGEN(b.x)]) == gen, bar);
            __builtin_amdgcn_fence(__ATOMIC_ACQUIRE, "agent");
            asm volatile("s_waitcnt vmcnt(0)" ::: "memory");
        }
    }
    __syncthreads();
}

struct Args { const float* in[N_INPUTS]; float* out; unsigned char* ws; int ph_lo, ph_hi, l_lo, l_hi; };
struct Frame {
    LAS unsigned char* lds;
    volatile LAS unsigned* MISC;
    gu32* ctl;
    int tid, lane, wave, G, bid, zoff;
    unsigned char* ws;
    float* out;
};
#define FIN(k) (args.in[k])
#define WSP(T, off) ((T*)(F.ws + (off)))

__device__ __forceinline__ int wq_grab(Frame& F, int qid) {
    __syncthreads();
    if (F.tid == 0) F.MISC[16] = __hip_atomic_fetch_add((unsigned*)(F.ctl + CW_Q + qid * 64), 1u, RLX_AGENT);
    __syncthreads();
    return (int)F.MISC[16];
}
__device__ __forceinline__ float block_sum(Frame& F, float v, LAS float* red  ) {
    v = wave_sum(v);
    __syncthreads();
    if (F.lane == 0) red[F.wave] = v;
    __syncthreads();
    float s = 0.f;
#pragma unroll
    for (int w = 0; w < 8; ++w) s += red[w];
    return s;
}

__device__ __forceinline__ void ln_row(f32x4 (&v)[4], const float* g, const float* b, int lane) {
    float s = 0.f;
#pragma unroll
    for (int j = 0; j < 4; ++j) s += (v[j].x + v[j].y) + (v[j].z + v[j].w);
    const float mean = wave_sum(s) * (1.f / DM); float s2 = 0.f;
#pragma unroll
    for (int j = 0; j < 4; ++j) { v[j] = v[j] - mean; s2 += (v[j].x * v[j].x + v[j].y * v[j].y) + (v[j].z * v[j].z + v[j].w * v[j].w); }
    const float rstd = 1.f / sqrtf(wave_sum(s2) * (1.f / DM) + LN_EPS);
#pragma unroll
    for (int j = 0; j < 4; ++j) { const f32x4 gg = *(const f32x4*)(g + 4 * lane + 256 * j), bb = *(const f32x4*)(b + 4 * lane + 256 * j); v[j] = v[j] * rstd * gg + bb; }
}
__device__ __forceinline__ void store_row_bf16(const f32x4 (&v)[4], bf16* o16, int lane) {
#pragma unroll
    for (int j = 0; j < 4; ++j) { v2u w; w.x = pk2(v[j].x, v[j].y); w.y = pk2(v[j].z, v[j].w); *(v2u*)(o16 + 4 * lane + 256 * j) = w; }
}
__device__ __forceinline__ void load_row_bf16(f32x4 (&v)[4], const bf16* p, int lane, float scale) {
#pragma unroll
    for (int j = 0; j < 4; ++j) { const v2u w = *(const v2u*)(p + 4 * lane + 256 * j); v[j] = (f32x4){bflo(w.x), bfhi(w.x), bflo(w.y), bfhi(w.y)} * scale; }
}
__device__ __forceinline__ void store_row_f32_bf16(const f32x4 (&v)[4], float* o32, bf16* o16, int lane) {
#pragma unroll
    for (int j = 0; j < 4; ++j) { *(f32x4*)(o32 + 4 * lane + 256 * j) = v[j];
        v2u w; w.x = pk2(v[j].x, v[j].y); w.y = pk2(v[j].z, v[j].w); *(v2u*)(o16 + 4 * lane + 256 * j) = w; }
}

template <class RowPtr>
__device__ __forceinline__ void transpose_item(const float* W, int ldw, int k0, int n0, const RowPtr& rp, LAS float* scr, int lane) {
    const float* src = W + (size_t)k0 * ldw + n0 + lane;
#pragma unroll 16
    for (int kk = 0; kk < 64; ++kk) scr[kk * 65 + lane] = src[(size_t)kk * ldw];
    LDS_WAIT(); asm volatile("" ::: "memory");
    const int c = lane & 7;
#pragma unroll
    for (int j = 0; j < 8; ++j) { const int n = (lane >> 3) + 8 * j; const LAS float* s = scr + (8 * c) * 65 + n;
        v4u o; o.x = pk2(s[0 * 65], s[1 * 65]); o.y = pk2(s[2 * 65], s[3 * 65]); o.z = pk2(s[4 * 65], s[5 * 65]); o.w = pk2(s[6 * 65], s[7 * 65]);
        *(v4u*)(rp(n0 + n) + k0 + 8 * c) = o; }
    LDS_WAIT(); asm volatile("" ::: "memory");
}
struct RowPlain { bf16* base; int ld; __device__ __forceinline__ bf16* operator()(int n) const { return base + (size_t)n * ld; } };
struct RowGU { bf16* base; int half; __device__ __forceinline__ bf16* operator()(int f) const { return base + (size_t)((f >> 7) * 256 + half * 128 + (f & 127)) * 1024; } };

__device__ __forceinline__ void convert_layer(Frame& F, const Args& args, int l, int gw, int NGW) {
    LAS float* scr = (LAS float*)(F.lds + F.wave * 16640);
    unsigned char* wb = F.ws + WS_W;
    constexpr int I_IN = 16 * 124, I_BR = 4 * 4 * 16, I_OUT = 16 * 16, I_GLU = 4 * 4, I_EX = 16 * 256;
    constexpr int NIT = I_IN + I_BR + I_OUT + I_GLU + 3 * I_EX;
    for (int it = gw; it < NIT; it += NGW) {
        int r = it;
        if (r < I_IN) { const int kb = r / 124, nb = r % 124; transpose_item(FIN(I_WIN) + (size_t)l * DM * NIN, NIN, 64 * kb, 64 * nb, RowPlain{(bf16*)(wb + W_WIN), 1024}, scr, F.lane); continue; } r -= I_IN;
        if (r < I_BR) { const int i = r / 64, q = r % 64, kb = q / 16, nb = q % 16;
            transpose_item(FIN(I_WBR) + ((size_t)l * 4 + i) * 256 * 1024, 1024, 64 * kb, 64 * nb, RowPlain{(bf16*)(wb + W_WB) + (size_t)i * 1024 * 256, 256}, scr, F.lane); continue; } r -= I_BR;
        if (r < I_OUT) { const int kb = r / 16, nb = r % 16; transpose_item(FIN(I_WOUT) + (size_t)l * 1024 * 1024, 1024, 64 * kb, 64 * nb, RowPlain{(bf16*)(wb + W_WO), 1024}, scr, F.lane); continue; } r -= I_OUT;
        if (r < I_GLU) { const int kb = r / 4, nb = r % 4; transpose_item(FIN(I_S5_GW) + (size_t)l * 256 * 256, 256, 64 * kb, 64 * nb, RowPlain{(bf16*)(wb + W_GLU), 256}, scr, F.lane); continue; } r -= I_GLU;
        const int which = r / I_EX, q = r % I_EX, e = q / 256, q2 = q % 256, kb = q2 / 16, nb = q2 % 16;
        const size_t esz = (size_t)1024 * 1024;
        if (which == 0) transpose_item(FIN(I_EWG) + ((size_t)l * NE + e) * esz, 1024, 64 * kb, 64 * nb, RowGU{(bf16*)(wb + W_GU) + (size_t)e * 2048 * 1024, 0}, scr, F.lane);
        else if (which == 1) transpose_item(FIN(I_EWU) + ((size_t)l * NE + e) * esz, 1024, 64 * kb, 64 * nb, RowGU{(bf16*)(wb + W_GU) + (size_t)e * 2048 * 1024, 1}, scr, F.lane);
        else transpose_item(FIN(I_EWD) + ((size_t)l * NE + e) * esz, 1024, 64 * kb, 64 * nb, RowPlain{(bf16*)(wb + W_DN) + (size_t)e * esz, 1024}, scr, F.lane);
    }
}

__device__ __forceinline__ f32x2 cmul(f32x2 a, f32x2 b) { return (f32x2){a.x * b.x - a.y * b.y, a.x * b.y + a.y * b.x}; }

__device__ __forceinline__ void s5_build_item(Frame& F, const Args& args, int l, int g, int q4  ) {
    LAS f32x2* ap = (LAS f32x2*)F.lds;
    LAS f32x2* bb = ap + 2 * 64 * 33;
    LAS f32x2* cm = bb + 2 * 64 * 16;
    LAS float* kern = (LAS float*)(cm + 2 * 16 * 64);
    const int tid = F.tid;
    __syncthreads();
    if (tid < 128) {
        const int dir = tid >> 6, p = tid & 63; const size_t gi = ((size_t)(l * 2 + dir) * 16 + g);
        const float lre = FIN(I_S5_LRE)[gi * 64 + p], lim = FIN(I_S5_LIM)[gi * 64 + p], dt = expf(FIN(I_S5_LDT)[gi]);
        const float x = lre * dt, y = lim * dt;
        for (int tau = 0; tau <= 32; ++tau) { float s, c; sincosf((float)tau * y, &s, &c); const float e = expf((float)tau * x); ap[(dir * 64 + p) * 33 + tau] = (f32x2){e * c, e * s}; }
        if (q4 == 0) { float s, c; sincosf(32.f * y, &s, &c); const float e = expf(32.f * x); WSP(f32x2, WS_S5A32)[gi * 64 + p] = (f32x2){e * c, e * s}; }
        float s1, c1; sincosf(y, &s1, &c1); const float sh = sinf(0.5f * y);
        const f32x2 em1 = (f32x2){expm1f(x) * c1 - 2.f * sh * sh, expf(x) * s1};
        const float inv = 1.f / (lre * lre + lim * lim);
        const f32x2 q = (f32x2){(em1.x * lre + em1.y * lim) * inv, (em1.y * lre - em1.x * lim) * inv};
        for (int ci = 0; ci < 16; ++ci) { const f32x2 bm = (f32x2){FIN(I_S5_BRE)[(gi * 64 + p) * 16 + ci], FIN(I_S5_BIM)[(gi * 64 + p) * 16 + ci]}; bb[(dir * 64 + p) * 16 + ci] = cmul(q, bm); }
    }
    for (int i = tid; i < 2 * 16 * 64; i += 512) { const int dir = i >> 10, co = (i >> 6) & 15, p = i & 63; const size_t gi = ((size_t)(l * 2 + dir) * 16 + g);
        cm[i] = (f32x2){FIN(I_S5_CRE)[(gi * 16 + co) * 64 + p], FIN(I_S5_CIM)[(gi * 16 + co) * 64 + p]}; }
    __syncthreads();
    for (int e4 = tid; e4 < 63 * 64; e4 += 512) {
        const int ti = e4 >> 6, co = 4 * q4 + ((e4 >> 4) & 3), ci = e4 & 15, tau = ti - 31, e = ti * 256 + co * 16 + ci; float acc = 0.f;
        if (tau >= 0) for (int p = 0; p < 64; ++p) { const f32x2 w = cmul(cm[(0 * 16 + co) * 64 + p], ap[(0 * 64 + p) * 33 + tau]); const f32x2 b = bb[(0 * 64 + p) * 16 + ci]; acc += w.x * b.x - w.y * b.y; }
        if (tau <= 0) for (int p = 0; p < 64; ++p) { const f32x2 w = cmul(cm[(1 * 16 + co) * 64 + p], ap[(1 * 64 + p) * 33 - tau]); const f32x2 b = bb[(1 * 64 + p) * 16 + ci]; acc += w.x * b.x - w.y * b.y; }
        if (tau == 0 && co == ci) acc += FIN(I_S5_D)[l * 256 + g * 16 + co];
        kern[e] = acc;
    }
    __syncthreads();
    bf16* wcat = (bf16*)(F.ws + WS_S5W + (size_t)l * S5W_LAYER + S5_WCAT_OFF) + (size_t)g * 512 * 768;
    for (int ch = tid; ch < 128 * 96; ch += 512) {
        const int ml = ch / 96, k8 = ch % 96, t = ml >> 2, co = 4 * q4 + (ml & 3), m = 16 * t + co; float v[8];
        if (k8 < 64) { const int j = k8 >> 1, ci0 = (k8 & 1) * 8;
#pragma unroll
            for (int e = 0; e < 8; ++e) v[e] = kern[(t - j + 31) * 256 + co * 16 + ci0 + e]; }
        else { const int kk = (k8 - 64) * 8, dir = kk >> 7, p0 = (kk & 127) >> 1, tau = dir == 0 ? t + 1 : 32 - t;
#pragma unroll
            for (int pp = 0; pp < 4; ++pp) { const f32x2 w = cmul(cm[(dir * 16 + co) * 64 + p0 + pp], ap[(dir * 64 + p0 + pp) * 33 + tau]); v[2 * pp] = w.x; v[2 * pp + 1] = -w.y; } }
        v4u o; o.x = pk2(v[0], v[1]); o.y = pk2(v[2], v[3]); o.z = pk2(v[4], v[5]); o.w = pk2(v[6], v[7]);
        *(v4u*)(wcat + (size_t)m * 768 + k8 * 8) = o;
    }
    bf16* wst = (bf16*)(F.ws + WS_S5W + (size_t)l * S5W_LAYER + S5_WST_OFF) + (size_t)g * 2 * 128 * 512;
    if (q4 == 0) for (int ch = tid; ch < 2 * 128 * 64; ch += 512) {
        const int dir = ch >> 13, o = (ch >> 6) & 127, k8 = ch & 63, p = o >> 1, ri = o & 1, j = k8 >> 1, ci0 = (k8 & 1) * 8; float v[8];
        const f32x2 a = ap[(dir * 64 + p) * 33 + (dir == 0 ? 31 - j : j)];
#pragma unroll
        for (int e = 0; e < 8; ++e) { const f32x2 w = cmul(a, bb[(dir * 64 + p) * 16 + ci0 + e]); v[e] = ri ? w.y : w.x; }
        v4u q; q.x = pk2(v[0], v[1]); q.y = pk2(v[2], v[3]); q.z = pk2(v[4], v[5]); q.w = pk2(v[6], v[7]);
        *(v4u*)(wst + ((size_t)dir * 128 + o) * 512 + k8 * 8) = q;
    }
    __syncthreads();
}

__device__ __forceinline__ void hf2_item(Frame& F, const Args& args, int l, int t) {
    const int lane = F.lane;
    const float tn = (float)t * (1.f / 4095.f), w = 6.283185307179586f * (float)t * (1.f / 4096.f);
    float zv = 0.f;
    if (lane == 0) zv = tn;
    else if (lane <= 16) { const float f = 1e-4f + (float)(lane - 1) * ((15.f - 1e-4f) / 15.f); zv = cosf(f * w); }
    else if (lane <= 32) { const float f = 1e-4f + (float)(lane - 17) * ((15.f - 1e-4f) / 15.f); zv = -sinf(f * w); }
    float acc = FIN(I_HY_B1)[l * 64 + lane];
    const float* w1 = FIN(I_HY_W1) + (size_t)l * 33 * 64;
    for (int i = 0; i < 33; ++i) acc += __shfl(zv, i) * w1[i * 64 + lane];
    const float f1 = sinf(FIN(I_HY_FREQ)[(l * 2 + 0) * 64 + lane] * acc);
    float acc2 = FIN(I_HY_B2)[l * 64 + lane];
    const float* w2 = FIN(I_HY_W2) + (size_t)l * 64 * 64;
    for (int i = 0; i < 64; ++i) acc2 += __shfl(f1, i) * w2[i * 64 + lane];
    WSP(float, WS_HF2)[((size_t)l * 4096 + t) * 64 + lane] = sinf(FIN(I_HY_FREQ)[(l * 2 + 1) * 64 + lane] * acc2);
}

__device__ __forceinline__ void prologue_phase(Frame& F, const Args& args) {
    const int gw = F.bid * 8 + F.wave, NGW = F.G * 8;
    for (int it = F.bid; it < DEPTH * 16 * 4; it += F.G) s5_build_item(F, args, it >> 6, (it >> 2) & 15, it & 3);
    __syncthreads();
    { const int gi = F.bid * 512 + F.tid; if (gi < 1024) { const int pos = gi >> 4, i = gi & 15; const float inv = expf(-(float)(2 * i) * (1.f / 32.f) * 9.210340371976184f);
        float s, c; sincosf((float)pos * inv, &s, &c); WSP(f32x2, WS_ROPE)[gi] = (f32x2){c, s}; } }
    for (int it = gw; it < DEPTH * 4096; it += NGW) hf2_item(F, args, it >> 12, it & 4095);
    for (int m = gw; m < M; m += NGW) { f32x4 v[4];
#pragma unroll
        for (int j = 0; j < 4; ++j) v[j] = *(const f32x4*)(FIN(I_X) + (size_t)m * DM + 4 * F.lane + 256 * j);
        ln_row(v, FIN(I_LNIN_G), FIN(I_LNIN_B), F.lane);
        store_row_bf16(v, WSP(bf16, WS_HB) + (size_t)m * DM, F.lane); }
    convert_layer(F, args, 0, gw, NGW);
}
namespace attn_body {
using bf16=__hip_bfloat16;
using bf16x8=__attribute__((ext_vector_type(8)))short;
using s16x4=__attribute__((ext_vector_type(4)))short;
using f32x16=__attribute__((ext_vector_type(16)))float;
using u32x4=__attribute__((ext_vector_type(4)))unsigned;
constexpr int SEQ=4096,D=64,QP=512,KP=512,VP=512,OP=1024;
constexpr int NW=8,QBLK=32,QB=QBLK*NW,KVBLK=64,NQB=SEQ/QB;
constexpr int ATTN_UNIT_ROWS=QB;
__device__ __forceinline__ int crow(int r,int hi){return (r&3)+8*(r>>2)+4*hi;}
#define SBAR() __builtin_amdgcn_sched_barrier(0)
__device__ __forceinline__ void cmask(f32x16&p0,f32x16&p1,int jb,int qrel,int hi){
  const float NEG=-INFINITY; int kb=64*jb+4*hi;
  #pragma unroll
  for(int r=0;r<16;++r){int kv=kb+(r&3)+8*(r>>2); if(kv>qrel)p0[r]=NEG; if(kv+32>qrel)p1[r]=NEG;}
}

constexpr int NSLOT=3, SLOTB=8192;
constexpr int LDS_K=0, LDS_V=NSLOT*SLOTB, LDS_WS=2*NSLOT*SLOTB, LDS_OST=LDS_WS+NW*64*4, LDS_BYTES=LDS_OST+NW*4096;
constexpr float C2=0.125f*1.4426950408889634f;
__device__ __forceinline__ void glds16(const void*gsrc,unsigned lds_dst){unsigned keep;
  asm volatile("s_mov_b32 %0, m0\n\ts_mov_b32 m0, %2\n\ts_nop 0\n\tglobal_load_lds_dwordx4 %1, off\n\ts_mov_b32 m0, %0":"=&s"(keep):"v"(gsrc),"s"(lds_dst):"memory");}
__device__ __forceinline__ float max3f(float a,float b,float c){float r;asm("v_max3_f32 %0, %1, %2, %3":"=v"(r):"v"(a),"v"(b),"v"(c));return r;}
__device__ __forceinline__ float max2f(float a,float b){float r;asm("v_max_f32_e32 %0, %1, %2":"=v"(r):"v"(a),"v"(b));return r;}
__device__ __forceinline__ float fadd_s(float a,float b){float r;asm("v_add_f32_e32 %0, %1, %2":"=v"(r):"v"(a),"v"(b));return r;}
__device__ __forceinline__ float fsub_s(float a,float b){float r;asm("v_sub_f32_e32 %0, %1, %2":"=v"(r):"v"(a),"v"(b));return r;}
typedef float f32x2_t __attribute__((ext_vector_type(2))); typedef __bf16 bf16x2_t __attribute__((ext_vector_type(2)));
__device__ __forceinline__ unsigned cvtpk_s(float lo,float hi){f32x2_t v={lo,hi};bf16x2_t b=__builtin_convertvector(v,bf16x2_t);return __builtin_bit_cast(unsigned,b);}
#define WAIT_BAR(N) asm volatile("s_waitcnt vmcnt(" #N ") lgkmcnt(0)\n\ts_barrier":::"memory")

__device__ __forceinline__ void qkt(f32x16&p0,f32x16&p1,const char*Kslot,const bf16x8*qr,const f32x16&negm,int r32,int hi){
  const char*kb=Kslot+hi*1024+r32*16;
  #pragma unroll
  for(int d0=0;d0<4;++d0){
    const bf16x8 b0=*reinterpret_cast<const bf16x8*>(kb+d0*2048);
    const bf16x8 b1=*reinterpret_cast<const bf16x8*>(kb+d0*2048+512);
    if(d0==0){p0=__builtin_amdgcn_mfma_f32_32x32x16_bf16(b0,qr[0],negm,0,0,0);p1=__builtin_amdgcn_mfma_f32_32x32x16_bf16(b1,qr[0],negm,0,0,0);}
    else{p0=__builtin_amdgcn_mfma_f32_32x32x16_bf16(b0,qr[d0],p0,0,0,0);p1=__builtin_amdgcn_mfma_f32_32x32x16_bf16(b1,qr[d0],p1,0,0,0);}}
}
typedef __attribute__((address_space(3))) const char* lds_cptr;
typedef short v4i16_t __attribute__((ext_vector_type(4)));
__device__ __forceinline__ void kload8(bf16x8*kf,lds_cptr kp){
  kf[0]=*(const __attribute__((address_space(3))) bf16x8*)(kp);      kf[1]=*(const __attribute__((address_space(3))) bf16x8*)(kp+512);
  kf[2]=*(const __attribute__((address_space(3))) bf16x8*)(kp+2048); kf[3]=*(const __attribute__((address_space(3))) bf16x8*)(kp+2560);
  kf[4]=*(const __attribute__((address_space(3))) bf16x8*)(kp+4096); kf[5]=*(const __attribute__((address_space(3))) bf16x8*)(kp+4608);
  kf[6]=*(const __attribute__((address_space(3))) bf16x8*)(kp+6144); kf[7]=*(const __attribute__((address_space(3))) bf16x8*)(kp+6656);
}
__device__ __forceinline__ void kload2(bf16x8*kf,lds_cptr kp,int j){ kf[2*j]=*(const __attribute__((address_space(3))) bf16x8*)(kp+j*2048); kf[2*j+1]=*(const __attribute__((address_space(3))) bf16x8*)(kp+j*2048+512); }
__device__ __forceinline__ s16x4 vtr(lds_cptr p){ return __builtin_bit_cast(s16x4,__builtin_amdgcn_ds_read_tr16_b64_v4i16((__attribute__((address_space(3))) v4i16_t*)p)); }
__device__ __forceinline__ float rowmax(const f32x16&p0,const f32x16&p1){
  float a=max3f(p0[0],p0[1],p1[0]),b=max3f(p0[2],p0[3],p1[1]);a=max3f(a,p1[2],p1[3]);
  #pragma unroll
  for(int r=4;r<16;r+=4){a=max3f(a,p0[r],p0[r+1]);b=max3f(b,p0[r+2],p0[r+3]);a=max3f(a,p1[r],p1[r+1]);b=max3f(b,p1[r+2],p1[r+3]);}
  const float m=max2f(a,b);
  auto rr=__builtin_amdgcn_permlane32_swap(__float_as_uint(m),__float_as_uint(m),false,false);
  return max2f(__uint_as_float(rr[0]),__uint_as_float(rr[1]));
}
__device__ __forceinline__ void pv(f32x16*o,int vb,bf16x8 pa0,bf16x8 pa1,bf16x8 pa2,bf16x8 pa3){
  #pragma unroll
  for(int d0=0;d0<2;++d0){s16x4 lo[4],hi[4];
    #pragma unroll
    for(int ks=0;ks<4;++ks){
      asm volatile("ds_read_b64_tr_b16 %0,%1 offset:%c2":"=&v"(lo[ks]):"v"(vb),"i"(d0*4096+ks*1024):"memory");
      asm volatile("ds_read_b64_tr_b16 %0,%1 offset:%c2":"=&v"(hi[ks]):"v"(vb),"i"(d0*4096+ks*1024+512):"memory");}
    asm volatile("s_waitcnt lgkmcnt(0)":::"memory");SBAR();
    #define PK(k) (bf16x8){lo[k][0],lo[k][1],lo[k][2],lo[k][3],hi[k][0],hi[k][1],hi[k][2],hi[k][3]}
    o[d0]=__builtin_amdgcn_mfma_f32_32x32x16_bf16(pa0,PK(0),o[d0],0,0,0);
    o[d0]=__builtin_amdgcn_mfma_f32_32x32x16_bf16(pa1,PK(1),o[d0],0,0,0);
    o[d0]=__builtin_amdgcn_mfma_f32_32x32x16_bf16(pa2,PK(2),o[d0],0,0,0);
    o[d0]=__builtin_amdgcn_mfma_f32_32x32x16_bf16(pa3,PK(3),o[d0],0,0,0);
    #undef PK
  }
}

#ifndef ATTN_STORE16
#define ATTN_STORE16(p,v) (*(u32x4*)(p)=(v))
#endif
template<int THRL> __device__ __forceinline__ void attn_unit(int b,int h,int qb,const bf16*Q,const bf16*__restrict__ K,const bf16*__restrict__ V,bf16*O,char*shm,int tid_in){
  int tid=tid_in; asm volatile("":"+v"(tid)); const int lane=tid&63,r32=lane&31,hi=lane>>5; const int wid=__builtin_amdgcn_readfirstlane(tid>>6);
  const long rowbase=(long)b*SEQ; const int q0=qb*QB;
  const bf16*Qw=Q+(rowbase+q0+wid*QBLK)*QP+h*D;
  const bf16*Kh=K+rowbase*KP+(h>>1)*D,*Vh=V+rowbase*VP+(h>>1)*D;
  const unsigned lds0=(unsigned)(uintptr_t)shm;
  float*wsf=(float*)(shm+LDS_WS)+wid*64;
  const bf16*ksrc=Kh+(long)lane*KP+wid*8;
  const bf16*vsrc=Vh+(long)(16*(wid&3)+(lane>>2))*VP+(wid>>2)*32+(lane&3)*8;
  const unsigned kdst=lds0+LDS_K+wid*1024, vdst=lds0+LDS_V+wid*1024;
  #define DMA_K(t,slot) glds16(ksrc+(long)(t)*KVBLK*KP,(unsigned)__builtin_amdgcn_readfirstlane(kdst+(slot)))
  #define DMA_V(t,slot) glds16(vsrc+(long)(t)*KVBLK*VP,(unsigned)__builtin_amdgcn_readfirstlane(vdst+(slot)))
  const int vb0=(int)(lds0+LDS_V)+((lane>>4)&1)*32+(lane&3)*8+(4*hi+((lane&15)>>2))*64;
  const char*Kbase=shm+LDS_K; bf16x8 kf[8];
  const lds_cptr shm3=(lds_cptr)shm; const lds_cptr kp0=shm3+LDS_K+hi*1024+r32*16; const lds_cptr vp0=shm3+LDS_V+((lane>>4)&1)*32+(lane&3)*8+(4*hi+((lane&15)>>2))*64;
  const int NT=SEQ/KVBLK;
  DMA_K(0,0);DMA_V(0,0);DMA_K(1,SLOTB);
  bf16x8 qr[4];
  #pragma unroll
  for(int d0=0;d0<4;++d0)qr[d0]=*reinterpret_cast<const bf16x8*>(&Qw[(long)r32*QP+d0*16+hi*8]);
  float mhat=0.f,l_reg=0.f;f32x16 o[2];o[0]=f32x16{};o[1]=f32x16{};f32x16 negm=f32x16{};asm volatile("":"+v"(negm));
  #define CMASK(P0,P1,t) do{}while(0)
  bool resc=false;
  #define START(P0,P1) do{ const float rm=rowmax(P0,P1); resc=false; \
    { const float dl=rm; mhat=fadd_s(mhat,dl); \
      _Pragma("unroll") for(int r=0;r<16;++r){P0[r]=fsub_s(P0[r],dl);P1[r]=fsub_s(P1[r],dl);} \
      _Pragma("unroll") for(int r=0;r<16;++r)negm[r]=-mhat; asm volatile("":"+v"(negm)); } \
    _Pragma("unroll") for(int r=0;r<16;++r)P0[r]=__builtin_amdgcn_exp2f(P0[r]); }while(0)
  #define RESC() do{ if(resc){ asm volatile("s_waitcnt lgkmcnt(0)":::"memory"); \
      _Pragma("unroll") for(int d_=0;d_<2;++d_) _Pragma("unroll") for(int r=0;r<16;++r)o[d_][r]*=wsf[crow(r,hi)]; } }while(0)
  f32x16 pA0,pA1,pB0,pB1;
  int sl_prev=0,sl_cur=0,sl_next=SLOTB;
  #define ROT() do{sl_prev=sl_cur;sl_cur=sl_next;sl_next=(sl_next==(NSLOT-1)*SLOTB)?0:sl_next+SLOTB;}while(0)
  DMA_K(2,2*SLOTB);
  WAIT_BAR(3);
  qkt(pA0,pA1,Kbase,qr,negm,r32,hi);asm volatile("s_nop 15\n\ts_nop 7":"+v"(pA0),"+v"(pA1));CMASK(pA0,pA1,0);
  START(pA0,pA1);
  _Pragma("unroll") for(int r=0;r<16;++r)pA1[r]=__builtin_amdgcn_exp2f(pA1[r]);
  WAIT_BAR(0);
  DMA_K(3,0);DMA_V(1,SLOTB);
  ROT();
  kload8(kf,kp0+sl_cur);
  WAIT_BAR(2);
  s16x4 vlo[8],vhi[8]; u32x4 pw0,pw1,pw2,pw3;
  #define PKW(P,B) cvtpk_s(P[B],P[B+1])
  #define PAF(k) __builtin_bit_cast(bf16x8,pw##k)
  #define VFR(i) (bf16x8){vlo[i][0],vlo[i][1],vlo[i][2],vlo[i][3],vhi[i][0],vhi[i][1],vhi[i][2],vhi[i][3]}
  #define PIN(x) asm volatile("":"+v"(x))
  #define MX3(a,b,c) __builtin_fmaxf(__builtin_fmaxf((a),(b)),(c))
  #define GAPA(MF,A0,A1,A2,A3,W0,W1,PW) do{ MF; sacc+=A0; sacc+=A1; sacc+=A2; sacc+=A3; PIN(sacc); W0; W1; PIN(PW); SBAR(); }while(0)
  #define EX(v) __builtin_amdgcn_exp2f(v)
  #define GAPB(MF,X,B) do{ MF; X[B]=EX(X[B]); X[B+1]=EX(X[B+1]); X[B+2]=EX(X[B+2]); X[B+3]=EX(X[B+3]); PIN(X); SBAR(); }while(0)
  #define VRD(i) do{ vlo[i]=vtr(vp_+(((i)>>2)*4096+((i)&3)*1024)); vhi[i]=vtr(vp_+(((i)>>2)*4096+((i)&3)*1024+512)); }while(0)
  #define KRD(G,j) do{ if(G){ kload2(kf,kp0+sl_next,j); SBAR(); } }while(0)
  #define STEP(C0,C1,P0,P1,t,GK,GV,GL) do{ SBAR(); \
    const lds_cptr vp_=vp0+sl_prev; \
    VRD(0); SBAR(); float sacc=(P0[0]+P0[1]); \
    GAPA(C0=__builtin_amdgcn_mfma_f32_32x32x16_bf16(kf[0],qr[0],negm,0,0,0), P0[2],P0[3],P0[4],P0[5],     pw0[0]=PKW(P0,0), pw0[1]=PKW(P0,2), pw0); \
    VRD(4); SBAR(); GAPA(C1=__builtin_amdgcn_mfma_f32_32x32x16_bf16(kf[1],qr[0],negm,0,0,0), P0[6],P0[7],P0[8],P0[9],     pw0[2]=PKW(P0,4), pw0[3]=PKW(P0,6), pw0); \
    VRD(1); SBAR(); GAPA(C0=__builtin_amdgcn_mfma_f32_32x32x16_bf16(kf[2],qr[1],C0,0,0,0),   P0[10],P0[11],P0[12],P0[13], pw1[0]=PKW(P0,8), pw1[1]=PKW(P0,10), pw1); \
    VRD(5); SBAR(); GAPA(C1=__builtin_amdgcn_mfma_f32_32x32x16_bf16(kf[3],qr[1],C1,0,0,0),   P0[14],P0[15],P1[0],P1[1],   pw1[2]=PKW(P0,12),pw1[3]=PKW(P0,14), pw1); \
    VRD(2); SBAR(); GAPA(C0=__builtin_amdgcn_mfma_f32_32x32x16_bf16(kf[4],qr[2],C0,0,0,0),   P1[2],P1[3],P1[4],P1[5],     pw2[0]=PKW(P1,0), pw2[1]=PKW(P1,2), pw2); \
    VRD(6); SBAR(); GAPA(C1=__builtin_amdgcn_mfma_f32_32x32x16_bf16(kf[5],qr[2],C1,0,0,0),   P1[6],P1[7],P1[8],P1[9],     pw2[2]=PKW(P1,4), pw2[3]=PKW(P1,6), pw2); \
    VRD(3); SBAR(); GAPA(C0=__builtin_amdgcn_mfma_f32_32x32x16_bf16(kf[6],qr[3],C0,0,0,0),   P1[10],P1[11],P1[12],P1[13], pw3[0]=PKW(P1,8), pw3[1]=PKW(P1,10), pw3); \
    VRD(7); SBAR(); GAPA(C1=__builtin_amdgcn_mfma_f32_32x32x16_bf16(kf[7],qr[3],C1,0,0,0),   P1[14],P1[15],0.f,0.f,       pw3[2]=PKW(P1,12),pw3[3]=PKW(P1,14), pw3); \
    l_reg+=sacc; \
    if(GK){DMA_K((t)+3,sl_cur);} if(GV){DMA_V((t)+1,sl_next);} \
    CMASK(C0,C1,t); \
    { float a=MX3(C0[0],C0[1],C1[0]),b=MX3(C0[2],C0[3],C1[1]); a=MX3(a,C1[2],C1[3]); \
      _Pragma("unroll") for(int r=4;r<16;r+=4){a=MX3(a,C0[r],C0[r+1]);b=MX3(b,C0[r+2],C0[r+3]);a=MX3(a,C1[r],C1[r+1]);b=MX3(b,C1[r+2],C1[r+3]);} \
      float rm=__builtin_fmaxf(a,b); { auto rr=__builtin_amdgcn_permlane32_swap(__float_as_uint(rm),__float_as_uint(rm),false,false); rm=__builtin_fmaxf(__uint_as_float(rr[0]),__uint_as_float(rr[1])); } \
      resc=false; \
      if(__builtin_expect(__any(rm>(float)THRL),0)){ const float dl=__builtin_fmaxf(rm,0.f); mhat+=dl; \
        _Pragma("unroll") for(int r=0;r<16;++r){C0[r]-=dl;C1[r]-=dl;} \
        _Pragma("unroll") for(int r=0;r<16;++r)negm[r]=-mhat; asm volatile("":"+v"(negm)); \
        const float f=__builtin_amdgcn_exp2f(-dl); l_reg*=f; if(hi==0)wsf[r32]=f; resc=true; } } \
    SBAR(); \
    GAPB(o[0]=__builtin_amdgcn_mfma_f32_32x32x16_bf16(PAF(0),VFR(0),o[0],0,0,0), C0,0); \
    GAPB(o[1]=__builtin_amdgcn_mfma_f32_32x32x16_bf16(PAF(0),VFR(4),o[1],0,0,0), C0,4); \
    KRD(GL,0); GAPB(o[0]=__builtin_amdgcn_mfma_f32_32x32x16_bf16(PAF(1),VFR(1),o[0],0,0,0), C0,8); \
    KRD(GL,1); GAPB(o[1]=__builtin_amdgcn_mfma_f32_32x32x16_bf16(PAF(1),VFR(5),o[1],0,0,0), C0,12); \
    KRD(GL,2); GAPB(o[0]=__builtin_amdgcn_mfma_f32_32x32x16_bf16(PAF(2),VFR(2),o[0],0,0,0), C1,0); \
    KRD(GL,3); GAPB(o[1]=__builtin_amdgcn_mfma_f32_32x32x16_bf16(PAF(2),VFR(6),o[1],0,0,0), C1,4); \
    GAPB(o[0]=__builtin_amdgcn_mfma_f32_32x32x16_bf16(PAF(3),VFR(3),o[0],0,0,0), C1,8); \
    GAPB(o[1]=__builtin_amdgcn_mfma_f32_32x32x16_bf16(PAF(3),VFR(7),o[1],0,0,0), C1,12); \
    }while(0)
  int t=1;
  #undef CMASK
  #define CMASK(P0,P1,t) do{}while(0)
  for(;t+5<NT;t+=2){
    STEP(pB0,pB1,pA0,pA1,t,true,true,true);     WAIT_BAR(2); RESC(); ROT();
    STEP(pA0,pA1,pB0,pB1,t+1,true,true,true);   WAIT_BAR(2); RESC(); ROT();
  }
  #undef CMASK
  #define CMASK(P0,P1,t) do{}while(0)
  #define ENDW(tt) do{ if((tt)+3<NT){WAIT_BAR(2);} else if((tt)+2<NT){WAIT_BAR(1);} else {WAIT_BAR(0);} }while(0)
  for(;t+1<NT;t+=2){
    STEP(pB0,pB1,pA0,pA1,t,(t+3<NT),(t+1<NT),(t+1<NT));       ENDW(t);   RESC(); ROT();
    STEP(pA0,pA1,pB0,pB1,t+1,(t+4<NT),(t+2<NT),(t+2<NT));     ENDW(t+1); RESC(); ROT();
  }
  STEP(pB0,pB1,pA0,pA1,NT-1,false,false,false); RESC();
  { float sacc=pB0[0]+pB0[1]; _Pragma("unroll") for(int r=2;r<16;++r)sacc+=pB0[r]; _Pragma("unroll") for(int r=0;r<16;++r)sacc+=pB1[r]; l_reg+=sacc;
    pw0=(u32x4){PKW(pB0,0),PKW(pB0,2),PKW(pB0,4),PKW(pB0,6)};pw1=(u32x4){PKW(pB0,8),PKW(pB0,10),PKW(pB0,12),PKW(pB0,14)};pw2=(u32x4){PKW(pB1,0),PKW(pB1,2),PKW(pB1,4),PKW(pB1,6)};pw3=(u32x4){PKW(pB1,8),PKW(pB1,10),PKW(pB1,12),PKW(pB1,14)};
    SBAR(); pv(o,vb0+sl_cur,PAF(0),PAF(1),PAF(2),PAF(3)); }
  #undef PKW
  #undef PAF
  #undef VFR
  #undef PIN
  #undef MX3
  #undef GAPA
  #undef GAPB
  #undef EX
  #undef VRD
  #undef KRD
  #undef STEP
  #undef ENDW
  {auto rr=__builtin_amdgcn_permlane32_swap(__float_as_uint(l_reg),__float_as_uint(l_reg),false,false);l_reg=__uint_as_float(rr[0])+__uint_as_float(rr[1]);}
  if(hi==0)wsf[32+r32]=l_reg;asm volatile("s_waitcnt lgkmcnt(0)":::"memory");
  float rli[16];
  #pragma unroll
  for(int r=0;r<16;++r)rli[r]=__builtin_amdgcn_rcpf(wsf[32+crow(r,hi)]);
  bf16*Ow=O+(rowbase+q0+wid*QBLK)*OP+h*D;
  { bf16*stg=(bf16*)(shm+LDS_OST)+wid*2048;
    #pragma unroll
    for(int r=0;r<16;++r){const int orow=crow(r,hi);
      #pragma unroll
      for(int d0=0;d0<2;++d0)stg[orow*64+d0*32+r32]=__float2bfloat16(o[d0][r]*rli[r]);}
    asm volatile("s_waitcnt lgkmcnt(0)":::"memory");
    #pragma unroll
    for(int i=0;i<4;++i){const int row=i*8+(lane>>3),ch=lane&7; const u32x4 v=*(const u32x4*)(stg+row*64+ch*8); ATTN_STORE16(Ow+(long)row*OP+ch*8,v);} }
  asm volatile("s_waitcnt lgkmcnt(0)\n\ts_barrier":::"memory");
  #undef DMA_K
  #undef DMA_V
  #undef CMASK
  #undef START
  #undef RESC
  #undef ROT
}
constexpr int ATTN_LDS_BYTES=LDS_BYTES;
#undef SBAR
#undef WAIT_BAR
}

constexpr int FBUF = 8720;
__device__ __forceinline__ int fpad(int i) { return i + (i >> 5) + 18 * (i >> 9); }
constexpr float kTwC[16] = {1.000000000e+00f, 9.807852804e-01f, 9.238795325e-01f, 8.314696123e-01f, 7.071067812e-01f, 5.555702330e-01f, 3.826834324e-01f, 1.950903220e-01f,
                            0.0f, -1.950903220e-01f, -3.826834324e-01f, -5.555702330e-01f, -7.071067812e-01f, -8.314696123e-01f, -9.238795325e-01f, -9.807852804e-01f};
constexpr float kTwS[16] = {0.000000000e+00f, 1.950903220e-01f, 3.826834324e-01f, 5.555702330e-01f, 7.071067812e-01f, 8.314696123e-01f, 9.238795325e-01f, 9.807852804e-01f,
                            1.000000000e+00f, 9.807852804e-01f, 9.238795325e-01f, 8.314696123e-01f, 7.071067812e-01f, 5.555702330e-01f, 3.826834324e-01f, 1.950903220e-01f};
template <int N> __device__ __forceinline__ void dft_dif(f32x2 (&v)[N]) {
#pragma unroll
    for (int len = N; len >= 2; len >>= 1) {
        const int half = len / 2;
#pragma unroll
        for (int base = 0; base < N; base += len)
#pragma unroll
            for (int j = 0; j < half; ++j) {
                const f32x2 a = v[base + j], b = v[base + j + half];
                v[base + j] = a + b;
                const f32x2 d = a - b;
                const int ti = j * (32 / len);
                v[base + j + half] = (ti == 0) ? d : (f32x2){d.x * kTwC[ti] + d.y * kTwS[ti], d.y * kTwC[ti] - d.x * kTwS[ti]};
            }
    }
}
__host__ __device__ constexpr int brev(int i, int bits) { int r = 0; for (int b = 0; b < bits; ++b) r |= ((i >> b) & 1) << (bits - 1 - b); return r; }

#define FFT_BAR() asm volatile("s_waitcnt lgkmcnt(0)\n\ts_barrier" ::: "memory")
__device__ __forceinline__ void fft8192(LAS f32x2* buf, int tid_in) {
    int tid = tid_in; asm volatile("" : "+v"(tid));
    {
        const int n2 = tid; f32x2 v[16];
        LAS f32x2* p = buf + n2 + (n2 >> 5);
#pragma unroll
        for (int n1 = 0; n1 < 16; ++n1) v[n1] = p[546 * n1];
        dft_dif<16>(v);
        const float rv1 = (float)n2 * (1.f / 8192.f); const float c = __builtin_amdgcn_cosf(rv1), s = -__builtin_amdgcn_sinf(rv1);
        f32x2 pw[16]; pw[0] = (f32x2){1.f, 0.f}; pw[1] = (f32x2){c, s};
#pragma unroll
        for (int k = 2; k < 16; ++k) pw[k] = cmul(pw[k - 1], pw[1]);
#pragma unroll
        for (int i = 0; i < 16; ++i) { const int k1 = brev(i, 4); p[546 * k1] = cmul(v[i], pw[k1]); }
    }
    FFT_BAR();
    {
        const int k1 = tid >> 5, b = tid & 31; f32x2 v[16];
        LAS f32x2* p = buf + 546 * k1 + b;
#pragma unroll
        for (int a = 0; a < 16; ++a) v[a] = p[33 * a];
        dft_dif<16>(v);
        const float rv2 = (float)b * (1.f / 512.f); const float c = __builtin_amdgcn_cosf(rv2), s = -__builtin_amdgcn_sinf(rv2);
        f32x2 pw[16]; pw[0] = (f32x2){1.f, 0.f}; pw[1] = (f32x2){c, s};
#pragma unroll
        for (int k = 2; k < 16; ++k) pw[k] = cmul(pw[k - 1], pw[1]);
#pragma unroll
        for (int i = 0; i < 16; ++i) { const int ka = brev(i, 4); p[33 * ka] = cmul(v[i], pw[ka]); }
    }
    FFT_BAR();
    {
        const int ka = (tid >> 4) & 15, k1 = tid & 15; f32x2 v[32];
        if (tid < 256) {
            const LAS f32x2* p = buf + 546 * k1 + 33 * ka;
#pragma unroll
            for (int b = 0; b < 32; ++b) v[b] = p[b];
            dft_dif<32>(v);
        }
        FFT_BAR();
        if (tid < 256) {
            LAS f32x2* q = buf + k1 + 16 * ka + (ka >> 1);
#pragma unroll
            for (int i = 0; i < 32; ++i) { const int kb = brev(i, 5); q[264 * kb + 18 * (kb >> 1)] = v[i]; }
        }
    }
    FFT_BAR();
}

__device__ __forceinline__ float hy_sconv(const bf16* xrow, unsigned t, float w0, float w1, float w2, float bias) {
    const unsigned tm = t > 0u ? t - 1u : 0u, tp = t < (unsigned)(SEQ - 1) ? t + 1u : (unsigned)(SEQ - 1);
    const float xm = t > 0u ? bf2f(xrow[tm]) : 0.f, x0 = bf2f(xrow[t]), xp = t < (unsigned)(SEQ - 1) ? bf2f(xrow[tp]) : 0.f;
    return xm * w0 + x0 * w1 + xp * w2 + bias;
}

__device__ __forceinline__ void hy_sconv_row(Frame& F, const Args& args, int l, int row  ) {
    const int lane = F.lane, ch = row >> 3;
    bf16* x = WSP(bf16, WS_RB + RB_HYT) + (size_t)ch * M + (size_t)(row & 7) * SEQ;
    const float* cw = FIN(I_HY_CW) + (size_t)l * 3 * 768; const float w0 = cw[ch], w1 = cw[768 + ch], w2 = cw[1536 + ch], bias = FIN(I_HY_CB)[(size_t)l * 768 + ch];
    v4u raw[8];
#pragma unroll
    for (int k = 0; k < 8; ++k) raw[k] = *(const v4u*)(x + 8 * lane + 512 * k);
    float first[8], lastv[8];
#pragma unroll
    for (int k = 0; k < 8; ++k) { first[k] = bflo(raw[k].x); lastv[k] = bfhi(raw[k].w); }
#pragma unroll
    for (int k = 0; k < 8; ++k) {
        float v[10];
        v[1] = bflo(raw[k].x); v[2] = bfhi(raw[k].x); v[3] = bflo(raw[k].y); v[4] = bfhi(raw[k].y); v[5] = bflo(raw[k].z); v[6] = bfhi(raw[k].z); v[7] = bflo(raw[k].w); v[8] = bfhi(raw[k].w);
        const float lft = __shfl_up(lastv[k], 1), lft0 = k > 0 ? __shfl(lastv[k > 0 ? k - 1 : 0], 63) : 0.f;
        const float rgt = __shfl_down(first[k], 1), rgt63 = k < 7 ? __shfl(first[k < 7 ? k + 1 : 7], 0) : 0.f;
        v[0] = lane == 0 ? lft0 : lft; v[9] = lane == 63 ? rgt63 : rgt;
        float o[8];
#pragma unroll
        for (int e = 0; e < 8; ++e) o[e] = v[e] * w0 + v[e + 1] * w1 + v[e + 2] * w2 + bias;
        v4u w; w.x = pk2(o[0], o[1]); w.y = pk2(o[2], o[3]); w.z = pk2(o[4], o[5]); w.w = pk2(o[6], o[7]);
        *(v4u*)(x + 8 * lane + 512 * k) = w;
    }
}
__device__ __forceinline__ void hy_taps_block(Frame& F, const Args& args, int l, int tb) {
    LAS float* F2 = (LAS float*)F.lds;
    const int tid = F.tid, t0 = tb * 16;
    const float* f2 = WSP(float, WS_HF2) + ((size_t)l * 4096 + t0) * 64;
    __syncthreads();
    for (int i = tid; i < 16 * 64; i += 512) F2[i] = f2[i];
    __syncthreads();
    const float* w3 = FIN(I_HY_W3) + (size_t)l * 64 * 1024;
    float acc0[16], acc1[16];
#pragma unroll
    for (int j = 0; j < 16; ++j) { acc0[j] = 0.f; acc1[j] = 0.f; }
#pragma unroll 4
    for (int i = 0; i < 64; ++i) { const float wa = w3[i * 1024 + tid], wb = w3[i * 1024 + 512 + tid];
#pragma unroll
        for (int j = 0; j < 16; ++j) { const float x = F2[j * 64 + i]; acc0[j] += x * wa; acc1[j] += x * wb; } }
    const int c = tid & 255;
    const float delta = fabsf(-3.0701134573253945f + (float)c * ((-15.350567286626973f + 3.0701134573253945f) / 255.f));
    float* tt = WSP(float, WS_TT);
#pragma unroll
    for (int j = 0; j < 16; j += 4) { f32x4 o0, o1;
#pragma unroll
        for (int q = 0; q < 4; ++q) { const float dec = expf(-(float)(t0 + j + q) * (1.f / 4095.f) * delta); o0[q] = acc0[j + q] * dec; o1[q] = acc1[j + q] * dec; }
        *(f32x4*)(tt + (size_t)tid * SEQ + t0 + j) = o0; *(f32x4*)(tt + (size_t)(512 + tid) * SEQ + t0 + j) = o1; }
}

__device__ __forceinline__ void hyena_item(Frame& F, const Args& args, int l, int c) {
    LAS f32x2* A = (LAS f32x2*)F.lds;
    LAS f32x2* B = A + FBUF;
    LAS float* W3L = (LAS float*)(B + FBUF);
    LAS float* red = W3L + 256;
    const bf16* hyT = WSP(bf16, WS_RB + RB_HYT);
    float* HV = WSP(float, WS_RD + RD_HV) + (size_t)c * 8 * SEQ;
    bf16* yaT = WSP(bf16, WS_RD + RD_YAT) + (size_t)c * M;
    const float* f2 = WSP(float, WS_HF2) + (size_t)l * 4096 * 64;
    __syncthreads();
    __syncthreads();
#pragma unroll 1
    for (int n = 0; n < 2; ++n) {
        int tid = F.tid; asm volatile("" : "+v"(tid));
        float ss = 0.f;
        {   const float* tf = WSP(float, WS_TT) + ((size_t)(0 * 2 + n) * 256 + c) * SEQ; const float* tbk = WSP(float, WS_TT) + ((size_t)(1 * 2 + n) * 256 + c) * SEQ;
#pragma unroll
            for (int j = 0; j < 8; ++j) { const int t = tid + 512 * j; const float fw = tf[t], bw = tbk[t];
                A[tid + (tid >> 5) + 546 * j] = (f32x2){fw, 0.f}; ss += fw * fw;
                if (t >= 1) { A[fpad(8192 - t)] = (f32x2){bw, 0.f}; ss += bw * bw; } } }
        if (tid == 0) A[fpad(4096)] = (f32x2){0.f, 0.f};
        ss = block_sum(F, ss, red);
        const float scale = (1.f / sqrtf(ss)) * (1.f / 8192.f);
        const float biasN = FIN(I_HY_BIAS)[((size_t)l * 2 + n) * 256 + c] * (1.f / 8192.f);
        fft8192(A, tid);
#pragma unroll
        for (int j = 0; j < 16; ++j) { LAS f32x2* p = A + tid + (tid >> 5) + 546 * j; f32x2 a = *p * scale; a.x += biasN; *p = a; }
#pragma unroll 1
        for (int pb = 0; pb < 4; ++pb) {
            int tq = tid; asm volatile("" : "+v"(tq));
            const bf16* zr0 = hyT + (size_t)c * M + (size_t)(2 * pb) * SEQ; const bf16* zr1 = zr0 + SEQ;
            const bf16* gr0 = hyT + (size_t)((n + 1) * 256 + c) * M + (size_t)(2 * pb) * SEQ; const bf16* gr1 = gr0 + SEQ;
            float* hv0 = HV + (size_t)(2 * pb) * SEQ; float* hv1 = hv0 + SEQ;
            __syncthreads();
#pragma unroll
            for (int j = 0; j < 8; ++j) { const unsigned t = (unsigned)tq + 512u * j; float z0, z1;
                if (n == 0) { z0 = bf2f(zr0[t]); z1 = bf2f(zr1[t]); }
                else { z0 = hv0[t]; z1 = hv1[t]; }
                B[tq + (tq >> 5) + 546 * j] = (f32x2){z0, z1}; B[tq + (tq >> 5) + 546 * (j + 8)] = (f32x2){0.f, 0.f}; }
            float g0[8], g1[8];
#pragma unroll
            for (int j = 0; j < 8; ++j) { const unsigned t = (unsigned)tq + 512u * j; g0[j] = bf2f(gr0[t]); g1[j] = bf2f(gr1[t]); }
            FFT_BAR();
            fft8192(B, tq);
#pragma unroll
            for (int j = 0; j < 16; ++j) { const int p = tq + (tq >> 5) + 546 * j; const f32x2 y = cmul(B[p], A[p]); B[p] = (f32x2){y.x, -y.y}; }
            FFT_BAR();
            fft8192(B, tq);
#pragma unroll
            for (int j = 0; j < 8; ++j) { const unsigned t = (unsigned)tq + 512u * j; const f32x2 y = B[tq + (tq >> 5) + 546 * j];
                const float o0 = g0[j] * y.x, o1 = g1[j] * -y.y;
                if (n == 0) { hv0[t] = o0; hv1[t] = o1; }
                else { yaT[(size_t)(2 * pb) * SEQ + t] = (bf16)f2bf(o0); yaT[(size_t)(2 * pb + 1) * SEQ + t] = (bf16)f2bf(o1); } }
        }
        __syncthreads();
    }
}

__device__ __forceinline__ f32x16 mfma32(bf16x8 a, bf16x8 b, f32x16 c) { return __builtin_amdgcn_mfma_f32_32x32x16_bf16(a, b, c, 0, 0, 0); }
__device__ __forceinline__ int crow(int r, int hi) { return (r & 3) + 8 * (r >> 2) + 4 * hi; }
__device__ __forceinline__ float gelu_tanh(float x) {
    const float u = 0.7978845608028654f * (x + 0.044715f * x * x * x);
    const float e = __builtin_amdgcn_exp2f(2.885390081777927f * u);
    const float th = 1.f - 2.f * __builtin_amdgcn_rcpf(e + 1.f);
    return 0.5f * x * (1.f + th);
}
__device__ __forceinline__ void s5_item(Frame& F, const Args& args, int l, int b, int g) {
    constexpr int SP = 129, XP = 136;
    LAS float* S = (LAS float*)F.lds;
    LAS bf16* XB = (LAS bf16*)(F.lds + 128 * SP * 4);
    const int tid = F.tid, lane = F.lane, w = F.wave, r32 = lane & 31, hi = lane >> 5;
    const bf16* U = WSP(bf16, WS_RB + RB_PROJ2) + (size_t)b * SEQ * PROJ2_W + PC_S5 + g * 16;
    const bf16* wst = WSP(bf16, WS_S5W + (size_t)l * S5W_LAYER + S5_WST_OFF) + (size_t)g * 2 * 128 * 512;
    const bf16* wcat = WSP(bf16, WS_S5W + (size_t)l * S5W_LAYER + S5_WCAT_OFF) + (size_t)g * 512 * 768;
    bf16* Z = WSP(bf16, WS_RD + RD_S5Z) + (size_t)b * SEQ * 256 + g * 16;
    __syncthreads();
    for (int dir = 0; dir < 2; ++dir) {
        {
            const int rt = w >> 1, ct0 = 2 * (w & 1);
            f32x16 acc[2]; acc[0] = f32x16{}; acc[1] = f32x16{};
            const bf16* ap = wst + ((size_t)dir * 128 + rt * 32 + r32) * 512 + 8 * hi;
            const bf16* bp0 = U + (size_t)(32 * (ct0 * 32 + r32)) * PROJ2_W + 8 * hi;
            const bf16* bp1 = bp0 + (size_t)(32 * 32) * PROJ2_W;
#pragma unroll 4
            for (int ks = 0; ks < 32; ++ks) {
                const bf16x8 a = *(const bf16x8*)(ap + 16 * ks);
                const bf16x8 b0 = *(const bf16x8*)(bp0 + (size_t)ks * PROJ2_W), b1 = *(const bf16x8*)(bp1 + (size_t)ks * PROJ2_W);
                acc[0] = mfma32(a, b0, acc[0]); acc[1] = mfma32(a, b1, acc[1]);
            }
#pragma unroll
            for (int q = 0; q < 2; ++q)
#pragma unroll
                for (int r = 0; r < 16; ++r) S[((ct0 + q) * 32 + r32) * SP + rt * 32 + crow(r, hi)] = acc[q][r];
        }
        __syncthreads();
        if (tid < 64) {
            const f32x2 a32 = WSP(f32x2, WS_S5A32)[((size_t)(l * 2 + dir) * 16 + g) * 64 + tid];
            f32x2 X = (f32x2){0.f, 0.f};
#pragma unroll 8
            for (int cc = 0; cc < 128; ++cc) { const int c = dir == 0 ? cc : 127 - cc;
                const f32x2 s = (f32x2){S[c * SP + 2 * tid], S[c * SP + 2 * tid + 1]};
                X = cmul(a32, X) + s;
                *(LAS unsigned*)(XB + ((size_t)dir * 128 + c) * XP + 2 * tid) = pk2(X.x, X.y); }
        }
        __syncthreads();
    }
    {
        f32x16 acc[2][4];
#pragma unroll
        for (int i = 0; i < 2; ++i)
#pragma unroll
            for (int j = 0; j < 4; ++j) acc[i][j] = f32x16{};
        const bf16* ap = wcat + (size_t)(2 * w * 32 + r32) * 768 + 8 * hi;
        const bf16* bp = U + (size_t)(32 * r32) * PROJ2_W + 8 * hi;
#pragma unroll 2
        for (int ks = 0; ks < 32; ++ks) {
            const bf16x8 a0 = *(const bf16x8*)(ap + 16 * ks), a1 = *(const bf16x8*)(ap + 32 * 768 + 16 * ks);
#pragma unroll
            for (int ct = 0; ct < 4; ++ct) { const bf16x8 bv = *(const bf16x8*)(bp + (size_t)(32 * 32 * ct + ks) * PROJ2_W);
                acc[0][ct] = mfma32(a0, bv, acc[0][ct]); acc[1][ct] = mfma32(a1, bv, acc[1][ct]); }
        }
#pragma unroll 2
        for (int ks = 0; ks < 16; ++ks) {
            const int dir = ks >> 3, kk = ks & 7;
            const bf16x8 a0 = *(const bf16x8*)(ap + 512 + 16 * ks), a1 = *(const bf16x8*)(ap + 32 * 768 + 512 + 16 * ks);
#pragma unroll
            for (int ct = 0; ct < 4; ++ct) { const int c = ct * 32 + r32, cs = dir == 0 ? c - 1 : c + 1;
                bf16x8 bv = (bf16x8){0, 0, 0, 0, 0, 0, 0, 0};
                if (cs >= 0 && cs < 128) bv = *(const LAS bf16x8*)(XB + ((size_t)dir * 128 + cs) * XP + 16 * kk + 8 * hi);
                acc[0][ct] = mfma32(a0, bv, acc[0][ct]); acc[1][ct] = mfma32(a1, bv, acc[1][ct]); }
        }
#pragma unroll
        for (int i = 0; i < 2; ++i)
#pragma unroll
            for (int ct = 0; ct < 4; ++ct)
#pragma unroll
                for (int q = 0; q < 4; ++q) {
                    const int tl = (2 * w + i) * 2 + (q >> 1), co = 8 * (q & 1) + 4 * hi, c = ct * 32 + r32;
                    v2u o; o.x = pk2(gelu_tanh(acc[i][ct][4 * q]), gelu_tanh(acc[i][ct][4 * q + 1])); o.y = pk2(gelu_tanh(acc[i][ct][4 * q + 2]), gelu_tanh(acc[i][ct][4 * q + 3]));
                    *(v2u*)(Z + (size_t)(32 * c + tl) * 256 + co) = o; }
    }
    __syncthreads();
}

__device__ __forceinline__ void dil_item(Frame& F, const Args& args, int it) {
    constexpr int RS = 144;
    LAS unsigned char* Ks = F.lds; LAS unsigned char* Vs = F.lds + 384 * RS;
    int lane = F.lane; asm volatile("" : "+v"(lane));
    const int r32 = lane & 31, hi = lane >> 5, w = F.wave;
    const int u0 = it * 8, g = u0 >> 12, b = (u0 >> 9) & 7, hh = (u0 >> 7) & 3, tile0 = u0 & 127;
    const int dsh = 2 * g, Lp = SEQ >> dsh, tpr = Lp >> 5, rho = tile0 / tpr, q0 = (tile0 % tpr) * 32, h = g * 4 + hh;
    const float slope2 = exp2f(-8.f * (float)(h + 1) * (1.f / 12.f)) * (float)(1 << dsh) * 1.4426950408889634f;
    const char* P2 = (const char*)(WSP(bf16, WS_RB + RB_PROJ2) + (size_t)b * SEQ * PROJ2_W);
#define DIL_ROWB(tp) ((unsigned)(rho + ((tp) << dsh)) * (unsigned)(PROJ2_W * 2))
    __syncthreads();
    {   int tq = F.tid; asm volatile("" : "+v"(tq));
#pragma unroll
        for (int k = 0; k < 6; ++k) { const int id = tq + 512 * k, row = id >> 3, ch = id & 7;
            int tj = q0 - 64 + row; tj = tj < 0 ? 0 : (tj > Lp - 1 ? Lp - 1 : tj);
            const unsigned ro = DIL_ROWB(tj) + (unsigned)(h * 64 + ch * 8) * 2u;
            const v4u kv = *(const v4u*)(P2 + ro + PC_DK * 2), vv = *(const v4u*)(P2 + ro + PC_DV * 2);
            *(LAS v4u*)(Ks + row * RS + ch * 16) = kv; *(LAS v4u*)(Vs + row * RS + ch * 16) = vv; } }
    const int tau0 = q0 + 32 * w;
    bf16x8 qf[4];
    { const unsigned qo = DIL_ROWB(tau0 + r32) + (unsigned)(PC_DQ + h * 64 + 8 * hi) * 2u;
#pragma unroll
      for (int ks = 0; ks < 4; ++ks) qf[ks] = *(const bf16x8*)(P2 + qo + 32 * ks); }
    __syncthreads();
    f32x16 S[5];
#pragma unroll
    for (int kt = 0; kt < 5; ++kt) {
        const LAS unsigned char* kp = Ks + (32 * w + 32 * kt + r32) * RS + 16 * hi;
        f32x16 a = f32x16{};
#pragma unroll
        for (int ks = 0; ks < 4; ++ks) a = mfma32(*(const LAS bf16x8*)(kp + 32 * ks), qf[ks], a);
        S[kt] = a;
    }
    float mx = -1e30f;
    const float cr32 = (float)r32;
    if (tau0 >= 64 && tau0 + 96 <= Lp) {
#pragma unroll
        for (int kt = 0; kt < 5; ++kt)
#pragma unroll
            for (int r = 0; r < 16; ++r) { const float dlf = (float)(-64 + 32 * kt + crow(r, 0)) + (float)(4 * hi) - cr32;
                float sc = S[kt][r] * (0.125f * 1.4426950408889634f) - slope2 * fabsf(dlf);
                if (kt == 0) sc = dlf >= -64.f ? sc : -1e30f;
                if (kt == 4) sc = dlf <= 64.f ? sc : -1e30f;
                S[kt][r] = sc; mx = fmaxf(mx, sc); }
    } else {
#pragma unroll
        for (int kt = 0; kt < 5; ++kt)
#pragma unroll
            for (int r = 0; r < 16; ++r) { const int dl = -64 + 32 * kt + crow(r, hi) - r32, tj = tau0 + r32 + dl;
                const bool ok = dl >= -64 && dl <= 64 && tj >= 0 && tj < Lp;
                const float sc = S[kt][r] * (0.125f * 1.4426950408889634f) - slope2 * (float)(dl < 0 ? -dl : dl);
                S[kt][r] = ok ? sc : -1e30f; mx = fmaxf(mx, S[kt][r]); }
    }
    mx = fmaxf(mx, __shfl_xor(mx, 32));
    float lsum = 0.f;
#pragma unroll
    for (int kt = 0; kt < 5; ++kt)
#pragma unroll
        for (int r = 0; r < 16; ++r) { const float p = __builtin_amdgcn_exp2f(S[kt][r] - mx); S[kt][r] = p; lsum += p; }
    lsum += __shfl_xor(lsum, 32);
    f32x16 O[2]; O[0] = f32x16{}; O[1] = f32x16{};
    const LAS unsigned short* vb = (const LAS unsigned short*)(Vs + (32 * w + 4 * hi) * RS) + r32;
#pragma unroll
    for (int kt = 0; kt < 5; ++kt)
#pragma unroll
        for (int s = 0; s < 2; ++s) {
            bf16x8 pa; bf16x8 v0, v1;
#pragma unroll
            for (int j = 0; j < 8; j += 2) { const unsigned pw = pk2(S[kt][8 * s + j], S[kt][8 * s + j + 1]); pa[j] = (short)(pw & 0xffff); pa[j + 1] = (short)(pw >> 16); }
#pragma unroll
            for (int j = 0; j < 8; ++j) { const LAS unsigned short* vp = vb + (32 * kt + 16 * s + 8 * (j >> 2) + (j & 3)) * (RS / 2); v0[j] = (short)vp[0]; v1[j] = (short)vp[32]; }
            O[0] = mfma32(pa, v0, O[0]); O[1] = mfma32(pa, v1, O[1]);
        }
    const float linv = 1.f / lsum;
    bf16* Og = WSP(bf16, WS_RD + RD_DILO) + (size_t)g * M * 256 + (size_t)b * SEQ * 256 + hh * 64 + r32;
#pragma unroll
    for (int r = 0; r < 16; ++r) { const int i = crow(r, hi); const float li = __shfl(linv, i);
        const unsigned ro = (unsigned)(rho + ((tau0 + i) << dsh)) * 256u;
        Og[ro] = (bf16)f2bf(O[0][r] * li); Og[ro + 32] = (bf16)f2bf(O[1][r] * li); }
    if (hi == 0) WSP(float, WS_DLSE)[((size_t)g * M + (size_t)b * SEQ + rho + ((tau0 + r32) << dsh)) * 4 + hh] = (mx + log2f(lsum)) * 0.6931471805599453f;
#undef DIL_ROWB
}

__device__ __forceinline__ void gqa_prep_rows(Frame& F, const Args& args, int l, int m0) {
    const int lane = F.lane, grp = lane >> 4, li = lane & 15;
    const bf16* P2 = WSP(bf16, WS_RB + RB_PROJ2); bf16* QK = WSP(bf16, WS_RD + RD_QKVG);
    const f32x4 qn = *(const f32x4*)(FIN(I_GQ_QN) + l * 64 + 4 * li), kn = *(const f32x4*)(FIN(I_GQ_KN) + l * 64 + 4 * li);
#pragma unroll
    for (int p = 0; p < 3; ++p) {
        const int s = 4 * p + grp, rsel = s >= 6 ? 1 : 0, hs = s - 6 * rsel, m = m0 + rsel, t = m & (SEQ - 1);
        const v2u raw = *(const v2u*)(P2 + (size_t)m * PROJ2_W + PC_GQ + hs * 64 + 4 * li);
        f32x4 x = (f32x4){bflo(raw.x), bfhi(raw.x), bflo(raw.y), bfhi(raw.y)};
        float ss = (x[0] * x[0] + x[1] * x[1]) + (x[2] * x[2] + x[3] * x[3]);
        ss += __shfl_xor(ss, 1); ss += __shfl_xor(ss, 2); ss += __shfl_xor(ss, 4); ss += __shfl_xor(ss, 8);
        const float rn = 1.f / sqrtf(ss * (1.f / 64.f) + RMS_EPS);
        x = x * rn * (hs < 4 ? qn : kn);
        f32x4 pr; pr[0] = __shfl_xor(x[0], 4); pr[1] = __shfl_xor(x[1], 4); pr[2] = __shfl_xor(x[2], 4); pr[3] = __shfl_xor(x[3], 4);
        const int pos = li >= 8 ? (t & 63) : (t >> 6);
        const f32x4* cs = (const f32x4*)(WSP(f32x2, WS_ROPE) + pos * 16 + 4 * (li & 3));
        const f32x4 cs0 = cs[0], cs1 = cs[1];
        const float sg = (li & 4) ? 1.f : -1.f, sc = hs < 4 ? 0.125f * 1.4426950408889634f : 1.f;
        f32x4 o; o[0] = (x[0] * cs0[0] + sg * pr[0] * cs0[1]) * sc; o[1] = (x[1] * cs0[2] + sg * pr[1] * cs0[3]) * sc; o[2] = (x[2] * cs1[0] + sg * pr[2] * cs1[1]) * sc; o[3] = (x[3] * cs1[2] + sg * pr[3] * cs1[3]) * sc;
        v2u w; w.x = pk2(o[0], o[1]); w.y = pk2(o[2], o[3]);
        *(v2u*)(QK + (size_t)m * 512 + hs * 64 + 4 * li) = w;
    }
    { const int m = m0 + (lane >> 5), c4 = 4 * (lane & 31);
      *(v2u*)(QK + (size_t)m * 512 + 384 + c4) = *(const v2u*)(P2 + (size_t)m * PROJ2_W + PC_GV + c4); }
}

__device__ __forceinline__ void hy_transpose_item(Frame& F, int item) {
    LAS bf16* T = (LAS bf16*)F.lds + F.wave * (64 * 66);
    const int lane = F.lane, mb = item >> 2, cb = item & 3;
    const bf16* src = WSP(bf16, WS_RD + RD_YAT) + (size_t)(cb * 64) * M + (size_t)mb * 64;
    bf16* dst = WSP(bf16, WS_Y) + (size_t)(mb * 64) * 1024 + cb * 64;
#pragma unroll
    for (int i = 0; i < 8; ++i) { const int c = 8 * i + (lane >> 3), m0 = (lane & 7) * 8; const v4u v = *(const v4u*)(src + (size_t)c * M + m0);
        LAS unsigned* tp = (LAS unsigned*)(T + c * 66 + m0); tp[0] = v.x; tp[1] = v.y; tp[2] = v.z; tp[3] = v.w; }
    LDS_WAIT(); asm volatile("" ::: "memory");
#pragma unroll
    for (int i = 0; i < 8; ++i) { const int m = 8 * i + (lane >> 3), c0 = (lane & 7) * 8; unsigned short e[8];
#pragma unroll
        for (int j = 0; j < 8; ++j) e[j] = T[(c0 + j) * 66 + m];
        v4u o; o.x = e[0] | ((unsigned)e[1] << 16); o.y = e[2] | ((unsigned)e[3] << 16); o.z = e[4] | ((unsigned)e[5] << 16); o.w = e[6] | ((unsigned)e[7] << 16);
        *(v4u*)(dst + (size_t)m * 1024 + c0) = o; }
    LDS_WAIT(); asm volatile("" ::: "memory");
}
__device__ __forceinline__ void dil_combine_row(Frame& F, int m) {
    const int lane = F.lane, hh = lane >> 4;
    const float* ls = WSP(float, WS_DLSE);
    const float l0 = ls[((size_t)0 * M + m) * 4 + hh], l1 = ls[((size_t)1 * M + m) * 4 + hh], l2 = ls[((size_t)2 * M + m) * 4 + hh];
    const float mx = fmaxf(l0, fmaxf(l1, l2)); const float e0 = expf(l0 - mx), e1 = expf(l1 - mx), e2 = expf(l2 - mx), inv = 1.f / (e0 + e1 + e2);
    const bf16* o = WSP(bf16, WS_RD + RD_DILO) + (size_t)m * 256 + 4 * lane;
    const v2u a = *(const v2u*)o, b = *(const v2u*)(o + (size_t)M * 256), c = *(const v2u*)(o + (size_t)2 * M * 256);
    const float w0 = e0 * inv, w1 = e1 * inv, w2 = e2 * inv;
    v2u r; r.x = pk2(w0 * bflo(a.x) + w1 * bflo(b.x) + w2 * bflo(c.x), w0 * bfhi(a.x) + w1 * bfhi(b.x) + w2 * bfhi(c.x));
    r.y = pk2(w0 * bflo(a.y) + w1 * bflo(b.y) + w2 * bflo(c.y), w0 * bfhi(a.y) + w1 * bfhi(b.y) + w2 * bfhi(c.y));
    *(v2u*)(WSP(bf16, WS_Y) + (size_t)m * 1024 + 256 + 4 * lane) = r;
}

__device__ __forceinline__ void ln1_router_phase(Frame& F, const Args& args, int l) {
    LAS float* RT = (LAS float*)F.lds;
    const float* rw = FIN(I_ROUTER) + (size_t)l * 1024 * 16;
    __syncthreads();
    for (int i = F.tid; i < 1024 * 16; i += 512) { const int col = i >> 4, e = i & 15; RT[e * 1024 + col] = rw[i]; }
    __syncthreads();
    const int gw = F.bid * 8 + F.wave, NGW = F.G * 8, lane = F.lane;
    const bf16* pre = WSP(bf16, WS_RB + RB_PRE);
    v2u nx[4];
#pragma unroll
    for (int j = 0; j < 4; ++j) nx[j] = *(const v2u*)(pre + (size_t)gw * DM + 4 * lane + 256 * j);
    for (int m = gw; m < M; m += NGW) {
        f32x4 v[4];
#pragma unroll
        for (int j = 0; j < 4; ++j) v[j] = (f32x4){bflo(nx[j].x), bfhi(nx[j].x), bflo(nx[j].y), bfhi(nx[j].y)};
        if (m + NGW < M) {
#pragma unroll
            for (int j = 0; j < 4; ++j) nx[j] = *(const v2u*)(pre + (size_t)(m + NGW) * DM + 4 * lane + 256 * j); }
        ln_row(v, FIN(I_LN1G) + l * DM, FIN(I_LN1B) + l * DM, lane);
        store_row_bf16(v, WSP(bf16, WS_HB) + (size_t)m * DM, lane);
        float lg[16];
#pragma unroll
        for (int e = 0; e < 16; ++e) { float a = 0.f;
#pragma unroll
            for (int j = 0; j < 4; ++j) { const f32x4 w = *(const LAS f32x4*)(RT + e * 1024 + 4 * lane + 256 * j); a += v[j].x * w.x + v[j].y * w.y + v[j].z * w.z + v[j].w * w.w; }
            lg[e] = a; if (e & 1) asm volatile("" ::: "memory"); }
#pragma unroll
        for (int e = 0; e < 8; ++e) { const bool up = (lane & 32) != 0; const float keep = up ? lg[e + 8] : lg[e], give = up ? lg[e] : lg[e + 8]; lg[e] = keep + __shfl_xor(give, 32); }
#pragma unroll
        for (int e = 0; e < 4; ++e) { const bool up = (lane & 16) != 0; const float keep = up ? lg[e + 4] : lg[e], give = up ? lg[e] : lg[e + 4]; lg[e] = keep + __shfl_xor(give, 16); }
#pragma unroll
        for (int e = 0; e < 2; ++e) { const bool up = (lane & 8) != 0; const float keep = up ? lg[e + 2] : lg[e], give = up ? lg[e] : lg[e + 2]; lg[e] = keep + __shfl_xor(give, 8); }
        { const bool up = (lane & 4) != 0; const float keep = up ? lg[1] : lg[0], give = up ? lg[0] : lg[1]; lg[0] = keep + __shfl_xor(give, 4); }
        float z = lg[0]; z += __shfl_xor(z, 2); z += __shfl_xor(z, 1);
        float mx = z; mx = fmaxf(mx, __shfl_xor(mx, 4)); mx = fmaxf(mx, __shfl_xor(mx, 8)); mx = fmaxf(mx, __shfl_xor(mx, 16)); mx = fmaxf(mx, __shfl_xor(mx, 32));
        const float p = expf(z - mx); float den = p; den += __shfl_xor(den, 4); den += __shfl_xor(den, 8); den += __shfl_xor(den, 16); den += __shfl_xor(den, 32);
        if ((lane & 3) == 0) { const int e = ((lane >> 5) & 1) * 8 + ((lane >> 4) & 1) * 4 + ((lane >> 3) & 1) * 2 + ((lane >> 2) & 1); WSP(float, WS_AFF)[(size_t)m * 16 + e] = p / den; }
    }
}

__device__ __forceinline__ int wave_incl_scan(int v, int lane) {
#pragma unroll
    for (int o = 1; o < 64; o <<= 1) { const int n = __shfl_up(v, o); if (lane >= o) v += n; }
    return v;
}
__device__ __forceinline__ int block_excl_scan(Frame& F, int v, LAS int* sc) {
    const int inc = wave_incl_scan(v, F.lane);
    __syncthreads();
    if (F.lane == 63) sc[F.wave] = inc;
    __syncthreads();
    int base = 0;
#pragma unroll
    for (int w = 0; w < 8; ++w) { const int x = sc[w]; if (w < F.wave) base += x; }
    return base + inc - v;
}
__device__ __forceinline__ void topk_item(Frame& F, int e, int b, int half, int nhalf) {
    LAS int* H = (LAS int*)F.lds;
    LAS int* SH = H + 256;
    LAS int* SC = SH + 4;
    LAS int* SEL = SC + 16;
    const int tid = F.tid, lane = F.lane, eb = e * 8 + b;
    const float* aff = WSP(float, WS_AFF) + (size_t)b * SEQ * 16 + e;
    unsigned key[8];
#pragma unroll
    for (int j = 0; j < 8; ++j) key[j] = __float_as_uint(aff[(size_t)(8 * tid + j) * 16]);
    unsigned prefix = 0u, pmask = 0u; int need = CAP;
    for (int pass = 3; pass >= 0; --pass) {
        __syncthreads();
        if (tid < 256) H[tid] = 0;
        __syncthreads();
#pragma unroll
        for (int j = 0; j < 8; ++j) if ((key[j] & pmask) == prefix) __hip_atomic_fetch_add(&H[(key[j] >> (8 * pass)) & 255u], 1, __ATOMIC_RELAXED, __HIP_MEMORY_SCOPE_WORKGROUP);
        __syncthreads();
        if (F.wave == 0) {
            const int c0 = H[255 - 4 * lane], c1 = H[254 - 4 * lane], c2 = H[253 - 4 * lane], c3 = H[252 - 4 * lane];
            const int s = c0 + c1 + c2 + c3, inc = wave_incl_scan(s, lane), exc = inc - s;
            if (exc < need && need <= inc) { const int r = need - exc; int bin, nn;
                if (r <= c0) { bin = 255 - 4 * lane; nn = r; } else if (r <= c0 + c1) { bin = 254 - 4 * lane; nn = r - c0; }
                else if (r <= c0 + c1 + c2) { bin = 253 - 4 * lane; nn = r - c0 - c1; } else { bin = 252 - 4 * lane; nn = r - c0 - c1 - c2; }
                SH[0] = bin; SH[1] = nn; }
        }
        __syncthreads();
        prefix |= (unsigned)SH[0] << (8 * pass); pmask |= 0xffu << (8 * pass); need = SH[1];
    }
    const unsigned thr = prefix;
    int eqc = 0;
#pragma unroll
    for (int j = 0; j < 8; ++j) eqc += (key[j] == thr) ? 1 : 0;
    int eq = block_excl_scan(F, eqc, SC);
    int selc = 0; unsigned selm = 0u;
#pragma unroll
    for (int j = 0; j < 8; ++j) { bool s = key[j] > thr; if (key[j] == thr) { s = eq < need; ++eq; } if (s) { selm |= 1u << j; ++selc; } }
    int slot = block_excl_scan(F, selc, SC);
    unsigned short* inv = WSP(unsigned short, WS_INV) + (size_t)eb * SEQ;
    float* gwp = WSP(float, WS_GW) + (size_t)eb * CAP; int* idx = WSP(int, WS_IDX) + (size_t)eb * CAP;
#pragma unroll
    for (int j = 0; j < 8; ++j) { const int t = 8 * tid + j;
        if ((selm >> j) & 1u) { SEL[slot] = t; if (half == 0) { inv[t] = (unsigned short)(slot + 1); gwp[slot] = __uint_as_float(key[j]); idx[slot] = t; } ++slot; }
        else if (half == 0) inv[t] = (unsigned short)0; }
    __syncthreads();
    const bf16* hb = WSP(bf16, WS_HB) + (size_t)b * SEQ * DM; bf16* xs = WSP(bf16, WS_RA + RA_XS) + (size_t)eb * CAP * DM;
    for (int s = half * (CAP / nhalf) + F.wave; s < (half + 1) * (CAP / nhalf); s += 8) { const int t = SEL[s];
        const v4u* sp = (const v4u*)(hb + (size_t)t * DM); v4u* dp = (v4u*)(xs + (size_t)s * DM);
        dp[F.lane] = sp[F.lane]; dp[F.lane + 64] = sp[F.lane + 64]; }
    __syncthreads();
}

__device__ __forceinline__ void ln2_phase(Frame& F, const Args& args, int l) {
    const int gw = F.bid * 8 + F.wave, NGW = F.G * 8, lane = F.lane;
    const unsigned short* inv = WSP(unsigned short, WS_INV);
    const bf16* eo = WSP(bf16, WS_RA + RA_EOUT);
    v2u nx[4]; unsigned nslv = 0u;
    { const int b = gw >> 12, t = gw & (SEQ - 1); if (lane < NE) nslv = inv[((size_t)(lane * 8 + b)) * SEQ + t];
#pragma unroll
      for (int j = 0; j < 4; ++j) nx[j] = *(const v2u*)(WSP(bf16, WS_HB) + (size_t)gw * DM + 4 * lane + 256 * j); }
    for (int m = gw; m < M; m += NGW) {
        const int b = m >> 12;
        const unsigned slv = nslv;
        f32x4 v[4];
#pragma unroll
        for (int j = 0; j < 4; ++j) v[j] = (f32x4){bflo(nx[j].x), bfhi(nx[j].x), bflo(nx[j].y), bfhi(nx[j].y)} * DN_ALPHA;
        if (m + NGW < M) { const int m2 = m + NGW, b2 = m2 >> 12, t2 = m2 & (SEQ - 1); nslv = 0u; if (lane < NE) nslv = inv[((size_t)(lane * 8 + b2)) * SEQ + t2];
#pragma unroll
            for (int j = 0; j < 4; ++j) nx[j] = *(const v2u*)(WSP(bf16, WS_HB) + (size_t)m2 * DM + 4 * lane + 256 * j); }
        unsigned mask = (unsigned)__ballot(slv != 0u);
        while (mask) {
            int e[4]; float wgt[4];
#pragma unroll
            for (int k = 0; k < 4; ++k) { if (mask) { e[k] = __builtin_ctz(mask); mask &= mask - 1u; wgt[k] = 1.f; } else { e[k] = e[0]; wgt[k] = 0.f; } }
            v2u w[4][4];
#pragma unroll
            for (int k = 0; k < 4; ++k) { const int ek = __builtin_amdgcn_readfirstlane(e[k]); const unsigned sl = (unsigned)__builtin_amdgcn_readlane((int)slv, ek);
                const bf16* r = eo + ((size_t)(ek * 8 + b) * CAP + (sl - 1u)) * DM + 4 * lane;
#pragma unroll
                for (int j = 0; j < 4; ++j) w[k][j] = *(const v2u*)(r + 256 * j); }
#pragma unroll
            for (int k = 0; k < 4; ++k)
#pragma unroll
                for (int j = 0; j < 4; ++j) { v[j].x += wgt[k] * bflo(w[k][j].x); v[j].y += wgt[k] * bfhi(w[k][j].x); v[j].z += wgt[k] * bflo(w[k][j].y); v[j].w += wgt[k] * bfhi(w[k][j].y); }
        }
        ln_row(v, FIN(I_LN2G) + l * DM, FIN(I_LN2B) + l * DM, lane);
        if (l == DEPTH - 1) {
#pragma unroll
            for (int j = 0; j < 4; ++j) *(f32x4*)(F.out + (size_t)m * DM + 4 * lane + 256 * j) = v[j]; }
        else store_row_bf16(v, WSP(bf16, WS_HB) + (size_t)m * DM, lane);
    }
}

struct SchedTiles {
    const char* A0; const char* B0; size_t a_tile, b_tile; int nM, nN, G, c;
    __device__ __forceinline__ bool next(int i, pg8::Unit& u) const {
        const int L = i * G + c; if (L >= nM * nN) return false;
        int pm, pn; pg8::tile_of(L, nM, nN, pm, pn);
        u.A = A0 + (size_t)pm * a_tile; u.B = B0 + (size_t)pn * b_tile; u.orow = pm * 256; u.ocol = pn * 256; u.z = 0; return true;
    }
};
struct SchedMerge {
    const char* Y; const char* WB; int G, c;
    __device__ __forceinline__ bool next(int i, pg8::MergeUnit& u) const {
        const int L = (i >> 2) * G + c, z = i & 3; if (L >= 128 * 8) return false;
        int pm, pn; pg8::tile_of(L, 128, 8, pm, pn);
        u.A = Y + ((size_t)pm * 256 * 1024 + z * 256) * 2; u.B = WB + ((size_t)z * 1024 * 256 + (size_t)pn * 128 * 256) * 2; u.orow = pm * 256; u.ocol = pn * 128; u.z = z; return true;
    }
};
struct SchedMoe1 {
    const char* XS; const char* W; int G, c;
    __device__ __forceinline__ bool next(int i, pg8::Unit& u) const {
        const int L = i * G + c; if (L >= 128 * 16) return false;
        const int eb = L >> 4, sub = L & 15, pm2 = sub & 1, pn = sub >> 1, e = eb >> 3;
        u.A = XS + ((size_t)(eb * 512 + pm2 * 256) * 1024) * 2; u.B = W + ((size_t)(e * 2048 + pn * 256) * 1024) * 2; u.orow = eb * 512 + pm2 * 256; u.ocol = pn * 128; u.z = eb; return true;
    }
};
struct SchedMoe2 {
    const char* HID; const char* W; int G, c;
    __device__ __forceinline__ bool next(int i, pg8::Unit& u) const {
        const int L = i * G + c; if (L >= 128 * 8) return false;
        const int eb = L >> 3, sub = L & 7, pm2 = sub & 1, pn = sub >> 1, e = eb >> 3;
        u.A = HID + ((size_t)(eb * 512 + pm2 * 256) * 1024) * 2; u.B = W + ((size_t)(e * 1024 + pn * 256) * 1024) * 2; u.orow = eb * 512 + pm2 * 256; u.ocol = pn * 256; u.z = eb; return true;
    }
};

static_assert((size_t)(CW_Q + (DEPTH * 8 + 8) * 64) * 4 <= CTL_ZERO_BYTES && (size_t)(CW_BAR + 3456) * 4 <= (size_t)CW_Q * 4, "control words inside the per-call memset");
constexpr int NPH = 12;
__global__ void __launch_bounds__(512, 2) fwd_kernel(Args args_k) {
    const Args& args0 = args_k;
    extern __shared__ __attribute__((aligned(16))) unsigned char lds_raw[];
    Frame F;
    F.lds = (LAS unsigned char*)lds_raw;
    F.MISC = (volatile LAS unsigned*)(F.lds + MISC_OFF);
    F.tid = threadIdx.x; F.lane = F.tid & 63; F.wave = __builtin_amdgcn_readfirstlane(F.tid >> 6);
    F.G = gridDim.x; F.bid = blockIdx.x; F.zoff = 0;
    const int wave0 = __builtin_amdgcn_readfirstlane(threadIdx.x >> 6);
    F.ws = args0.ws; F.out = args0.out; F.ctl = (gu32*)(args0.ws + WS_CTL);
    for (int u = F.tid; u < (LDS_BYTES - MISC_OFF) / 4; u += 512) F.MISC[u] = 0u;
    __syncthreads();
#ifdef DBG_PROF
    if (blockIdx.x == 0 && threadIdx.x == 0) ((unsigned long long*)(args0.ws + WS_CTL))[50000 + 15] = __builtin_amdgcn_s_memrealtime();
#endif
    const bool multi = (args0.l_hi - args0.l_lo > 1) || (args0.ph_hi - args0.ph_lo > 1);
    XcdBarrier bar; bar.bar = (unsigned*)(F.ctl + CW_BAR); bar.x = 0; bar.st = F.MISC + 8;
    if (multi) bar = xcd_barrier_post((unsigned*)(F.ctl + CW_BAR), F.MISC + 8);
    const int lo = args0.ph_lo, hi = args0.ph_hi, l_lo = args0.l_lo, l_hi = args0.l_hi;
#ifndef DBL_MASK
#define DBL_MASK 0
#endif
#define NREP(k) (((DBL_MASK >> (k)) & 1) ? 2 : 1)
#ifndef DBG_ROT
#define DBG_ROT 0
#endif
#ifndef PHASE_MASK
#define PHASE_MASK 0xfff
#endif
#define IN(k) (((PHASE_MASK >> (k)) & 1) && lo <= (k) && (k) < hi)
#ifndef SUB_MASK
#define SUB_MASK 0xff
#endif
#define SUB(k) ((SUB_MASK >> (k)) & 1)
#define FRESH() do { { int b_ = blockIdx.x, g_ = gridDim.x; asm volatile("" : "+s"(b_)); asm volatile("" : "+s"(g_)); F.bid = b_; F.G = g_; } int ln_ = __builtin_amdgcn_mbcnt_hi(~0u, __builtin_amdgcn_mbcnt_lo(~0u, 0u)); asm volatile("" : "+v"(ln_)); int wv_ = wave0; asm volatile("" : "+s"(wv_)); F.lane = ln_; F.wave = wv_; F.tid = wv_ * 64 + ln_; } while (0)
#ifdef DBG_PROF
#define STAMP(k) do { if (blockIdx.x == 0 && threadIdx.x == 0) ((unsigned long long*)(F.ws + WS_CTL))[50000 + l * 16 + (k)] = __builtin_amdgcn_s_memrealtime(); } while (0)
#else
#define STAMP(k) do {} while (0)
#endif
#define SEAM(k) do { if (((k) + 1 < hi) || (l + 1 < l_hi)) { XcdBarrier b2_ = bar; asm volatile("" : "+s"(b2_.x)); asm volatile("" : "+s"(b2_.bar)); xcd_barrier(b2_, F.tid); } STAMP(k); } while (0)

#pragma unroll 1
    for (int l = l_lo; l < l_hi; ++l) {
        const Args& args = args_k;
        { size_t z_ = 0; asm volatile("" : "+s"(z_)); F.ws = args.ws + z_; F.out = args.out + z_; F.ctl = (gu32*)(F.ws + WS_CTL); }
        unsigned char* wb = F.ws + WS_W;
        const char* HBp = (const char*)(F.ws + WS_HB);
#define NGW (F.G * 8)
#define gw (F.bid * 8 + F.wave)
        if (IN(0) && l == 0) { FRESH(); prologue_phase(F, args); SEAM(0); }

        if (IN(1)) _Pragma("unroll 1") for (int rep_ = 0; rep_ < NREP(1); ++rep_) { FRESH();
            const pg8::Gemm g{1024, 1024, 1024};
            if (SUB(0)) {
                SchedTiles S{(const char*)(wb + W_WIN), HBp, (size_t)256 * 1024 * 2, (size_t)256 * 1024 * 2, 3, 128, F.G, F.bid};
                pg8::EpiBf16<0> E{WSP(bf16, WS_RB + RB_HYT), M};
                pg8::gemm_phase(F.lds, g, S, E, F.tid); }
            if (SUB(1)) {
                SchedTiles S{HBp, (const char*)(wb + W_WIN) + (size_t)768 * 1024 * 2, (size_t)256 * 1024 * 2, (size_t)256 * 1024 * 2, 128, 12, F.G, F.bid};
                pg8::EpiBf16<0> E{WSP(bf16, WS_RB + RB_PROJ2), PROJ2_W};
                pg8::gemm_phase(F.lds, g, S, E, F.tid); }
            if (SUB(2)) {
                SchedTiles S{HBp, (const char*)(wb + W_WIN) + (size_t)3840 * 1024 * 2, (size_t)256 * 1024 * 2, (size_t)256 * 1024 * 2, 128, 16, F.G, (F.bid + DBG_ROT) % F.G};
                pg8::EpiBf16<1> E{WSP(bf16, WS_RA + RA_G), 4096};
                pg8::gemm_phase(F.lds, g, S, E, F.tid); }
            SEAM(1);
        }
        if (IN(2)) _Pragma("unroll 1") for (int rep_ = 0; rep_ < NREP(2); ++rep_) { FRESH();
            if (l == 0) { for (int tb = F.bid; tb < 256; tb += F.G) hy_taps_block(F, args, 0, tb); __syncthreads(); }
            _Pragma("unroll 2") for (int m = 2 * gw; m < M; m += 2 * NGW) gqa_prep_rows(F, args, l, m);
            for (int r = gw; r < 768 * 8; r += NGW) hy_sconv_row(F, args, l, r);
            SEAM(2); }

        if (IN(3)) _Pragma("unroll 1") for (int rep_ = 0; rep_ < NREP(3); ++rep_) { FRESH();
#if MK_STATIC_Q
            if (SUB(0)) for (int it = F.bid; it < 256; it += F.G) hyena_item(F, args, l, it);
            if (SUB(1)) {   const attn_body::bf16* Qp = (const attn_body::bf16*)(F.ws + WS_RD + RD_QKVG);
                attn_body::bf16* Op = (attn_body::bf16*)(F.ws + WS_Y) + 768;
                for (int it = F.bid; it < 512; it += F.G) { __syncthreads();
                    attn_body::attn_unit<8>(it >> 6, (it >> 4) & 3, it & 15, Qp, Qp + 256, Qp + 384, Op, (char*)lds_raw, F.tid); } }
            if (SUB(2)) for (int it = F.bid; it < 128; it += F.G) s5_item(F, args, l, it >> 4, it & 15);
            __syncthreads();
            if (SUB(3)) for (int it = F.bid; it < 1536; it += F.G) dil_item(F, args, it);
#else
#ifndef DBL_SUB
#define DBL_SUB 0
#endif
#define NREPS(t) (((DBL_SUB >> (t)) & 1) ? 2 : 1)
            _Pragma("unroll 1") for (int r2 = 0; r2 < NREPS(2); ++r2) for (;;) { const int it = wq_grab(F, l * 8 + r2 * 4 + 2); if (it >= 128) break; s5_item(F, args, l, it >> 4, it & 15); }
            _Pragma("unroll 1") for (int r2 = 0; r2 < NREPS(0); ++r2) for (;;) { const int it = wq_grab(F, l * 8 + r2 * 4 + 0); if (it >= 256) break; hyena_item(F, args, l, it); }
            {   const attn_body::bf16* Qp = (const attn_body::bf16*)(F.ws + WS_RD + RD_QKVG);
                attn_body::bf16* Op = (attn_body::bf16*)(F.ws + WS_Y) + 768;
                _Pragma("unroll 1") for (int r2 = 0; r2 < NREPS(1); ++r2) for (;;) { const int it = wq_grab(F, l * 8 + r2 * 4 + 1); if (it >= 512) break;
                    attn_body::attn_unit<8>(it >> 6, (it >> 4) & 3, it & 15, Qp, Qp + 256, Qp + 384, Op, (char*)lds_raw, F.tid); } }
            _Pragma("unroll 1") for (int r2 = 0; r2 < NREPS(3); ++r2) for (;;) { const int it = wq_grab(F, l * 8 + r2 * 4 + 3); if (it >= 768) break; dil_item(F, args, 2 * it); dil_item(F, args, 2 * it + 1); }
#endif
            SEAM(3);
        }
        if (IN(4)) _Pragma("unroll 1") for (int rep_ = 0; rep_ < NREP(4); ++rep_) { FRESH();
            if (SUB(0)) {   const pg8::Gemm g{256, 256, 256};
                SchedTiles S{(const char*)(F.ws + WS_RD + RD_S5Z), (const char*)(wb + W_GLU), (size_t)256 * 256 * 2, 0, 128, 1, F.G, F.bid};
                pg8::EpiGlu E{WSP(bf16, WS_RD + RD_S5Z), WSP(bf16, WS_Y), FIN(I_S5_GB) + l * 256};
                pg8::gemm_phase(F.lds, g, S, E, F.tid); }
            __syncthreads();
            if (SUB(1)) for (int it = gw; it < 2048; it += NGW) hy_transpose_item(F, it);
            if (SUB(2)) for (int m = gw; m < M; m += NGW) dil_combine_row(F, m);
            SEAM(4);
        }
        if (IN(5)) _Pragma("unroll 1") for (int rep_ = 0; rep_ < NREP(5); ++rep_) { FRESH();
            const pg8::Gemm g{256, 1024, 256};
            SchedMerge S{(const char*)(F.ws + WS_Y), (const char*)(wb + W_WB), F.G, F.bid};
            pg8::gemm_merge_phase(F.lds, g, S, WSP(bf16, WS_RA + RA_G), WSP(bf16, WS_RB + RB_MB), F.tid);
            SEAM(5);
        }
        if (IN(6)) _Pragma("unroll 1") for (int rep_ = 0; rep_ < NREP(6); ++rep_) { FRESH();
            const pg8::Gemm g{1024, 1024, 1024};
            SchedTiles S{(const char*)(F.ws + WS_RB + RB_MB), (const char*)(wb + W_WO), (size_t)256 * 1024 * 2, (size_t)256 * 1024 * 2, 128, 4, F.G, F.bid};
            pg8::EpiPre E{WSP(bf16, WS_HB), WSP(bf16, WS_RB + RB_PRE), DN_ALPHA};
            pg8::gemm_phase(F.lds, g, S, E, F.tid);
            SEAM(6);
        }
        if (IN(7)) _Pragma("unroll 1") for (int rep_ = 0; rep_ < NREP(7); ++rep_) { FRESH(); ln1_router_phase(F, args, l); SEAM(7); }
        if (IN(8)) _Pragma("unroll 1") for (int rep_ = 0; rep_ < NREP(8); ++rep_) { FRESH(); if (F.G >= 256) { if (F.bid < 256) topk_item(F, (F.bid & 127) >> 3, F.bid & 7, F.bid >> 7, 2); } else for (int it = F.bid; it < 128; it += F.G) topk_item(F, it >> 3, it & 7, 0, 1);
            if (l + 1 < DEPTH) { __syncthreads(); for (int tb = F.bid; tb < 256; tb += F.G) hy_taps_block(F, args, l + 1, tb); }
            SEAM(8); }
        if (IN(9)) _Pragma("unroll 1") for (int rep_ = 0; rep_ < NREP(9); ++rep_) { FRESH();
            const pg8::Gemm g{1024, 1024, 1024};
            SchedMoe1 S{(const char*)(F.ws + WS_RA + RA_XS), (const char*)(wb + W_GU), F.G, F.bid};
            pg8::EpiSwiglu E{WSP(bf16, WS_RB + RB_HID)};
            pg8::gemm_phase(F.lds, g, S, E, F.tid);
            SEAM(9);
        }
        if (IN(10)) _Pragma("unroll 1") for (int rep_ = 0; rep_ < NREP(10); ++rep_) { FRESH();
            const pg8::Gemm g{1024, 1024, 1024};
            SchedMoe2 S{(const char*)(F.ws + WS_RB + RB_HID), (const char*)(wb + W_DN), F.G, F.bid};
            pg8::EpiRowScale E{WSP(bf16, WS_RA + RA_EOUT), WSP(float, WS_GW)};
            pg8::gemm_phase(F.lds, g, S, E, F.tid);
            SEAM(10);
        }
        if (IN(11)) { FRESH();
            ln2_phase(F, args, l);
            if (l + 1 < DEPTH) convert_layer(F, args, l + 1, gw, NGW);
#ifdef DBG_CONV2
            if (l + 1 < DEPTH) convert_layer(F, args, l + 1, gw, NGW);
#endif
            SEAM(11);
        }
    }
    if (multi) {
        { XcdBarrier b2_ = bar; asm volatile("" : "+s"(b2_.x)); asm volatile("" : "+s"(b2_.bar)); xcd_barrier(b2_, F.tid); }
        if (__hip_atomic_load((unsigned*)(F.ctl + CW_BAR) + XB_TMO, RLX_AGENT) != 0u) {
            const float q = __builtin_nanf("");
            for (size_t i = (size_t)F.bid * 512 + F.tid; i < (size_t)M * DM; i += (size_t)F.G * 512) args0.out[i] = q; }
    }
#undef IN
#undef gw
#undef NGW
#undef SEAM
}


#ifdef DBG_STOP
__global__ void dbg_dump_kernel(const unsigned char* ws, float* out, size_t off, int isf32, int ld, int ncols) {
    const size_t n = (size_t)M * DM;
    for (size_t i = (size_t)blockIdx.x * blockDim.x + threadIdx.x; i < n; i += (size_t)gridDim.x * blockDim.x) {
        const size_t r = i / DM, c = i % DM; float v = 0.f;
        if ((int)c < ncols) { if (isf32) v = ((const float*)(ws + off))[r * ld + c]; else v = bf2f(((const bf16*)(ws + off))[r * ld + c]); }
        out[i] = v; }
}
#endif

#ifdef DBG_RACE
constexpr int CW_DBG = 65536;
__global__ void dbg_sum_kernel(const unsigned* p, size_t nwords, unsigned long long* slot) {
    unsigned long long s = 0;
    for (size_t i = (size_t)blockIdx.x * blockDim.x + threadIdx.x; i < nwords; i += (size_t)gridDim.x * blockDim.x) s += (unsigned long long)p[i] * (unsigned long long)((i & 1023u) + 1u);
    for (int o = 32; o >= 1; o >>= 1) s += __shfl_xor(s, o);
    if ((threadIdx.x & 63) == 0) atomicAdd(slot, s);
}
__global__ void dbg_final_kernel(const unsigned long long* T, float* out) {
    int V = 0;
    for (int s = 56; s <= 60; ++s) if (T[s] != T[64 + s]) V |= 1 << (s - 56);
    const float c = 10.f * (float)(V + 1);
    for (size_t i = (size_t)blockIdx.x * blockDim.x + threadIdx.x; i < (size_t)M * DM; i += (size_t)gridDim.x * blockDim.x) out[i] = c;
}
#endif

#ifdef DBG_STAT
__global__ void dbg_stat_kernel(const unsigned char* ws, size_t off, int ld, int ncols, unsigned* res) {
    unsigned mx = 0, cnt = 0;
    for (size_t i = (size_t)blockIdx.x * blockDim.x + threadIdx.x; i < (size_t)M * ncols; i += (size_t)gridDim.x * blockDim.x) {
        const size_t r = i / ncols, c = i % ncols; const float v = fabsf(bf2f(((const bf16*)(ws + off))[r * ld + c]));
        const unsigned b = __float_as_uint(v); mx = b > mx ? b : mx; cnt += (v > DBG_THR || v != v) ? 1u : 0u; }
    atomicMax(res, mx); atomicAdd(res + 1, cnt);
    for (size_t r = (size_t)blockIdx.x * blockDim.x + threadIdx.x; r < (size_t)M; r += (size_t)gridDim.x * blockDim.x) { bool bad = false; unsigned first = 0xffffffffu;
        for (int c = 0; c < ncols; ++c) { const float v = fabsf(bf2f(((const bf16*)(ws + off))[r * ld + c])); if (v > DBG_THR || v != v) { bad = true; if (first == 0xffffffffu) first = c; } }
        if (bad) { atomicAdd(res + 2, 1u); atomicMin(res + 3, (unsigned)r); atomicMin(res + 4, first); } }
}
__global__ void dbg_statout_kernel(const unsigned* res, float* out) {
    const float c = DBG_STAT == 0 ? 100.f * __uint_as_float(res[0]) : DBG_STAT == 1 ? sqrtf((float)res[1]) : DBG_STAT == 2 ? sqrtf((float)res[2]) : DBG_STAT == 3 ? (float)(res[3] / 2048u + 20u) : (float)(res[4] / 256u + 20u);
    for (size_t i = (size_t)blockIdx.x * blockDim.x + threadIdx.x; i < (size_t)M * DM; i += (size_t)gridDim.x * blockDim.x) out[i] = c;
}
#endif

#ifdef DBG_PROF
__global__ void dbg_prof_kernel(const unsigned long long* ts, float* out) {
    float tp[12];
    for (int p = 0; p < 12; ++p) { double s = 0; for (int l = 0; l < DEPTH; ++l) { if (p == 0 && l > 0) continue;
        const unsigned long long e = ts[l * 16 + p]; unsigned long long b;
        if (p == 0) b = ts[15]; else if (p == 1 && l > 0) b = ts[(l - 1) * 16 + 11]; else b = ts[l * 16 + p - 1];
        if (p == 11 && l == DEPTH - 1) continue;
        s += (double)(e - b) * 0.01; } tp[p] = (float)s; }
    const float c = tp[DBG_PA], d = 1000.f * tp[DBG_PB];
    for (size_t i = (size_t)blockIdx.x * blockDim.x + threadIdx.x; i < (size_t)M * DM; i += (size_t)gridDim.x * blockDim.x) out[i] = (i == 0) ? d : c;
}
#endif
extern "C" void kernel_launch(void* const* d_in, const int* in_sizes, int n_in, void* d_out, int out_size, void* d_ws, size_t ws_size, hipStream_t stream) {
    static int grid = 0;
    if (grid == 0) {
        if (n_in != N_INPUTS || out_size != M * DM || ws_size < WS_END) { fprintf(stderr, "kernel_launch: unexpected problem (n_in %d, out %d, ws %zu)\n", n_in, out_size, ws_size); grid = -1; return; }
        int dev = 0, cus = 0, per_cu = 0;
        if (hipGetDevice(&dev) != hipSuccess || hipDeviceGetAttribute(&cus, hipDeviceAttributeMultiprocessorCount, dev) != hipSuccess) { grid = -1; return; }
        if (hipFuncSetAttribute((const void*)fwd_kernel, hipFuncAttributeMaxDynamicSharedMemorySize, LDS_BYTES) != hipSuccess) { fprintf(stderr, "kernel_launch: hipFuncSetAttribute failed\n"); grid = -1; return; }
        if (hipOccupancyMaxActiveBlocksPerMultiprocessor(&per_cu, (const void*)fwd_kernel, 512, LDS_BYTES) != hipSuccess || per_cu < 1)
            fprintf(stderr, "kernel_launch: occupancy query reports %d workgroups per CU\n", per_cu);
        (void)hipGetLastError();
        grid = cus;
    }
    if (grid < 0) return;
    if (hipMemsetAsync((char*)d_ws + WS_CTL, 0, CTL_ZERO_BYTES, stream) != hipSuccess) return;
    Args a{};
    for (int i = 0; i < N_INPUTS; ++i) a.in[i] = (const float*)d_in[i];
    a.out = (float*)d_out; a.ws = (unsigned char*)d_ws;
#if MK_ONE_LAUNCH
    a.ph_lo = 0; a.ph_hi = NPH; a.l_lo = 0; a.l_hi = DEPTH;
    hipLaunchKernelGGL(fwd_kernel, dim3(grid), dim3(512), LDS_BYTES, stream, a);
#ifdef DBG_PROF
    hipLaunchKernelGGL(dbg_prof_kernel, dim3(1024), dim3(256), 0, stream, (const unsigned long long*)((char*)d_ws + WS_CTL) + 50000, (float*)d_out);
#endif
#else
#ifdef DBG_RACE
    {
    unsigned char* ws = (unsigned char*)d_ws; unsigned long long* T = (unsigned long long*)(ws + WS_CTL) + CW_DBG / 2;
    auto sum = [&](size_t off, size_t bytes, int slot) { hipLaunchKernelGGL(dbg_sum_kernel, dim3(1024), dim3(256), 0, stream, (const unsigned*)(ws + off), bytes / 4, T + slot); };
    auto sumout = [&](int slot) { hipLaunchKernelGGL(dbg_sum_kernel, dim3(1024), dim3(256), 0, stream, (const unsigned*)d_out, (size_t)M * DM, T + slot); };
    for (int run = 0; run < 2; ++run) {
        if (run == 1) hipMemsetAsync((char*)d_ws + WS_CTL, 0, CW_DBG * 4, stream);
        hipMemsetAsync((char*)d_ws + 1 * MiB, run == 0 ? 0xAA : 0x55, WS_END - 1 * MiB, stream);
        for (int l = 0; l < DBG_LAYERS; ++l)
            for (int p = (l == 0 ? 0 : 1); p < DBG_NPH; ++p) { a.ph_lo = p; a.ph_hi = p + 1; a.l_lo = l; a.l_hi = l + 1;
                hipLaunchKernelGGL(fwd_kernel, dim3(grid), dim3(512), LDS_BYTES, stream, a);
                const int s = run * 64 + l * 12 + p;
                switch (p) {
                case 0: sum(WS_HB, 64 * MiB, s); sumout(s); sum(WS_W, 115 * MiB, s); sum(WS_S5W, 64 * MiB, s); sum(WS_HF2, 4 * MiB, s); sum(WS_ROPE, 8 * KiB, s); sum(WS_S5A32, 64 * KiB, s); break;
                case 1: sum(WS_RB, 240 * MiB, s); sum(WS_RA, 256 * MiB, s); break;
                case 2: sum(WS_RD + RD_QKVG, 32 * MiB, s); break;
                case 3: sum(WS_RD + RD_YAT, 16 * MiB, run * 64 + 56); sum(WS_RD + RD_HV, 32 * MiB, run * 64 + 57); sum(WS_RD + RD_DILO, 48 * MiB, run * 64 + 58); sum(WS_DLSE, 1536 * KiB, run * 64 + 59); sum(WS_RD + RD_S5Z, 16 * MiB, run * 64 + 60); break;
                case 4: sum(WS_Y, 64 * MiB, s); break;
                case 5: sum(WS_RB + RB_MB, 64 * MiB, s); sum(WS_RB, 128 * MiB, s); break;
                case 6: sum(WS_RB, 128 * MiB, s); break;
                case 7: sumout(s); sum(WS_HB, 64 * MiB, s); sum(WS_AFF, 2 * MiB, s); break;
                case 8: sum(WS_RA, 128 * MiB, s); sum(WS_IDX, 512 * KiB, s); sum(WS_INV, 1 * MiB, s); break;
                case 9: sum(WS_RB, 128 * MiB, s); break;
                case 10: sum(WS_RA + RA_EOUT, 128 * MiB, s); break;
                case 11: sumout(s); sum(WS_HB, 64 * MiB, s); break;
                } }
    }
    hipLaunchKernelGGL(dbg_final_kernel, dim3(1024), dim3(256), 0, stream, (const unsigned long long*)T, (float*)d_out);
    }
#elif defined(DBG_STOP)
    for (int l = 0; l <= DBG_STOP_L; ++l)
        for (int p = (l == 0 ? 0 : 1); p < NPH; ++p) { if (l == DBG_STOP_L && p > DBG_STOP) break; a.ph_lo = p; a.ph_hi = p + 1; a.l_lo = l; a.l_hi = l + 1;
            hipLaunchKernelGGL(fwd_kernel, dim3(grid), dim3(512), LDS_BYTES, stream, a);
#ifdef DBG_REPEAT
            if (p == DBG_REPEAT) hipLaunchKernelGGL(fwd_kernel, dim3(grid), dim3(512), LDS_BYTES, stream, a);
#endif
            }
#ifdef DBG_STAT
    { unsigned* res = (unsigned*)((char*)d_ws + WS_CTL) + 100000; hipMemsetAsync(res + 3, 0x7f, 8, stream); hipLaunchKernelGGL(dbg_stat_kernel, dim3(2048), dim3(256), 0, stream, (const unsigned char*)d_ws, (size_t)(DBG_OFF), DBG_LD, DBG_NC, res);
      hipLaunchKernelGGL(dbg_statout_kernel, dim3(2048), dim3(256), 0, stream, (const unsigned*)res, (float*)d_out); }
#elif defined(DBG_OFF)
    hipLaunchKernelGGL(dbg_dump_kernel, dim3(2048), dim3(256), 0, stream, (const unsigned char*)d_ws, (float*)d_out, (size_t)(DBG_OFF), DBG_F32, DBG_LD, DBG_NC);
#endif
#else
    for (int l = 0; l < DEPTH; ++l)
        for (int p = (l == 0 ? 0 : 1); p < NPH; ++p) { a.ph_lo = p; a.ph_hi = p + 1; a.l_lo = l; a.l_hi = l + 1;
            hipLaunchKernelGGL(fwd_kernel, dim3(grid), dim3(512), LDS_BYTES, stream, a); }
#endif
#endif
}
```

```cpp
#include <hip/hip_runtime.h>
#include <hip/hip_bf16.h>
#include <cstdio>
#include <cstdint>
#include <cmath>

#ifndef MK_STATIC_Q
#define MK_STATIC_Q 0
#endif
#ifndef MK_ONE_LAUNCH
#define MK_ONE_LAUNCH 1
#endif

constexpr int BATCH = 8, SEQ = 4096, DM = 1024, DEPTH = 4, M = BATCH * SEQ;
constexpr int NIN = 7936;
constexpr int NE = 16, CAP = 512, FFD = 1024;
constexpr float LN_EPS = 1e-5f, RMS_EPS = 1e-6f;
constexpr float DN_ALPHA = 1.6817928305074292f;
constexpr int PC_DQ = 0, PC_DK = 768, PC_DV = 1536, PC_S5 = 2304, PC_GQ = 2560, PC_GK = 2816, PC_GV = 2944, PROJ2_W = 3072;
enum { I_X = 0, I_LNIN_G, I_LNIN_B, I_WIN, I_HY_CW, I_HY_CB, I_HY_W1, I_HY_B1, I_HY_W2, I_HY_B2, I_HY_W3, I_HY_FREQ, I_HY_BIAS,
       I_S5_LRE, I_S5_LIM, I_S5_LDT, I_S5_BRE, I_S5_BIM, I_S5_CRE, I_S5_CIM, I_S5_D, I_S5_GW, I_S5_GB, I_GQ_QN, I_GQ_KN,
       I_WBR, I_WOUT, I_LN1G, I_LN1B, I_ROUTER, I_EWG, I_EWU, I_EWD, I_LN2G, I_LN2B, N_INPUTS };

constexpr size_t MiB = 1u << 20, KiB = 1u << 10;
constexpr size_t WS_CTL = 0, CTL_ZERO_BYTES = 64 * KiB;
constexpr size_t WS_AFF = 1 * MiB;
constexpr size_t WS_IDX = 3 * MiB;
constexpr size_t WS_GW = 3 * MiB + 256 * KiB;
constexpr size_t WS_INV = 4 * MiB;
constexpr size_t WS_DLSE = 5 * MiB;
constexpr size_t WS_ROPE = 7 * MiB;
constexpr size_t WS_S5A32 = 7 * MiB + 256 * KiB;
constexpr size_t WS_HF2 = 8 * MiB;
constexpr size_t WS_S5W = 12 * MiB;
constexpr size_t S5W_LAYER = 16 * MiB, S5_WST_OFF = 0, S5_WCAT_OFF = 4 * MiB;
constexpr size_t WS_W = 76 * MiB;
constexpr size_t W_WIN = 0;
constexpr size_t W_WB = W_WIN + (size_t)NIN * DM * 2;
constexpr size_t W_WO = W_WB + (size_t)4 * 1024 * 256 * 2;
constexpr size_t W_GLU = W_WO + (size_t)1024 * 1024 * 2;
constexpr size_t W_GU = W_GLU + (size_t)256 * 256 * 2;
constexpr size_t W_DN = W_GU + (size_t)16 * 2048 * 1024 * 2;
constexpr size_t W_END = W_DN + (size_t)16 * 1024 * 1024 * 2;
static_assert(W_END <= 116 * MiB, "weights region");
constexpr size_t WS_HB = 192 * MiB;
constexpr size_t WS_RA = 256 * MiB;
constexpr size_t WS_RB = 512 * MiB;
constexpr size_t RB_HYT = 0, RB_PROJ2 = 48 * MiB, RB_MF32 = 0, RB_PRE = 0, RB_HID = 0, RB_MB = 128 * MiB;
constexpr size_t RA_G = 0, RA_XS = 0, RA_EOUT = 128 * MiB;
constexpr size_t WS_Y = 768 * MiB;
constexpr size_t WS_RD = 832 * MiB;
constexpr size_t RD_YAT = 0;
constexpr size_t RD_DILO = 16 * MiB;
constexpr size_t RD_S5Z = 64 * MiB;
constexpr size_t RD_HV = 80 * MiB;
constexpr size_t RD_QKVG = 112 * MiB;
constexpr size_t WS_TT = 976 * MiB;
constexpr size_t WS_END = 992 * MiB;

constexpr int CW_BAR = 4096;
constexpr int CW_Q = 8192;

constexpr int LDS_SCRATCH = 147456;
constexpr int MISC_OFF = LDS_SCRATCH;
constexpr int LDS_BYTES = LDS_SCRATCH + 1024;

#define GAS __attribute__((address_space(1)))
#define LAS __attribute__((address_space(3)))
typedef unsigned short bf16;
typedef unsigned v4u __attribute__((ext_vector_type(4)));
typedef unsigned v2u __attribute__((ext_vector_type(2)));
typedef float f32x4 __attribute__((ext_vector_type(4)));
typedef float f32x2 __attribute__((ext_vector_type(2)));
typedef float f32x16 __attribute__((ext_vector_type(16)));
typedef short bf16x8 __attribute__((ext_vector_type(8)));
typedef short s16x4 __attribute__((ext_vector_type(4)));
typedef GAS unsigned gu32;
#define RLX_AGENT __ATOMIC_RELAXED, __HIP_MEMORY_SCOPE_AGENT
#define LDS_WAIT() asm volatile("s_waitcnt lgkmcnt(0)" ::: "memory")
#define VM_WAIT() asm volatile("s_waitcnt vmcnt(0)" ::: "memory")

__device__ __forceinline__ unsigned f2bf(float f) { unsigned u = __builtin_bit_cast(unsigned, f); return (u + 0x7fffu + ((u >> 16) & 1u)) >> 16; }
__device__ __forceinline__ unsigned pk2(float lo, float hi) { return f2bf(lo) | (f2bf(hi) << 16); }
__device__ __forceinline__ float bf2f(unsigned short b) { return __builtin_bit_cast(float, (unsigned)b << 16); }
__device__ __forceinline__ float bflo(unsigned w) { return __builtin_bit_cast(float, w << 16); }
__device__ __forceinline__ float bfhi(unsigned w) { return __builtin_bit_cast(float, w & 0xffff0000u); }
__device__ __forceinline__ float sigmoidf_(float x) { return __builtin_amdgcn_rcpf(1.0f + __builtin_amdgcn_exp2f(-1.4426950408889634f * x)); }
__device__ __forceinline__ float wave_sum(float v) {
#pragma unroll
    for (int o = 1; o < 64; o <<= 1) v += __shfl_xor(v, o);
    return v;
}
__device__ __forceinline__ float wave_max(float v) {
#pragma unroll
    for (int o = 1; o < 64; o <<= 1) v = fmaxf(v, __shfl_xor(v, o));
    return v;
}

namespace pg8 {
#define PG8_LAS __attribute__((address_space(3)))
typedef unsigned short bf16_t;
typedef unsigned u32x4 __attribute__((ext_vector_type(4)));
constexpr int BM = 256, BK = 64, HALF = 128, HTB = HALF * BK * 2  , STAGE_BYTES = 8 * HTB, NXCD = 8, WGM = 8;

__host__ __device__ __forceinline__ int lds_byte(int r, int c) { const int st = (r >> 4) * 2 + (c >> 5), rr = r & 15, cc = c & 31, ob = rr * 64 + cc * 2; return st * 1024 + (ob ^ (((ob >> 9) & 1) << 5)); }
__host__ __device__ __forceinline__ void stage_rc(int b, int& R, int& C) { const int st = b / 1024, sb = b % 1024, swz = sb ^ (((sb >> 9) & 1) << 5); R = (st >> 1) * 16 + swz / 64; C = (st & 1) * 32 + (swz % 64) / 2; }
__host__ __device__ __forceinline__ int perm32(int rho) { const int n = rho >> 4, i = rho & 15; return 8 * (i >> 2) + 4 * n + (i & 3); }

struct Unit { const char* A; const char* B; int orow, ocol, z; };
struct Gemm { int K, lda, ldb; };

__device__ __forceinline__ void tile_of(int L, int nM, int nN, int& pm, int& pn) {
    const int nwg = nM * nN; int wgid = L; { const int q = nwg / NXCD, r = nwg % NXCD, xcd = wgid % NXCD, off = wgid / NXCD; wgid = (xcd < r ? xcd * (q + 1) : r * (q + 1) + (xcd - r) * q) + off; }
    const int nig = WGM * nN, gid = wgid / nig, fm = gid * WGM, gsz = (nM - fm) < WGM ? (nM - fm) : WGM;
    pm = fm + ((wgid % nig) % gsz); pn = (wgid % nig) / gsz;
}

typedef __bf16 bf16x2_t __attribute__((ext_vector_type(2)));
__device__ __forceinline__ unsigned cvt_pk_bf16(float lo, float hi) { const f32x2 v = {lo, hi}; const bf16x2_t b = __builtin_convertvector(v, bf16x2_t); return __builtin_bit_cast(unsigned, b); }
template <int ACT  > struct EpiBf16 {
    static constexpr bool PERM = true;
    bf16_t* O; int ldc;
    __device__ __forceinline__ void operator()(const f32x4 (&acc)[2][2][4][2], const Unit& u, int wr, int wc, int fr, int fq) const {
        const int row0 = u.orow + wr * 64 + fr, col0 = u.ocol + wc * 32 + 8 * fq;
#pragma unroll
        for (int ai = 0; ai < 2; ++ai)
#pragma unroll
            for (int m = 0; m < 4; ++m) { bf16_t* rowp = O + (size_t)(row0 + ai * HALF + m * 16) * ldc + col0;
#pragma unroll
                for (int bj = 0; bj < 2; ++bj) { f32x4 v0 = acc[ai][bj][m][0], v1 = acc[ai][bj][m][1];
                    if (ACT == 1) {
#pragma unroll
                        for (int j = 0; j < 4; ++j) { v0[j] = sigmoidf_(v0[j]); v1[j] = sigmoidf_(v1[j]); }
#ifdef DBG_HALF
                        for (int j = 0; j < 4; ++j) { v0[j] = 0.5f; v1[j] = 0.5f; }
#endif
                    }
                    u32x4 w; w.x = cvt_pk_bf16(v0[0], v0[1]); w.y = cvt_pk_bf16(v0[2], v0[3]); w.z = cvt_pk_bf16(v1[0], v1[1]); w.w = cvt_pk_bf16(v1[2], v1[3]);
                    *(u32x4*)(rowp + bj * HALF) = w; } }
    }
};
struct EpiMerge {
    static constexpr bool PERM = true;
    const bf16_t* G; float* F; bf16_t* MB;
    __device__ __forceinline__ void operator()(const f32x4 (&acc)[2][2][4][2], const Unit& u, int wr, int wc, int fr, int fq) const {
        const int row0 = u.orow + wr * 64 + fr, col0 = u.ocol + wc * 32 + 8 * fq, i = u.z;
#pragma unroll
        for (int ai = 0; ai < 2; ++ai)
#pragma unroll
            for (int m = 0; m < 4; ++m) { const size_t row = (size_t)(row0 + ai * HALF + m * 16);
#pragma unroll
                for (int bj = 0; bj < 2; ++bj) { const int col = col0 + bj * HALF;
                    const u32x4 g = *(const u32x4*)(G + row * 4096 + i * 1024 + col);
                    f32x4 v0 = acc[ai][bj][m][0], v1 = acc[ai][bj][m][1];
                    v0[0] *= bflo(g.x); v0[1] *= bfhi(g.x); v0[2] *= bflo(g.y); v0[3] *= bfhi(g.y);
                    v1[0] *= bflo(g.z); v1[1] *= bfhi(g.z); v1[2] *= bflo(g.w); v1[3] *= bfhi(g.w);
                    float* fp = F + row * 1024 + col;
                    if (i > 0) { f32x4 p0, p1;
                        asm volatile("global_load_dwordx4 %0, %2, off sc0 sc1\n\tglobal_load_dwordx4 %1, %2, off offset:16 sc0 sc1\n\ts_waitcnt vmcnt(0)" : "=&v"(p0), "=&v"(p1) : "v"(fp) : "memory");
                        v0 += p0; v1 += p1; }
                    if (i < 3) { *(f32x4*)fp = v0; *(f32x4*)(fp + 4) = v1; }
                    else { u32x4 w; w.x = cvt_pk_bf16(v0[0], v0[1]); w.y = cvt_pk_bf16(v0[2], v0[3]); w.z = cvt_pk_bf16(v1[0], v1[1]); w.w = cvt_pk_bf16(v1[2], v1[3]);
                        *(u32x4*)(MB + row * 1024 + col) = w; } } }
    }
};
struct EpiPre {
    static constexpr bool PERM = true;
    const bf16_t* H; bf16_t* P; float alpha;
    __device__ __forceinline__ void operator()(const f32x4 (&acc)[2][2][4][2], const Unit& u, int wr, int wc, int fr, int fq) const {
        const int row0 = u.orow + wr * 64 + fr, col0 = u.ocol + wc * 32 + 8 * fq;
#pragma unroll
        for (int ai = 0; ai < 2; ++ai)
#pragma unroll
            for (int m = 0; m < 4; ++m) { const size_t off = (size_t)(row0 + ai * HALF + m * 16) * 1024 + col0;
#pragma unroll
                for (int bj = 0; bj < 2; ++bj) { const u32x4 h = *(const u32x4*)(H + off + bj * HALF); const f32x4 a0 = acc[ai][bj][m][0], a1 = acc[ai][bj][m][1];
                    u32x4 w; w.x = cvt_pk_bf16(bflo(h.x) * alpha + a0[0], bfhi(h.x) * alpha + a0[1]); w.y = cvt_pk_bf16(bflo(h.y) * alpha + a0[2], bfhi(h.y) * alpha + a0[3]);
                    w.z = cvt_pk_bf16(bflo(h.z) * alpha + a1[0], bfhi(h.z) * alpha + a1[1]); w.w = cvt_pk_bf16(bflo(h.w) * alpha + a1[2], bfhi(h.w) * alpha + a1[3]);
                    *(u32x4*)(P + off + bj * HALF) = w; } }
    }
};
struct EpiSwiglu {
    static constexpr bool PERM = true;
    bf16_t* O;
    __device__ __forceinline__ void operator()(const f32x4 (&acc)[2][2][4][2], const Unit& u, int wr, int wc, int fr, int fq) const {
        const int row0 = u.orow + wr * 64 + fr, col0 = u.ocol + wc * 32 + 8 * fq;
#pragma unroll
        for (int ai = 0; ai < 2; ++ai)
#pragma unroll
            for (int m = 0; m < 4; ++m) { f32x4 v[2];
#pragma unroll
                for (int n = 0; n < 2; ++n)
#pragma unroll
                    for (int j = 0; j < 4; ++j) { const float g = acc[ai][0][m][n][j]; v[n][j] = g * sigmoidf_(g) * acc[ai][1][m][n][j]; }
                u32x4 w; w.x = cvt_pk_bf16(v[0][0], v[0][1]); w.y = cvt_pk_bf16(v[0][2], v[0][3]); w.z = cvt_pk_bf16(v[1][0], v[1][1]); w.w = cvt_pk_bf16(v[1][2], v[1][3]);
                *(u32x4*)(O + (size_t)(row0 + ai * HALF + m * 16) * 1024 + col0) = w; }
    }
};
struct EpiRowScale {
    static constexpr bool PERM = true;
    bf16_t* O; const float* rs;
    __device__ __forceinline__ void operator()(const f32x4 (&acc)[2][2][4][2], const Unit& u, int wr, int wc, int fr, int fq) const {
        const int row0 = u.orow + wr * 64 + fr, col0 = u.ocol + wc * 32 + 8 * fq;
#pragma unroll
        for (int ai = 0; ai < 2; ++ai)
#pragma unroll
            for (int m = 0; m < 4; ++m) { const int row = row0 + ai * HALF + m * 16; const float s = rs[row];
#pragma unroll
                for (int bj = 0; bj < 2; ++bj) { const f32x4 v0 = acc[ai][bj][m][0] * s, v1 = acc[ai][bj][m][1] * s;
                    u32x4 w; w.x = cvt_pk_bf16(v0[0], v0[1]); w.y = cvt_pk_bf16(v0[2], v0[3]); w.z = cvt_pk_bf16(v1[0], v1[1]); w.w = cvt_pk_bf16(v1[2], v1[3]);
                    *(u32x4*)(O + (size_t)row * 1024 + col0 + bj * HALF) = w; } }
    }
};
struct EpiGlu {
    static constexpr bool PERM = true;
    const bf16_t* Z; bf16_t* O; const float* gb;
    __device__ __forceinline__ void operator()(const f32x4 (&acc)[2][2][4][2], const Unit& u, int wr, int wc, int fr, int fq) const {
        const int row0 = u.orow + wr * 64 + fr, col0 = wc * 32 + 8 * fq;
#pragma unroll
        for (int ai = 0; ai < 2; ++ai)
#pragma unroll
            for (int m = 0; m < 4; ++m) { const size_t row = (size_t)(row0 + ai * HALF + m * 16);
#pragma unroll
                for (int bj = 0; bj < 2; ++bj) { const int col = col0 + bj * HALF;
                    const u32x4 z = *(const u32x4*)(Z + row * 256 + col); const f32x4 b0 = *(const f32x4*)(gb + col), b1 = *(const f32x4*)(gb + col + 4);
                    const f32x4 a0 = acc[ai][bj][m][0] + b0, a1 = acc[ai][bj][m][1] + b1; f32x4 v0, v1;
                    v0[0] = bflo(z.x) * sigmoidf_(a0[0]); v0[1] = bfhi(z.x) * sigmoidf_(a0[1]); v0[2] = bflo(z.y) * sigmoidf_(a0[2]); v0[3] = bfhi(z.y) * sigmoidf_(a0[3]);
                    v1[0] = bflo(z.z) * sigmoidf_(a1[0]); v1[1] = bfhi(z.z) * sigmoidf_(a1[1]); v1[2] = bflo(z.w) * sigmoidf_(a1[2]); v1[3] = bfhi(z.w) * sigmoidf_(a1[3]);
                    u32x4 w; w.x = cvt_pk_bf16(v0[0], v0[1]); w.y = cvt_pk_bf16(v0[2], v0[3]); w.z = cvt_pk_bf16(v1[0], v1[1]); w.w = cvt_pk_bf16(v1[2], v1[3]);
                    *(u32x4*)(O + row * 1024 + 512 + col) = w; }
                asm volatile("" ::: "memory"); }
    }
};

#ifndef PG8_SP2
#define PG8_SP2 1
#endif
template <class Epi, class Sched>
__device__ __forceinline__ void gemm_phase(PG8_LAS unsigned char* lds, const Gemm g, const Sched& S, const Epi& E, int tid_in) {
    int tid = tid_in; asm volatile("" : "+v"(tid));
    const int wid = __builtin_amdgcn_readfirstlane(tid >> 6), lane = tid & 63, wr = wid >> 2, wc = wid & 3, fr = lane & 15, fq = lane >> 4;
    int K = g.K; asm volatile("" : "+s"(K)); const int nt = K / BK;
    unsigned voffA[2], voffB[2];
#pragma unroll
    for (int i = 0; i < 2; ++i) { int R, C; stage_rc(tid * 16 + i * 8192, R, C); const int Rb = Epi::PERM ? ((R & ~31) + perm32(R & 31)) : R;
        voffA[i] = (unsigned)(R * g.lda + C) * 2u; voffB[i] = (unsigned)(Rb * g.ldb + C) * 2u; }
    const size_t kstep = (size_t)(BK * 2);
    const size_t hstepA = (size_t)HALF * g.lda * 2, hstepB = (size_t)HALF * g.ldb * 2;
    const unsigned ldsw = (unsigned)wid * 1024u;
    const int aoff = lds_byte(wr * 64 + fr, fq * 8), boff = lds_byte(wc * 32 + fr, fq * 8);
#define PG8_SA(b, h) (((b) * 2 + (h)) * HTB)
#define PG8_SB(b, h) ((4 + (b) * 2 + (h)) * HTB)
#define PG8_STAGE(bufoff, gbase, voff) do { _Pragma("unroll") for (int _i = 0; _i < 2; ++_i) \
        __builtin_amdgcn_global_load_lds((const unsigned*)((const char*)(gbase) + (voff)[_i]), (PG8_LAS unsigned*)(lds + (bufoff) + ldsw + _i * 8192), 16, 0, 0); } while (0)
#define PG8_LDA(dst, b, h) do { _Pragma("unroll") for (int m = 0; m < 4; ++m) _Pragma("unroll") for (int k = 0; k < 2; ++k) dst[m][k] = *(const PG8_LAS bf16x8*)(lds + PG8_SA(b, h) + aoff + m * 2048 + k * 1024); } while (0)
#define PG8_LDB(dst, b, h) do { _Pragma("unroll") for (int n = 0; n < 2; ++n) _Pragma("unroll") for (int k = 0; k < 2; ++k) dst[n][k] = *(const PG8_LAS bf16x8*)(lds + PG8_SB(b, h) + boff + n * 2048 + k * 1024); } while (0)
#define PG8_MMA(ai, bj, At, Bt) do { __builtin_amdgcn_s_setprio(1); _Pragma("unroll") for (int m = 0; m < 4; ++m) _Pragma("unroll") for (int n = 0; n < 2; ++n) _Pragma("unroll") for (int k = 0; k < 2; ++k) \
        acc[ai][bj][m][n] = __builtin_amdgcn_mfma_f32_16x16x32_bf16(Bt[n][k], At[m][k], acc[ai][bj][m][n], 0, 0, 0); __builtin_amdgcn_s_setprio(0); } while (0)
#define PG8_WAIT_V(n) asm volatile("s_waitcnt vmcnt(" #n ")" ::: "memory")
#define PG8_WAIT_L(n) asm volatile("s_waitcnt lgkmcnt(" #n ")" ::: "memory")
#define PG8_BAR __builtin_amdgcn_s_barrier()
#define PG8_SCHED __builtin_amdgcn_sched_barrier(0)
    Unit cur, nxt; int ui = 0;
    if (!S.next(0, cur)) return;
    f32x4 acc[2][2][4][2];
#pragma unroll
    for (int a = 0; a < 2; ++a)
#pragma unroll
        for (int b = 0; b < 2; ++b)
#pragma unroll
            for (int m = 0; m < 4; ++m)
#pragma unroll
                for (int n = 0; n < 2; ++n) acc[a][b][m][n] = (f32x4){0.f, 0.f, 0.f, 0.f};
    bf16x8 At[4][2], B0[2][2], B1[2][2];
    const char* cA = cur.A; const char* cB = cur.B;
#if PG8_SP2
    PG8_STAGE(PG8_SB(0, 0), cB, voffB); PG8_STAGE(PG8_SB(0, 1), cB + hstepB, voffB); PG8_STAGE(PG8_SA(0, 0), cA, voffA); PG8_STAGE(PG8_SA(0, 1), cA + hstepA, voffA);
    if (wr == 1) PG8_BAR;
    PG8_WAIT_V(2); PG8_BAR;
    PG8_STAGE(PG8_SB(1, 0), cB + kstep, voffB); PG8_STAGE(PG8_SA(1, 0), cA + kstep, voffA); PG8_STAGE(PG8_SB(1, 1), cB + hstepB + kstep, voffB);
    PG8_WAIT_V(6); PG8_BAR;
#else
    PG8_STAGE(PG8_SB(0, 0), cB, voffB); PG8_STAGE(PG8_SA(0, 0), cA, voffA); PG8_STAGE(PG8_SB(0, 1), cB + hstepB, voffB); PG8_STAGE(PG8_SA(0, 1), cA + hstepA, voffA);
    if (wr == 1) PG8_BAR;
    PG8_WAIT_V(4); PG8_BAR;
    PG8_STAGE(PG8_SB(1, 0), cB + kstep, voffB); PG8_STAGE(PG8_SA(1, 0), cA + kstep, voffA); PG8_STAGE(PG8_SB(1, 1), cB + hstepB + kstep, voffB);
    PG8_WAIT_V(6); PG8_BAR;
#endif
    for (;;) {
        const bool has_next = S.next(ui + 1, nxt);
        const char* nA = has_next ? nxt.A : cA; const char* nB = has_next ? nxt.B : cB;
#pragma unroll 1
        for (int t = 0; t < nt; t += 2) {
            const bool last = (t == nt - 2);
            const char* a1 = cA + (size_t)(t + 1) * kstep;
            const char* a2 = last ? nA : cA + (size_t)(t + 2) * kstep; const char* b2 = last ? nB : cB + (size_t)(t + 2) * kstep;
            const char* a3 = a2 + kstep; const char* b3 = b2 + kstep;
#if PG8_SP2
            PG8_LDB(B0, 0, 0); PG8_LDB(B1, 0, 1); PG8_SCHED; PG8_LDA(At, 0, 0); PG8_STAGE(PG8_SA(1, 1), a1 + hstepA, voffA);
            PG8_WAIT_V(8); PG8_WAIT_L(0); PG8_BAR; PG8_MMA(0, 0, At, B0); PG8_MMA(0, 1, At, B1); PG8_BAR; PG8_SCHED;
            PG8_LDA(At, 0, 1); PG8_STAGE(PG8_SB(0, 0), b2, voffB); PG8_STAGE(PG8_SB(0, 1), b2 + hstepB, voffB); PG8_STAGE(PG8_SA(0, 0), a2, voffA);
            PG8_WAIT_V(8); PG8_WAIT_L(0); PG8_BAR; PG8_MMA(1, 0, At, B0); PG8_MMA(1, 1, At, B1); PG8_BAR; PG8_SCHED;
            PG8_LDB(B0, 1, 0); PG8_LDB(B1, 1, 1); PG8_SCHED; PG8_LDA(At, 1, 0); PG8_STAGE(PG8_SA(0, 1), a2 + hstepA, voffA);
            PG8_WAIT_V(8); PG8_WAIT_L(0); PG8_BAR; PG8_MMA(0, 0, At, B0); PG8_MMA(0, 1, At, B1); PG8_BAR; PG8_SCHED;
            PG8_LDA(At, 1, 1); PG8_STAGE(PG8_SB(1, 0), b3, voffB); PG8_STAGE(PG8_SB(1, 1), b3 + hstepB, voffB); PG8_STAGE(PG8_SA(1, 0), a3, voffA);
            PG8_WAIT_V(8); PG8_WAIT_L(0); PG8_BAR; PG8_MMA(1, 0, At, B0); PG8_MMA(1, 1, At, B1); PG8_BAR; PG8_SCHED;
#else
            PG8_LDB(B0, 0, 0); PG8_SCHED; PG8_LDA(At, 0, 0); PG8_STAGE(PG8_SA(1, 1), a1 + hstepA, voffA);
            PG8_WAIT_L(8); PG8_BAR; PG8_WAIT_L(0); PG8_MMA(0, 0, At, B0); PG8_BAR; PG8_SCHED;
            PG8_LDB(B1, 0, 1); PG8_STAGE(PG8_SB(0, 0), b2, voffB);
            PG8_BAR; PG8_WAIT_L(0); PG8_MMA(0, 1, At, B1); PG8_BAR;
            PG8_LDA(At, 0, 1); PG8_STAGE(PG8_SA(0, 0), a2, voffA);
            PG8_BAR; PG8_WAIT_L(0); PG8_MMA(1, 0, At, B0); PG8_BAR; PG8_SCHED;
            PG8_STAGE(PG8_SB(0, 1), b2 + hstepB, voffB);
            PG8_WAIT_V(6); PG8_BAR; PG8_MMA(1, 1, At, B1); PG8_BAR;
            PG8_LDB(B0, 1, 0); PG8_SCHED; PG8_LDA(At, 1, 0); PG8_STAGE(PG8_SA(0, 1), a2 + hstepA, voffA);
            PG8_WAIT_L(8); PG8_BAR; PG8_WAIT_L(0); PG8_MMA(0, 0, At, B0); PG8_BAR; PG8_SCHED;
            PG8_LDB(B1, 1, 1); PG8_STAGE(PG8_SB(1, 0), b3, voffB);
            PG8_BAR; PG8_WAIT_L(0); PG8_MMA(0, 1, At, B1); PG8_BAR;
            PG8_LDA(At, 1, 1); PG8_STAGE(PG8_SA(1, 0), a3, voffA);
            PG8_BAR; PG8_WAIT_L(0); PG8_MMA(1, 0, At, B0); PG8_BAR; PG8_SCHED;
            PG8_STAGE(PG8_SB(1, 1), b3 + hstepB, voffB);
            PG8_WAIT_V(6); PG8_BAR; PG8_MMA(1, 1, At, B1); PG8_BAR;
#endif
        }
        if (wr == 0) PG8_BAR;
        E(acc, cur, wr, wc, fr, fq);
        if (!has_next) break;
#pragma unroll
        for (int a = 0; a < 2; ++a)
#pragma unroll
            for (int b = 0; b < 2; ++b)
#pragma unroll
                for (int m = 0; m < 4; ++m)
#pragma unroll
                    for (int n = 0; n < 2; ++n) acc[a][b][m][n] = (f32x4){0.f, 0.f, 0.f, 0.f};
        cur = nxt; cA = nA; cB = nB; ++ui;
        if (wr == 1) PG8_BAR;
    }
    PG8_WAIT_V(0);
    PG8_BAR;
#undef PG8_SA
#undef PG8_SB
#undef PG8_STAGE
#undef PG8_LDA
#undef PG8_LDB
#undef PG8_MMA
#undef PG8_WAIT_V
#undef PG8_WAIT_L
#undef PG8_BAR
#undef PG8_SCHED
}

struct MergeUnit { const char* A; const char* B; int orow, ocol, z; };
template <class Sched>
__device__ __forceinline__ void gemm_merge_phase(PG8_LAS unsigned char* lds, const Gemm g, const Sched& S, const bf16_t* G, bf16_t* MB, int tid_in) {
    int tid = tid_in; asm volatile("" : "+v"(tid));
    const int wid = __builtin_amdgcn_readfirstlane(tid >> 6), lane = tid & 63, wr = wid >> 2, wc = wid & 3, fr = lane & 15, fq = lane >> 4;
    int K = g.K; asm volatile("" : "+s"(K)); const int nt = K / BK;
    unsigned voffA[2], voffB[2];
#pragma unroll
    for (int i = 0; i < 2; ++i) { int R, C; stage_rc(tid * 16 + i * 8192, R, C); const int Rb = (R & ~31) + perm32(R & 31);
        voffA[i] = (unsigned)(R * g.lda + C) * 2u; voffB[i] = (unsigned)(Rb * g.ldb + C) * 2u; }
    const size_t kstep = (size_t)(BK * 2);
    const size_t hstepA = (size_t)HALF * g.lda * 2;
    const unsigned ldsw = (unsigned)wid * 1024u;
    const int aoff = lds_byte(wr * 64 + fr, fq * 8), boff = lds_byte(wc * 32 + fr, fq * 8);
#define PG8_SA(b, h) (((b) * 2 + (h)) * HTB)
#define PG8_SB(b, h) ((4 + (b) * 2 + (h)) * HTB)
#define PG8_STAGE(bufoff, gbase, voff) do { _Pragma("unroll") for (int _i = 0; _i < 2; ++_i) \
        __builtin_amdgcn_global_load_lds((const unsigned*)((const char*)(gbase) + (voff)[_i]), (PG8_LAS unsigned*)(lds + (bufoff) + ldsw + _i * 8192), 16, 0, 0); } while (0)
#define PG8_LDA(dst, b, h) do { _Pragma("unroll") for (int m = 0; m < 4; ++m) _Pragma("unroll") for (int k = 0; k < 2; ++k) dst[m][k] = *(const PG8_LAS bf16x8*)(lds + PG8_SA(b, h) + aoff + m * 2048 + k * 1024); } while (0)
#define PG8_LDB(dst, b, h) do { _Pragma("unroll") for (int n = 0; n < 2; ++n) _Pragma("unroll") for (int k = 0; k < 2; ++k) dst[n][k] = *(const PG8_LAS bf16x8*)(lds + PG8_SB(b, h) + boff + n * 2048 + k * 1024); } while (0)
#define PG8_MMA1(ai, At, Bt) do { __builtin_amdgcn_s_setprio(1); _Pragma("unroll") for (int m = 0; m < 4; ++m) _Pragma("unroll") for (int n = 0; n < 2; ++n) _Pragma("unroll") for (int k = 0; k < 2; ++k) \
        acc[ai][m][n] = __builtin_amdgcn_mfma_f32_16x16x32_bf16(Bt[n][k], At[m][k], acc[ai][m][n], 0, 0, 0); __builtin_amdgcn_s_setprio(0); } while (0)
#define PG8_WAIT_V(n) asm volatile("s_waitcnt vmcnt(" #n ")" ::: "memory")
#define PG8_WAIT_L(n) asm volatile("s_waitcnt lgkmcnt(" #n ")" ::: "memory")
#define PG8_BAR __builtin_amdgcn_s_barrier()
#define PG8_SCHED __builtin_amdgcn_sched_barrier(0)
    MergeUnit cur, nxt; int ui = 0;
    if (!S.next(0, cur)) return;
    f32x4 acc[2][4][2], mrg[2][4][2];
#pragma unroll
    for (int a = 0; a < 2; ++a)
#pragma unroll
        for (int m = 0; m < 4; ++m)
#pragma unroll
            for (int n = 0; n < 2; ++n) { acc[a][m][n] = (f32x4){0.f, 0.f, 0.f, 0.f}; mrg[a][m][n] = (f32x4){0.f, 0.f, 0.f, 0.f}; }
    bf16x8 At[4][2], B0[2][2];
    const char* cA = cur.A; const char* cB = cur.B;
    PG8_STAGE(PG8_SB(0, 0), cB, voffB); PG8_STAGE(PG8_SA(0, 0), cA, voffA); PG8_STAGE(PG8_SA(0, 1), cA + hstepA, voffA);
    if (wr == 1) PG8_BAR;
    PG8_WAIT_V(2); PG8_BAR;
    PG8_STAGE(PG8_SB(1, 0), cB + kstep, voffB); PG8_STAGE(PG8_SA(1, 0), cA + kstep, voffA);
    PG8_WAIT_V(4); PG8_BAR;
    for (;;) {
        const bool has_next = S.next(ui + 1, nxt);
        const char* nA = has_next ? nxt.A : cA; const char* nB = has_next ? nxt.B : cB;
#pragma unroll 1
        for (int t = 0; t < nt; t += 2) {
            const bool last = (t == nt - 2);
            const char* a1 = cA + (size_t)(t + 1) * kstep;
            const char* a2 = last ? nA : cA + (size_t)(t + 2) * kstep; const char* b2 = last ? nB : cB + (size_t)(t + 2) * kstep;
            const char* a3 = a2 + kstep; const char* b3 = b2 + kstep;
            PG8_LDB(B0, 0, 0); PG8_SCHED; PG8_LDA(At, 0, 0); PG8_STAGE(PG8_SA(1, 1), a1 + hstepA, voffA);
            PG8_WAIT_V(6); PG8_WAIT_L(0); PG8_BAR; PG8_MMA1(0, At, B0); PG8_BAR; PG8_SCHED;
            PG8_LDA(At, 0, 1); PG8_STAGE(PG8_SB(0, 0), b2, voffB); PG8_STAGE(PG8_SA(0, 0), a2, voffA);
            PG8_WAIT_V(6); PG8_WAIT_L(0); PG8_BAR; PG8_MMA1(1, At, B0); PG8_BAR; PG8_SCHED;
            PG8_LDB(B0, 1, 0); PG8_SCHED; PG8_LDA(At, 1, 0); PG8_STAGE(PG8_SA(0, 1), a2 + hstepA, voffA);
            PG8_WAIT_V(6); PG8_WAIT_L(0); PG8_BAR; PG8_MMA1(0, At, B0); PG8_BAR; PG8_SCHED;
            PG8_LDA(At, 1, 1); PG8_STAGE(PG8_SB(1, 0), b3, voffB); PG8_STAGE(PG8_SA(1, 0), a3, voffA);
            PG8_WAIT_V(6); PG8_WAIT_L(0); PG8_BAR; PG8_MMA1(1, At, B0); PG8_BAR; PG8_SCHED;
        }
        if (wr == 0) PG8_BAR;
        {
            const int row0 = cur.orow + wr * 64 + fr, col0 = cur.ocol + wc * 32 + 8 * fq, z = cur.z;
            u32x4 gq[2][4];
#pragma unroll
            for (int ai = 0; ai < 2; ++ai)
#pragma unroll
                for (int m = 0; m < 4; ++m) gq[ai][m] = *(const u32x4*)(G + (size_t)(row0 + ai * HALF + m * 16) * 4096 + z * 1024 + col0);
#pragma unroll
            for (int ai = 0; ai < 2; ++ai)
#pragma unroll
                for (int m = 0; m < 4; ++m) { const size_t row = (size_t)(row0 + ai * HALF + m * 16);
                    const u32x4 gv = gq[ai][m];
                    f32x4 v0 = acc[ai][m][0], v1 = acc[ai][m][1];
                    v0[0] *= bflo(gv.x); v0[1] *= bfhi(gv.x); v0[2] *= bflo(gv.y); v0[3] *= bfhi(gv.y);
                    v1[0] *= bflo(gv.z); v1[1] *= bfhi(gv.z); v1[2] *= bflo(gv.w); v1[3] *= bfhi(gv.w);
                    if (z == 0) { mrg[ai][m][0] = v0; mrg[ai][m][1] = v1; } else { mrg[ai][m][0] += v0; mrg[ai][m][1] += v1; }
                    acc[ai][m][0] = (f32x4){0.f, 0.f, 0.f, 0.f}; acc[ai][m][1] = (f32x4){0.f, 0.f, 0.f, 0.f};
                    if (z == 3) { const f32x4 o0 = mrg[ai][m][0], o1 = mrg[ai][m][1];
                        u32x4 w; w.x = cvt_pk_bf16(o0[0], o0[1]); w.y = cvt_pk_bf16(o0[2], o0[3]); w.z = cvt_pk_bf16(o1[0], o1[1]); w.w = cvt_pk_bf16(o1[2], o1[3]);
                        *(u32x4*)(MB + row * 1024 + col0) = w; } }
        }
        if (!has_next) break;
        cur = nxt; cA = nA; cB = nB; ++ui;
        if (wr == 1) PG8_BAR;
    }
    PG8_WAIT_V(0);
    PG8_BAR;
#undef PG8_SA
#undef PG8_SB
#undef PG8_STAGE
#undef PG8_LDA
#undef PG8_LDB
#undef PG8_MMA1
#undef PG8_WAIT_V
#undef PG8_WAIT_L
#undef PG8_BAR
#undef PG8_SCHED
}
}
#define XB_TMO      128
#define XB_XCNT(j)  (256  + 64 * (j))
#define XB_XSUB(j)  (1280 + 64 * (j))
#define XB_XGEN(j)  (2304 + 64 * (j))
#define XB_TOP      3328
#define XB_TOPGEN   3392
#define XCD_BAR_WORDS 3456
#define XB_SPIN_CAP (1u << 18)

__device__ __forceinline__ unsigned xb_ld(unsigned* p)              { return __hip_atomic_load(p, __ATOMIC_RELAXED, __HIP_MEMORY_SCOPE_AGENT); }
__device__ __forceinline__ unsigned xb_add(unsigned* p, unsigned v) { return __hip_atomic_fetch_add(p, v, __ATOMIC_RELAXED, __HIP_MEMORY_SCOPE_AGENT); }
__device__ __forceinline__ unsigned xb_xcc_id() { return (unsigned)__builtin_amdgcn_s_getreg((3 << 11) | 20) & 0xFu; }
#define XB_SPIN(cond, bar) do { unsigned _sp = 0; while (cond) { __builtin_amdgcn_s_sleep(1); \
    if ((++_sp & 255u) == 0u) { if (xb_ld(&(bar)[XB_TMO])) break; if (_sp > XB_SPIN_CAP) { atomicAdd(&(bar)[XB_TMO], 1u); break; } } } } while (0)

struct XcdBarrier {
    unsigned* bar; unsigned x;
    volatile LAS unsigned* st;
};

__device__ __forceinline__ XcdBarrier xcd_barrier_post(unsigned* bar, volatile LAS unsigned* st) {
    XcdBarrier b; b.bar = bar; b.x = xb_xcc_id(); b.st = st;
    if (threadIdx.x == 0) (void)xb_add(&bar[XB_XCNT(b.x)], 1u);
    return b;
}
__device__ __forceinline__ void xcd_barrier_complete(unsigned* bar, unsigned x, unsigned& nloc, unsigned& nx) {
    const unsigned G = gridDim.x * gridDim.y * gridDim.z;
    unsigned sum, cnt, mine, sp = 0u;
    for (;;) {
        sum = 0u; cnt = 0u; mine = 0u;
#pragma unroll
        for (unsigned j = 0; j < 16; ++j) { const unsigned c = xb_ld(&bar[XB_XCNT(j)]); sum += c; cnt += (c > 0u) ? 1u : 0u; mine = (j == x) ? c : mine; }
        if (sum == G) break;
        __builtin_amdgcn_s_sleep(1);
        if ((++sp & 255u) == 0u) { if (xb_ld(&bar[XB_TMO])) break; if (sp > XB_SPIN_CAP) { atomicAdd(&bar[XB_TMO], 1u); break; } }
    }
    nloc = mine > 0u ? mine : 1u; nx = cnt > 0u ? cnt : 1u;
}

__device__ __forceinline__ void xcd_barrier(const XcdBarrier& b, int tid_now) {
    asm volatile("s_waitcnt vmcnt(0)" ::: "memory");
    __syncthreads();
    if (tid_now == 0) {
        unsigned* bar = b.bar;
        __builtin_amdgcn_s_waitcnt(0);
        unsigned nloc = b.st[0], nx = b.st[1];
        if (nloc == 0u) { xcd_barrier_complete(bar, b.x, nloc, nx); b.st[0] = nloc; b.st[1] = nx; }
        const unsigned old = xb_add(&bar[XB_XSUB(b.x)], 1u);
        const unsigned gen = old / nloc;
        if (old + 1u == (gen + 1u) * nloc) {
            __builtin_amdgcn_fence(__ATOMIC_RELEASE, "agent");
            asm volatile("s_waitcnt vmcnt(0)" ::: "memory");
            const unsigned og = xb_add(&bar[XB_TOP], 1u);
            const unsigned tg = og / nx;
            if (og + 1u == (tg + 1u) * nx) xb_add(&bar[XB_TOPGEN], 1u);
            else XB_SPIN(xb_ld(&bar[XB_TOPGEN]) == tg, bar);
            __builtin_amdgcn_fence(__ATOMIC_ACQUIRE, "agent");
            xb_add(&bar[XB_XGEN(b.x)], 1u);
            asm volatile("s_waitcnt vmcnt(0)" ::: "memory");
        } else {
            XB_SPIN(xb_ld(&bar[XB_XGEN(b.x)]) == gen, bar);
            __builtin_amdgcn_fence(__ATOMIC_ACQUIRE, "agent");
            asm volatile("s_waitcnt vmcnt(0)" ::: "memory");
        }
    }
    __syncthreads();
}

struct Args { const float* in[N_INPUTS]; float* out; unsigned char* ws; int ph_lo, ph_hi, l_lo, l_hi; };
struct Frame {
    LAS unsigned char* lds;
    volatile LAS unsigned* MISC;
    gu32* ctl;
    int tid, lane, wave, G, bid, zoff;
    unsigned char* ws;
    float* out;
};
#define FIN(k) (args.in[k])
#define WSP(T, off) ((T*)(F.ws + (off)))

__device__ __forceinline__ int wq_grab(Frame& F, int qid) {
    __syncthreads();
    if (F.tid == 0) F.MISC[16] = __hip_atomic_fetch_add((unsigned*)(F.ctl + CW_Q + qid * 64), 1u, RLX_AGENT);
    __syncthreads();
    return (int)F.MISC[16];
}
__device__ __forceinline__ float block_sum(Frame& F, float v, LAS float* red  ) {
    v = wave_sum(v);
    __syncthreads();
    if (F.lane == 0) red[F.wave] = v;
    __syncthreads();
    float s = 0.f;
#pragma unroll
    for (int w = 0; w < 8; ++w) s += red[w];
    return s;
}

__device__ __forceinline__ void ln_row(f32x4 (&v)[4], const float* g, const float* b, int lane) {
    float s = 0.f;
#pragma unroll
    for (int j = 0; j < 4; ++j) s += (v[j].x + v[j].y) + (v[j].z + v[j].w);
    const float mean = wave_sum(s) * (1.f / DM); float s2 = 0.f;
#pragma unroll
    for (int j = 0; j < 4; ++j) { v[j] = v[j] - mean; s2 += (v[j].x * v[j].x + v[j].y * v[j].y) + (v[j].z * v[j].z + v[j].w * v[j].w); }
    const float rstd = 1.f / sqrtf(wave_sum(s2) * (1.f / DM) + LN_EPS);
#pragma unroll
    for (int j = 0; j < 4; ++j) { const f32x4 gg = *(const f32x4*)(g + 4 * lane + 256 * j), bb = *(const f32x4*)(b + 4 * lane + 256 * j); v[j] = v[j] * rstd * gg + bb; }
}
__device__ __forceinline__ void store_row_bf16(const f32x4 (&v)[4], bf16* o16, int lane) {
#pragma unroll
    for (int j = 0; j < 4; ++j) { v2u w; w.x = pk2(v[j].x, v[j].y); w.y = pk2(v[j].z, v[j].w); *(v2u*)(o16 + 4 * lane + 256 * j) = w; }
}
__device__ __forceinline__ void load_row_bf16(f32x4 (&v)[4], const bf16* p, int lane, float scale) {
#pragma unroll
    for (int j = 0; j < 4; ++j) { const v2u w = *(const v2u*)(p + 4 * lane + 256 * j); v[j] = (f32x4){bflo(w.x), bfhi(w.x), bflo(w.y), bfhi(w.y)} * scale; }
}
__device__ __forceinline__ void store_row_f32_bf16(const f32x4 (&v)[4], float* o32, bf16* o16, int lane) {
#pragma unroll
    for (int j = 0; j < 4; ++j) { *(f32x4*)(o32 + 4 * lane + 256 * j) = v[j];
        v2u w; w.x = pk2(v[j].x, v[j].y); w.y = pk2(v[j].z, v[j].w); *(v2u*)(o16 + 4 * lane + 256 * j) = w; }
}

struct CvItem { const float* src; bf16* dst; int ldw, ldd; };
constexpr int CV_IN = 16 * 124, CV_BR = 4 * 4 * 16, CV_OUT = 16 * 16, CV_GLU = 4 * 4, CV_EX = 16 * 256, CV_NIT = CV_IN + CV_BR + CV_OUT + CV_GLU + 3 * CV_EX;
__device__ __forceinline__ CvItem cv_decode(Frame& F, const Args& args, int l, int it) {
    unsigned char* wb = F.ws + WS_W; CvItem c; int r = it;
    if (r < CV_IN) { const int kb = r / 124, nb = r % 124; c.src = FIN(I_WIN) + (size_t)l * DM * NIN + (size_t)(64 * kb) * NIN + 64 * nb; c.ldw = NIN;
        c.dst = (bf16*)(wb + W_WIN) + (size_t)(64 * nb) * 1024 + 64 * kb; c.ldd = 1024; return c; } r -= CV_IN;
    if (r < CV_BR) { const int i = r / 64, q = r % 64, kb = q / 16, nb = q % 16; c.src = FIN(I_WBR) + ((size_t)l * 4 + i) * 256 * 1024 + (size_t)(64 * kb) * 1024 + 64 * nb; c.ldw = 1024;
        c.dst = (bf16*)(wb + W_WB) + (size_t)i * 1024 * 256 + (size_t)(64 * nb) * 256 + 64 * kb; c.ldd = 256; return c; } r -= CV_BR;
    if (r < CV_OUT) { const int kb = r / 16, nb = r % 16; c.src = FIN(I_WOUT) + (size_t)l * 1024 * 1024 + (size_t)(64 * kb) * 1024 + 64 * nb; c.ldw = 1024;
        c.dst = (bf16*)(wb + W_WO) + (size_t)(64 * nb) * 1024 + 64 * kb; c.ldd = 1024; return c; } r -= CV_OUT;
    if (r < CV_GLU) { const int kb = r / 4, nb = r % 4; c.src = FIN(I_S5_GW) + (size_t)l * 256 * 256 + (size_t)(64 * kb) * 256 + 64 * nb; c.ldw = 256;
        c.dst = (bf16*)(wb + W_GLU) + (size_t)(64 * nb) * 256 + 64 * kb; c.ldd = 256; return c; } r -= CV_GLU;
    const int which = r / CV_EX, q = r % CV_EX, e = q / 256, q2 = q % 256, kb = q2 / 16, nb = q2 % 16;
    const size_t esz = (size_t)1024 * 1024, so = ((size_t)l * NE + e) * esz + (size_t)(64 * kb) * 1024 + 64 * nb;
    c.ldw = 1024; c.ldd = 1024;
    if (which == 2) { c.src = FIN(I_EWD) + so; c.dst = (bf16*)(wb + W_DN) + (size_t)e * esz + (size_t)(64 * nb) * 1024 + 64 * kb; }
    else {
        c.src = (which == 0 ? FIN(I_EWG) : FIN(I_EWU)) + so; const int f0 = 64 * nb;
        c.dst = (bf16*)(wb + W_GU) + (size_t)e * 2048 * 1024 + (size_t)((f0 >> 7) * 256 + which * 128 + (f0 & 127)) * 1024 + 64 * kb; }
    return c;
}
__device__ __forceinline__ void cv_load(f32x4 (&v)[16], const CvItem& c, int lane) {
    const float* p = c.src + (size_t)(lane >> 4) * c.ldw + 4 * (lane & 15);
#pragma unroll
    for (int i = 0; i < 16; ++i) v[i] = *(const f32x4*)(p + (size_t)(4 * i) * c.ldw);
}
__device__ __forceinline__ void cv_store(const f32x4 (&v)[16], const CvItem& c, LAS float* scr, int lane) {
    LAS float* w = scr + (lane >> 4) * 65 + 4 * (lane & 15);
#pragma unroll
    for (int i = 0; i < 16; ++i) { w[(4 * i) * 65 + 0] = v[i].x; w[(4 * i) * 65 + 1] = v[i].y; w[(4 * i) * 65 + 2] = v[i].z; w[(4 * i) * 65 + 3] = v[i].w; }
    LDS_WAIT(); asm volatile("" ::: "memory");
    const int c8 = lane & 7;
#pragma unroll
    for (int j = 0; j < 8; ++j) { const int n = (lane >> 3) + 8 * j; const LAS float* s = scr + (8 * c8) * 65 + n;
        v4u o; o.x = pg8::cvt_pk_bf16(s[0 * 65], s[1 * 65]); o.y = pg8::cvt_pk_bf16(s[2 * 65], s[3 * 65]); o.z = pg8::cvt_pk_bf16(s[4 * 65], s[5 * 65]); o.w = pg8::cvt_pk_bf16(s[6 * 65], s[7 * 65]);
        *(v4u*)(c.dst + (size_t)n * c.ldd + 8 * c8) = o; }
    LDS_WAIT(); asm volatile("" ::: "memory");
}
__device__ __forceinline__ void convert_layer(Frame& F, const Args& args, int l, int gw, int NGW) {
    LAS float* scr = (LAS float*)(F.lds + F.wave * 16640);
    int it = gw; if (it >= CV_NIT) return;
    CvItem c0 = cv_decode(F, args, l, it); f32x4 a[16]; cv_load(a, c0, F.lane);
    for (;;) {
        const int it1 = it + NGW; const bool more = it1 < CV_NIT; CvItem c1 = c0; f32x4 b[16];
        if (more) { c1 = cv_decode(F, args, l, it1); cv_load(b, c1, F.lane); }
        asm volatile("" ::: "memory");
        cv_store(a, c0, scr, F.lane);
        if (!more) break;
        it = it1; c0 = c1;
#pragma unroll
        for (int i = 0; i < 16; ++i) a[i] = b[i];
    }
}

__device__ __forceinline__ f32x2 cmul(f32x2 a, f32x2 b) { return (f32x2){a.x * b.x - a.y * b.y, a.x * b.y + a.y * b.x}; }

__device__ __forceinline__ void s5_build_item(Frame& F, const Args& args, int l, int g, int q4  ) {
    LAS f32x2* ap = (LAS f32x2*)F.lds;
    LAS f32x2* bb = ap + 2 * 64 * 33;
    LAS f32x2* cm = bb + 2 * 64 * 16;
    LAS float* kern = (LAS float*)(cm + 2 * 16 * 64);
    const int tid = F.tid;
    __syncthreads();
    if (tid < 128) {
        const int dir = tid >> 6, p = tid & 63; const size_t gi = ((size_t)(l * 2 + dir) * 16 + g);
        const float lre = FIN(I_S5_LRE)[gi * 64 + p], lim = FIN(I_S5_LIM)[gi * 64 + p], dt = expf(FIN(I_S5_LDT)[gi]);
        const float x = lre * dt, y = lim * dt;
        for (int tau = 0; tau <= 32; ++tau) { float s, c; sincosf((float)tau * y, &s, &c); const float e = expf((float)tau * x); ap[(dir * 64 + p) * 33 + tau] = (f32x2){e * c, e * s}; }
        if (q4 == 0) { float s, c; sincosf(32.f * y, &s, &c); const float e = expf(32.f * x); WSP(f32x2, WS_S5A32)[gi * 64 + p] = (f32x2){e * c, e * s}; }
        float s1, c1; sincosf(y, &s1, &c1); const float sh = sinf(0.5f * y);
        const f32x2 em1 = (f32x2){expm1f(x) * c1 - 2.f * sh * sh, expf(x) * s1};
        const float inv = 1.f / (lre * lre + lim * lim);
        const f32x2 q = (f32x2){(em1.x * lre + em1.y * lim) * inv, (em1.y * lre - em1.x * lim) * inv};
        for (int ci = 0; ci < 16; ++ci) { const f32x2 bm = (f32x2){FIN(I_S5_BRE)[(gi * 64 + p) * 16 + ci], FIN(I_S5_BIM)[(gi * 64 + p) * 16 + ci]}; bb[(dir * 64 + p) * 16 + ci] = cmul(q, bm); }
    }
    for (int i = tid; i < 2 * 16 * 64; i += 512) { const int dir = i >> 10, co = (i >> 6) & 15, p = i & 63; const size_t gi = ((size_t)(l * 2 + dir) * 16 + g);
        cm[i] = (f32x2){FIN(I_S5_CRE)[(gi * 16 + co) * 64 + p], FIN(I_S5_CIM)[(gi * 16 + co) * 64 + p]}; }
    __syncthreads();
    for (int e4 = tid; e4 < 63 * 64; e4 += 512) {
        const int ti = e4 >> 6, co = 4 * q4 + ((e4 >> 4) & 3), ci = e4 & 15, tau = ti - 31, e = ti * 256 + co * 16 + ci; float acc = 0.f;
        if (tau >= 0) for (int p = 0; p < 64; ++p) { const f32x2 w = cmul(cm[(0 * 16 + co) * 64 + p], ap[(0 * 64 + p) * 33 + tau]); const f32x2 b = bb[(0 * 64 + p) * 16 + ci]; acc += w.x * b.x - w.y * b.y; }
        if (tau <= 0) for (int p = 0; p < 64; ++p) { const f32x2 w = cmul(cm[(1 * 16 + co) * 64 + p], ap[(1 * 64 + p) * 33 - tau]); const f32x2 b = bb[(1 * 64 + p) * 16 + ci]; acc += w.x * b.x - w.y * b.y; }
        if (tau == 0 && co == ci) acc += FIN(I_S5_D)[l * 256 + g * 16 + co];
        kern[e] = acc;
    }
    __syncthreads();
    bf16* wcat = (bf16*)(F.ws + WS_S5W + (size_t)l * S5W_LAYER + S5_WCAT_OFF) + (size_t)g * 512 * 768;
    for (int ch = tid; ch < 128 * 96; ch += 512) {
        const int ml = ch / 96, k8 = ch % 96, t = ml >> 2, co = 4 * q4 + (ml & 3), m = 16 * t + co; float v[8];
        if (k8 < 64) { const int j = k8 >> 1, ci0 = (k8 & 1) * 8;
#pragma unroll
            for (int e = 0; e < 8; ++e) v[e] = kern[(t - j + 31) * 256 + co * 16 + ci0 + e]; }
        else { const int kk = (k8 - 64) * 8, dir = kk >> 7, p0 = (kk & 127) >> 1, tau = dir == 0 ? t + 1 : 32 - t;
#pragma unroll
            for (int pp = 0; pp < 4; ++pp) { const f32x2 w = cmul(cm[(dir * 16 + co) * 64 + p0 + pp], ap[(dir * 64 + p0 + pp) * 33 + tau]); v[2 * pp] = w.x; v[2 * pp + 1] = -w.y; } }
        v4u o; o.x = pk2(v[0], v[1]); o.y = pk2(v[2], v[3]); o.z = pk2(v[4], v[5]); o.w = pk2(v[6], v[7]);
        *(v4u*)(wcat + (size_t)m * 768 + k8 * 8) = o;
    }
    bf16* wst = (bf16*)(F.ws + WS_S5W + (size_t)l * S5W_LAYER + S5_WST_OFF) + (size_t)g * 2 * 128 * 512;
    if (q4 == 0) for (int ch = tid; ch < 2 * 128 * 64; ch += 512) {
        const int dir = ch >> 13, o = (ch >> 6) & 127, k8 = ch & 63, p = o >> 1, ri = o & 1, j = k8 >> 1, ci0 = (k8 & 1) * 8; float v[8];
        const f32x2 a = ap[(dir * 64 + p) * 33 + (dir == 0 ? 31 - j : j)];
#pragma unroll
        for (int e = 0; e < 8; ++e) { const f32x2 w = cmul(a, bb[(dir * 64 + p) * 16 + ci0 + e]); v[e] = ri ? w.y : w.x; }
        v4u q; q.x = pk2(v[0], v[1]); q.y = pk2(v[2], v[3]); q.z = pk2(v[4], v[5]); q.w = pk2(v[6], v[7]);
        *(v4u*)(wst + ((size_t)dir * 128 + o) * 512 + k8 * 8) = q;
    }
    __syncthreads();
}

__device__ __forceinline__ void hf2_item(Frame& F, const Args& args, int l, int t) {
    const int lane = F.lane;
    const float tn = (float)t * (1.f / 4095.f), w = 6.283185307179586f * (float)t * (1.f / 4096.f);
    float zv = 0.f;
    if (lane == 0) zv = tn;
    else if (lane <= 16) { const float f = 1e-4f + (float)(lane - 1) * ((15.f - 1e-4f) / 15.f); zv = cosf(f * w); }
    else if (lane <= 32) { const float f = 1e-4f + (float)(lane - 17) * ((15.f - 1e-4f) / 15.f); zv = -sinf(f * w); }
    float acc = FIN(I_HY_B1)[l * 64 + lane];
    const float* w1 = FIN(I_HY_W1) + (size_t)l * 33 * 64;
    for (int i = 0; i < 33; ++i) acc += __shfl(zv, i) * w1[i * 64 + lane];
    const float f1 = sinf(FIN(I_HY_FREQ)[(l * 2 + 0) * 64 + lane] * acc);
    float acc2 = FIN(I_HY_B2)[l * 64 + lane];
    const float* w2 = FIN(I_HY_W2) + (size_t)l * 64 * 64;
    for (int i = 0; i < 64; ++i) acc2 += __shfl(f1, i) * w2[i * 64 + lane];
    WSP(float, WS_HF2)[((size_t)l * 4096 + t) * 64 + lane] = sinf(FIN(I_HY_FREQ)[(l * 2 + 1) * 64 + lane] * acc2);
}

__device__ __forceinline__ void prologue_phase(Frame& F, const Args& args) {
    const int gw = F.bid * 8 + F.wave, NGW = F.G * 8;
    for (int it = F.bid; it < DEPTH * 16 * 4; it += F.G) s5_build_item(F, args, it >> 6, (it >> 2) & 15, it & 3);
    __syncthreads();
    { const int gi = F.bid * 512 + F.tid; if (gi < 1024) { const int pos = gi >> 4, i = gi & 15; const float inv = expf(-(float)(2 * i) * (1.f / 32.f) * 9.210340371976184f);
        float s, c; sincosf((float)pos * inv, &s, &c); WSP(f32x2, WS_ROPE)[gi] = (f32x2){c, s}; } }
    for (int it = gw; it < DEPTH * 4096; it += NGW) hf2_item(F, args, it >> 12, it & 4095);
    for (int m = gw; m < M; m += NGW) { f32x4 v[4];
#pragma unroll
        for (int j = 0; j < 4; ++j) v[j] = *(const f32x4*)(FIN(I_X) + (size_t)m * DM + 4 * F.lane + 256 * j);
        ln_row(v, FIN(I_LNIN_G), FIN(I_LNIN_B), F.lane);
        store_row_bf16(v, WSP(bf16, WS_HB) + (size_t)m * DM, F.lane); }
    convert_layer(F, args, 0, gw, NGW);
}
namespace attn_body {
using bf16=__hip_bfloat16;
using bf16x8=__attribute__((ext_vector_type(8)))short;
using s16x4=__attribute__((ext_vector_type(4)))short;
using f32x16=__attribute__((ext_vector_type(16)))float;
using u32x4=__attribute__((ext_vector_type(4)))unsigned;
constexpr int SEQ=4096,D=64,QP=512,KP=512,VP=512,OP=1024;
constexpr int NW=8,QBLK=32,QB=QBLK*NW,KVBLK=64,NQB=SEQ/QB;
constexpr int ATTN_UNIT_ROWS=QB;
__device__ __forceinline__ int crow(int r,int hi){return (r&3)+8*(r>>2)+4*hi;}
#define SBAR() __builtin_amdgcn_sched_barrier(0)
__device__ __forceinline__ void cmask(f32x16&p0,f32x16&p1,int jb,int qrel,int hi){
  const float NEG=-INFINITY; int kb=64*jb+4*hi;
  #pragma unroll
  for(int r=0;r<16;++r){int kv=kb+(r&3)+8*(r>>2); if(kv>qrel)p0[r]=NEG; if(kv+32>qrel)p1[r]=NEG;}
}

constexpr int NSLOT=3, SLOTB=8192;
constexpr int LDS_K=0, LDS_V=NSLOT*SLOTB, LDS_WS=2*NSLOT*SLOTB, LDS_OST=LDS_WS+NW*64*4, LDS_BYTES=LDS_OST+NW*4096;
constexpr float C2=0.125f*1.4426950408889634f;
__device__ __forceinline__ void glds16(const void*gsrc,unsigned lds_dst){unsigned keep;
  asm volatile("s_mov_b32 %0, m0\n\ts_mov_b32 m0, %2\n\ts_nop 0\n\tglobal_load_lds_dwordx4 %1, off\n\ts_mov_b32 m0, %0":"=&s"(keep):"v"(gsrc),"s"(lds_dst):"memory");}
__device__ __forceinline__ float max3f(float a,float b,float c){float r;asm("v_max3_f32 %0, %1, %2, %3":"=v"(r):"v"(a),"v"(b),"v"(c));return r;}
__device__ __forceinline__ float max2f(float a,float b){float r;asm("v_max_f32_e32 %0, %1, %2":"=v"(r):"v"(a),"v"(b));return r;}
__device__ __forceinline__ float fadd_s(float a,float b){float r;asm("v_add_f32_e32 %0, %1, %2":"=v"(r):"v"(a),"v"(b));return r;}
__device__ __forceinline__ float fsub_s(float a,float b){float r;asm("v_sub_f32_e32 %0, %1, %2":"=v"(r):"v"(a),"v"(b));return r;}
typedef float f32x2_t __attribute__((ext_vector_type(2))); typedef __bf16 bf16x2_t __attribute__((ext_vector_type(2)));
__device__ __forceinline__ unsigned cvtpk_s(float lo,float hi){f32x2_t v={lo,hi};bf16x2_t b=__builtin_convertvector(v,bf16x2_t);return __builtin_bit_cast(unsigned,b);}
#define WAIT_BAR(N) asm volatile("s_waitcnt vmcnt(" #N ") lgkmcnt(0)\n\ts_barrier":::"memory")

__device__ __forceinline__ void qkt(f32x16&p0,f32x16&p1,const char*Kslot,const bf16x8*qr,const f32x16&negm,int r32,int hi){
  const char*kb=Kslot+hi*1024+r32*16;
  #pragma unroll
  for(int d0=0;d0<4;++d0){
    const bf16x8 b0=*reinterpret_cast<const bf16x8*>(kb+d0*2048);
    const bf16x8 b1=*reinterpret_cast<const bf16x8*>(kb+d0*2048+512);
    if(d0==0){p0=__builtin_amdgcn_mfma_f32_32x32x16_bf16(b0,qr[0],negm,0,0,0);p1=__builtin_amdgcn_mfma_f32_32x32x16_bf16(b1,qr[0],negm,0,0,0);}
    else{p0=__builtin_amdgcn_mfma_f32_32x32x16_bf16(b0,qr[d0],p0,0,0,0);p1=__builtin_amdgcn_mfma_f32_32x32x16_bf16(b1,qr[d0],p1,0,0,0);}}
}
typedef __attribute__((address_space(3))) const char* lds_cptr;
typedef short v4i16_t __attribute__((ext_vector_type(4)));
__device__ __forceinline__ void kload8(bf16x8*kf,lds_cptr kp){
  kf[0]=*(const __attribute__((address_space(3))) bf16x8*)(kp);      kf[1]=*(const __attribute__((address_space(3))) bf16x8*)(kp+512);
  kf[2]=*(const __attribute__((address_space(3))) bf16x8*)(kp+2048); kf[3]=*(const __attribute__((address_space(3))) bf16x8*)(kp+2560);
  kf[4]=*(const __attribute__((address_space(3))) bf16x8*)(kp+4096); kf[5]=*(const __attribute__((address_space(3))) bf16x8*)(kp+4608);
  kf[6]=*(const __attribute__((address_space(3))) bf16x8*)(kp+6144); kf[7]=*(const __attribute__((address_space(3))) bf16x8*)(kp+6656);
}
__device__ __forceinline__ void kload2(bf16x8*kf,lds_cptr kp,int j){ kf[2*j]=*(const __attribute__((address_space(3))) bf16x8*)(kp+j*2048); kf[2*j+1]=*(const __attribute__((address_space(3))) bf16x8*)(kp+j*2048+512); }
__device__ __forceinline__ s16x4 vtr(lds_cptr p){ return __builtin_bit_cast(s16x4,__builtin_amdgcn_ds_read_tr16_b64_v4i16((__attribute__((address_space(3))) v4i16_t*)p)); }
__device__ __forceinline__ float rowmax(const f32x16&p0,const f32x16&p1){
  float a=max3f(p0[0],p0[1],p1[0]),b=max3f(p0[2],p0[3],p1[1]);a=max3f(a,p1[2],p1[3]);
  #pragma unroll
  for(int r=4;r<16;r+=4){a=max3f(a,p0[r],p0[r+1]);b=max3f(b,p0[r+2],p0[r+3]);a=max3f(a,p1[r],p1[r+1]);b=max3f(b,p1[r+2],p1[r+3]);}
  const float m=max2f(a,b);
  auto rr=__builtin_amdgcn_permlane32_swap(__float_as_uint(m),__float_as_uint(m),false,false);
  return max2f(__uint_as_float(rr[0]),__uint_as_float(rr[1]));
}
__device__ __forceinline__ void pv(f32x16*o,int vb,bf16x8 pa0,bf16x8 pa1,bf16x8 pa2,bf16x8 pa3){
  #pragma unroll
  for(int d0=0;d0<2;++d0){s16x4 lo[4],hi[4];
    #pragma unroll
    for(int ks=0;ks<4;++ks){
      asm volatile("ds_read_b64_tr_b16 %0,%1 offset:%c2":"=&v"(lo[ks]):"v"(vb),"i"(d0*4096+ks*1024):"memory");
      asm volatile("ds_read_b64_tr_b16 %0,%1 offset:%c2":"=&v"(hi[ks]):"v"(vb),"i"(d0*4096+ks*1024+512):"memory");}
    asm volatile("s_waitcnt lgkmcnt(0)":::"memory");SBAR();
    #define PK(k) (bf16x8){lo[k][0],lo[k][1],lo[k][2],lo[k][3],hi[k][0],hi[k][1],hi[k][2],hi[k][3]}
    o[d0]=__builtin_amdgcn_mfma_f32_32x32x16_bf16(pa0,PK(0),o[d0],0,0,0);
    o[d0]=__builtin_amdgcn_mfma_f32_32x32x16_bf16(pa1,PK(1),o[d0],0,0,0);
    o[d0]=__builtin_amdgcn_mfma_f32_32x32x16_bf16(pa2,PK(2),o[d0],0,0,0);
    o[d0]=__builtin_amdgcn_mfma_f32_32x32x16_bf16(pa3,PK(3),o[d0],0,0,0);
    #undef PK
  }
}

#ifndef ATTN_STORE16
#define ATTN_STORE16(p,v) (*(u32x4*)(p)=(v))
#endif
template<int THRL> __device__ __forceinline__ void attn_unit(int b,int h,int qb,const bf16*Q,const bf16*__restrict__ K,const bf16*__restrict__ V,bf16*O,char*shm,int tid_in){
  int tid=tid_in; asm volatile("":"+v"(tid)); const int lane=tid&63,r32=lane&31,hi=lane>>5; const int wid=__builtin_amdgcn_readfirstlane(tid>>6);
  const long rowbase=(long)b*SEQ; const int q0=qb*QB;
  const bf16*Qw=Q+(rowbase+q0+wid*QBLK)*QP+h*D;
  const bf16*Kh=K+rowbase*KP+(h>>1)*D,*Vh=V+rowbase*VP+(h>>1)*D;
  const unsigned lds0=(unsigned)(uintptr_t)shm;
  float*wsf=(float*)(shm+LDS_WS)+wid*64;
  const bf16*ksrc=Kh+(long)lane*KP+wid*8;
  const bf16*vsrc=Vh+(long)(16*(wid&3)+(lane>>2))*VP+(wid>>2)*32+(lane&3)*8;
  const unsigned kdst=lds0+LDS_K+wid*1024, vdst=lds0+LDS_V+wid*1024;
  #define DMA_K(t,slot) glds16(ksrc+(long)(t)*KVBLK*KP,(unsigned)__builtin_amdgcn_readfirstlane(kdst+(slot)))
  #define DMA_V(t,slot) glds16(vsrc+(long)(t)*KVBLK*VP,(unsigned)__builtin_amdgcn_readfirstlane(vdst+(slot)))
  const int vb0=(int)(lds0+LDS_V)+((lane>>4)&1)*32+(lane&3)*8+(4*hi+((lane&15)>>2))*64;
  const char*Kbase=shm+LDS_K; bf16x8 kf[8];
  const lds_cptr shm3=(lds_cptr)shm; const lds_cptr kp0=shm3+LDS_K+hi*1024+r32*16; const lds_cptr vp0=shm3+LDS_V+((lane>>4)&1)*32+(lane&3)*8+(4*hi+((lane&15)>>2))*64;
  const int NT=SEQ/KVBLK;
  DMA_K(0,0);DMA_V(0,0);DMA_K(1,SLOTB);
  bf16x8 qr[4];
  #pragma unroll
  for(int d0=0;d0<4;++d0)qr[d0]=*reinterpret_cast<const bf16x8*>(&Qw[(long)r32*QP+d0*16+hi*8]);
  float mhat=0.f,l_reg=0.f;f32x16 o[2];o[0]=f32x16{};o[1]=f32x16{};f32x16 negm=f32x16{};asm volatile("":"+v"(negm));
  #define CMASK(P0,P1,t) do{}while(0)
  bool resc=false;
  #define START(P0,P1) do{ const float rm=rowmax(P0,P1); resc=false; \
    { const float dl=rm; mhat=fadd_s(mhat,dl); \
      _Pragma("unroll") for(int r=0;r<16;++r){P0[r]=fsub_s(P0[r],dl);P1[r]=fsub_s(P1[r],dl);} \
      _Pragma("unroll") for(int r=0;r<16;++r)negm[r]=-mhat; asm volatile("":"+v"(negm)); } \
    _Pragma("unroll") for(int r=0;r<16;++r)P0[r]=__builtin_amdgcn_exp2f(P0[r]); }while(0)
  #define RESC() do{ if(resc){ asm volatile("s_waitcnt lgkmcnt(0)":::"memory"); \
      _Pragma("unroll") for(int d_=0;d_<2;++d_) _Pragma("unroll") for(int r=0;r<16;++r)o[d_][r]*=wsf[crow(r,hi)]; } }while(0)
  f32x16 pA0,pA1,pB0,pB1;
  int sl_prev=0,sl_cur=0,sl_next=SLOTB;
  #define ROT() do{sl_prev=sl_cur;sl_cur=sl_next;sl_next=(sl_next==(NSLOT-1)*SLOTB)?0:sl_next+SLOTB;}while(0)
  DMA_K(2,2*SLOTB);
  WAIT_BAR(3);
  qkt(pA0,pA1,Kbase,qr,negm,r32,hi);asm volatile("s_nop 15\n\ts_nop 7":"+v"(pA0),"+v"(pA1));CMASK(pA0,pA1,0);
  START(pA0,pA1);
  _Pragma("unroll") for(int r=0;r<16;++r)pA1[r]=__builtin_amdgcn_exp2f(pA1[r]);
  WAIT_BAR(0);
  DMA_K(3,0);DMA_V(1,SLOTB);
  ROT();
  kload8(kf,kp0+sl_cur);
  WAIT_BAR(2);
  s16x4 vlo[8],vhi[8]; u32x4 pw0,pw1,pw2,pw3;
  #define PKW(P,B) cvtpk_s(P[B],P[B+1])
  #define PAF(k) __builtin_bit_cast(bf16x8,pw##k)
  #define VFR(i) (bf16x8){vlo[i][0],vlo[i][1],vlo[i][2],vlo[i][3],vhi[i][0],vhi[i][1],vhi[i][2],vhi[i][3]}
  #define PIN(x) asm volatile("":"+v"(x))
  #define MX3(a,b,c) __builtin_fmaxf(__builtin_fmaxf((a),(b)),(c))
  #define GAPA(MF,A0,A1,A2,A3,W0,W1,PW) do{ MF; sacc+=A0; sacc+=A1; sacc+=A2; sacc+=A3; PIN(sacc); W0; W1; PIN(PW); SBAR(); }while(0)
  #define EX(v) __builtin_amdgcn_exp2f(v)
  #define GAPB(MF,X,B) do{ MF; X[B]=EX(X[B]); X[B+1]=EX(X[B+1]); X[B+2]=EX(X[B+2]); X[B+3]=EX(X[B+3]); PIN(X); SBAR(); }while(0)
  #define VRD(i) do{ vlo[i]=vtr(vp_+(((i)>>2)*4096+((i)&3)*1024)); vhi[i]=vtr(vp_+(((i)>>2)*4096+((i)&3)*1024+512)); }while(0)
  #define KRD(G,j) do{ if(G){ kload2(kf,kp0+sl_next,j); SBAR(); } }while(0)
  #define STEP(C0,C1,P0,P1,t,GK,GV,GL) do{ SBAR(); \
    const lds_cptr vp_=vp0+sl_prev; \
    VRD(0); SBAR(); float sacc=(P0[0]+P0[1]); \
    GAPA(C0=__builtin_amdgcn_mfma_f32_32x32x16_bf16(kf[0],qr[0],negm,0,0,0), P0[2],P0[3],P0[4],P0[5],     pw0[0]=PKW(P0,0), pw0[1]=PKW(P0,2), pw0); \
    VRD(4); SBAR(); GAPA(C1=__builtin_amdgcn_mfma_f32_32x32x16_bf16(kf[1],qr[0],negm,0,0,0), P0[6],P0[7],P0[8],P0[9],     pw0[2]=PKW(P0,4), pw0[3]=PKW(P0,6), pw0); \
    VRD(1); SBAR(); GAPA(C0=__builtin_amdgcn_mfma_f32_32x32x16_bf16(kf[2],qr[1],C0,0,0,0),   P0[10],P0[11],P0[12],P0[13], pw1[0]=PKW(P0,8), pw1[1]=PKW(P0,10), pw1); \
    VRD(5); SBAR(); GAPA(C1=__builtin_amdgcn_mfma_f32_32x32x16_bf16(kf[3],qr[1],C1,0,0,0),   P0[14],P0[15],P1[0],P1[1],   pw1[2]=PKW(P0,12),pw1[3]=PKW(P0,14), pw1); \
    VRD(2); SBAR(); GAPA(C0=__builtin_amdgcn_mfma_f32_32x32x16_bf16(kf[4],qr[2],C0,0,0,0),   P1[2],P1[3],P1[4],P1[5],     pw2[0]=PKW(P1,0), pw2[1]=PKW(P1,2), pw2); \
    VRD(6); SBAR(); GAPA(C1=__builtin_amdgcn_mfma_f32_32x32x16_bf16(kf[5],qr[2],C1,0,0,0),   P1[6],P1[7],P1[8],P1[9],     pw2[2]=PKW(P1,4), pw2[3]=PKW(P1,6), pw2); \
    VRD(3); SBAR(); GAPA(C0=__builtin_amdgcn_mfma_f32_32x32x16_bf16(kf[6],qr[3],C0,0,0,0),   P1[10],P1[11],P1[12],P1[13], pw3[0]=PKW(P1,8), pw3[1]=PKW(P1,10), pw3); \
    VRD(7); SBAR(); GAPA(C1=__builtin_amdgcn_mfma_f32_32x32x16_bf16(kf[7],qr[3],C1,0,0,0),   P1[14],P1[15],0.f,0.f,       pw3[2]=PKW(P1,12),pw3[3]=PKW(P1,14), pw3); \
    l_reg+=sacc; \
    if(GK){DMA_K((t)+3,sl_cur);} if(GV){DMA_V((t)+1,sl_next);} \
    CMASK(C0,C1,t); \
    { float a=MX3(C0[0],C0[1],C1[0]),b=MX3(C0[2],C0[3],C1[1]); a=MX3(a,C1[2],C1[3]); \
      _Pragma("unroll") for(int r=4;r<16;r+=4){a=MX3(a,C0[r],C0[r+1]);b=MX3(b,C0[r+2],C0[r+3]);a=MX3(a,C1[r],C1[r+1]);b=MX3(b,C1[r+2],C1[r+3]);} \
      float rm=__builtin_fmaxf(a,b); { auto rr=__builtin_amdgcn_permlane32_swap(__float_as_uint(rm),__float_as_uint(rm),false,false); rm=__builtin_fmaxf(__uint_as_float(rr[0]),__uint_as_float(rr[1])); } \
      resc=false; \
      if(__builtin_expect(__any(rm>(float)THRL),0)){ const float dl=__builtin_fmaxf(rm,0.f); mhat+=dl; \
        _Pragma("unroll") for(int r=0;r<16;++r){C0[r]-=dl;C1[r]-=dl;} \
        _Pragma("unroll") for(int r=0;r<16;++r)negm[r]=-mhat; asm volatile("":"+v"(negm)); \
        const float f=__builtin_amdgcn_exp2f(-dl); l_reg*=f; if(hi==0)wsf[r32]=f; resc=true; } } \
    SBAR(); \
    GAPB(o[0]=__builtin_amdgcn_mfma_f32_32x32x16_bf16(PAF(0),VFR(0),o[0],0,0,0), C0,0); \
    GAPB(o[1]=__builtin_amdgcn_mfma_f32_32x32x16_bf16(PAF(0),VFR(4),o[1],0,0,0), C0,4); \
    KRD(GL,0); GAPB(o[0]=__builtin_amdgcn_mfma_f32_32x32x16_bf16(PAF(1),VFR(1),o[0],0,0,0), C0,8); \
    KRD(GL,1); GAPB(o[1]=__builtin_amdgcn_mfma_f32_32x32x16_bf16(PAF(1),VFR(5),o[1],0,0,0), C0,12); \
    KRD(GL,2); GAPB(o[0]=__builtin_amdgcn_mfma_f32_32x32x16_bf16(PAF(2),VFR(2),o[0],0,0,0), C1,0); \
    KRD(GL,3); GAPB(o[1]=__builtin_amdgcn_mfma_f32_32x32x16_bf16(PAF(2),VFR(6),o[1],0,0,0), C1,4); \
    GAPB(o[0]=__builtin_amdgcn_mfma_f32_32x32x16_bf16(PAF(3),VFR(3),o[0],0,0,0), C1,8); \
    GAPB(o[1]=__builtin_amdgcn_mfma_f32_32x32x16_bf16(PAF(3),VFR(7),o[1],0,0,0), C1,12); \
    }while(0)
  int t=1;
  #undef CMASK
  #define CMASK(P0,P1,t) do{}while(0)
  for(;t+5<NT;t+=2){
    STEP(pB0,pB1,pA0,pA1,t,true,true,true);     WAIT_BAR(2); RESC(); ROT();
    STEP(pA0,pA1,pB0,pB1,t+1,true,true,true);   WAIT_BAR(2); RESC(); ROT();
  }
  #undef CMASK
  #define CMASK(P0,P1,t) do{}while(0)
  #define ENDW(tt) do{ if((tt)+3<NT){WAIT_BAR(2);} else if((tt)+2<NT){WAIT_BAR(1);} else {WAIT_BAR(0);} }while(0)
  for(;t+1<NT;t+=2){
    STEP(pB0,pB1,pA0,pA1,t,(t+3<NT),(t+1<NT),(t+1<NT));       ENDW(t);   RESC(); ROT();
    STEP(pA0,pA1,pB0,pB1,t+1,(t+4<NT),(t+2<NT),(t+2<NT));     ENDW(t+1); RESC(); ROT();
  }
  STEP(pB0,pB1,pA0,pA1,NT-1,false,false,false); RESC();
  { float sacc=pB0[0]+pB0[1]; _Pragma("unroll") for(int r=2;r<16;++r)sacc+=pB0[r]; _Pragma("unroll") for(int r=0;r<16;++r)sacc+=pB1[r]; l_reg+=sacc;
    pw0=(u32x4){PKW(pB0,0),PKW(pB0,2),PKW(pB0,4),PKW(pB0,6)};pw1=(u32x4){PKW(pB0,8),PKW(pB0,10),PKW(pB0,12),PKW(pB0,14)};pw2=(u32x4){PKW(pB1,0),PKW(pB1,2),PKW(pB1,4),PKW(pB1,6)};pw3=(u32x4){PKW(pB1,8),PKW(pB1,10),PKW(pB1,12),PKW(pB1,14)};
    SBAR(); pv(o,vb0+sl_cur,PAF(0),PAF(1),PAF(2),PAF(3)); }
  #undef PKW
  #undef PAF
  #undef VFR
  #undef PIN
  #undef MX3
  #undef GAPA
  #undef GAPB
  #undef EX
  #undef VRD
  #undef KRD
  #undef STEP
  #undef ENDW
  {auto rr=__builtin_amdgcn_permlane32_swap(__float_as_uint(l_reg),__float_as_uint(l_reg),false,false);l_reg=__uint_as_float(rr[0])+__uint_as_float(rr[1]);}
  if(hi==0)wsf[32+r32]=l_reg;asm volatile("s_waitcnt lgkmcnt(0)":::"memory");
  float rli[16];
  #pragma unroll
  for(int r=0;r<16;++r)rli[r]=__builtin_amdgcn_rcpf(wsf[32+crow(r,hi)]);
  bf16*Ow=O+(rowbase+q0+wid*QBLK)*OP+h*D;
  { bf16*stg=(bf16*)(shm+LDS_OST)+wid*2048;
    #pragma unroll
    for(int r=0;r<16;++r){const int orow=crow(r,hi);
      #pragma unroll
      for(int d0=0;d0<2;++d0)stg[orow*64+d0*32+r32]=__float2bfloat16(o[d0][r]*rli[r]);}
    asm volatile("s_waitcnt lgkmcnt(0)":::"memory");
    #pragma unroll
    for(int i=0;i<4;++i){const int row=i*8+(lane>>3),ch=lane&7; const u32x4 v=*(const u32x4*)(stg+row*64+ch*8); ATTN_STORE16(Ow+(long)row*OP+ch*8,v);} }
  asm volatile("s_waitcnt lgkmcnt(0)\n\ts_barrier":::"memory");
  #undef DMA_K
  #undef DMA_V
  #undef CMASK
  #undef START
  #undef RESC
  #undef ROT
}
constexpr int ATTN_LDS_BYTES=LDS_BYTES;
#undef SBAR
#undef WAIT_BAR
}

constexpr int FBUF = 8720;
__device__ __forceinline__ int fpad(int i) { return i + (i >> 5) + 18 * (i >> 9); }
constexpr float kTwC[16] = {1.000000000e+00f, 9.807852804e-01f, 9.238795325e-01f, 8.314696123e-01f, 7.071067812e-01f, 5.555702330e-01f, 3.826834324e-01f, 1.950903220e-01f,
                            0.0f, -1.950903220e-01f, -3.826834324e-01f, -5.555702330e-01f, -7.071067812e-01f, -8.314696123e-01f, -9.238795325e-01f, -9.807852804e-01f};
constexpr float kTwS[16] = {0.000000000e+00f, 1.950903220e-01f, 3.826834324e-01f, 5.555702330e-01f, 7.071067812e-01f, 8.314696123e-01f, 9.238795325e-01f, 9.807852804e-01f,
                            1.000000000e+00f, 9.807852804e-01f, 9.238795325e-01f, 8.314696123e-01f, 7.071067812e-01f, 5.555702330e-01f, 3.826834324e-01f, 1.950903220e-01f};
template <int N> __device__ __forceinline__ void dft_dif(f32x2 (&v)[N]) {
#pragma unroll
    for (int len = N; len >= 2; len >>= 1) {
        const int half = len / 2;
#pragma unroll
        for (int base = 0; base < N; base += len)
#pragma unroll
            for (int j = 0; j < half; ++j) {
                const f32x2 a = v[base + j], b = v[base + j + half];
                v[base + j] = a + b;
                const f32x2 d = a - b;
                const int ti = j * (32 / len);
                v[base + j + half] = (ti == 0) ? d : (f32x2){d.x * kTwC[ti] + d.y * kTwS[ti], d.y * kTwC[ti] - d.x * kTwS[ti]};
            }
    }
}
__host__ __device__ constexpr int brev(int i, int bits) { int r = 0; for (int b = 0; b < bits; ++b) r |= ((i >> b) & 1) << (bits - 1 - b); return r; }

#define FFT_BAR() asm volatile("s_waitcnt lgkmcnt(0)\n\ts_barrier" ::: "memory")
__device__ __forceinline__ void fft8192(LAS f32x2* buf, int tid_in) {
    int tid = tid_in; asm volatile("" : "+v"(tid));
    {
        const int n2 = tid; f32x2 v[16];
        LAS f32x2* p = buf + n2 + (n2 >> 5);
#pragma unroll
        for (int n1 = 0; n1 < 16; ++n1) v[n1] = p[546 * n1];
        dft_dif<16>(v);
        const float rv1 = (float)n2 * (1.f / 8192.f); const float c = __builtin_amdgcn_cosf(rv1), s = -__builtin_amdgcn_sinf(rv1);
        f32x2 pw[16]; pw[0] = (f32x2){1.f, 0.f}; pw[1] = (f32x2){c, s};
#pragma unroll
        for (int k = 2; k < 16; ++k) pw[k] = cmul(pw[k - 1], pw[1]);
#pragma unroll
        for (int i = 0; i < 16; ++i) { const int k1 = brev(i, 4); p[546 * k1] = cmul(v[i], pw[k1]); }
    }
    FFT_BAR();
    {
        const int k1 = tid >> 5, b = tid & 31; f32x2 v[16];
        LAS f32x2* p = buf + 546 * k1 + b;
#pragma unroll
        for (int a = 0; a < 16; ++a) v[a] = p[33 * a];
        dft_dif<16>(v);
        const float rv2 = (float)b * (1.f / 512.f); const float c = __builtin_amdgcn_cosf(rv2), s = -__builtin_amdgcn_sinf(rv2);
        f32x2 pw[16]; pw[0] = (f32x2){1.f, 0.f}; pw[1] = (f32x2){c, s};
#pragma unroll
        for (int k = 2; k < 16; ++k) pw[k] = cmul(pw[k - 1], pw[1]);
#pragma unroll
        for (int i = 0; i < 16; ++i) { const int ka = brev(i, 4); p[33 * ka] = cmul(v[i], pw[ka]); }
    }
    FFT_BAR();
    {
        const int ka = (tid >> 4) & 15, k1 = tid & 15; f32x2 v[32];
        if (tid < 256) {
            const LAS f32x2* p = buf + 546 * k1 + 33 * ka;
#pragma unroll
            for (int b = 0; b < 32; ++b) v[b] = p[b];
            dft_dif<32>(v);
        }
        FFT_BAR();
        if (tid < 256) {
            LAS f32x2* q = buf + k1 + 16 * ka + (ka >> 1);
#pragma unroll
            for (int i = 0; i < 32; ++i) { const int kb = brev(i, 5); q[264 * kb + 18 * (kb >> 1)] = v[i]; }
        }
    }
    FFT_BAR();
}

__device__ __forceinline__ float hy_sconv(const bf16* xrow, unsigned t, float w0, float w1, float w2, float bias) {
    const unsigned tm = t > 0u ? t - 1u : 0u, tp = t < (unsigned)(SEQ - 1) ? t + 1u : (unsigned)(SEQ - 1);
    const float xm = t > 0u ? bf2f(xrow[tm]) : 0.f, x0 = bf2f(xrow[t]), xp = t < (unsigned)(SEQ - 1) ? bf2f(xrow[tp]) : 0.f;
    return xm * w0 + x0 * w1 + xp * w2 + bias;
}

__device__ __forceinline__ void hy_sconv_row(Frame& F, const Args& args, int l, int row  , size_t dummy_off = 0) {
    const int lane = F.lane, ch = row >> 3;
    bf16* x = WSP(bf16, WS_RB + RB_HYT) + (size_t)ch * M + (size_t)(row & 7) * SEQ;
    const float* cw = FIN(I_HY_CW) + (size_t)l * 3 * 768; const float w0 = cw[ch], w1 = cw[768 + ch], w2 = cw[1536 + ch], bias = FIN(I_HY_CB)[(size_t)l * 768 + ch];
    v4u raw[8];
#pragma unroll
    for (int k = 0; k < 8; ++k) raw[k] = *(const v4u*)(x + 8 * lane + 512 * k);
    float first[8], lastv[8];
#pragma unroll
    for (int k = 0; k < 8; ++k) { first[k] = bflo(raw[k].x); lastv[k] = bfhi(raw[k].w); }
#pragma unroll
    for (int k = 0; k < 8; ++k) {
        float v[10];
        v[1] = bflo(raw[k].x); v[2] = bfhi(raw[k].x); v[3] = bflo(raw[k].y); v[4] = bfhi(raw[k].y); v[5] = bflo(raw[k].z); v[6] = bfhi(raw[k].z); v[7] = bflo(raw[k].w); v[8] = bfhi(raw[k].w);
        const float lft = __shfl_up(lastv[k], 1), lft0 = k > 0 ? __shfl(lastv[k > 0 ? k - 1 : 0], 63) : 0.f;
        const float rgt = __shfl_down(first[k], 1), rgt63 = k < 7 ? __shfl(first[k < 7 ? k + 1 : 7], 0) : 0.f;
        v[0] = lane == 0 ? lft0 : lft; v[9] = lane == 63 ? rgt63 : rgt;
        float o[8];
#pragma unroll
        for (int e = 0; e < 8; ++e) o[e] = v[e] * w0 + v[e + 1] * w1 + v[e + 2] * w2 + bias;
        v4u w; w.x = pk2(o[0], o[1]); w.y = pk2(o[2], o[3]); w.z = pk2(o[4], o[5]); w.w = pk2(o[6], o[7]);
        *(v4u*)((bf16*)((char*)x + dummy_off) + 8 * lane + 512 * k) = w;
    }
}
__device__ __forceinline__ void hy_taps_block(Frame& F, const Args& args, int l, int tb) {
    LAS float* F2 = (LAS float*)F.lds;
    const int tid = F.tid, t0 = tb * 16;
    const float* f2 = WSP(float, WS_HF2) + ((size_t)l * 4096 + t0) * 64;
    __syncthreads();
    for (int i = tid; i < 16 * 64; i += 512) F2[i] = f2[i];
    __syncthreads();
    const float* w3 = FIN(I_HY_W3) + (size_t)l * 64 * 1024;
    float acc0[16], acc1[16];
#pragma unroll
    for (int j = 0; j < 16; ++j) { acc0[j] = 0.f; acc1[j] = 0.f; }
#pragma unroll 4
    for (int i = 0; i < 64; ++i) { const float wa = w3[i * 1024 + tid], wb = w3[i * 1024 + 512 + tid];
#pragma unroll
        for (int j = 0; j < 16; ++j) { const float x = F2[j * 64 + i]; acc0[j] += x * wa; acc1[j] += x * wb; } }
    const int c = tid & 255;
    const float delta = fabsf(-3.0701134573253945f + (float)c * ((-15.350567286626973f + 3.0701134573253945f) / 255.f));
    float* tt = WSP(float, WS_TT);
#pragma unroll
    for (int j = 0; j < 16; j += 4) { f32x4 o0, o1;
#pragma unroll
        for (int q = 0; q < 4; ++q) { const float dec = expf(-(float)(t0 + j + q) * (1.f / 4095.f) * delta); o0[q] = acc0[j + q] * dec; o1[q] = acc1[j + q] * dec; }
        *(f32x4*)(tt + (size_t)tid * SEQ + t0 + j) = o0; *(f32x4*)(tt + (size_t)(512 + tid) * SEQ + t0 + j) = o1; }
}

__device__ __forceinline__ void hyena_item(Frame& F, const Args& args, int l, int c) {
    LAS f32x2* A = (LAS f32x2*)F.lds;
    LAS f32x2* B = A + FBUF;
    LAS float* W3L = (LAS float*)(B + FBUF);
    LAS float* red = W3L + 256;
    const bf16* hyT = WSP(bf16, WS_RB + RB_HYT);
    float* HV = WSP(float, WS_RD + RD_HV) + (size_t)c * 8 * SEQ;
    bf16* yaT = WSP(bf16, WS_RD + RD_YAT) + (size_t)c * M;
    const float* f2 = WSP(float, WS_HF2) + (size_t)l * 4096 * 64;
    __syncthreads();
    __syncthreads();
#pragma unroll 1
    for (int n = 0; n < 2; ++n) {
        int tid = F.tid; asm volatile("" : "+v"(tid));
        float ss = 0.f;
        {   const float* tf = WSP(float, WS_TT) + ((size_t)(0 * 2 + n) * 256 + c) * SEQ; const float* tbk = WSP(float, WS_TT) + ((size_t)(1 * 2 + n) * 256 + c) * SEQ;
#pragma unroll
            for (int j = 0; j < 8; ++j) { const int t = tid + 512 * j; const float fw = tf[t], bw = tbk[t];
                A[tid + (tid >> 5) + 546 * j] = (f32x2){fw, 0.f}; ss += fw * fw;
                if (t >= 1) { A[fpad(8192 - t)] = (f32x2){bw, 0.f}; ss += bw * bw; } } }
        if (tid == 0) A[fpad(4096)] = (f32x2){0.f, 0.f};
        ss = block_sum(F, ss, red);
        const float scale = (1.f / sqrtf(ss)) * (1.f / 8192.f);
        const float biasN = FIN(I_HY_BIAS)[((size_t)l * 2 + n) * 256 + c] * (1.f / 8192.f);
        fft8192(A, tid);
#pragma unroll
        for (int j = 0; j < 16; ++j) { LAS f32x2* p = A + tid + (tid >> 5) + 546 * j; f32x2 a = *p * scale; a.x += biasN; *p = a; }
#pragma unroll 1
        for (int pb = 0; pb < 4; ++pb) {
            int tq = tid; asm volatile("" : "+v"(tq));
            const bf16* zr0 = hyT + (size_t)c * M + (size_t)(2 * pb) * SEQ; const bf16* zr1 = zr0 + SEQ;
            const bf16* gr0 = hyT + (size_t)((n + 1) * 256 + c) * M + (size_t)(2 * pb) * SEQ; const bf16* gr1 = gr0 + SEQ;
            float* hv0 = HV + (size_t)(2 * pb) * SEQ; float* hv1 = hv0 + SEQ;
            __syncthreads();
#pragma unroll
            for (int j = 0; j < 8; ++j) { const unsigned t = (unsigned)tq + 512u * j; float z0, z1;
                if (n == 0) { z0 = bf2f(zr0[t]); z1 = bf2f(zr1[t]); }
                else { z0 = hv0[t]; z1 = hv1[t]; }
                B[tq + (tq >> 5) + 546 * j] = (f32x2){z0, z1}; B[tq + (tq >> 5) + 546 * (j + 8)] = (f32x2){0.f, 0.f}; }
            float g0[8], g1[8];
#pragma unroll
            for (int j = 0; j < 8; ++j) { const unsigned t = (unsigned)tq + 512u * j; g0[j] = bf2f(gr0[t]); g1[j] = bf2f(gr1[t]); }
            FFT_BAR();
            fft8192(B, tq);
#pragma unroll
            for (int j = 0; j < 16; ++j) { const int p = tq + (tq >> 5) + 546 * j; const f32x2 y = cmul(B[p], A[p]); B[p] = (f32x2){y.x, -y.y}; }
            FFT_BAR();
            fft8192(B, tq);
#pragma unroll
            for (int j = 0; j < 8; ++j) { const unsigned t = (unsigned)tq + 512u * j; const f32x2 y = B[tq + (tq >> 5) + 546 * j];
                const float o0 = g0[j] * y.x, o1 = g1[j] * -y.y;
                if (n == 0) { hv0[t] = o0; hv1[t] = o1; }
                else { yaT[(size_t)(2 * pb) * SEQ + t] = (bf16)f2bf(o0); yaT[(size_t)(2 * pb + 1) * SEQ + t] = (bf16)f2bf(o1); } }
        }
        __syncthreads();
    }
}

__device__ __forceinline__ f32x16 mfma32(bf16x8 a, bf16x8 b, f32x16 c) { return __builtin_amdgcn_mfma_f32_32x32x16_bf16(a, b, c, 0, 0, 0); }
__device__ __forceinline__ int crow(int r, int hi) { return (r & 3) + 8 * (r >> 2) + 4 * hi; }
__device__ __forceinline__ float gelu_tanh(float x) {
    const float u = 0.7978845608028654f * (x + 0.044715f * x * x * x);
    const float e = __builtin_amdgcn_exp2f(2.885390081777927f * u);
    const float th = 1.f - 2.f * __builtin_amdgcn_rcpf(e + 1.f);
    return 0.5f * x * (1.f + th);
}
__device__ __forceinline__ void s5_item(Frame& F, const Args& args, int l, int b, int g) {
    constexpr int SP = 129, XP = 136;
    LAS float* S = (LAS float*)F.lds;
    LAS bf16* XB = (LAS bf16*)(F.lds + 128 * SP * 4);
    const int tid = F.tid, lane = F.lane, w = F.wave, r32 = lane & 31, hi = lane >> 5;
    const bf16* U = WSP(bf16, WS_RB + RB_PROJ2) + (size_t)b * SEQ * PROJ2_W + PC_S5 + g * 16;
    const bf16* wst = WSP(bf16, WS_S5W + (size_t)l * S5W_LAYER + S5_WST_OFF) + (size_t)g * 2 * 128 * 512;
    const bf16* wcat = WSP(bf16, WS_S5W + (size_t)l * S5W_LAYER + S5_WCAT_OFF) + (size_t)g * 512 * 768;
    bf16* Z = WSP(bf16, WS_RD + RD_S5Z) + (size_t)b * SEQ * 256 + g * 16;
    __syncthreads();
    for (int dir = 0; dir < 2; ++dir) {
        {
            const int rt = w >> 1, ct0 = 2 * (w & 1);
            f32x16 acc[2]; acc[0] = f32x16{}; acc[1] = f32x16{};
            const bf16* ap = wst + ((size_t)dir * 128 + rt * 32 + r32) * 512 + 8 * hi;
            const bf16* bp0 = U + (size_t)(32 * (ct0 * 32 + r32)) * PROJ2_W + 8 * hi;
            const bf16* bp1 = bp0 + (size_t)(32 * 32) * PROJ2_W;
#pragma unroll 4
            for (int ks = 0; ks < 32; ++ks) {
                const bf16x8 a = *(const bf16x8*)(ap + 16 * ks);
                const bf16x8 b0 = *(const bf16x8*)(bp0 + (size_t)ks * PROJ2_W), b1 = *(const bf16x8*)(bp1 + (size_t)ks * PROJ2_W);
                acc[0] = mfma32(a, b0, acc[0]); acc[1] = mfma32(a, b1, acc[1]);
            }
#pragma unroll
            for (int q = 0; q < 2; ++q)
#pragma unroll
                for (int r = 0; r < 16; ++r) S[((ct0 + q) * 32 + r32) * SP + rt * 32 + crow(r, hi)] = acc[q][r];
        }
        __syncthreads();
        if (tid < 64) {
            const f32x2 a32 = WSP(f32x2, WS_S5A32)[((size_t)(l * 2 + dir) * 16 + g) * 64 + tid];
            f32x2 X = (f32x2){0.f, 0.f};
#pragma unroll 8
            for (int cc = 0; cc < 128; ++cc) { const int c = dir == 0 ? cc : 127 - cc;
                const f32x2 s = (f32x2){S[c * SP + 2 * tid], S[c * SP + 2 * tid + 1]};
                X = cmul(a32, X) + s;
                *(LAS unsigned*)(XB + ((size_t)dir * 128 + c) * XP + 2 * tid) = pk2(X.x, X.y); }
        }
        __syncthreads();
    }
    {
        f32x16 acc[2][4];
#pragma unroll
        for (int i = 0; i < 2; ++i)
#pragma unroll
            for (int j = 0; j < 4; ++j) acc[i][j] = f32x16{};
        const bf16* ap = wcat + (size_t)(2 * w * 32 + r32) * 768 + 8 * hi;
        const bf16* bp = U + (size_t)(32 * r32) * PROJ2_W + 8 * hi;
#pragma unroll 2
        for (int ks = 0; ks < 32; ++ks) {
            const bf16x8 a0 = *(const bf16x8*)(ap + 16 * ks), a1 = *(const bf16x8*)(ap + 32 * 768 + 16 * ks);
#pragma unroll
            for (int ct = 0; ct < 4; ++ct) { const bf16x8 bv = *(const bf16x8*)(bp + (size_t)(32 * 32 * ct + ks) * PROJ2_W);
                acc[0][ct] = mfma32(a0, bv, acc[0][ct]); acc[1][ct] = mfma32(a1, bv, acc[1][ct]); }
        }
#pragma unroll 2
        for (int ks = 0; ks < 16; ++ks) {
            const int dir = ks >> 3, kk = ks & 7;
            const bf16x8 a0 = *(const bf16x8*)(ap + 512 + 16 * ks), a1 = *(const bf16x8*)(ap + 32 * 768 + 512 + 16 * ks);
#pragma unroll
            for (int ct = 0; ct < 4; ++ct) { const int c = ct * 32 + r32, cs = dir == 0 ? c - 1 : c + 1;
                bf16x8 bv = (bf16x8){0, 0, 0, 0, 0, 0, 0, 0};
                if (cs >= 0 && cs < 128) bv = *(const LAS bf16x8*)(XB + ((size_t)dir * 128 + cs) * XP + 16 * kk + 8 * hi);
                acc[0][ct] = mfma32(a0, bv, acc[0][ct]); acc[1][ct] = mfma32(a1, bv, acc[1][ct]); }
        }
#pragma unroll
        for (int i = 0; i < 2; ++i)
#pragma unroll
            for (int ct = 0; ct < 4; ++ct)
#pragma unroll
                for (int q = 0; q < 4; ++q) {
                    const int tl = (2 * w + i) * 2 + (q >> 1), co = 8 * (q & 1) + 4 * hi, c = ct * 32 + r32;
                    v2u o; o.x = pk2(gelu_tanh(acc[i][ct][4 * q]), gelu_tanh(acc[i][ct][4 * q + 1])); o.y = pk2(gelu_tanh(acc[i][ct][4 * q + 2]), gelu_tanh(acc[i][ct][4 * q + 3]));
                    *(v2u*)(Z + (size_t)(32 * c + tl) * 256 + co) = o; }
    }
    __syncthreads();
}

__device__ __forceinline__ void dil_item(Frame& F, const Args& args, int it) {
    constexpr int RS = 144;
    LAS unsigned char* Ks = F.lds; LAS unsigned char* Vs = F.lds + 384 * RS;
    int lane = F.lane; asm volatile("" : "+v"(lane));
    const int r32 = lane & 31, hi = lane >> 5, w = F.wave;
    const int u0 = it * 8, g = u0 >> 12, b = (u0 >> 9) & 7, hh = (u0 >> 7) & 3, tile0 = u0 & 127;
    const int dsh = 2 * g, Lp = SEQ >> dsh, tpr = Lp >> 5, rho = tile0 / tpr, q0 = (tile0 % tpr) * 32, h = g * 4 + hh;
    const float slope2 = exp2f(-8.f * (float)(h + 1) * (1.f / 12.f)) * (float)(1 << dsh) * 1.4426950408889634f;
    const char* P2 = (const char*)(WSP(bf16, WS_RB + RB_PROJ2) + (size_t)b * SEQ * PROJ2_W);
#define DIL_ROWB(tp) ((unsigned)(rho + ((tp) << dsh)) * (unsigned)(PROJ2_W * 2))
    __syncthreads();
    {   int tq = F.tid; asm volatile("" : "+v"(tq));
#pragma unroll
        for (int k = 0; k < 6; ++k) { const int id = tq + 512 * k, row = id >> 3, ch = id & 7;
            int tj = q0 - 64 + row; tj = tj < 0 ? 0 : (tj > Lp - 1 ? Lp - 1 : tj);
            const unsigned ro = DIL_ROWB(tj) + (unsigned)(h * 64 + ch * 8) * 2u;
            const v4u kv = *(const v4u*)(P2 + ro + PC_DK * 2), vv = *(const v4u*)(P2 + ro + PC_DV * 2);
            *(LAS v4u*)(Ks + row * RS + ch * 16) = kv; *(LAS v4u*)(Vs + row * RS + ch * 16) = vv; } }
    const int tau0 = q0 + 32 * w;
    bf16x8 qf[4];
    { const unsigned qo = DIL_ROWB(tau0 + r32) + (unsigned)(PC_DQ + h * 64 + 8 * hi) * 2u;
#pragma unroll
      for (int ks = 0; ks < 4; ++ks) qf[ks] = *(const bf16x8*)(P2 + qo + 32 * ks); }
    __syncthreads();
    f32x16 S[5];
#pragma unroll
    for (int kt = 0; kt < 5; ++kt) {
        const LAS unsigned char* kp = Ks + (32 * w + 32 * kt + r32) * RS + 16 * hi;
        f32x16 a = f32x16{};
#pragma unroll
        for (int ks = 0; ks < 4; ++ks) a = mfma32(*(const LAS bf16x8*)(kp + 32 * ks), qf[ks], a);
        S[kt] = a;
    }
    float mx = -1e30f;
    const float cr32 = (float)r32;
    if (tau0 >= 64 && tau0 + 96 <= Lp) {
#pragma unroll
        for (int kt = 0; kt < 5; ++kt)
#pragma unroll
            for (int r = 0; r < 16; ++r) { const float dlf = (float)(-64 + 32 * kt + crow(r, 0)) + (float)(4 * hi) - cr32;
                float sc = S[kt][r] * (0.125f * 1.4426950408889634f) - slope2 * fabsf(dlf);
                if (kt == 0) sc = dlf >= -64.f ? sc : -1e30f;
                if (kt == 4) sc = dlf <= 64.f ? sc : -1e30f;
                S[kt][r] = sc; mx = fmaxf(mx, sc); }
    } else {
#pragma unroll
        for (int kt = 0; kt < 5; ++kt)
#pragma unroll
            for (int r = 0; r < 16; ++r) { const int dl = -64 + 32 * kt + crow(r, hi) - r32, tj = tau0 + r32 + dl;
                const bool ok = dl >= -64 && dl <= 64 && tj >= 0 && tj < Lp;
                const float sc = S[kt][r] * (0.125f * 1.4426950408889634f) - slope2 * (float)(dl < 0 ? -dl : dl);
                S[kt][r] = ok ? sc : -1e30f; mx = fmaxf(mx, S[kt][r]); }
    }
    mx = fmaxf(mx, __shfl_xor(mx, 32));
    float lsum = 0.f;
#pragma unroll
    for (int kt = 0; kt < 5; ++kt)
#pragma unroll
        for (int r = 0; r < 16; ++r) { const float p = __builtin_amdgcn_exp2f(S[kt][r] - mx); S[kt][r] = p; lsum += p; }
    lsum += __shfl_xor(lsum, 32);
    f32x16 O[2]; O[0] = f32x16{}; O[1] = f32x16{};
    const LAS unsigned short* vb = (const LAS unsigned short*)(Vs + (32 * w + 4 * hi) * RS) + r32;
#pragma unroll
    for (int kt = 0; kt < 5; ++kt)
#pragma unroll
        for (int s = 0; s < 2; ++s) {
            bf16x8 pa; bf16x8 v0, v1;
#pragma unroll
            for (int j = 0; j < 8; j += 2) { const unsigned pw = pk2(S[kt][8 * s + j], S[kt][8 * s + j + 1]); pa[j] = (short)(pw & 0xffff); pa[j + 1] = (short)(pw >> 16); }
#pragma unroll
            for (int j = 0; j < 8; ++j) { const LAS unsigned short* vp = vb + (32 * kt + 16 * s + 8 * (j >> 2) + (j & 3)) * (RS / 2); v0[j] = (short)vp[0]; v1[j] = (short)vp[32]; }
            O[0] = mfma32(pa, v0, O[0]); O[1] = mfma32(pa, v1, O[1]);
        }
    const float linv = 1.f / lsum;
    bf16* Og = WSP(bf16, WS_RD + RD_DILO) + (size_t)g * M * 256 + (size_t)b * SEQ * 256 + hh * 64 + r32;
#pragma unroll
    for (int r = 0; r < 16; ++r) { const int i = crow(r, hi); const float li = __shfl(linv, i);
        const unsigned ro = (unsigned)(rho + ((tau0 + i) << dsh)) * 256u;
        Og[ro] = (bf16)f2bf(O[0][r] * li); Og[ro + 32] = (bf16)f2bf(O[1][r] * li); }
    if (hi == 0) WSP(float, WS_DLSE)[((size_t)g * M + (size_t)b * SEQ + rho + ((tau0 + r32) << dsh)) * 4 + hh] = (mx + log2f(lsum)) * 0.6931471805599453f;
#undef DIL_ROWB
}

__device__ __forceinline__ void gqa_prep_rows(Frame& F, const Args& args, int l, int m0) {
    const int lane = F.lane, grp = lane >> 4, li = lane & 15;
    const bf16* P2 = WSP(bf16, WS_RB + RB_PROJ2); bf16* QK = WSP(bf16, WS_RD + RD_QKVG);
    const f32x4 qn = *(const f32x4*)(FIN(I_GQ_QN) + l * 64 + 4 * li), kn = *(const f32x4*)(FIN(I_GQ_KN) + l * 64 + 4 * li);
#pragma unroll
    for (int p = 0; p < 3; ++p) {
        const int s = 4 * p + grp, rsel = s >= 6 ? 1 : 0, hs = s - 6 * rsel, m = m0 + rsel, t = m & (SEQ - 1);
        const v2u raw = *(const v2u*)(P2 + (size_t)m * PROJ2_W + PC_GQ + hs * 64 + 4 * li);
        f32x4 x = (f32x4){bflo(raw.x), bfhi(raw.x), bflo(raw.y), bfhi(raw.y)};
        float ss = (x[0] * x[0] + x[1] * x[1]) + (x[2] * x[2] + x[3] * x[3]);
        ss += __shfl_xor(ss, 1); ss += __shfl_xor(ss, 2); ss += __shfl_xor(ss, 4); ss += __shfl_xor(ss, 8);
        const float rn = 1.f / sqrtf(ss * (1.f / 64.f) + RMS_EPS);
        x = x * rn * (hs < 4 ? qn : kn);
        f32x4 pr; pr[0] = __shfl_xor(x[0], 4); pr[1] = __shfl_xor(x[1], 4); pr[2] = __shfl_xor(x[2], 4); pr[3] = __shfl_xor(x[3], 4);
        const int pos = li >= 8 ? (t & 63) : (t >> 6);
        const f32x4* cs = (const f32x4*)(WSP(f32x2, WS_ROPE) + pos * 16 + 4 * (li & 3));
        const f32x4 cs0 = cs[0], cs1 = cs[1];
        const float sg = (li & 4) ? 1.f : -1.f, sc = hs < 4 ? 0.125f * 1.4426950408889634f : 1.f;
        f32x4 o; o[0] = (x[0] * cs0[0] + sg * pr[0] * cs0[1]) * sc; o[1] = (x[1] * cs0[2] + sg * pr[1] * cs0[3]) * sc; o[2] = (x[2] * cs1[0] + sg * pr[2] * cs1[1]) * sc; o[3] = (x[3] * cs1[2] + sg * pr[3] * cs1[3]) * sc;
        v2u w; w.x = pk2(o[0], o[1]); w.y = pk2(o[2], o[3]);
        *(v2u*)(QK + (size_t)m * 512 + hs * 64 + 4 * li) = w;
    }
    { const int m = m0 + (lane >> 5), c4 = 4 * (lane & 31);
      *(v2u*)(QK + (size_t)m * 512 + 384 + c4) = *(const v2u*)(P2 + (size_t)m * PROJ2_W + PC_GV + c4); }
}

__device__ __forceinline__ void hy_transpose_item(Frame& F, int item) {
    LAS bf16* T = (LAS bf16*)F.lds + F.wave * (64 * 66);
    const int lane = F.lane, mb = item >> 2, cb = item & 3;
    const bf16* src = WSP(bf16, WS_RD + RD_YAT) + (size_t)(cb * 64) * M + (size_t)mb * 64;
    bf16* dst = WSP(bf16, WS_Y) + (size_t)(mb * 64) * 1024 + cb * 64;
#pragma unroll
    for (int i = 0; i < 8; ++i) { const int c = 8 * i + (lane >> 3), m0 = (lane & 7) * 8; const v4u v = *(const v4u*)(src + (size_t)c * M + m0);
        LAS unsigned* tp = (LAS unsigned*)(T + c * 66 + m0); tp[0] = v.x; tp[1] = v.y; tp[2] = v.z; tp[3] = v.w; }
    LDS_WAIT(); asm volatile("" ::: "memory");
#pragma unroll
    for (int i = 0; i < 8; ++i) { const int m = 8 * i + (lane >> 3), c0 = (lane & 7) * 8; unsigned short e[8];
#pragma unroll
        for (int j = 0; j < 8; ++j) e[j] = T[(c0 + j) * 66 + m];
        v4u o; o.x = e[0] | ((unsigned)e[1] << 16); o.y = e[2] | ((unsigned)e[3] << 16); o.z = e[4] | ((unsigned)e[5] << 16); o.w = e[6] | ((unsigned)e[7] << 16);
        *(v4u*)(dst + (size_t)m * 1024 + c0) = o; }
    LDS_WAIT(); asm volatile("" ::: "memory");
}
__device__ __forceinline__ void dil_combine_row(Frame& F, int m) {
    const int lane = F.lane, hh = lane >> 4;
    const float* ls = WSP(float, WS_DLSE);
    const float l0 = ls[((size_t)0 * M + m) * 4 + hh], l1 = ls[((size_t)1 * M + m) * 4 + hh], l2 = ls[((size_t)2 * M + m) * 4 + hh];
    const float mx = fmaxf(l0, fmaxf(l1, l2)); const float e0 = expf(l0 - mx), e1 = expf(l1 - mx), e2 = expf(l2 - mx), inv = 1.f / (e0 + e1 + e2);
    const bf16* o = WSP(bf16, WS_RD + RD_DILO) + (size_t)m * 256 + 4 * lane;
    const v2u a = *(const v2u*)o, b = *(const v2u*)(o + (size_t)M * 256), c = *(const v2u*)(o + (size_t)2 * M * 256);
    const float w0 = e0 * inv, w1 = e1 * inv, w2 = e2 * inv;
    v2u r; r.x = pk2(w0 * bflo(a.x) + w1 * bflo(b.x) + w2 * bflo(c.x), w0 * bfhi(a.x) + w1 * bfhi(b.x) + w2 * bfhi(c.x));
    r.y = pk2(w0 * bflo(a.y) + w1 * bflo(b.y) + w2 * bflo(c.y), w0 * bfhi(a.y) + w1 * bfhi(b.y) + w2 * bfhi(c.y));
    *(v2u*)(WSP(bf16, WS_Y) + (size_t)m * 1024 + 256 + 4 * lane) = r;
}

__device__ __forceinline__ void ln1_router_phase(Frame& F, const Args& args, int l) {
    LAS float* RT = (LAS float*)F.lds;
    const float* rw = FIN(I_ROUTER) + (size_t)l * 1024 * 16;
    __syncthreads();
    for (int i = F.tid; i < 1024 * 16; i += 512) { const int col = i >> 4, e = i & 15; RT[e * 1024 + col] = rw[i]; }
    __syncthreads();
    const int gw = F.bid * 8 + F.wave, NGW = F.G * 8, lane = F.lane;
    const bf16* pre = WSP(bf16, WS_RB + RB_PRE);
    v2u nx[4];
#pragma unroll
    for (int j = 0; j < 4; ++j) nx[j] = *(const v2u*)(pre + (size_t)gw * DM + 4 * lane + 256 * j);
    for (int m = gw; m < M; m += NGW) {
        f32x4 v[4];
#pragma unroll
        for (int j = 0; j < 4; ++j) v[j] = (f32x4){bflo(nx[j].x), bfhi(nx[j].x), bflo(nx[j].y), bfhi(nx[j].y)};
        if (m + NGW < M) {
#pragma unroll
            for (int j = 0; j < 4; ++j) nx[j] = *(const v2u*)(pre + (size_t)(m + NGW) * DM + 4 * lane + 256 * j); }
        ln_row(v, FIN(I_LN1G) + l * DM, FIN(I_LN1B) + l * DM, lane);
        store_row_bf16(v, WSP(bf16, WS_HB) + (size_t)m * DM, lane);
        float lg[16];
#pragma unroll
        for (int e = 0; e < 16; ++e) { float a = 0.f;
#pragma unroll
            for (int j = 0; j < 4; ++j) { const f32x4 w = *(const LAS f32x4*)(RT + e * 1024 + 4 * lane + 256 * j); a += v[j].x * w.x + v[j].y * w.y + v[j].z * w.z + v[j].w * w.w; }
            lg[e] = a; if (e & 1) asm volatile("" ::: "memory"); }
#pragma unroll
        for (int e = 0; e < 8; ++e) { const bool up = (lane & 32) != 0; const float keep = up ? lg[e + 8] : lg[e], give = up ? lg[e] : lg[e + 8]; lg[e] = keep + __shfl_xor(give, 32); }
#pragma unroll
        for (int e = 0; e < 4; ++e) { const bool up = (lane & 16) != 0; const float keep = up ? lg[e + 4] : lg[e], give = up ? lg[e] : lg[e + 4]; lg[e] = keep + __shfl_xor(give, 16); }
#pragma unroll
        for (int e = 0; e < 2; ++e) { const bool up = (lane & 8) != 0; const float keep = up ? lg[e + 2] : lg[e], give = up ? lg[e] : lg[e + 2]; lg[e] = keep + __shfl_xor(give, 8); }
        { const bool up = (lane & 4) != 0; const float keep = up ? lg[1] : lg[0], give = up ? lg[0] : lg[1]; lg[0] = keep + __shfl_xor(give, 4); }
        float z = lg[0]; z += __shfl_xor(z, 2); z += __shfl_xor(z, 1);
        float mx = z; mx = fmaxf(mx, __shfl_xor(mx, 4)); mx = fmaxf(mx, __shfl_xor(mx, 8)); mx = fmaxf(mx, __shfl_xor(mx, 16)); mx = fmaxf(mx, __shfl_xor(mx, 32));
        const float p = expf(z - mx); float den = p; den += __shfl_xor(den, 4); den += __shfl_xor(den, 8); den += __shfl_xor(den, 16); den += __shfl_xor(den, 32);
        if ((lane & 3) == 0) { const int e = ((lane >> 5) & 1) * 8 + ((lane >> 4) & 1) * 4 + ((lane >> 3) & 1) * 2 + ((lane >> 2) & 1); WSP(float, WS_AFF)[(size_t)m * 16 + e] = p / den; }
    }
}

__device__ __forceinline__ int wave_incl_scan(int v, int lane) {
#pragma unroll
    for (int o = 1; o < 64; o <<= 1) { const int n = __shfl_up(v, o); if (lane >= o) v += n; }
    return v;
}
__device__ __forceinline__ int block_excl_scan(Frame& F, int v, LAS int* sc) {
    const int inc = wave_incl_scan(v, F.lane);
    __syncthreads();
    if (F.lane == 63) sc[F.wave] = inc;
    __syncthreads();
    int base = 0;
#pragma unroll
    for (int w = 0; w < 8; ++w) { const int x = sc[w]; if (w < F.wave) base += x; }
    return base + inc - v;
}
__device__ __forceinline__ void topk_item(Frame& F, int e, int b, int half, int nhalf) {
    LAS int* H = (LAS int*)F.lds;
    LAS int* SH = H + 256;
    LAS int* SC = SH + 4;
    LAS int* SEL = SC + 16;
    const int tid = F.tid, lane = F.lane, eb = e * 8 + b;
    const float* aff = WSP(float, WS_AFF) + (size_t)b * SEQ * 16 + e;
    unsigned key[8];
#pragma unroll
    for (int j = 0; j < 8; ++j) key[j] = __float_as_uint(aff[(size_t)(8 * tid + j) * 16]);
    unsigned prefix = 0u, pmask = 0u; int need = CAP;
    for (int pass = 3; pass >= 0; --pass) {
        __syncthreads();
        if (tid < 256) H[tid] = 0;
        __syncthreads();
#pragma unroll
        for (int j = 0; j < 8; ++j) if ((key[j] & pmask) == prefix) __hip_atomic_fetch_add(&H[(key[j] >> (8 * pass)) & 255u], 1, __ATOMIC_RELAXED, __HIP_MEMORY_SCOPE_WORKGROUP);
        __syncthreads();
        if (F.wave == 0) {
            const int c0 = H[255 - 4 * lane], c1 = H[254 - 4 * lane], c2 = H[253 - 4 * lane], c3 = H[252 - 4 * lane];
            const int s = c0 + c1 + c2 + c3, inc = wave_incl_scan(s, lane), exc = inc - s;
            if (exc < need && need <= inc) { const int r = need - exc; int bin, nn;
                if (r <= c0) { bin = 255 - 4 * lane; nn = r; } else if (r <= c0 + c1) { bin = 254 - 4 * lane; nn = r - c0; }
                else if (r <= c0 + c1 + c2) { bin = 253 - 4 * lane; nn = r - c0 - c1; } else { bin = 252 - 4 * lane; nn = r - c0 - c1 - c2; }
                SH[0] = bin; SH[1] = nn; }
        }
        __syncthreads();
        prefix |= (unsigned)SH[0] << (8 * pass); pmask |= 0xffu << (8 * pass); need = SH[1];
    }
    const unsigned thr = prefix;
    int eqc = 0;
#pragma unroll
    for (int j = 0; j < 8; ++j) eqc += (key[j] == thr) ? 1 : 0;
    int eq = block_excl_scan(F, eqc, SC);
    int selc = 0; unsigned selm = 0u;
#pragma unroll
    for (int j = 0; j < 8; ++j) { bool s = key[j] > thr; if (key[j] == thr) { s = eq < need; ++eq; } if (s) { selm |= 1u << j; ++selc; } }
    int slot = block_excl_scan(F, selc, SC);
    unsigned short* inv = WSP(unsigned short, WS_INV) + (size_t)eb * SEQ;
    float* gwp = WSP(float, WS_GW) + (size_t)eb * CAP; int* idx = WSP(int, WS_IDX) + (size_t)eb * CAP;
#pragma unroll
    for (int j = 0; j < 8; ++j) { const int t = 8 * tid + j;
        if ((selm >> j) & 1u) { SEL[slot] = t; if (half == 0) { inv[t] = (unsigned short)(slot + 1); gwp[slot] = __uint_as_float(key[j]); idx[slot] = t; } ++slot; }
        else if (half == 0) inv[t] = (unsigned short)0; }
    __syncthreads();
    const bf16* hb = WSP(bf16, WS_HB) + (size_t)b * SEQ * DM; bf16* xs = WSP(bf16, WS_RA + RA_XS) + (size_t)eb * CAP * DM;
    for (int s0 = half * (CAP / nhalf) + F.wave; s0 < (half + 1) * (CAP / nhalf); s0 += 64) {
        v4u a[8][2];
#pragma unroll
        for (int k = 0; k < 8; ++k) { const int t = SEL[s0 + 8 * k]; const v4u* sp = (const v4u*)(hb + (size_t)t * DM); a[k][0] = sp[F.lane]; a[k][1] = sp[F.lane + 64]; }
#pragma unroll
        for (int k = 0; k < 8; ++k) { v4u* dp = (v4u*)(xs + (size_t)(s0 + 8 * k) * DM); dp[F.lane] = a[k][0]; dp[F.lane + 64] = a[k][1]; }
    }
    __syncthreads();
}

__device__ __forceinline__ void ln2_phase(Frame& F, const Args& args, int l, bool dummy = false) {
    const int gw = F.bid * 8 + F.wave, NGW = F.G * 8, lane = F.lane;
    const unsigned short* inv = WSP(unsigned short, WS_INV);
    const bf16* eo = WSP(bf16, WS_RA + RA_EOUT);
    v2u nx[2][4]; unsigned nslv[2];
#pragma unroll
    for (int r = 0; r < 2; ++r) { const int m = gw + r * NGW; nslv[r] = 0u;
#pragma unroll
        for (int j = 0; j < 4; ++j) nx[r][j] = (v2u){0u, 0u};
        if (m < M) { const int b = m >> 12, t = m & (SEQ - 1); if (lane < NE) nslv[r] = inv[((size_t)(lane * 8 + b)) * SEQ + t];
#pragma unroll
            for (int j = 0; j < 4; ++j) nx[r][j] = *(const v2u*)(WSP(bf16, WS_HB) + (size_t)m * DM + 4 * lane + 256 * j); } }
    for (int m0 = gw; m0 < M; m0 += 2 * NGW) {
        f32x4 v[2][4]; unsigned slv[2], mask[2];
#pragma unroll
        for (int r = 0; r < 2; ++r) { slv[r] = nslv[r];
#pragma unroll
            for (int j = 0; j < 4; ++j) v[r][j] = (f32x4){bflo(nx[r][j].x), bfhi(nx[r][j].x), bflo(nx[r][j].y), bfhi(nx[r][j].y)} * DN_ALPHA; }
#pragma unroll
        for (int r = 0; r < 2; ++r) { const int m2 = m0 + 2 * NGW + r * NGW; nslv[r] = 0u;
            if (m2 < M) { const int b2 = m2 >> 12, t2 = m2 & (SEQ - 1); if (lane < NE) nslv[r] = inv[((size_t)(lane * 8 + b2)) * SEQ + t2];
#pragma unroll
                for (int j = 0; j < 4; ++j) nx[r][j] = *(const v2u*)(WSP(bf16, WS_HB) + (size_t)m2 * DM + 4 * lane + 256 * j); } }
#pragma unroll
        for (int r = 0; r < 2; ++r) mask[r] = (unsigned)__ballot(slv[r] != 0u);
        while (mask[0] | mask[1]) {
            v2u w[2][4][4]; float wgt[2][4];
#pragma unroll
            for (int r = 0; r < 2; ++r) { const int m = m0 + r * NGW, b = (m < M ? m : m0) >> 12;
#pragma unroll
                for (int k = 0; k < 4; ++k) { int e = 0; wgt[r][k] = 0.f; if (mask[r]) { e = __builtin_ctz(mask[r]); mask[r] &= mask[r] - 1u; wgt[r][k] = 1.f; }
                    const int ek = __builtin_amdgcn_readfirstlane(e); unsigned sl = (unsigned)__builtin_amdgcn_readlane((int)slv[r], ek); sl = sl ? sl - 1u : 0u;
                    const bf16* rp = eo + ((size_t)(ek * 8 + b) * CAP + sl) * DM + 4 * lane;
#pragma unroll
                    for (int j = 0; j < 4; ++j) w[r][k][j] = *(const v2u*)(rp + 256 * j); } }
#pragma unroll
            for (int r = 0; r < 2; ++r)
#pragma unroll
                for (int k = 0; k < 4; ++k)
#pragma unroll
                    for (int j = 0; j < 4; ++j) { v[r][j].x += wgt[r][k] * bflo(w[r][k][j].x); v[r][j].y += wgt[r][k] * bfhi(w[r][k][j].x); v[r][j].z += wgt[r][k] * bflo(w[r][k][j].y); v[r][j].w += wgt[r][k] * bfhi(w[r][k][j].y); }
        }
#pragma unroll
        for (int r = 0; r < 2; ++r) { const int m = m0 + r * NGW; if (m >= M) break;
            ln_row(v[r], FIN(I_LN2G) + l * DM, FIN(I_LN2B) + l * DM, lane);
            if (l == DEPTH - 1) {
#pragma unroll
                for (int j = 0; j < 4; ++j) *(f32x4*)((dummy ? WSP(float, WS_RB) : F.out) + (size_t)m * DM + 4 * lane + 256 * j) = v[r][j]; }
            else store_row_bf16(v[r], WSP(bf16, dummy ? WS_Y : WS_HB) + (size_t)m * DM, lane); }
    }
}

struct SchedTiles {
    const char* A0; const char* B0; size_t a_tile, b_tile; int nM, nN, G, c;
    __device__ __forceinline__ bool next(int i, pg8::Unit& u) const {
        const int L = i * G + c; if (L >= nM * nN) return false;
        int pm, pn; pg8::tile_of(L, nM, nN, pm, pn);
        u.A = A0 + (size_t)pm * a_tile; u.B = B0 + (size_t)pn * b_tile; u.orow = pm * 256; u.ocol = pn * 256; u.z = 0; return true;
    }
};
struct SchedMerge {
    const char* Y; const char* WB; int G, c;
    __device__ __forceinline__ bool next(int i, pg8::MergeUnit& u) const {
        const int L = (i >> 2) * G + c, z = i & 3; if (L >= 128 * 8) return false;
        int pm, pn; pg8::tile_of(L, 128, 8, pm, pn);
        u.A = Y + ((size_t)pm * 256 * 1024 + z * 256) * 2; u.B = WB + ((size_t)z * 1024 * 256 + (size_t)pn * 128 * 256) * 2; u.orow = pm * 256; u.ocol = pn * 128; u.z = z; return true;
    }
};
struct SchedMoe1 {
    const char* XS; const char* W; int G, c;
    __device__ __forceinline__ bool next(int i, pg8::Unit& u) const {
        const int L = i * G + c; if (L >= 128 * 16) return false;
        const int eb = L >> 4, sub = L & 15, pm2 = sub & 1, pn = sub >> 1, e = eb >> 3;
        u.A = XS + ((size_t)(eb * 512 + pm2 * 256) * 1024) * 2; u.B = W + ((size_t)(e * 2048 + pn * 256) * 1024) * 2; u.orow = eb * 512 + pm2 * 256; u.ocol = pn * 128; u.z = eb; return true;
    }
};
struct SchedMoe2 {
    const char* HID; const char* W; int G, c;
    __device__ __forceinline__ bool next(int i, pg8::Unit& u) const {
        const int L = i * G + c; if (L >= 128 * 8) return false;
        const int eb = L >> 3, sub = L & 7, pm2 = sub & 1, pn = sub >> 1, e = eb >> 3;
        u.A = HID + ((size_t)(eb * 512 + pm2 * 256) * 1024) * 2; u.B = W + ((size_t)(e * 1024 + pn * 256) * 1024) * 2; u.orow = eb * 512 + pm2 * 256; u.ocol = pn * 256; u.z = eb; return true;
    }
};

static_assert((size_t)(CW_Q + (DEPTH * 8 + 8) * 64) * 4 <= CTL_ZERO_BYTES && (size_t)(CW_BAR + 3456) * 4 <= (size_t)CW_Q * 4, "control words inside the per-call memset");
constexpr int NPH = 12;
__global__ void __launch_bounds__(512, 2) fwd_kernel(Args args_k) {
    const Args& args0 = args_k;
    extern __shared__ __attribute__((aligned(16))) unsigned char lds_raw[];
    Frame F;
    F.lds = (LAS unsigned char*)lds_raw;
    F.MISC = (volatile LAS unsigned*)(F.lds + MISC_OFF);
    F.tid = threadIdx.x; F.lane = F.tid & 63; F.wave = __builtin_amdgcn_readfirstlane(F.tid >> 6);
    F.G = gridDim.x; F.bid = blockIdx.x; F.zoff = 0;
    const int wave0 = __builtin_amdgcn_readfirstlane(threadIdx.x >> 6);
    F.ws = args0.ws; F.out = args0.out; F.ctl = (gu32*)(args0.ws + WS_CTL);
    for (int u = F.tid; u < (LDS_BYTES - MISC_OFF) / 4; u += 512) F.MISC[u] = 0u;
    __syncthreads();
#if defined(DBG_PROF) || defined(DBG_DLY)
    if (blockIdx.x == 0 && threadIdx.x == 0) ((unsigned long long*)(args0.ws + WS_CTL))[50000 + 15] = __builtin_amdgcn_s_memrealtime();
#endif
    const bool multi = (args0.l_hi - args0.l_lo > 1) || (args0.ph_hi - args0.ph_lo > 1);
    XcdBarrier bar; bar.bar = (unsigned*)(F.ctl + CW_BAR); bar.x = 0; bar.st = F.MISC + 8;
    if (multi) bar = xcd_barrier_post((unsigned*)(F.ctl + CW_BAR), F.MISC + 8);
    const int lo = args0.ph_lo, hi = args0.ph_hi, l_lo = args0.l_lo, l_hi = args0.l_hi;
#ifndef DBL_MASK
#define DBL_MASK 0
#endif
#define NREP(k) (((DBL_MASK >> (k)) & 1) ? 2 : 1)
#ifndef DBG_ROT
#define DBG_ROT 0
#endif
#ifndef PHASE_MASK
#define PHASE_MASK 0xfff
#endif
#define IN(k) (((PHASE_MASK >> (k)) & 1) && lo <= (k) && (k) < hi)
#ifndef SUB_MASK
#define SUB_MASK 0xff
#endif
#define SUB(k) ((SUB_MASK >> (k)) & 1)
#define FRESH() do { { int b_ = blockIdx.x, g_ = gridDim.x; asm volatile("" : "+s"(b_)); asm volatile("" : "+s"(g_)); F.bid = b_; F.G = g_; } int ln_ = __builtin_amdgcn_mbcnt_hi(~0u, __builtin_amdgcn_mbcnt_lo(~0u, 0u)); asm volatile("" : "+v"(ln_)); int wv_ = wave0; asm volatile("" : "+s"(wv_)); F.lane = ln_; F.wave = wv_; F.tid = wv_ * 64 + ln_; } while (0)
#if defined(DBG_PROF) || defined(DBG_DLY)
#define STAMP(k) do { if (blockIdx.x == 0 && threadIdx.x == 0) ((unsigned long long*)(F.ws + WS_CTL))[50000 + l * 16 + (k)] = __builtin_amdgcn_s_memrealtime(); } while (0)
#else
#define STAMP(k) do {} while (0)
#endif
#define SEAM(k) do { if (((k) + 1 < hi) || (l + 1 < l_hi)) { XcdBarrier b2_ = bar; asm volatile("" : "+s"(b2_.x)); asm volatile("" : "+s"(b2_.bar)); xcd_barrier(b2_, F.tid); } STAMP(k); } while (0)

#pragma unroll 1
    for (int l = l_lo; l < l_hi; ++l) {
        const Args& args = args_k;
        { size_t z_ = 0; asm volatile("" : "+s"(z_)); F.ws = args.ws + z_; F.out = args.out + z_; F.ctl = (gu32*)(F.ws + WS_CTL); }
        unsigned char* wb = F.ws + WS_W;
        const char* HBp = (const char*)(F.ws + WS_HB);
#define NGW (F.G * 8)
#define gw (F.bid * 8 + F.wave)
        if (IN(0) && l == 0) { FRESH(); prologue_phase(F, args); SEAM(0); if (NREP(0) > 1) { FRESH(); prologue_phase(F, args); SEAM(0); } }

        if (IN(1)) _Pragma("unroll 1") for (int rep_ = 0; rep_ < NREP(1); ++rep_) { FRESH();
            const pg8::Gemm g{1024, 1024, 1024};
            if (SUB(0)) {
                SchedTiles S{(const char*)(wb + W_WIN), HBp, (size_t)256 * 1024 * 2, (size_t)256 * 1024 * 2, 3, 128, F.G, F.bid};
                pg8::EpiBf16<0> E{WSP(bf16, WS_RB + RB_HYT), M};
                pg8::gemm_phase(F.lds, g, S, E, F.tid); }
            if (SUB(1)) {
                SchedTiles S{HBp, (const char*)(wb + W_WIN) + (size_t)768 * 1024 * 2, (size_t)256 * 1024 * 2, (size_t)256 * 1024 * 2, 128, 12, F.G, F.bid};
                pg8::EpiBf16<0> E{WSP(bf16, WS_RB + RB_PROJ2), PROJ2_W};
                pg8::gemm_phase(F.lds, g, S, E, F.tid); }
            if (SUB(2)) {
                SchedTiles S{HBp, (const char*)(wb + W_WIN) + (size_t)3840 * 1024 * 2, (size_t)256 * 1024 * 2, (size_t)256 * 1024 * 2, 128, 16, F.G, (F.bid + DBG_ROT) % F.G};
                pg8::EpiBf16<1> E{WSP(bf16, WS_RA + RA_G), 4096};
                pg8::gemm_phase(F.lds, g, S, E, F.tid); }
            SEAM(1);
        }
        if (IN(2)) _Pragma("unroll 1") for (int rep_ = 0; rep_ < NREP(2); ++rep_) { FRESH();
            if (l == 0) { for (int tb = F.bid; tb < 256; tb += F.G) hy_taps_block(F, args, 0, tb); __syncthreads(); }
            _Pragma("unroll 2") for (int m = 2 * gw; m < M; m += 2 * NGW) gqa_prep_rows(F, args, l, m);
            if (rep_ + 1 < NREP(2)) { for (int r = gw; r < 768 * 8; r += NGW) hy_sconv_row(F, args, l, r, (WS_RD + RD_DILO) - (WS_RB + RB_HYT)); } else
            for (int r = gw; r < 768 * 8; r += NGW) hy_sconv_row(F, args, l, r);
            SEAM(2); }

        if (IN(3)) _Pragma("unroll 1") for (int rep_ = 0; rep_ < NREP(3); ++rep_) { FRESH();
#if MK_STATIC_Q
            if (SUB(0)) for (int it = F.bid; it < 256; it += F.G) hyena_item(F, args, l, it);
            if (SUB(1)) {   const attn_body::bf16* Qp = (const attn_body::bf16*)(F.ws + WS_RD + RD_QKVG);
                attn_body::bf16* Op = (attn_body::bf16*)(F.ws + WS_Y) + 768;
                for (int it = F.bid; it < 512; it += F.G) { __syncthreads();
                    attn_body::attn_unit<8>(it >> 6, (it >> 4) & 3, it & 15, Qp, Qp + 256, Qp + 384, Op, (char*)lds_raw, F.tid); } }
            if (SUB(2)) for (int it = F.bid; it < 128; it += F.G) s5_item(F, args, l, it >> 4, it & 15);
            __syncthreads();
            if (SUB(3)) for (int it = F.bid; it < 1536; it += F.G) dil_item(F, args, it);
#else
#ifndef DBL_SUB
#define DBL_SUB 0
#endif
#define NREPS(t) (((DBL_SUB >> (t)) & 1) ? 2 : 1)
            _Pragma("unroll 1") for (int r2 = 0; r2 < NREPS(2); ++r2) for (;;) { const int it = wq_grab(F, l * 8 + (r2 + rep_) * 4 + 2); if (it >= 128) break; s5_item(F, args, l, it >> 4, it & 15); }
            _Pragma("unroll 1") for (int r2 = 0; r2 < NREPS(0); ++r2) for (;;) { const int it = wq_grab(F, l * 8 + (r2 + rep_) * 4 + 0); if (it >= 256) break; hyena_item(F, args, l, it); }
            {   const attn_body::bf16* Qp = (const attn_body::bf16*)(F.ws + WS_RD + RD_QKVG);
                attn_body::bf16* Op = (attn_body::bf16*)(F.ws + WS_Y) + 768;
                _Pragma("unroll 1") for (int r2 = 0; r2 < NREPS(1); ++r2) for (;;) { const int it = wq_grab(F, l * 8 + (r2 + rep_) * 4 + 1); if (it >= 512) break;
                    attn_body::attn_unit<8>(it >> 6, (it >> 4) & 3, it & 15, Qp, Qp + 256, Qp + 384, Op, (char*)lds_raw, F.tid); } }
            _Pragma("unroll 1") for (int r2 = 0; r2 < NREPS(3); ++r2) for (;;) { const int it = wq_grab(F, l * 8 + (r2 + rep_) * 4 + 3); if (it >= 768) break; dil_item(F, args, 2 * it); dil_item(F, args, 2 * it + 1); }
#endif
            SEAM(3);
        }
        if (IN(4)) _Pragma("unroll 1") for (int rep_ = 0; rep_ < NREP(4); ++rep_) { FRESH();
            if (SUB(0)) {   const pg8::Gemm g{256, 256, 256};
                SchedTiles S{(const char*)(F.ws + WS_RD + RD_S5Z), (const char*)(wb + W_GLU), (size_t)256 * 256 * 2, 0, 128, 1, F.G, F.bid};
                pg8::EpiGlu E{WSP(bf16, WS_RD + RD_S5Z), WSP(bf16, WS_Y), FIN(I_S5_GB) + l * 256};
                pg8::gemm_phase(F.lds, g, S, E, F.tid); }
            __syncthreads();
            if (SUB(1)) for (int it = gw; it < 2048; it += NGW) hy_transpose_item(F, it);
            if (SUB(2)) for (int m = gw; m < M; m += NGW) dil_combine_row(F, m);
            SEAM(4);
        }
        if (IN(5)) _Pragma("unroll 1") for (int rep_ = 0; rep_ < NREP(5); ++rep_) { FRESH();
            const pg8::Gemm g{256, 1024, 256};
            SchedMerge S{(const char*)(F.ws + WS_Y), (const char*)(wb + W_WB), F.G, F.bid};
            pg8::gemm_merge_phase(F.lds, g, S, WSP(bf16, WS_RA + RA_G), WSP(bf16, WS_RB + RB_MB), F.tid);
            SEAM(5);
        }
        if (IN(6)) _Pragma("unroll 1") for (int rep_ = 0; rep_ < NREP(6); ++rep_) { FRESH();
            const pg8::Gemm g{1024, 1024, 1024};
            SchedTiles S{(const char*)(F.ws + WS_RB + RB_MB), (const char*)(wb + W_WO), (size_t)256 * 1024 * 2, (size_t)256 * 1024 * 2, 128, 4, F.G, F.bid};
            pg8::EpiPre E{WSP(bf16, WS_HB), WSP(bf16, WS_RB + RB_PRE), DN_ALPHA};
            pg8::gemm_phase(F.lds, g, S, E, F.tid);
            SEAM(6);
        }
        if (IN(7)) _Pragma("unroll 1") for (int rep_ = 0; rep_ < NREP(7); ++rep_) { FRESH(); ln1_router_phase(F, args, l); SEAM(7); }
        if (IN(8)) _Pragma("unroll 1") for (int rep_ = 0; rep_ < NREP(8); ++rep_) { FRESH(); if (F.G >= 256) { if (F.bid < 256) topk_item(F, (F.bid & 127) >> 3, F.bid & 7, F.bid >> 7, 2); } else for (int it = F.bid; it < 128; it += F.G) topk_item(F, it >> 3, it & 7, 0, 1);
            if (l + 1 < DEPTH) { __syncthreads(); for (int tb = F.bid; tb < 256; tb += F.G) hy_taps_block(F, args, l + 1, tb); }
            SEAM(8); }
        if (IN(9)) _Pragma("unroll 1") for (int rep_ = 0; rep_ < NREP(9); ++rep_) { FRESH();
            const pg8::Gemm g{1024, 1024, 1024};
            SchedMoe1 S{(const char*)(F.ws + WS_RA + RA_XS), (const char*)(wb + W_GU), F.G, F.bid};
            pg8::EpiSwiglu E{WSP(bf16, WS_RB + RB_HID)};
            pg8::gemm_phase(F.lds, g, S, E, F.tid);
            SEAM(9);
        }
        if (IN(10)) _Pragma("unroll 1") for (int rep_ = 0; rep_ < NREP(10); ++rep_) { FRESH();
            const pg8::Gemm g{1024, 1024, 1024};
            SchedMoe2 S{(const char*)(F.ws + WS_RB + RB_HID), (const char*)(wb + W_DN), F.G, F.bid};
            pg8::EpiRowScale E{WSP(bf16, WS_RA + RA_EOUT), WSP(float, WS_GW)};
            pg8::gemm_phase(F.lds, g, S, E, F.tid);
            SEAM(10);
        }
        if (IN(11)) { FRESH();
            if (NREP(11) > 1) { ln2_phase(F, args, l, true); FRESH(); }
            ln2_phase(F, args, l);
            if (l + 1 < DEPTH) convert_layer(F, args, l + 1, gw, NGW);
#ifdef DBG_CONV2
            if (l + 1 < DEPTH) convert_layer(F, args, l + 1, gw, NGW);
#endif
            SEAM(11);
        }
    }
    if (multi) {
        { XcdBarrier b2_ = bar; asm volatile("" : "+s"(b2_.x)); asm volatile("" : "+s"(b2_.bar)); xcd_barrier(b2_, F.tid); }
        if (__hip_atomic_load((unsigned*)(F.ctl + CW_BAR) + XB_TMO, RLX_AGENT) != 0u) {
            const float q = __builtin_nanf("");
            for (size_t i = (size_t)F.bid * 512 + F.tid; i < (size_t)M * DM; i += (size_t)F.G * 512) args0.out[i] = q; }
    }
#ifdef DBG_DLY
    if (blockIdx.x == 0 && threadIdx.x == 0) {
        const unsigned long long* ts = (const unsigned long long*)(args0.ws + WS_CTL) + 50000; unsigned long long s = 0;
        for (int l = 0; l < DEPTH; ++l) for (int p = 0; p < NPH; ++p) { if (!((DBG_DLY >> p) & 1) || (p == 0 && l > 0)) continue;
            const unsigned long long e = ts[l * 16 + p], b = p == 0 ? ts[15] : (p == 1 && l > 0) ? ts[(l - 1) * 16 + 11] : ts[l * 16 + p - 1]; s += e - b; }
        const unsigned long long t0 = __builtin_amdgcn_s_memrealtime();
        while (__builtin_amdgcn_s_memrealtime() - t0 < s * DLY_MULT) __builtin_amdgcn_s_sleep(32);
    }
#endif
#undef IN
#undef gw
#undef NGW
#undef SEAM
}


#ifdef DBG_STOP
__global__ void dbg_dump_kernel(const unsigned char* ws, float* out, size_t off, int isf32, int ld, int ncols) {
    const size_t n = (size_t)M * DM;
    for (size_t i = (size_t)blockIdx.x * blockDim.x + threadIdx.x; i < n; i += (size_t)gridDim.x * blockDim.x) {
        const size_t r = i / DM, c = i % DM; float v = 0.f;
        if ((int)c < ncols) { if (isf32) v = ((const float*)(ws + off))[r * ld + c]; else v = bf2f(((const bf16*)(ws + off))[r * ld + c]); }
        out[i] = v; }
}
#endif

#ifdef DBG_RACE
constexpr int CW_DBG = 65536;
__global__ void dbg_sum_kernel(const unsigned* p, size_t nwords, unsigned long long* slot) {
    unsigned long long s = 0;
    for (size_t i = (size_t)blockIdx.x * blockDim.x + threadIdx.x; i < nwords; i += (size_t)gridDim.x * blockDim.x) s += (unsigned long long)p[i] * (unsigned long long)((i & 1023u) + 1u);
    for (int o = 32; o >= 1; o >>= 1) s += __shfl_xor(s, o);
    if ((threadIdx.x & 63) == 0) atomicAdd(slot, s);
}
__global__ void dbg_final_kernel(const unsigned long long* T, float* out) {
    int V = 0;
    for (int s = 56; s <= 60; ++s) if (T[s] != T[64 + s]) V |= 1 << (s - 56);
    const float c = 10.f * (float)(V + 1);
    for (size_t i = (size_t)blockIdx.x * blockDim.x + threadIdx.x; i < (size_t)M * DM; i += (size_t)gridDim.x * blockDim.x) out[i] = c;
}
#endif

#ifdef DBG_STAT
__global__ void dbg_stat_kernel(const unsigned char* ws, size_t off, int ld, int ncols, unsigned* res) {
    unsigned mx = 0, cnt = 0;
    for (size_t i = (size_t)blockIdx.x * blockDim.x + threadIdx.x; i < (size_t)M * ncols; i += (size_t)gridDim.x * blockDim.x) {
        const size_t r = i / ncols, c = i % ncols; const float v = fabsf(bf2f(((const bf16*)(ws + off))[r * ld + c]));
        const unsigned b = __float_as_uint(v); mx = b > mx ? b : mx; cnt += (v > DBG_THR || v != v) ? 1u : 0u; }
    atomicMax(res, mx); atomicAdd(res + 1, cnt);
    for (size_t r = (size_t)blockIdx.x * blockDim.x + threadIdx.x; r < (size_t)M; r += (size_t)gridDim.x * blockDim.x) { bool bad = false; unsigned first = 0xffffffffu;
        for (int c = 0; c < ncols; ++c) { const float v = fabsf(bf2f(((const bf16*)(ws + off))[r * ld + c])); if (v > DBG_THR || v != v) { bad = true; if (first == 0xffffffffu) first = c; } }
        if (bad) { atomicAdd(res + 2, 1u); atomicMin(res + 3, (unsigned)r); atomicMin(res + 4, first); } }
}
__global__ void dbg_statout_kernel(const unsigned* res, float* out) {
    const float c = DBG_STAT == 0 ? 100.f * __uint_as_float(res[0]) : DBG_STAT == 1 ? sqrtf((float)res[1]) : DBG_STAT == 2 ? sqrtf((float)res[2]) : DBG_STAT == 3 ? (float)(res[3] / 2048u + 20u) : (float)(res[4] / 256u + 20u);
    for (size_t i = (size_t)blockIdx.x * blockDim.x + threadIdx.x; i < (size_t)M * DM; i += (size_t)gridDim.x * blockDim.x) out[i] = c;
}
#endif

#ifdef DBG_PROF
__global__ void dbg_prof_kernel(const unsigned long long* ts, float* out) {
    float tp[12];
    for (int p = 0; p < 12; ++p) { double s = 0; for (int l = 0; l < DEPTH; ++l) { if (p == 0 && l > 0) continue;
        const unsigned long long e = ts[l * 16 + p]; unsigned long long b;
        if (p == 0) b = ts[15]; else if (p == 1 && l > 0) b = ts[(l - 1) * 16 + 11]; else b = ts[l * 16 + p - 1];
        if (p == 11 && l == DEPTH - 1) continue;
        s += (double)(e - b) * 0.01; } tp[p] = (float)s; }
    const float c = tp[DBG_PA], d = 1000.f * tp[DBG_PB];
    for (size_t i = (size_t)blockIdx.x * blockDim.x + threadIdx.x; i < (size_t)M * DM; i += (size_t)gridDim.x * blockDim.x) out[i] = (i == 0) ? d : c;
}
#endif
extern "C" void kernel_launch(void* const* d_in, const int* in_sizes, int n_in, void* d_out, int out_size, void* d_ws, size_t ws_size, hipStream_t stream) {
    static int grid = 0;
    if (grid == 0) {
        if (n_in != N_INPUTS || out_size != M * DM || ws_size < WS_END) { fprintf(stderr, "kernel_launch: unexpected problem (n_in %d, out %d, ws %zu)\n", n_in, out_size, ws_size); grid = -1; return; }
        int dev = 0, cus = 0, per_cu = 0;
        if (hipGetDevice(&dev) != hipSuccess || hipDeviceGetAttribute(&cus, hipDeviceAttributeMultiprocessorCount, dev) != hipSuccess) { grid = -1; return; }
        if (hipFuncSetAttribute((const void*)fwd_kernel, hipFuncAttributeMaxDynamicSharedMemorySize, LDS_BYTES) != hipSuccess) { fprintf(stderr, "kernel_launch: hipFuncSetAttribute failed\n"); grid = -1; return; }
        if (hipOccupancyMaxActiveBlocksPerMultiprocessor(&per_cu, (const void*)fwd_kernel, 512, LDS_BYTES) != hipSuccess || per_cu < 1)
            fprintf(stderr, "kernel_launch: occupancy query reports %d workgroups per CU\n", per_cu);
        (void)hipGetLastError();
        grid = cus;
    }
    if (grid < 0) return;
    if (hipMemsetAsync((char*)d_ws + WS_CTL, 0, CTL_ZERO_BYTES, stream) != hipSuccess) return;
    Args a{};
    for (int i = 0; i < N_INPUTS; ++i) a.in[i] = (const float*)d_in[i];
    a.out = (float*)d_out; a.ws = (unsigned char*)d_ws;
#if MK_ONE_LAUNCH
    a.ph_lo = 0; a.ph_hi = NPH; a.l_lo = 0; a.l_hi = DEPTH;
    hipLaunchKernelGGL(fwd_kernel, dim3(grid), dim3(512), LDS_BYTES, stream, a);
#ifdef DBG_PROF
    hipLaunchKernelGGL(dbg_prof_kernel, dim3(1024), dim3(256), 0, stream, (const unsigned long long*)((char*)d_ws + WS_CTL) + 50000, (float*)d_out);
#endif
#else
#ifdef DBG_RACE
    {
    unsigned char* ws = (unsigned char*)d_ws; unsigned long long* T = (unsigned long long*)(ws + WS_CTL) + CW_DBG / 2;
    auto sum = [&](size_t off, size_t bytes, int slot) { hipLaunchKernelGGL(dbg_sum_kernel, dim3(1024), dim3(256), 0, stream, (const unsigned*)(ws + off), bytes / 4, T + slot); };
    auto sumout = [&](int slot) { hipLaunchKernelGGL(dbg_sum_kernel, dim3(1024), dim3(256), 0, stream, (const unsigned*)d_out, (size_t)M * DM, T + slot); };
    for (int run = 0; run < 2; ++run) {
        if (run == 1) hipMemsetAsync((char*)d_ws + WS_CTL, 0, CW_DBG * 4, stream);
        hipMemsetAsync((char*)d_ws + 1 * MiB, run == 0 ? 0xAA : 0x55, WS_END - 1 * MiB, stream);
        for (int l = 0; l < DBG_LAYERS; ++l)
            for (int p = (l == 0 ? 0 : 1); p < DBG_NPH; ++p) { a.ph_lo = p; a.ph_hi = p + 1; a.l_lo = l; a.l_hi = l + 1;
                hipLaunchKernelGGL(fwd_kernel, dim3(grid), dim3(512), LDS_BYTES, stream, a);
                const int s = run * 64 + l * 12 + p;
                switch (p) {
                case 0: sum(WS_HB, 64 * MiB, s); sumout(s); sum(WS_W, 115 * MiB, s); sum(WS_S5W, 64 * MiB, s); sum(WS_HF2, 4 * MiB, s); sum(WS_ROPE, 8 * KiB, s); sum(WS_S5A32, 64 * KiB, s); break;
                case 1: sum(WS_RB, 240 * MiB, s); sum(WS_RA, 256 * MiB, s); break;
                case 2: sum(WS_RD + RD_QKVG, 32 * MiB, s); break;
                case 3: sum(WS_RD + RD_YAT, 16 * MiB, run * 64 + 56); sum(WS_RD + RD_HV, 32 * MiB, run * 64 + 57); sum(WS_RD + RD_DILO, 48 * MiB, run * 64 + 58); sum(WS_DLSE, 1536 * KiB, run * 64 + 59); sum(WS_RD + RD_S5Z, 16 * MiB, run * 64 + 60); break;
                case 4: sum(WS_Y, 64 * MiB, s); break;
                case 5: sum(WS_RB + RB_MB, 64 * MiB, s); sum(WS_RB, 128 * MiB, s); break;
                case 6: sum(WS_RB, 128 * MiB, s); break;
                case 7: sumout(s); sum(WS_HB, 64 * MiB, s); sum(WS_AFF, 2 * MiB, s); break;
                case 8: sum(WS_RA, 128 * MiB, s); sum(WS_IDX, 512 * KiB, s); sum(WS_INV, 1 * MiB, s); break;
                case 9: sum(WS_RB, 128 * MiB, s); break;
                case 10: sum(WS_RA + RA_EOUT, 128 * MiB, s); break;
                case 11: sumout(s); sum(WS_HB, 64 * MiB, s); break;
                } }
    }
    hipLaunchKernelGGL(dbg_final_kernel, dim3(1024), dim3(256), 0, stream, (const unsigned long long*)T, (float*)d_out);
    }
#elif defined(DBG_STOP)
    for (int l = 0; l <= DBG_STOP_L; ++l)
        for (int p = (l == 0 ? 0 : 1); p < NPH; ++p) { if (l == DBG_STOP_L && p > DBG_STOP) break; a.ph_lo = p; a.ph_hi = p + 1; a.l_lo = l; a.l_hi = l + 1;
            hipLaunchKernelGGL(fwd_kernel, dim3(grid), dim3(512), LDS_BYTES, stream, a);
#ifdef DBG_REPEAT
            if (p == DBG_REPEAT) hipLaunchKernelGGL(fwd_kernel, dim3(grid), dim3(512), LDS_BYTES, stream, a);
#endif
            }
#ifdef DBG_STAT
    { unsigned* res = (unsigned*)((char*)d_ws + WS_CTL) + 100000; hipMemsetAsync(res + 3, 0x7f, 8, stream); hipLaunchKernelGGL(dbg_stat_kernel, dim3(2048), dim3(256), 0, stream, (const unsigned char*)d_ws, (size_t)(DBG_OFF), DBG_LD, DBG_NC, res);
      hipLaunchKernelGGL(dbg_statout_kernel, dim3(2048), dim3(256), 0, stream, (const unsigned*)res, (float*)d_out); }
#elif defined(DBG_OFF)
    hipLaunchKernelGGL(dbg_dump_kernel, dim3(2048), dim3(256), 0, stream, (const unsigned char*)d_ws, (float*)d_out, (size_t)(DBG_OFF), DBG_F32, DBG_LD, DBG_NC);
#endif
#else
    for (int l = 0; l < DEPTH; ++l)
        for (int p = (l == 0 ? 0 : 1); p < NPH; ++p) { a.ph_lo = p; a.ph_hi = p + 1; a.l_lo = l; a.l_hi = l + 1;
            hipLaunchKernelGGL(fwd_kernel, dim3(grid), dim3(512), LDS_BYTES, stream, a); }
#endif
#endif
}
```

```cpp
#include <hip/hip_runtime.h>
#include <hip/hip_bf16.h>
#include <cstdio>
#include <cstdint>
#include <cmath>

#ifndef MK_STATIC_Q
#define MK_STATIC_Q 0
#endif
#ifndef MK_ONE_LAUNCH
#define MK_ONE_LAUNCH 1
#endif

constexpr int BATCH = 8, SEQ = 4096, DM = 1024, DEPTH = 4, M = BATCH * SEQ;
constexpr int NIN = 7936;
constexpr int NE = 16, CAP = 512, FFD = 1024;
constexpr float LN_EPS = 1e-5f, RMS_EPS = 1e-6f;
constexpr float DN_ALPHA = 1.6817928305074292f;
constexpr int PC_DQ = 0, PC_DK = 768, PC_DV = 1536, PC_S5 = 2304, PC_GQ = 2560, PC_GK = 2816, PC_GV = 2944, PROJ2_W = 3072;
enum { I_X = 0, I_LNIN_G, I_LNIN_B, I_WIN, I_HY_CW, I_HY_CB, I_HY_W1, I_HY_B1, I_HY_W2, I_HY_B2, I_HY_W3, I_HY_FREQ, I_HY_BIAS,
       I_S5_LRE, I_S5_LIM, I_S5_LDT, I_S5_BRE, I_S5_BIM, I_S5_CRE, I_S5_CIM, I_S5_D, I_S5_GW, I_S5_GB, I_GQ_QN, I_GQ_KN,
       I_WBR, I_WOUT, I_LN1G, I_LN1B, I_ROUTER, I_EWG, I_EWU, I_EWD, I_LN2G, I_LN2B, N_INPUTS };

constexpr size_t MiB = 1u << 20, KiB = 1u << 10;
constexpr size_t WS_CTL = 0, CTL_ZERO_BYTES = 64 * KiB;
constexpr size_t WS_AFF = 1 * MiB;
constexpr size_t WS_IDX = 3 * MiB;
constexpr size_t WS_GW = 3 * MiB + 256 * KiB;
constexpr size_t WS_INV = 4 * MiB;
constexpr size_t WS_DLSE = 5 * MiB;
constexpr size_t WS_ROPE = 7 * MiB;
constexpr size_t WS_S5A32 = 7 * MiB + 256 * KiB;
constexpr size_t WS_HF2 = 8 * MiB;
constexpr size_t WS_S5W = 12 * MiB;
constexpr size_t S5W_LAYER = 16 * MiB, S5_WST_OFF = 0, S5_WCAT_OFF = 4 * MiB;
constexpr size_t WS_W = 76 * MiB;
constexpr size_t W_WIN = 0;
constexpr size_t W_WB = W_WIN + (size_t)NIN * DM * 2;
constexpr size_t W_WO = W_WB + (size_t)4 * 1024 * 256 * 2;
constexpr size_t W_GLU = W_WO + (size_t)1024 * 1024 * 2;
constexpr size_t W_GU = W_GLU + (size_t)256 * 256 * 2;
constexpr size_t W_DN = W_GU + (size_t)16 * 2048 * 1024 * 2;
constexpr size_t W_END = W_DN + (size_t)16 * 1024 * 1024 * 2;
static_assert(W_END <= 116 * MiB, "weights region");
constexpr size_t WS_HB = 192 * MiB;
constexpr size_t WS_RA = 256 * MiB;
constexpr size_t WS_RB = 512 * MiB;
constexpr size_t RB_HYT = 0, RB_PROJ2 = 48 * MiB, RB_MF32 = 0, RB_PRE = 0, RB_HID = 0, RB_MB = 128 * MiB;
constexpr size_t RA_G = 0, RA_XS = 0, RA_EOUT = 128 * MiB;
constexpr size_t WS_Y = 768 * MiB;
constexpr size_t WS_RD = 832 * MiB;
constexpr size_t RD_YAT = 0;
constexpr size_t RD_DILO = 16 * MiB;
constexpr size_t RD_S5Z = 64 * MiB;
constexpr size_t RD_HV = 80 * MiB;
constexpr size_t RD_QKVG = 112 * MiB;
constexpr size_t WS_TT = 976 * MiB;
constexpr size_t WS_END = 992 * MiB;

constexpr int CW_BAR = 4096;
constexpr int CW_Q = 8192;

constexpr int LDS_SCRATCH = 147456;
constexpr int MISC_OFF = LDS_SCRATCH;
constexpr int LDS_BYTES = LDS_SCRATCH + 1024;

#define GAS __attribute__((address_space(1)))
#define LAS __attribute__((address_space(3)))
typedef unsigned short bf16;
typedef unsigned v4u __attribute__((ext_vector_type(4)));
typedef unsigned v2u __attribute__((ext_vector_type(2)));
typedef float f32x4 __attribute__((ext_vector_type(4)));
typedef float f32x2 __attribute__((ext_vector_type(2)));
typedef float f32x16 __attribute__((ext_vector_type(16)));
typedef short bf16x8 __attribute__((ext_vector_type(8)));
typedef short s16x4 __attribute__((ext_vector_type(4)));
typedef GAS unsigned gu32;
#define RLX_AGENT __ATOMIC_RELAXED, __HIP_MEMORY_SCOPE_AGENT
#define LDS_WAIT() asm volatile("s_waitcnt lgkmcnt(0)" ::: "memory")
#define VM_WAIT() asm volatile("s_waitcnt vmcnt(0)" ::: "memory")

__device__ __forceinline__ unsigned f2bf(float f) { unsigned u = __builtin_bit_cast(unsigned, f); return (u + 0x7fffu + ((u >> 16) & 1u)) >> 16; }
__device__ __forceinline__ unsigned pk2(float lo, float hi) { return f2bf(lo) | (f2bf(hi) << 16); }
__device__ __forceinline__ float bf2f(unsigned short b) { return __builtin_bit_cast(float, (unsigned)b << 16); }
__device__ __forceinline__ float bflo(unsigned w) { return __builtin_bit_cast(float, w << 16); }
__device__ __forceinline__ float bfhi(unsigned w) { return __builtin_bit_cast(float, w & 0xffff0000u); }
__device__ __forceinline__ float sigmoidf_(float x) { return __builtin_amdgcn_rcpf(1.0f + __builtin_amdgcn_exp2f(-1.4426950408889634f * x)); }
__device__ __forceinline__ float wave_sum(float v) {
#pragma unroll
    for (int o = 1; o < 64; o <<= 1) v += __shfl_xor(v, o);
    return v;
}
__device__ __forceinline__ float wave_max(float v) {
#pragma unroll
    for (int o = 1; o < 64; o <<= 1) v = fmaxf(v, __shfl_xor(v, o));
    return v;
}

namespace pg8 {
#define PG8_LAS __attribute__((address_space(3)))
typedef unsigned short bf16_t;
typedef unsigned u32x4 __attribute__((ext_vector_type(4)));
constexpr int BM = 256, BK = 64, HALF = 128, HTB = HALF * BK * 2  , STAGE_BYTES = 8 * HTB, NXCD = 8, WGM = 8;

__host__ __device__ __forceinline__ int lds_byte(int r, int c) { const int st = (r >> 4) * 2 + (c >> 5), rr = r & 15, cc = c & 31, ob = rr * 64 + cc * 2; return st * 1024 + (ob ^ (((ob >> 9) & 1) << 5)); }
__host__ __device__ __forceinline__ void stage_rc(int b, int& R, int& C) { const int st = b / 1024, sb = b % 1024, swz = sb ^ (((sb >> 9) & 1) << 5); R = (st >> 1) * 16 + swz / 64; C = (st & 1) * 32 + (swz % 64) / 2; }
__host__ __device__ __forceinline__ int perm32(int rho) { const int n = rho >> 4, i = rho & 15; return 8 * (i >> 2) + 4 * n + (i & 3); }

struct Unit { const char* A; const char* B; int orow, ocol, z; };
struct Gemm { int K, lda, ldb; };

__device__ __forceinline__ void tile_of(int L, int nM, int nN, int& pm, int& pn) {
    const int nwg = nM * nN; int wgid = L; { const int q = nwg / NXCD, r = nwg % NXCD, xcd = wgid % NXCD, off = wgid / NXCD; wgid = (xcd < r ? xcd * (q + 1) : r * (q + 1) + (xcd - r) * q) + off; }
    const int nig = WGM * nN, gid = wgid / nig, fm = gid * WGM, gsz = (nM - fm) < WGM ? (nM - fm) : WGM;
    pm = fm + ((wgid % nig) % gsz); pn = (wgid % nig) / gsz;
}

typedef __bf16 bf16x2_t __attribute__((ext_vector_type(2)));
__device__ __forceinline__ unsigned cvt_pk_bf16(float lo, float hi) { const f32x2 v = {lo, hi}; const bf16x2_t b = __builtin_convertvector(v, bf16x2_t); return __builtin_bit_cast(unsigned, b); }
template <int ACT  > struct EpiBf16 {
    static constexpr bool PERM = true;
    bf16_t* O; int ldc;
    __device__ __forceinline__ void operator()(const f32x4 (&acc)[2][2][4][2], const Unit& u, int wr, int wc, int fr, int fq) const {
        const int row0 = u.orow + wr * 64 + fr, col0 = u.ocol + wc * 32 + 8 * fq;
#pragma unroll
        for (int ai = 0; ai < 2; ++ai)
#pragma unroll
            for (int m = 0; m < 4; ++m) { bf16_t* rowp = O + (size_t)(row0 + ai * HALF + m * 16) * ldc + col0;
#pragma unroll
                for (int bj = 0; bj < 2; ++bj) { f32x4 v0 = acc[ai][bj][m][0], v1 = acc[ai][bj][m][1];
                    if (ACT == 1) {
#pragma unroll
                        for (int j = 0; j < 4; ++j) { v0[j] = sigmoidf_(v0[j]); v1[j] = sigmoidf_(v1[j]); }
#ifdef DBG_HALF
                        for (int j = 0; j < 4; ++j) { v0[j] = 0.5f; v1[j] = 0.5f; }
#endif
                    }
                    u32x4 w; w.x = cvt_pk_bf16(v0[0], v0[1]); w.y = cvt_pk_bf16(v0[2], v0[3]); w.z = cvt_pk_bf16(v1[0], v1[1]); w.w = cvt_pk_bf16(v1[2], v1[3]);
                    *(u32x4*)(rowp + bj * HALF) = w; } }
    }
};
struct EpiMerge {
    static constexpr bool PERM = true;
    const bf16_t* G; float* F; bf16_t* MB;
    __device__ __forceinline__ void operator()(const f32x4 (&acc)[2][2][4][2], const Unit& u, int wr, int wc, int fr, int fq) const {
        const int row0 = u.orow + wr * 64 + fr, col0 = u.ocol + wc * 32 + 8 * fq, i = u.z;
#pragma unroll
        for (int ai = 0; ai < 2; ++ai)
#pragma unroll
            for (int m = 0; m < 4; ++m) { const size_t row = (size_t)(row0 + ai * HALF + m * 16);
#pragma unroll
                for (int bj = 0; bj < 2; ++bj) { const int col = col0 + bj * HALF;
                    const u32x4 g = *(const u32x4*)(G + row * 4096 + i * 1024 + col);
                    f32x4 v0 = acc[ai][bj][m][0], v1 = acc[ai][bj][m][1];
                    v0[0] *= bflo(g.x); v0[1] *= bfhi(g.x); v0[2] *= bflo(g.y); v0[3] *= bfhi(g.y);
                    v1[0] *= bflo(g.z); v1[1] *= bfhi(g.z); v1[2] *= bflo(g.w); v1[3] *= bfhi(g.w);
                    float* fp = F + row * 1024 + col;
                    if (i > 0) { f32x4 p0, p1;
                        asm volatile("global_load_dwordx4 %0, %2, off sc0 sc1\n\tglobal_load_dwordx4 %1, %2, off offset:16 sc0 sc1\n\ts_waitcnt vmcnt(0)" : "=&v"(p0), "=&v"(p1) : "v"(fp) : "memory");
                        v0 += p0; v1 += p1; }
                    if (i < 3) { *(f32x4*)fp = v0; *(f32x4*)(fp + 4) = v1; }
                    else { u32x4 w; w.x = cvt_pk_bf16(v0[0], v0[1]); w.y = cvt_pk_bf16(v0[2], v0[3]); w.z = cvt_pk_bf16(v1[0], v1[1]); w.w = cvt_pk_bf16(v1[2], v1[3]);
                        *(u32x4*)(MB + row * 1024 + col) = w; } } }
    }
};
struct EpiPre {
    static constexpr bool PERM = true;
    const bf16_t* H; bf16_t* P; float alpha;
    __device__ __forceinline__ void operator()(const f32x4 (&acc)[2][2][4][2], const Unit& u, int wr, int wc, int fr, int fq) const {
        const int row0 = u.orow + wr * 64 + fr, col0 = u.ocol + wc * 32 + 8 * fq;
#pragma unroll
        for (int ai = 0; ai < 2; ++ai)
#pragma unroll
            for (int m = 0; m < 4; ++m) { const size_t off = (size_t)(row0 + ai * HALF + m * 16) * 1024 + col0;
#pragma unroll
                for (int bj = 0; bj < 2; ++bj) { const u32x4 h = *(const u32x4*)(H + off + bj * HALF); const f32x4 a0 = acc[ai][bj][m][0], a1 = acc[ai][bj][m][1];
                    u32x4 w; w.x = cvt_pk_bf16(bflo(h.x) * alpha + a0[0], bfhi(h.x) * alpha + a0[1]); w.y = cvt_pk_bf16(bflo(h.y) * alpha + a0[2], bfhi(h.y) * alpha + a0[3]);
                    w.z = cvt_pk_bf16(bflo(h.z) * alpha + a1[0], bfhi(h.z) * alpha + a1[1]); w.w = cvt_pk_bf16(bflo(h.w) * alpha + a1[2], bfhi(h.w) * alpha + a1[3]);
                    *(u32x4*)(P + off + bj * HALF) = w; } }
    }
};
struct EpiSwiglu {
    static constexpr bool PERM = true;
    bf16_t* O;
    __device__ __forceinline__ void operator()(const f32x4 (&acc)[2][2][4][2], const Unit& u, int wr, int wc, int fr, int fq) const {
        const int row0 = u.orow + wr * 64 + fr, col0 = u.ocol + wc * 32 + 8 * fq;
#pragma unroll
        for (int ai = 0; ai < 2; ++ai)
#pragma unroll
            for (int m = 0; m < 4; ++m) { f32x4 v[2];
#pragma unroll
                for (int n = 0; n < 2; ++n)
#pragma unroll
                    for (int j = 0; j < 4; ++j) { const float g = acc[ai][0][m][n][j]; v[n][j] = g * sigmoidf_(g) * acc[ai][1][m][n][j]; }
                u32x4 w; w.x = cvt_pk_bf16(v[0][0], v[0][1]); w.y = cvt_pk_bf16(v[0][2], v[0][3]); w.z = cvt_pk_bf16(v[1][0], v[1][1]); w.w = cvt_pk_bf16(v[1][2], v[1][3]);
                *(u32x4*)(O + (size_t)(row0 + ai * HALF + m * 16) * 1024 + col0) = w; }
    }
};
struct EpiRowScale {
    static constexpr bool PERM = true;
    bf16_t* O; const float* rs;
    __device__ __forceinline__ void operator()(const f32x4 (&acc)[2][2][4][2], const Unit& u, int wr, int wc, int fr, int fq) const {
        const int row0 = u.orow + wr * 64 + fr, col0 = u.ocol + wc * 32 + 8 * fq;
#pragma unroll
        for (int ai = 0; ai < 2; ++ai)
#pragma unroll
            for (int m = 0; m < 4; ++m) { const int row = row0 + ai * HALF + m * 16; const float s = rs[row];
#pragma unroll
                for (int bj = 0; bj < 2; ++bj) { const f32x4 v0 = acc[ai][bj][m][0] * s, v1 = acc[ai][bj][m][1] * s;
                    u32x4 w; w.x = cvt_pk_bf16(v0[0], v0[1]); w.y = cvt_pk_bf16(v0[2], v0[3]); w.z = cvt_pk_bf16(v1[0], v1[1]); w.w = cvt_pk_bf16(v1[2], v1[3]);
                    *(u32x4*)(O + (size_t)row * 1024 + col0 + bj * HALF) = w; } }
    }
};
struct EpiGlu {
    static constexpr bool PERM = true;
    const bf16_t* Z; bf16_t* O; const float* gb;
    __device__ __forceinline__ void operator()(const f32x4 (&acc)[2][2][4][2], const Unit& u, int wr, int wc, int fr, int fq) const {
        const int row0 = u.orow + wr * 64 + fr, col0 = wc * 32 + 8 * fq;
#pragma unroll
        for (int ai = 0; ai < 2; ++ai)
#pragma unroll
            for (int m = 0; m < 4; ++m) { const size_t row = (size_t)(row0 + ai * HALF + m * 16);
#pragma unroll
                for (int bj = 0; bj < 2; ++bj) { const int col = col0 + bj * HALF;
                    const u32x4 z = *(const u32x4*)(Z + row * 256 + col); const f32x4 b0 = *(const f32x4*)(gb + col), b1 = *(const f32x4*)(gb + col + 4);
                    const f32x4 a0 = acc[ai][bj][m][0] + b0, a1 = acc[ai][bj][m][1] + b1; f32x4 v0, v1;
                    v0[0] = bflo(z.x) * sigmoidf_(a0[0]); v0[1] = bfhi(z.x) * sigmoidf_(a0[1]); v0[2] = bflo(z.y) * sigmoidf_(a0[2]); v0[3] = bfhi(z.y) * sigmoidf_(a0[3]);
                    v1[0] = bflo(z.z) * sigmoidf_(a1[0]); v1[1] = bfhi(z.z) * sigmoidf_(a1[1]); v1[2] = bflo(z.w) * sigmoidf_(a1[2]); v1[3] = bfhi(z.w) * sigmoidf_(a1[3]);
                    u32x4 w; w.x = cvt_pk_bf16(v0[0], v0[1]); w.y = cvt_pk_bf16(v0[2], v0[3]); w.z = cvt_pk_bf16(v1[0], v1[1]); w.w = cvt_pk_bf16(v1[2], v1[3]);
                    *(u32x4*)(O + row * 1024 + 512 + col) = w; }
                asm volatile("" ::: "memory"); }
    }
};

#ifndef PG8_SP2
#define PG8_SP2 1
#endif
template <class Epi, class Sched>
__device__ __forceinline__ void gemm_phase(PG8_LAS unsigned char* lds, const Gemm g, const Sched& S, const Epi& E, int tid_in) {
    int tid = tid_in; asm volatile("" : "+v"(tid));
    const int wid = __builtin_amdgcn_readfirstlane(tid >> 6), lane = tid & 63, wr = wid >> 2, wc = wid & 3, fr = lane & 15, fq = lane >> 4;
    int K = g.K; asm volatile("" : "+s"(K)); const int nt = K / BK;
    unsigned voffA[2], voffB[2];
#pragma unroll
    for (int i = 0; i < 2; ++i) { int R, C; stage_rc(tid * 16 + i * 8192, R, C); const int Rb = Epi::PERM ? ((R & ~31) + perm32(R & 31)) : R;
        voffA[i] = (unsigned)(R * g.lda + C) * 2u; voffB[i] = (unsigned)(Rb * g.ldb + C) * 2u; }
    const size_t kstep = (size_t)(BK * 2);
    const size_t hstepA = (size_t)HALF * g.lda * 2, hstepB = (size_t)HALF * g.ldb * 2;
    const unsigned ldsw = (unsigned)wid * 1024u;
    const int aoff = lds_byte(wr * 64 + fr, fq * 8), boff = lds_byte(wc * 32 + fr, fq * 8);
#define PG8_SA(b, h) (((b) * 2 + (h)) * HTB)
#define PG8_SB(b, h) ((4 + (b) * 2 + (h)) * HTB)
#define PG8_STAGE(bufoff, gbase, voff) do { _Pragma("unroll") for (int _i = 0; _i < 2; ++_i) \
        __builtin_amdgcn_global_load_lds((const unsigned*)((const char*)(gbase) + (voff)[_i]), (PG8_LAS unsigned*)(lds + (bufoff) + ldsw + _i * 8192), 16, 0, 0); } while (0)
#define PG8_LDA(dst, b, h) do { _Pragma("unroll") for (int m = 0; m < 4; ++m) _Pragma("unroll") for (int k = 0; k < 2; ++k) dst[m][k] = *(const PG8_LAS bf16x8*)(lds + PG8_SA(b, h) + aoff + m * 2048 + k * 1024); } while (0)
#define PG8_LDB(dst, b, h) do { _Pragma("unroll") for (int n = 0; n < 2; ++n) _Pragma("unroll") for (int k = 0; k < 2; ++k) dst[n][k] = *(const PG8_LAS bf16x8*)(lds + PG8_SB(b, h) + boff + n * 2048 + k * 1024); } while (0)
#define PG8_MMA(ai, bj, At, Bt) do { __builtin_amdgcn_s_setprio(1); _Pragma("unroll") for (int m = 0; m < 4; ++m) _Pragma("unroll") for (int n = 0; n < 2; ++n) _Pragma("unroll") for (int k = 0; k < 2; ++k) \
        acc[ai][bj][m][n] = __builtin_amdgcn_mfma_f32_16x16x32_bf16(Bt[n][k], At[m][k], acc[ai][bj][m][n], 0, 0, 0); __builtin_amdgcn_s_setprio(0); } while (0)
#define PG8_WAIT_V(n) asm volatile("s_waitcnt vmcnt(" #n ")" ::: "memory")
#define PG8_WAIT_L(n) asm volatile("s_waitcnt lgkmcnt(" #n ")" ::: "memory")
#define PG8_BAR __builtin_amdgcn_s_barrier()
#define PG8_SCHED __builtin_amdgcn_sched_barrier(0)
    Unit cur, nxt; int ui = 0;
    if (!S.next(0, cur)) return;
    f32x4 acc[2][2][4][2];
#pragma unroll
    for (int a = 0; a < 2; ++a)
#pragma unroll
        for (int b = 0; b < 2; ++b)
#pragma unroll
            for (int m = 0; m < 4; ++m)
#pragma unroll
                for (int n = 0; n < 2; ++n) acc[a][b][m][n] = (f32x4){0.f, 0.f, 0.f, 0.f};
    bf16x8 At[4][2], B0[2][2], B1[2][2];
    const char* cA = cur.A; const char* cB = cur.B;
#if PG8_SP2
    PG8_STAGE(PG8_SB(0, 0), cB, voffB); PG8_STAGE(PG8_SB(0, 1), cB + hstepB, voffB); PG8_STAGE(PG8_SA(0, 0), cA, voffA); PG8_STAGE(PG8_SA(0, 1), cA + hstepA, voffA);
    if (wr == 1) PG8_BAR;
    PG8_WAIT_V(2); PG8_BAR;
    PG8_STAGE(PG8_SB(1, 0), cB + kstep, voffB); PG8_STAGE(PG8_SA(1, 0), cA + kstep, voffA); PG8_STAGE(PG8_SB(1, 1), cB + hstepB + kstep, voffB);
    PG8_WAIT_V(6); PG8_BAR;
#else
    PG8_STAGE(PG8_SB(0, 0), cB, voffB); PG8_STAGE(PG8_SA(0, 0), cA, voffA); PG8_STAGE(PG8_SB(0, 1), cB + hstepB, voffB); PG8_STAGE(PG8_SA(0, 1), cA + hstepA, voffA);
    if (wr == 1) PG8_BAR;
    PG8_WAIT_V(4); PG8_BAR;
    PG8_STAGE(PG8_SB(1, 0), cB + kstep, voffB); PG8_STAGE(PG8_SA(1, 0), cA + kstep, voffA); PG8_STAGE(PG8_SB(1, 1), cB + hstepB + kstep, voffB);
    PG8_WAIT_V(6); PG8_BAR;
#endif
    for (;;) {
        const bool has_next = S.next(ui + 1, nxt);
        const char* nA = has_next ? nxt.A : cA; const char* nB = has_next ? nxt.B : cB;
#pragma unroll 1
        for (int t = 0; t < nt; t += 2) {
            const bool last = (t == nt - 2);
            const char* a1 = cA + (size_t)(t + 1) * kstep;
            const char* a2 = last ? nA : cA + (size_t)(t + 2) * kstep; const char* b2 = last ? nB : cB + (size_t)(t + 2) * kstep;
            const char* a3 = a2 + kstep; const char* b3 = b2 + kstep;
#if PG8_SP2
            PG8_LDB(B0, 0, 0); PG8_LDB(B1, 0, 1); PG8_SCHED; PG8_LDA(At, 0, 0); PG8_STAGE(PG8_SA(1, 1), a1 + hstepA, voffA);
            PG8_WAIT_V(8); PG8_WAIT_L(0); PG8_BAR; PG8_MMA(0, 0, At, B0); PG8_MMA(0, 1, At, B1); PG8_BAR; PG8_SCHED;
            PG8_LDA(At, 0, 1); PG8_STAGE(PG8_SB(0, 0), b2, voffB); PG8_STAGE(PG8_SB(0, 1), b2 + hstepB, voffB); PG8_STAGE(PG8_SA(0, 0), a2, voffA);
            PG8_WAIT_V(8); PG8_WAIT_L(0); PG8_BAR; PG8_MMA(1, 0, At, B0); PG8_MMA(1, 1, At, B1); PG8_BAR; PG8_SCHED;
            PG8_LDB(B0, 1, 0); PG8_LDB(B1, 1, 1); PG8_SCHED; PG8_LDA(At, 1, 0); PG8_STAGE(PG8_SA(0, 1), a2 + hstepA, voffA);
            PG8_WAIT_V(8); PG8_WAIT_L(0); PG8_BAR; PG8_MMA(0, 0, At, B0); PG8_MMA(0, 1, At, B1); PG8_BAR; PG8_SCHED;
            PG8_LDA(At, 1, 1); PG8_STAGE(PG8_SB(1, 0), b3, voffB); PG8_STAGE(PG8_SB(1, 1), b3 + hstepB, voffB); PG8_STAGE(PG8_SA(1, 0), a3, voffA);
            PG8_WAIT_V(8); PG8_WAIT_L(0); PG8_BAR; PG8_MMA(1, 0, At, B0); PG8_MMA(1, 1, At, B1); PG8_BAR; PG8_SCHED;
#else
            PG8_LDB(B0, 0, 0); PG8_SCHED; PG8_LDA(At, 0, 0); PG8_STAGE(PG8_SA(1, 1), a1 + hstepA, voffA);
            PG8_WAIT_L(8); PG8_BAR; PG8_WAIT_L(0); PG8_MMA(0, 0, At, B0); PG8_BAR; PG8_SCHED;
            PG8_LDB(B1, 0, 1); PG8_STAGE(PG8_SB(0, 0), b2, voffB);
            PG8_BAR; PG8_WAIT_L(0); PG8_MMA(0, 1, At, B1); PG8_BAR;
            PG8_LDA(At, 0, 1); PG8_STAGE(PG8_SA(0, 0), a2, voffA);
            PG8_BAR; PG8_WAIT_L(0); PG8_MMA(1, 0, At, B0); PG8_BAR; PG8_SCHED;
            PG8_STAGE(PG8_SB(0, 1), b2 + hstepB, voffB);
            PG8_WAIT_V(6); PG8_BAR; PG8_MMA(1, 1, At, B1); PG8_BAR;
            PG8_LDB(B0, 1, 0); PG8_SCHED; PG8_LDA(At, 1, 0); PG8_STAGE(PG8_SA(0, 1), a2 + hstepA, voffA);
            PG8_WAIT_L(8); PG8_BAR; PG8_WAIT_L(0); PG8_MMA(0, 0, At, B0); PG8_BAR; PG8_SCHED;
            PG8_LDB(B1, 1, 1); PG8_STAGE(PG8_SB(1, 0), b3, voffB);
            PG8_BAR; PG8_WAIT_L(0); PG8_MMA(0, 1, At, B1); PG8_BAR;
            PG8_LDA(At, 1, 1); PG8_STAGE(PG8_SA(1, 0), a3, voffA);
            PG8_BAR; PG8_WAIT_L(0); PG8_MMA(1, 0, At, B0); PG8_BAR; PG8_SCHED;
            PG8_STAGE(PG8_SB(1, 1), b3 + hstepB, voffB);
            PG8_WAIT_V(6); PG8_BAR; PG8_MMA(1, 1, At, B1); PG8_BAR;
#endif
        }
        if (wr == 0) PG8_BAR;
        E(acc, cur, wr, wc, fr, fq);
        if (!has_next) break;
#pragma unroll
        for (int a = 0; a < 2; ++a)
#pragma unroll
            for (int b = 0; b < 2; ++b)
#pragma unroll
                for (int m = 0; m < 4; ++m)
#pragma unroll
                    for (int n = 0; n < 2; ++n) acc[a][b][m][n] = (f32x4){0.f, 0.f, 0.f, 0.f};
        cur = nxt; cA = nA; cB = nB; ++ui;
        if (wr == 1) PG8_BAR;
    }
    PG8_WAIT_V(0);
    PG8_BAR;
#undef PG8_SA
#undef PG8_SB
#undef PG8_STAGE
#undef PG8_LDA
#undef PG8_LDB
#undef PG8_MMA
#undef PG8_WAIT_V
#undef PG8_WAIT_L
#undef PG8_BAR
#undef PG8_SCHED
}

struct MergeUnit { const char* A; const char* B; int orow, ocol, z; };
template <class Sched>
__device__ __forceinline__ void gemm_merge_phase(PG8_LAS unsigned char* lds, const Gemm g, const Sched& S, const bf16_t* G, bf16_t* MB, int tid_in) {
    int tid = tid_in; asm volatile("" : "+v"(tid));
    const int wid = __builtin_amdgcn_readfirstlane(tid >> 6), lane = tid & 63, wr = wid >> 2, wc = wid & 3, fr = lane & 15, fq = lane >> 4;
    int K = g.K; asm volatile("" : "+s"(K)); const int nt = K / BK;
    unsigned voffA[2], voffB[2];
#pragma unroll
    for (int i = 0; i < 2; ++i) { int R, C; stage_rc(tid * 16 + i * 8192, R, C); const int Rb = (R & ~31) + perm32(R & 31);
        voffA[i] = (unsigned)(R * g.lda + C) * 2u; voffB[i] = (unsigned)(Rb * g.ldb + C) * 2u; }
    const size_t kstep = (size_t)(BK * 2);
    const size_t hstepA = (size_t)HALF * g.lda * 2;
    const unsigned ldsw = (unsigned)wid * 1024u;
    const int aoff = lds_byte(wr * 64 + fr, fq * 8), boff = lds_byte(wc * 32 + fr, fq * 8);
#define PG8_SA(b, h) (((b) * 2 + (h)) * HTB)
#define PG8_SB(b, h) ((4 + (b) * 2 + (h)) * HTB)
#define PG8_STAGE(bufoff, gbase, voff) do { _Pragma("unroll") for (int _i = 0; _i < 2; ++_i) \
        __builtin_amdgcn_global_load_lds((const unsigned*)((const char*)(gbase) + (voff)[_i]), (PG8_LAS unsigned*)(lds + (bufoff) + ldsw + _i * 8192), 16, 0, 0); } while (0)
#define PG8_LDA(dst, b, h) do { _Pragma("unroll") for (int m = 0; m < 4; ++m) _Pragma("unroll") for (int k = 0; k < 2; ++k) dst[m][k] = *(const PG8_LAS bf16x8*)(lds + PG8_SA(b, h) + aoff + m * 2048 + k * 1024); } while (0)
#define PG8_LDB(dst, b, h) do { _Pragma("unroll") for (int n = 0; n < 2; ++n) _Pragma("unroll") for (int k = 0; k < 2; ++k) dst[n][k] = *(const PG8_LAS bf16x8*)(lds + PG8_SB(b, h) + boff + n * 2048 + k * 1024); } while (0)
#define PG8_MMA1(ai, At, Bt) do { __builtin_amdgcn_s_setprio(1); _Pragma("unroll") for (int m = 0; m < 4; ++m) _Pragma("unroll") for (int n = 0; n < 2; ++n) _Pragma("unroll") for (int k = 0; k < 2; ++k) \
        acc[ai][m][n] = __builtin_amdgcn_mfma_f32_16x16x32_bf16(Bt[n][k], At[m][k], acc[ai][m][n], 0, 0, 0); __builtin_amdgcn_s_setprio(0); } while (0)
#define PG8_WAIT_V(n) asm volatile("s_waitcnt vmcnt(" #n ")" ::: "memory")
#define PG8_WAIT_L(n) asm volatile("s_waitcnt lgkmcnt(" #n ")" ::: "memory")
#define PG8_BAR __builtin_amdgcn_s_barrier()
#define PG8_SCHED __builtin_amdgcn_sched_barrier(0)
    MergeUnit cur, nxt; int ui = 0;
    if (!S.next(0, cur)) return;
    f32x4 acc[2][4][2], mrg[2][4][2];
#pragma unroll
    for (int a = 0; a < 2; ++a)
#pragma unroll
        for (int m = 0; m < 4; ++m)
#pragma unroll
            for (int n = 0; n < 2; ++n) { acc[a][m][n] = (f32x4){0.f, 0.f, 0.f, 0.f}; mrg[a][m][n] = (f32x4){0.f, 0.f, 0.f, 0.f}; }
    bf16x8 At[4][2], B0[2][2];
    const char* cA = cur.A; const char* cB = cur.B;
    PG8_STAGE(PG8_SB(0, 0), cB, voffB); PG8_STAGE(PG8_SA(0, 0), cA, voffA); PG8_STAGE(PG8_SA(0, 1), cA + hstepA, voffA);
    if (wr == 1) PG8_BAR;
    PG8_WAIT_V(2); PG8_BAR;
    PG8_STAGE(PG8_SB(1, 0), cB + kstep, voffB); PG8_STAGE(PG8_SA(1, 0), cA + kstep, voffA);
    PG8_WAIT_V(4); PG8_BAR;
    for (;;) {
        const bool has_next = S.next(ui + 1, nxt);
        const char* nA = has_next ? nxt.A : cA; const char* nB = has_next ? nxt.B : cB;
#pragma unroll 1
        for (int t = 0; t < nt; t += 2) {
            const bool last = (t == nt - 2);
            const char* a1 = cA + (size_t)(t + 1) * kstep;
            const char* a2 = last ? nA : cA + (size_t)(t + 2) * kstep; const char* b2 = last ? nB : cB + (size_t)(t + 2) * kstep;
            const char* a3 = a2 + kstep; const char* b3 = b2 + kstep;
            PG8_LDB(B0, 0, 0); PG8_SCHED; PG8_LDA(At, 0, 0); PG8_STAGE(PG8_SA(1, 1), a1 + hstepA, voffA);
            PG8_WAIT_V(6); PG8_WAIT_L(0); PG8_BAR; PG8_MMA1(0, At, B0); PG8_BAR; PG8_SCHED;
            PG8_LDA(At, 0, 1); PG8_STAGE(PG8_SB(0, 0), b2, voffB); PG8_STAGE(PG8_SA(0, 0), a2, voffA);
            PG8_WAIT_V(6); PG8_WAIT_L(0); PG8_BAR; PG8_MMA1(1, At, B0); PG8_BAR; PG8_SCHED;
            PG8_LDB(B0, 1, 0); PG8_SCHED; PG8_LDA(At, 1, 0); PG8_STAGE(PG8_SA(0, 1), a2 + hstepA, voffA);
            PG8_WAIT_V(6); PG8_WAIT_L(0); PG8_BAR; PG8_MMA1(0, At, B0); PG8_BAR; PG8_SCHED;
            PG8_LDA(At, 1, 1); PG8_STAGE(PG8_SB(1, 0), b3, voffB); PG8_STAGE(PG8_SA(1, 0), a3, voffA);
            PG8_WAIT_V(6); PG8_WAIT_L(0); PG8_BAR; PG8_MMA1(1, At, B0); PG8_BAR; PG8_SCHED;
        }
        if (wr == 0) PG8_BAR;
        {
            const int row0 = cur.orow + wr * 64 + fr, col0 = cur.ocol + wc * 32 + 8 * fq, z = cur.z;
            u32x4 gq[2][4];
#pragma unroll
            for (int ai = 0; ai < 2; ++ai)
#pragma unroll
                for (int m = 0; m < 4; ++m) gq[ai][m] = *(const u32x4*)(G + (size_t)(row0 + ai * HALF + m * 16) * 4096 + z * 1024 + col0);
#pragma unroll
            for (int ai = 0; ai < 2; ++ai)
#pragma unroll
                for (int m = 0; m < 4; ++m) { const size_t row = (size_t)(row0 + ai * HALF + m * 16);
                    const u32x4 gv = gq[ai][m];
                    f32x4 v0 = acc[ai][m][0], v1 = acc[ai][m][1];
                    v0[0] *= bflo(gv.x); v0[1] *= bfhi(gv.x); v0[2] *= bflo(gv.y); v0[3] *= bfhi(gv.y);
                    v1[0] *= bflo(gv.z); v1[1] *= bfhi(gv.z); v1[2] *= bflo(gv.w); v1[3] *= bfhi(gv.w);
                    if (z == 0) { mrg[ai][m][0] = v0; mrg[ai][m][1] = v1; } else { mrg[ai][m][0] += v0; mrg[ai][m][1] += v1; }
                    acc[ai][m][0] = (f32x4){0.f, 0.f, 0.f, 0.f}; acc[ai][m][1] = (f32x4){0.f, 0.f, 0.f, 0.f};
                    if (z == 3) { const f32x4 o0 = mrg[ai][m][0], o1 = mrg[ai][m][1];
                        u32x4 w; w.x = cvt_pk_bf16(o0[0], o0[1]); w.y = cvt_pk_bf16(o0[2], o0[3]); w.z = cvt_pk_bf16(o1[0], o1[1]); w.w = cvt_pk_bf16(o1[2], o1[3]);
                        *(u32x4*)(MB + row * 1024 + col0) = w; } }
        }
        if (!has_next) break;
        cur = nxt; cA = nA; cB = nB; ++ui;
        if (wr == 1) PG8_BAR;
    }
    PG8_WAIT_V(0);
    PG8_BAR;
#undef PG8_SA
#undef PG8_SB
#undef PG8_STAGE
#undef PG8_LDA
#undef PG8_LDB
#undef PG8_MMA1
#undef PG8_WAIT_V
#undef PG8_WAIT_L
#undef PG8_BAR
#undef PG8_SCHED
}
}
#define XB_TMO      128
#define XB_XCNT(j)  (256  + 64 * (j))
#define XB_XSUB(j)  (1280 + 64 * (j))
#define XB_XGEN(j)  (2304 + 64 * (j))
#define XB_TOP      3328
#define XB_TOPGEN   3392
#define XCD_BAR_WORDS 3456
#define XB_SPIN_CAP (1u << 18)

__device__ __forceinline__ unsigned xb_ld(unsigned* p)              { return __hip_atomic_load(p, __ATOMIC_RELAXED, __HIP_MEMORY_SCOPE_AGENT); }
__device__ __forceinline__ unsigned xb_add(unsigned* p, unsigned v) { return __hip_atomic_fetch_add(p, v, __ATOMIC_RELAXED, __HIP_MEMORY_SCOPE_AGENT); }
__device__ __forceinline__ unsigned xb_xcc_id() { return (unsigned)__builtin_amdgcn_s_getreg((3 << 11) | 20) & 0xFu; }
#define XB_SPIN(cond, bar) do { unsigned _sp = 0; while (cond) { __builtin_amdgcn_s_sleep(1); \
    if ((++_sp & 255u) == 0u) { if (xb_ld(&(bar)[XB_TMO])) break; if (_sp > XB_SPIN_CAP) { atomicAdd(&(bar)[XB_TMO], 1u); break; } } } } while (0)

struct XcdBarrier {
    unsigned* bar; unsigned x;
    volatile LAS unsigned* st;
};

__device__ __forceinline__ XcdBarrier xcd_barrier_post(unsigned* bar, volatile LAS unsigned* st) {
    XcdBarrier b; b.bar = bar; b.x = xb_xcc_id(); b.st = st;
    if (threadIdx.x == 0) (void)xb_add(&bar[XB_XCNT(b.x)], 1u);
    return b;
}
__device__ __forceinline__ void xcd_barrier_complete(unsigned* bar, unsigned x, unsigned& nloc, unsigned& nx) {
    const unsigned G = gridDim.x * gridDim.y * gridDim.z;
    unsigned sum, cnt, mine, sp = 0u;
    for (;;) {
        sum = 0u; cnt = 0u; mine = 0u;
#pragma unroll
        for (unsigned j = 0; j < 16; ++j) { const unsigned c = xb_ld(&bar[XB_XCNT(j)]); sum += c; cnt += (c > 0u) ? 1u : 0u; mine = (j == x) ? c : mine; }
        if (sum == G) break;
        __builtin_amdgcn_s_sleep(1);
        if ((++sp & 255u) == 0u) { if (xb_ld(&bar[XB_TMO])) break; if (sp > XB_SPIN_CAP) { atomicAdd(&bar[XB_TMO], 1u); break; } }
    }
    nloc = mine > 0u ? mine : 1u; nx = cnt > 0u ? cnt : 1u;
}

__device__ __forceinline__ void xcd_barrier(const XcdBarrier& b, int tid_now) {
    asm volatile("s_waitcnt vmcnt(0)" ::: "memory");
    __syncthreads();
    if (tid_now == 0) {
        unsigned* bar = b.bar;
        __builtin_amdgcn_s_waitcnt(0);
        unsigned nloc = b.st[0], nx = b.st[1];
        if (nloc == 0u) { xcd_barrier_complete(bar, b.x, nloc, nx); b.st[0] = nloc; b.st[1] = nx; }
        const unsigned old = xb_add(&bar[XB_XSUB(b.x)], 1u);
        const unsigned gen = old / nloc;
        if (old + 1u == (gen + 1u) * nloc) {
            __builtin_amdgcn_fence(__ATOMIC_RELEASE, "agent");
            asm volatile("s_waitcnt vmcnt(0)" ::: "memory");
            const unsigned og = xb_add(&bar[XB_TOP], 1u);
            const unsigned tg = og / nx;
            if (og + 1u == (tg + 1u) * nx) xb_add(&bar[XB_TOPGEN], 1u);
            else XB_SPIN(xb_ld(&bar[XB_TOPGEN]) == tg, bar);
            __builtin_amdgcn_fence(__ATOMIC_ACQUIRE, "agent");
            xb_add(&bar[XB_XGEN(b.x)], 1u);
            asm volatile("s_waitcnt vmcnt(0)" ::: "memory");
        } else {
            XB_SPIN(xb_ld(&bar[XB_XGEN(b.x)]) == gen, bar);
            __builtin_amdgcn_fence(__ATOMIC_ACQUIRE, "agent");
            asm volatile("s_waitcnt vmcnt(0)" ::: "memory");
        }
    }
    __syncthreads();
}

struct Args { const float* in[N_INPUTS]; float* out; unsigned char* ws; int ph_lo, ph_hi, l_lo, l_hi; };
struct Frame {
    LAS unsigned char* lds;
    volatile LAS unsigned* MISC;
    gu32* ctl;
    int tid, lane, wave, G, bid, zoff;
    unsigned char* ws;
    float* out;
};
#define FIN(k) (args.in[k])
#define WSP(T, off) ((T*)(F.ws + (off)))

__device__ __forceinline__ int wq_grab(Frame& F, int qid) {
    __syncthreads();
    if (F.tid == 0) F.MISC[16] = __hip_atomic_fetch_add((unsigned*)(F.ctl + CW_Q + qid * 64), 1u, RLX_AGENT);
    __syncthreads();
    return (int)F.MISC[16];
}
__device__ __forceinline__ float block_sum(Frame& F, float v, LAS float* red  ) {
    v = wave_sum(v);
    __syncthreads();
    if (F.lane == 0) red[F.wave] = v;
    __syncthreads();
    float s = 0.f;
#pragma unroll
    for (int w = 0; w < 8; ++w) s += red[w];
    return s;
}

__device__ __forceinline__ void ln_row(f32x4 (&v)[4], const float* g, const float* b, int lane) {
    float s = 0.f;
#pragma unroll
    for (int j = 0; j < 4; ++j) s += (v[j].x + v[j].y) + (v[j].z + v[j].w);
    const float mean = wave_sum(s) * (1.f / DM); float s2 = 0.f;
#pragma unroll
    for (int j = 0; j < 4; ++j) { v[j] = v[j] - mean; s2 += (v[j].x * v[j].x + v[j].y * v[j].y) + (v[j].z * v[j].z + v[j].w * v[j].w); }
    const float rstd = 1.f / sqrtf(wave_sum(s2) * (1.f / DM) + LN_EPS);
#pragma unroll
    for (int j = 0; j < 4; ++j) { const f32x4 gg = *(const f32x4*)(g + 4 * lane + 256 * j), bb = *(const f32x4*)(b + 4 * lane + 256 * j); v[j] = v[j] * rstd * gg + bb; }
}
__device__ __forceinline__ void store_row_bf16(const f32x4 (&v)[4], bf16* o16, int lane) {
#pragma unroll
    for (int j = 0; j < 4; ++j) { v2u w; w.x = pk2(v[j].x, v[j].y); w.y = pk2(v[j].z, v[j].w); *(v2u*)(o16 + 4 * lane + 256 * j) = w; }
}
__device__ __forceinline__ void load_row_bf16(f32x4 (&v)[4], const bf16* p, int lane, float scale) {
#pragma unroll
    for (int j = 0; j < 4; ++j) { const v2u w = *(const v2u*)(p + 4 * lane + 256 * j); v[j] = (f32x4){bflo(w.x), bfhi(w.x), bflo(w.y), bfhi(w.y)} * scale; }
}
__device__ __forceinline__ void store_row_f32_bf16(const f32x4 (&v)[4], float* o32, bf16* o16, int lane) {
#pragma unroll
    for (int j = 0; j < 4; ++j) { *(f32x4*)(o32 + 4 * lane + 256 * j) = v[j];
        v2u w; w.x = pk2(v[j].x, v[j].y); w.y = pk2(v[j].z, v[j].w); *(v2u*)(o16 + 4 * lane + 256 * j) = w; }
}

struct CvItem { const float* src; bf16* dst; int ldw, ldd; };
constexpr int CV_IN = 16 * 124, CV_BR = 4 * 4 * 16, CV_OUT = 16 * 16, CV_GLU = 4 * 4, CV_EX = 16 * 256, CV_NIT = CV_IN + CV_BR + CV_OUT + CV_GLU + 3 * CV_EX;
__device__ __forceinline__ CvItem cv_decode(Frame& F, const Args& args, int l, int it) {
    unsigned char* wb = F.ws + WS_W; CvItem c; int r = it;
    if (r < CV_IN) { const int kb = r / 124, nb = r % 124; c.src = FIN(I_WIN) + (size_t)l * DM * NIN + (size_t)(64 * kb) * NIN + 64 * nb; c.ldw = NIN;
        c.dst = (bf16*)(wb + W_WIN) + (size_t)(64 * nb) * 1024 + 64 * kb; c.ldd = 1024; return c; } r -= CV_IN;
    if (r < CV_BR) { const int i = r / 64, q = r % 64, kb = q / 16, nb = q % 16; c.src = FIN(I_WBR) + ((size_t)l * 4 + i) * 256 * 1024 + (size_t)(64 * kb) * 1024 + 64 * nb; c.ldw = 1024;
        c.dst = (bf16*)(wb + W_WB) + (size_t)i * 1024 * 256 + (size_t)(64 * nb) * 256 + 64 * kb; c.ldd = 256; return c; } r -= CV_BR;
    if (r < CV_OUT) { const int kb = r / 16, nb = r % 16; c.src = FIN(I_WOUT) + (size_t)l * 1024 * 1024 + (size_t)(64 * kb) * 1024 + 64 * nb; c.ldw = 1024;
        c.dst = (bf16*)(wb + W_WO) + (size_t)(64 * nb) * 1024 + 64 * kb; c.ldd = 1024; return c; } r -= CV_OUT;
    if (r < CV_GLU) { const int kb = r / 4, nb = r % 4; c.src = FIN(I_S5_GW) + (size_t)l * 256 * 256 + (size_t)(64 * kb) * 256 + 64 * nb; c.ldw = 256;
        c.dst = (bf16*)(wb + W_GLU) + (size_t)(64 * nb) * 256 + 64 * kb; c.ldd = 256; return c; } r -= CV_GLU;
    const int which = r / CV_EX, q = r % CV_EX, e = q / 256, q2 = q % 256, kb = q2 / 16, nb = q2 % 16;
    const size_t esz = (size_t)1024 * 1024, so = ((size_t)l * NE + e) * esz + (size_t)(64 * kb) * 1024 + 64 * nb;
    c.ldw = 1024; c.ldd = 1024;
    if (which == 2) { c.src = FIN(I_EWD) + so; c.dst = (bf16*)(wb + W_DN) + (size_t)e * esz + (size_t)(64 * nb) * 1024 + 64 * kb; }
    else {
        c.src = (which == 0 ? FIN(I_EWG) : FIN(I_EWU)) + so; const int f0 = 64 * nb;
        c.dst = (bf16*)(wb + W_GU) + (size_t)e * 2048 * 1024 + (size_t)((f0 >> 7) * 256 + which * 128 + (f0 & 127)) * 1024 + 64 * kb; }
    return c;
}
__device__ __forceinline__ void cv_load(f32x4 (&v)[16], const CvItem& c, int lane) {
    const float* p = c.src + (size_t)(lane >> 4) * c.ldw + 4 * (lane & 15);
#pragma unroll
    for (int i = 0; i < 16; ++i) v[i] = *(const f32x4*)(p + (size_t)(4 * i) * c.ldw);
}
__device__ __forceinline__ void cv_store(const f32x4 (&v)[16], const CvItem& c, LAS float* scr, int lane) {
    LAS float* w = scr + (lane >> 4) * 65 + 4 * (lane & 15);
#pragma unroll
    for (int i = 0; i < 16; ++i) { w[(4 * i) * 65 + 0] = v[i].x; w[(4 * i) * 65 + 1] = v[i].y; w[(4 * i) * 65 + 2] = v[i].z; w[(4 * i) * 65 + 3] = v[i].w; }
    LDS_WAIT(); asm volatile("" ::: "memory");
    const int c8 = lane & 7;
#pragma unroll
    for (int j = 0; j < 8; ++j) { const int n = (lane >> 3) + 8 * j; const LAS float* s = scr + (8 * c8) * 65 + n;
        v4u o; o.x = pg8::cvt_pk_bf16(s[0 * 65], s[1 * 65]); o.y = pg8::cvt_pk_bf16(s[2 * 65], s[3 * 65]); o.z = pg8::cvt_pk_bf16(s[4 * 65], s[5 * 65]); o.w = pg8::cvt_pk_bf16(s[6 * 65], s[7 * 65]);
        *(v4u*)(c.dst + (size_t)n * c.ldd + 8 * c8) = o; }
    LDS_WAIT(); asm volatile("" ::: "memory");
}
__device__ __forceinline__ void convert_layer(Frame& F, const Args& args, int l, int gw, int NGW) {
    LAS float* scr = (LAS float*)(F.lds + F.wave * 16640);
    int it = gw; if (it >= CV_NIT) return;
    CvItem c0 = cv_decode(F, args, l, it); f32x4 a[16]; cv_load(a, c0, F.lane);
    for (;;) {
        const int it1 = it + NGW; const bool more = it1 < CV_NIT; f32x4 b[16];
        const CvItem c1 = cv_decode(F, args, l, more ? it1 : it); cv_load(b, c1, F.lane);
        asm volatile("" ::: "memory");
        cv_store(a, c0, scr, F.lane);
        if (!more) break;
        it = it1; c0 = c1;
#pragma unroll
        for (int i = 0; i < 16; ++i) a[i] = b[i];
    }
}

__device__ __forceinline__ f32x2 cmul(f32x2 a, f32x2 b) { return (f32x2){a.x * b.x - a.y * b.y, a.x * b.y + a.y * b.x}; }

__device__ __forceinline__ void s5_build_item(Frame& F, const Args& args, int l, int g, int q4  ) {
    LAS f32x2* ap = (LAS f32x2*)F.lds;
    LAS f32x2* bb = ap + 2 * 64 * 33;
    LAS f32x2* cm = bb + 2 * 64 * 16;
    LAS float* kern = (LAS float*)(cm + 2 * 16 * 64);
    const int tid = F.tid;
    __syncthreads();
    if (tid < 128) {
        const int dir = tid >> 6, p = tid & 63; const size_t gi = ((size_t)(l * 2 + dir) * 16 + g);
        const float lre = FIN(I_S5_LRE)[gi * 64 + p], lim = FIN(I_S5_LIM)[gi * 64 + p], dt = expf(FIN(I_S5_LDT)[gi]);
        const float x = lre * dt, y = lim * dt;
        for (int tau = 0; tau <= 32; ++tau) { float s, c; sincosf((float)tau * y, &s, &c); const float e = expf((float)tau * x); ap[(dir * 64 + p) * 33 + tau] = (f32x2){e * c, e * s}; }
        if (q4 == 0) { float s, c; sincosf(32.f * y, &s, &c); const float e = expf(32.f * x); WSP(f32x2, WS_S5A32)[gi * 64 + p] = (f32x2){e * c, e * s}; }
        float s1, c1; sincosf(y, &s1, &c1); const float sh = sinf(0.5f * y);
        const f32x2 em1 = (f32x2){expm1f(x) * c1 - 2.f * sh * sh, expf(x) * s1};
        const float inv = 1.f / (lre * lre + lim * lim);
        const f32x2 q = (f32x2){(em1.x * lre + em1.y * lim) * inv, (em1.y * lre - em1.x * lim) * inv};
        for (int ci = 0; ci < 16; ++ci) { const f32x2 bm = (f32x2){FIN(I_S5_BRE)[(gi * 64 + p) * 16 + ci], FIN(I_S5_BIM)[(gi * 64 + p) * 16 + ci]}; bb[(dir * 64 + p) * 16 + ci] = cmul(q, bm); }
    }
    for (int i = tid; i < 2 * 16 * 64; i += 512) { const int dir = i >> 10, co = (i >> 6) & 15, p = i & 63; const size_t gi = ((size_t)(l * 2 + dir) * 16 + g);
        cm[i] = (f32x2){FIN(I_S5_CRE)[(gi * 16 + co) * 64 + p], FIN(I_S5_CIM)[(gi * 16 + co) * 64 + p]}; }
    __syncthreads();
    for (int e4 = tid; e4 < 63 * 64; e4 += 512) {
        const int ti = e4 >> 6, co = 4 * q4 + ((e4 >> 4) & 3), ci = e4 & 15, tau = ti - 31, e = ti * 256 + co * 16 + ci; float acc = 0.f;
        if (tau >= 0) for (int p = 0; p < 64; ++p) { const f32x2 w = cmul(cm[(0 * 16 + co) * 64 + p], ap[(0 * 64 + p) * 33 + tau]); const f32x2 b = bb[(0 * 64 + p) * 16 + ci]; acc += w.x * b.x - w.y * b.y; }
        if (tau <= 0) for (int p = 0; p < 64; ++p) { const f32x2 w = cmul(cm[(1 * 16 + co) * 64 + p], ap[(1 * 64 + p) * 33 - tau]); const f32x2 b = bb[(1 * 64 + p) * 16 + ci]; acc += w.x * b.x - w.y * b.y; }
        if (tau == 0 && co == ci) acc += FIN(I_S5_D)[l * 256 + g * 16 + co];
        kern[e] = acc;
    }
    __syncthreads();
    bf16* wcat = (bf16*)(F.ws + WS_S5W + (size_t)l * S5W_LAYER + S5_WCAT_OFF) + (size_t)g * 512 * 768;
    for (int ch = tid; ch < 128 * 96; ch += 512) {
        const int ml = ch / 96, k8 = ch % 96, t = ml >> 2, co = 4 * q4 + (ml & 3), m = 16 * t + co; float v[8];
        if (k8 < 64) { const int j = k8 >> 1, ci0 = (k8 & 1) * 8;
#pragma unroll
            for (int e = 0; e < 8; ++e) v[e] = kern[(t - j + 31) * 256 + co * 16 + ci0 + e]; }
        else { const int kk = (k8 - 64) * 8, dir = kk >> 7, p0 = (kk & 127) >> 1, tau = dir == 0 ? t + 1 : 32 - t;
#pragma unroll
            for (int pp = 0; pp < 4; ++pp) { const f32x2 w = cmul(cm[(dir * 16 + co) * 64 + p0 + pp], ap[(dir * 64 + p0 + pp) * 33 + tau]); v[2 * pp] = w.x; v[2 * pp + 1] = -w.y; } }
        v4u o; o.x = pk2(v[0], v[1]); o.y = pk2(v[2], v[3]); o.z = pk2(v[4], v[5]); o.w = pk2(v[6], v[7]);
        *(v4u*)(wcat + (size_t)m * 768 + k8 * 8) = o;
    }
    bf16* wst = (bf16*)(F.ws + WS_S5W + (size_t)l * S5W_LAYER + S5_WST_OFF) + (size_t)g * 2 * 128 * 512;
    if (q4 == 0) for (int ch = tid; ch < 2 * 128 * 64; ch += 512) {
        const int dir = ch >> 13, o = (ch >> 6) & 127, k8 = ch & 63, p = o >> 1, ri = o & 1, j = k8 >> 1, ci0 = (k8 & 1) * 8; float v[8];
        const f32x2 a = ap[(dir * 64 + p) * 33 + (dir == 0 ? 31 - j : j)];
#pragma unroll
        for (int e = 0; e < 8; ++e) { const f32x2 w = cmul(a, bb[(dir * 64 + p) * 16 + ci0 + e]); v[e] = ri ? w.y : w.x; }
        v4u q; q.x = pk2(v[0], v[1]); q.y = pk2(v[2], v[3]); q.z = pk2(v[4], v[5]); q.w = pk2(v[6], v[7]);
        *(v4u*)(wst + ((size_t)dir * 128 + o) * 512 + k8 * 8) = q;
    }
    __syncthreads();
}

__device__ __forceinline__ void hf2_item(Frame& F, const Args& args, int l, int t) {
    const int lane = F.lane;
    const float tn = (float)t * (1.f / 4095.f), w = 6.283185307179586f * (float)t * (1.f / 4096.f);
    float zv = 0.f;
    if (lane == 0) zv = tn;
    else if (lane <= 16) { const float f = 1e-4f + (float)(lane - 1) * ((15.f - 1e-4f) / 15.f); zv = cosf(f * w); }
    else if (lane <= 32) { const float f = 1e-4f + (float)(lane - 17) * ((15.f - 1e-4f) / 15.f); zv = -sinf(f * w); }
    float acc = FIN(I_HY_B1)[l * 64 + lane];
    const float* w1 = FIN(I_HY_W1) + (size_t)l * 33 * 64;
    for (int i = 0; i < 33; ++i) acc += __shfl(zv, i) * w1[i * 64 + lane];
    const float f1 = sinf(FIN(I_HY_FREQ)[(l * 2 + 0) * 64 + lane] * acc);
    float acc2 = FIN(I_HY_B2)[l * 64 + lane];
    const float* w2 = FIN(I_HY_W2) + (size_t)l * 64 * 64;
    for (int i = 0; i < 64; ++i) acc2 += __shfl(f1, i) * w2[i * 64 + lane];
    WSP(float, WS_HF2)[((size_t)l * 4096 + t) * 64 + lane] = sinf(FIN(I_HY_FREQ)[(l * 2 + 1) * 64 + lane] * acc2);
}

__device__ __forceinline__ void prologue_phase(Frame& F, const Args& args) {
    const int gw = F.bid * 8 + F.wave, NGW = F.G * 8;
    for (int it = F.bid; it < DEPTH * 16 * 4; it += F.G) s5_build_item(F, args, it >> 6, (it >> 2) & 15, it & 3);
    __syncthreads();
    { const int gi = F.bid * 512 + F.tid; if (gi < 1024) { const int pos = gi >> 4, i = gi & 15; const float inv = expf(-(float)(2 * i) * (1.f / 32.f) * 9.210340371976184f);
        float s, c; sincosf((float)pos * inv, &s, &c); WSP(f32x2, WS_ROPE)[gi] = (f32x2){c, s}; } }
    for (int it = gw; it < DEPTH * 4096; it += NGW) hf2_item(F, args, it >> 12, it & 4095);
    for (int m = gw; m < M; m += NGW) { f32x4 v[4];
#pragma unroll
        for (int j = 0; j < 4; ++j) v[j] = *(const f32x4*)(FIN(I_X) + (size_t)m * DM + 4 * F.lane + 256 * j);
        ln_row(v, FIN(I_LNIN_G), FIN(I_LNIN_B), F.lane);
        store_row_bf16(v, WSP(bf16, WS_HB) + (size_t)m * DM, F.lane); }
    convert_layer(F, args, 0, gw, NGW);
}
namespace attn_body {
using bf16=__hip_bfloat16;
using bf16x8=__attribute__((ext_vector_type(8)))short;
using s16x4=__attribute__((ext_vector_type(4)))short;
using f32x16=__attribute__((ext_vector_type(16)))float;
using u32x4=__attribute__((ext_vector_type(4)))unsigned;
constexpr int SEQ=4096,D=64,QP=512,KP=512,VP=512,OP=1024;
constexpr int NW=8,QBLK=32,QB=QBLK*NW,KVBLK=64,NQB=SEQ/QB;
constexpr int ATTN_UNIT_ROWS=QB;
__device__ __forceinline__ int crow(int r,int hi){return (r&3)+8*(r>>2)+4*hi;}
#define SBAR() __builtin_amdgcn_sched_barrier(0)
__device__ __forceinline__ void cmask(f32x16&p0,f32x16&p1,int jb,int qrel,int hi){
  const float NEG=-INFINITY; int kb=64*jb+4*hi;
  #pragma unroll
  for(int r=0;r<16;++r){int kv=kb+(r&3)+8*(r>>2); if(kv>qrel)p0[r]=NEG; if(kv+32>qrel)p1[r]=NEG;}
}

constexpr int NSLOT=3, SLOTB=8192;
constexpr int LDS_K=0, LDS_V=NSLOT*SLOTB, LDS_WS=2*NSLOT*SLOTB, LDS_OST=LDS_WS+NW*64*4, LDS_BYTES=LDS_OST+NW*4096;
constexpr float C2=0.125f*1.4426950408889634f;
__device__ __forceinline__ void glds16(const void*gsrc,unsigned lds_dst){unsigned keep;
  asm volatile("s_mov_b32 %0, m0\n\ts_mov_b32 m0, %2\n\ts_nop 0\n\tglobal_load_lds_dwordx4 %1, off\n\ts_mov_b32 m0, %0":"=&s"(keep):"v"(gsrc),"s"(lds_dst):"memory");}
__device__ __forceinline__ float max3f(float a,float b,float c){float r;asm("v_max3_f32 %0, %1, %2, %3":"=v"(r):"v"(a),"v"(b),"v"(c));return r;}
__device__ __forceinline__ float max2f(float a,float b){float r;asm("v_max_f32_e32 %0, %1, %2":"=v"(r):"v"(a),"v"(b));return r;}
__device__ __forceinline__ float fadd_s(float a,float b){float r;asm("v_add_f32_e32 %0, %1, %2":"=v"(r):"v"(a),"v"(b));return r;}
__device__ __forceinline__ float fsub_s(float a,float b){float r;asm("v_sub_f32_e32 %0, %1, %2":"=v"(r):"v"(a),"v"(b));return r;}
typedef float f32x2_t __attribute__((ext_vector_type(2))); typedef __bf16 bf16x2_t __attribute__((ext_vector_type(2)));
__device__ __forceinline__ unsigned cvtpk_s(float lo,float hi){f32x2_t v={lo,hi};bf16x2_t b=__builtin_convertvector(v,bf16x2_t);return __builtin_bit_cast(unsigned,b);}
#define WAIT_BAR(N) asm volatile("s_waitcnt vmcnt(" #N ") lgkmcnt(0)\n\ts_barrier":::"memory")

__device__ __forceinline__ void qkt(f32x16&p0,f32x16&p1,const char*Kslot,const bf16x8*qr,const f32x16&negm,int r32,int hi){
  const char*kb=Kslot+hi*1024+r32*16;
  #pragma unroll
  for(int d0=0;d0<4;++d0){
    const bf16x8 b0=*reinterpret_cast<const bf16x8*>(kb+d0*2048);
    const bf16x8 b1=*reinterpret_cast<const bf16x8*>(kb+d0*2048+512);
    if(d0==0){p0=__builtin_amdgcn_mfma_f32_32x32x16_bf16(b0,qr[0],negm,0,0,0);p1=__builtin_amdgcn_mfma_f32_32x32x16_bf16(b1,qr[0],negm,0,0,0);}
    else{p0=__builtin_amdgcn_mfma_f32_32x32x16_bf16(b0,qr[d0],p0,0,0,0);p1=__builtin_amdgcn_mfma_f32_32x32x16_bf16(b1,qr[d0],p1,0,0,0);}}
}
typedef __attribute__((address_space(3))) const char* lds_cptr;
typedef short v4i16_t __attribute__((ext_vector_type(4)));
__device__ __forceinline__ void kload8(bf16x8*kf,lds_cptr kp){
  kf[0]=*(const __attribute__((address_space(3))) bf16x8*)(kp);      kf[1]=*(const __attribute__((address_space(3))) bf16x8*)(kp+512);
  kf[2]=*(const __attribute__((address_space(3))) bf16x8*)(kp+2048); kf[3]=*(const __attribute__((address_space(3))) bf16x8*)(kp+2560);
  kf[4]=*(const __attribute__((address_space(3))) bf16x8*)(kp+4096); kf[5]=*(const __attribute__((address_space(3))) bf16x8*)(kp+4608);
  kf[6]=*(const __attribute__((address_space(3))) bf16x8*)(kp+6144); kf[7]=*(const __attribute__((address_space(3))) bf16x8*)(kp+6656);
}
__device__ __forceinline__ void kload2(bf16x8*kf,lds_cptr kp,int j){ kf[2*j]=*(const __attribute__((address_space(3))) bf16x8*)(kp+j*2048); kf[2*j+1]=*(const __attribute__((address_space(3))) bf16x8*)(kp+j*2048+512); }
__device__ __forceinline__ s16x4 vtr(lds_cptr p){ return __builtin_bit_cast(s16x4,__builtin_amdgcn_ds_read_tr16_b64_v4i16((__attribute__((address_space(3))) v4i16_t*)p)); }
__device__ __forceinline__ float rowmax(const f32x16&p0,const f32x16&p1){
  float a=max3f(p0[0],p0[1],p1[0]),b=max3f(p0[2],p0[3],p1[1]);a=max3f(a,p1[2],p1[3]);
  #pragma unroll
  for(int r=4;r<16;r+=4){a=max3f(a,p0[r],p0[r+1]);b=max3f(b,p0[r+2],p0[r+3]);a=max3f(a,p1[r],p1[r+1]);b=max3f(b,p1[r+2],p1[r+3]);}
  const float m=max2f(a,b);
  auto rr=__builtin_amdgcn_permlane32_swap(__float_as_uint(m),__float_as_uint(m),false,false);
  return max2f(__uint_as_float(rr[0]),__uint_as_float(rr[1]));
}
__device__ __forceinline__ void pv(f32x16*o,int vb,bf16x8 pa0,bf16x8 pa1,bf16x8 pa2,bf16x8 pa3){
  #pragma unroll
  for(int d0=0;d0<2;++d0){s16x4 lo[4],hi[4];
    #pragma unroll
    for(int ks=0;ks<4;++ks){
      asm volatile("ds_read_b64_tr_b16 %0,%1 offset:%c2":"=&v"(lo[ks]):"v"(vb),"i"(d0*4096+ks*1024):"memory");
      asm volatile("ds_read_b64_tr_b16 %0,%1 offset:%c2":"=&v"(hi[ks]):"v"(vb),"i"(d0*4096+ks*1024+512):"memory");}
    asm volatile("s_waitcnt lgkmcnt(0)":::"memory");SBAR();
    #define PK(k) (bf16x8){lo[k][0],lo[k][1],lo[k][2],lo[k][3],hi[k][0],hi[k][1],hi[k][2],hi[k][3]}
    o[d0]=__builtin_amdgcn_mfma_f32_32x32x16_bf16(pa0,PK(0),o[d0],0,0,0);
    o[d0]=__builtin_amdgcn_mfma_f32_32x32x16_bf16(pa1,PK(1),o[d0],0,0,0);
    o[d0]=__builtin_amdgcn_mfma_f32_32x32x16_bf16(pa2,PK(2),o[d0],0,0,0);
    o[d0]=__builtin_amdgcn_mfma_f32_32x32x16_bf16(pa3,PK(3),o[d0],0,0,0);
    #undef PK
  }
}

#ifndef ATTN_STORE16
#define ATTN_STORE16(p,v) (*(u32x4*)(p)=(v))
#endif
template<int THRL> __device__ __forceinline__ void attn_unit(int b,int h,int qb,const bf16*Q,const bf16*__restrict__ K,const bf16*__restrict__ V,bf16*O,char*shm,int tid_in){
  int tid=tid_in; asm volatile("":"+v"(tid)); const int lane=tid&63,r32=lane&31,hi=lane>>5; const int wid=__builtin_amdgcn_readfirstlane(tid>>6);
  const long rowbase=(long)b*SEQ; const int q0=qb*QB;
  const bf16*Qw=Q+(rowbase+q0+wid*QBLK)*QP+h*D;
  const bf16*Kh=K+rowbase*KP+(h>>1)*D,*Vh=V+rowbase*VP+(h>>1)*D;
  const unsigned lds0=(unsigned)(uintptr_t)shm;
  float*wsf=(float*)(shm+LDS_WS)+wid*64;
  const bf16*ksrc=Kh+(long)lane*KP+wid*8;
  const bf16*vsrc=Vh+(long)(16*(wid&3)+(lane>>2))*VP+(wid>>2)*32+(lane&3)*8;
  const unsigned kdst=lds0+LDS_K+wid*1024, vdst=lds0+LDS_V+wid*1024;
  #define DMA_K(t,slot) glds16(ksrc+(long)(t)*KVBLK*KP,(unsigned)__builtin_amdgcn_readfirstlane(kdst+(slot)))
  #define DMA_V(t,slot) glds16(vsrc+(long)(t)*KVBLK*VP,(unsigned)__builtin_amdgcn_readfirstlane(vdst+(slot)))
  const int vb0=(int)(lds0+LDS_V)+((lane>>4)&1)*32+(lane&3)*8+(4*hi+((lane&15)>>2))*64;
  const char*Kbase=shm+LDS_K; bf16x8 kf[8];
  const lds_cptr shm3=(lds_cptr)shm; const lds_cptr kp0=shm3+LDS_K+hi*1024+r32*16; const lds_cptr vp0=shm3+LDS_V+((lane>>4)&1)*32+(lane&3)*8+(4*hi+((lane&15)>>2))*64;
  const int NT=SEQ/KVBLK;
  DMA_K(0,0);DMA_V(0,0);DMA_K(1,SLOTB);
  bf16x8 qr[4];
  #pragma unroll
  for(int d0=0;d0<4;++d0)qr[d0]=*reinterpret_cast<const bf16x8*>(&Qw[(long)r32*QP+d0*16+hi*8]);
  float mhat=0.f,l_reg=0.f;f32x16 o[2];o[0]=f32x16{};o[1]=f32x16{};f32x16 negm=f32x16{};asm volatile("":"+v"(negm));
  #define CMASK(P0,P1,t) do{}while(0)
  bool resc=false;
  #define START(P0,P1) do{ const float rm=rowmax(P0,P1); resc=false; \
    { const float dl=rm; mhat=fadd_s(mhat,dl); \
      _Pragma("unroll") for(int r=0;r<16;++r){P0[r]=fsub_s(P0[r],dl);P1[r]=fsub_s(P1[r],dl);} \
      _Pragma("unroll") for(int r=0;r<16;++r)negm[r]=-mhat; asm volatile("":"+v"(negm)); } \
    _Pragma("unroll") for(int r=0;r<16;++r)P0[r]=__builtin_amdgcn_exp2f(P0[r]); }while(0)
  #define RESC() do{ if(resc){ asm volatile("s_waitcnt lgkmcnt(0)":::"memory"); \
      _Pragma("unroll") for(int d_=0;d_<2;++d_) _Pragma("unroll") for(int r=0;r<16;++r)o[d_][r]*=wsf[crow(r,hi)]; } }while(0)
  f32x16 pA0,pA1,pB0,pB1;
  int sl_prev=0,sl_cur=0,sl_next=SLOTB;
  #define ROT() do{sl_prev=sl_cur;sl_cur=sl_next;sl_next=(sl_next==(NSLOT-1)*SLOTB)?0:sl_next+SLOTB;}while(0)
  DMA_K(2,2*SLOTB);
  WAIT_BAR(3);
  qkt(pA0,pA1,Kbase,qr,negm,r32,hi);asm volatile("s_nop 15\n\ts_nop 7":"+v"(pA0),"+v"(pA1));CMASK(pA0,pA1,0);
  START(pA0,pA1);
  _Pragma("unroll") for(int r=0;r<16;++r)pA1[r]=__builtin_amdgcn_exp2f(pA1[r]);
  WAIT_BAR(0);
  DMA_K(3,0);DMA_V(1,SLOTB);
  ROT();
  kload8(kf,kp0+sl_cur);
  WAIT_BAR(2);
  s16x4 vlo[8],vhi[8]; u32x4 pw0,pw1,pw2,pw3;
  #define PKW(P,B) cvtpk_s(P[B],P[B+1])
  #define PAF(k) __builtin_bit_cast(bf16x8,pw##k)
  #define VFR(i) (bf16x8){vlo[i][0],vlo[i][1],vlo[i][2],vlo[i][3],vhi[i][0],vhi[i][1],vhi[i][2],vhi[i][3]}
  #define PIN(x) asm volatile("":"+v"(x))
  #define MX3(a,b,c) __builtin_fmaxf(__builtin_fmaxf((a),(b)),(c))
  #define GAPA(MF,A0,A1,A2,A3,W0,W1,PW) do{ MF; sacc+=A0; sacc+=A1; sacc+=A2; sacc+=A3; PIN(sacc); W0; W1; PIN(PW); SBAR(); }while(0)
  #define EX(v) __builtin_amdgcn_exp2f(v)
  #define GAPB(MF,X,B) do{ MF; X[B]=EX(X[B]); X[B+1]=EX(X[B+1]); X[B+2]=EX(X[B+2]); X[B+3]=EX(X[B+3]); PIN(X); SBAR(); }while(0)
  #define VRD(i) do{ vlo[i]=vtr(vp_+(((i)>>2)*4096+((i)&3)*1024)); vhi[i]=vtr(vp_+(((i)>>2)*4096+((i)&3)*1024+512)); }while(0)
  #define KRD(G,j) do{ if(G){ kload2(kf,kp0+sl_next,j); SBAR(); } }while(0)
  #define STEP(C0,C1,P0,P1,t,GK,GV,GL) do{ SBAR(); \
    const lds_cptr vp_=vp0+sl_prev; \
    VRD(0); SBAR(); float sacc=(P0[0]+P0[1]); \
    GAPA(C0=__builtin_amdgcn_mfma_f32_32x32x16_bf16(kf[0],qr[0],negm,0,0,0), P0[2],P0[3],P0[4],P0[5],     pw0[0]=PKW(P0,0), pw0[1]=PKW(P0,2), pw0); \
    VRD(4); SBAR(); GAPA(C1=__builtin_amdgcn_mfma_f32_32x32x16_bf16(kf[1],qr[0],negm,0,0,0), P0[6],P0[7],P0[8],P0[9],     pw0[2]=PKW(P0,4), pw0[3]=PKW(P0,6), pw0); \
    VRD(1); SBAR(); GAPA(C0=__builtin_amdgcn_mfma_f32_32x32x16_bf16(kf[2],qr[1],C0,0,0,0),   P0[10],P0[11],P0[12],P0[13], pw1[0]=PKW(P0,8), pw1[1]=PKW(P0,10), pw1); \
    VRD(5); SBAR(); GAPA(C1=__builtin_amdgcn_mfma_f32_32x32x16_bf16(kf[3],qr[1],C1,0,0,0),   P0[14],P0[15],P1[0],P1[1],   pw1[2]=PKW(P0,12),pw1[3]=PKW(P0,14), pw1); \
    VRD(2); SBAR(); GAPA(C0=__builtin_amdgcn_mfma_f32_32x32x16_bf16(kf[4],qr[2],C0,0,0,0),   P1[2],P1[3],P1[4],P1[5],     pw2[0]=PKW(P1,0), pw2[1]=PKW(P1,2), pw2); \
    VRD(6); SBAR(); GAPA(C1=__builtin_amdgcn_mfma_f32_32x32x16_bf16(kf[5],qr[2],C1,0,0,0),   P1[6],P1[7],P1[8],P1[9],     pw2[2]=PKW(P1,4), pw2[3]=PKW(P1,6), pw2); \
    VRD(3); SBAR(); GAPA(C0=__builtin_amdgcn_mfma_f32_32x32x16_bf16(kf[6],qr[3],C0,0,0,0),   P1[10],P1[11],P1[12],P1[13], pw3[0]=PKW(P1,8), pw3[1]=PKW(P1,10), pw3); \
    VRD(7); SBAR(); GAPA(C1=__builtin_amdgcn_mfma_f32_32x32x16_bf16(kf[7],qr[3],C1,0,0,0),   P1[14],P1[15],0.f,0.f,       pw3[2]=PKW(P1,12),pw3[3]=PKW(P1,14), pw3); \
    l_reg+=sacc; \
    if(GK){DMA_K((t)+3,sl_cur);} if(GV){DMA_V((t)+1,sl_next);} \
    CMASK(C0,C1,t); \
    { float a=MX3(C0[0],C0[1],C1[0]),b=MX3(C0[2],C0[3],C1[1]); a=MX3(a,C1[2],C1[3]); \
      _Pragma("unroll") for(int r=4;r<16;r+=4){a=MX3(a,C0[r],C0[r+1]);b=MX3(b,C0[r+2],C0[r+3]);a=MX3(a,C1[r],C1[r+1]);b=MX3(b,C1[r+2],C1[r+3]);} \
      float rm=__builtin_fmaxf(a,b); { auto rr=__builtin_amdgcn_permlane32_swap(__float_as_uint(rm),__float_as_uint(rm),false,false); rm=__builtin_fmaxf(__uint_as_float(rr[0]),__uint_as_float(rr[1])); } \
      resc=false; \
      if(__builtin_expect(__any(rm>(float)THRL),0)){ const float dl=__builtin_fmaxf(rm,0.f); mhat+=dl; \
        _Pragma("unroll") for(int r=0;r<16;++r){C0[r]-=dl;C1[r]-=dl;} \
        _Pragma("unroll") for(int r=0;r<16;++r)negm[r]=-mhat; asm volatile("":"+v"(negm)); \
        const float f=__builtin_amdgcn_exp2f(-dl); l_reg*=f; if(hi==0)wsf[r32]=f; resc=true; } } \
    SBAR(); \
    GAPB(o[0]=__builtin_amdgcn_mfma_f32_32x32x16_bf16(PAF(0),VFR(0),o[0],0,0,0), C0,0); \
    GAPB(o[1]=__builtin_amdgcn_mfma_f32_32x32x16_bf16(PAF(0),VFR(4),o[1],0,0,0), C0,4); \
    KRD(GL,0); GAPB(o[0]=__builtin_amdgcn_mfma_f32_32x32x16_bf16(PAF(1),VFR(1),o[0],0,0,0), C0,8); \
    KRD(GL,1); GAPB(o[1]=__builtin_amdgcn_mfma_f32_32x32x16_bf16(PAF(1),VFR(5),o[1],0,0,0), C0,12); \
    KRD(GL,2); GAPB(o[0]=__builtin_amdgcn_mfma_f32_32x32x16_bf16(PAF(2),VFR(2),o[0],0,0,0), C1,0); \
    KRD(GL,3); GAPB(o[1]=__builtin_amdgcn_mfma_f32_32x32x16_bf16(PAF(2),VFR(6),o[1],0,0,0), C1,4); \
    GAPB(o[0]=__builtin_amdgcn_mfma_f32_32x32x16_bf16(PAF(3),VFR(3),o[0],0,0,0), C1,8); \
    GAPB(o[1]=__builtin_amdgcn_mfma_f32_32x32x16_bf16(PAF(3),VFR(7),o[1],0,0,0), C1,12); \
    }while(0)
  int t=1;
  #undef CMASK
  #define CMASK(P0,P1,t) do{}while(0)
  for(;t+5<NT;t+=2){
    STEP(pB0,pB1,pA0,pA1,t,true,true,true);     WAIT_BAR(2); RESC(); ROT();
    STEP(pA0,pA1,pB0,pB1,t+1,true,true,true);   WAIT_BAR(2); RESC(); ROT();
  }
  #undef CMASK
  #define CMASK(P0,P1,t) do{}while(0)
  #define ENDW(tt) do{ if((tt)+3<NT){WAIT_BAR(2);} else if((tt)+2<NT){WAIT_BAR(1);} else {WAIT_BAR(0);} }while(0)
  for(;t+1<NT;t+=2){
    STEP(pB0,pB1,pA0,pA1,t,(t+3<NT),(t+1<NT),(t+1<NT));       ENDW(t);   RESC(); ROT();
    STEP(pA0,pA1,pB0,pB1,t+1,(t+4<NT),(t+2<NT),(t+2<NT));     ENDW(t+1); RESC(); ROT();
  }
  STEP(pB0,pB1,pA0,pA1,NT-1,false,false,false); RESC();
  { float sacc=pB0[0]+pB0[1]; _Pragma("unroll") for(int r=2;r<16;++r)sacc+=pB0[r]; _Pragma("unroll") for(int r=0;r<16;++r)sacc+=pB1[r]; l_reg+=sacc;
    pw0=(u32x4){PKW(pB0,0),PKW(pB0,2),PKW(pB0,4),PKW(pB0,6)};pw1=(u32x4){PKW(pB0,8),PKW(pB0,10),PKW(pB0,12),PKW(pB0,14)};pw2=(u32x4){PKW(pB1,0),PKW(pB1,2),PKW(pB1,4),PKW(pB1,6)};pw3=(u32x4){PKW(pB1,8),PKW(pB1,10),PKW(pB1,12),PKW(pB1,14)};
    SBAR(); pv(o,vb0+sl_cur,PAF(0),PAF(1),PAF(2),PAF(3)); }
  #undef PKW
  #undef PAF
  #undef VFR
  #undef PIN
  #undef MX3
  #undef GAPA
  #undef GAPB
  #undef EX
  #undef VRD
  #undef KRD
  #undef STEP
  #undef ENDW
  {auto rr=__builtin_amdgcn_permlane32_swap(__float_as_uint(l_reg),__float_as_uint(l_reg),false,false);l_reg=__uint_as_float(rr[0])+__uint_as_float(rr[1]);}
  if(hi==0)wsf[32+r32]=l_reg;asm volatile("s_waitcnt lgkmcnt(0)":::"memory");
  float rli[16];
  #pragma unroll
  for(int r=0;r<16;++r)rli[r]=__builtin_amdgcn_rcpf(wsf[32+crow(r,hi)]);
  bf16*Ow=O+(rowbase+q0+wid*QBLK)*OP+h*D;
  { bf16*stg=(bf16*)(shm+LDS_OST)+wid*2048;
    #pragma unroll
    for(int r=0;r<16;++r){const int orow=crow(r,hi);
      #pragma unroll
      for(int d0=0;d0<2;++d0)stg[orow*64+d0*32+r32]=__float2bfloat16(o[d0][r]*rli[r]);}
    asm volatile("s_waitcnt lgkmcnt(0)":::"memory");
    #pragma unroll
    for(int i=0;i<4;++i){const int row=i*8+(lane>>3),ch=lane&7; const u32x4 v=*(const u32x4*)(stg+row*64+ch*8); ATTN_STORE16(Ow+(long)row*OP+ch*8,v);} }
  asm volatile("s_waitcnt lgkmcnt(0)\n\ts_barrier":::"memory");
  #undef DMA_K
  #undef DMA_V
  #undef CMASK
  #undef START
  #undef RESC
  #undef ROT
}
constexpr int ATTN_LDS_BYTES=LDS_BYTES;
#undef SBAR
#undef WAIT_BAR
}

constexpr int FBUF = 8720;
__device__ __forceinline__ int fpad(int i) { return i + (i >> 5) + 18 * (i >> 9); }
constexpr float kTwC[16] = {1.000000000e+00f, 9.807852804e-01f, 9.238795325e-01f, 8.314696123e-01f, 7.071067812e-01f, 5.555702330e-01f, 3.826834324e-01f, 1.950903220e-01f,
                            0.0f, -1.950903220e-01f, -3.826834324e-01f, -5.555702330e-01f, -7.071067812e-01f, -8.314696123e-01f, -9.238795325e-01f, -9.807852804e-01f};
constexpr float kTwS[16] = {0.000000000e+00f, 1.950903220e-01f, 3.826834324e-01f, 5.555702330e-01f, 7.071067812e-01f, 8.314696123e-01f, 9.238795325e-01f, 9.807852804e-01f,
                            1.000000000e+00f, 9.807852804e-01f, 9.238795325e-01f, 8.314696123e-01f, 7.071067812e-01f, 5.555702330e-01f, 3.826834324e-01f, 1.950903220e-01f};
template <int N> __device__ __forceinline__ void dft_dif(f32x2 (&v)[N]) {
#pragma unroll
    for (int len = N; len >= 2; len >>= 1) {
        const int half = len / 2;
#pragma unroll
        for (int base = 0; base < N; base += len)
#pragma unroll
            for (int j = 0; j < half; ++j) {
                const f32x2 a = v[base + j], b = v[base + j + half];
                v[base + j] = a + b;
                const f32x2 d = a - b;
                const int ti = j * (32 / len);
                v[base + j + half] = (ti == 0) ? d : (f32x2){d.x * kTwC[ti] + d.y * kTwS[ti], d.y * kTwC[ti] - d.x * kTwS[ti]};
            }
    }
}
__host__ __device__ constexpr int brev(int i, int bits) { int r = 0; for (int b = 0; b < bits; ++b) r |= ((i >> b) & 1) << (bits - 1 - b); return r; }

#define FFT_BAR() asm volatile("s_waitcnt lgkmcnt(0)\n\ts_barrier" ::: "memory")
__device__ __forceinline__ void fft8192(LAS f32x2* buf, int tid_in) {
    int tid = tid_in; asm volatile("" : "+v"(tid));
    {
        const int n2 = tid; f32x2 v[16];
        LAS f32x2* p = buf + n2 + (n2 >> 5);
#pragma unroll
        for (int n1 = 0; n1 < 16; ++n1) v[n1] = p[546 * n1];
        dft_dif<16>(v);
        const float rv1 = (float)n2 * (1.f / 8192.f); const float c = __builtin_amdgcn_cosf(rv1), s = -__builtin_amdgcn_sinf(rv1);
        f32x2 pw[16]; pw[0] = (f32x2){1.f, 0.f}; pw[1] = (f32x2){c, s};
#pragma unroll
        for (int k = 2; k < 16; ++k) pw[k] = cmul(pw[k - 1], pw[1]);
#pragma unroll
        for (int i = 0; i < 16; ++i) { const int k1 = brev(i, 4); p[546 * k1] = cmul(v[i], pw[k1]); }
    }
    FFT_BAR();
    {
        const int k1 = tid >> 5, b = tid & 31; f32x2 v[16];
        LAS f32x2* p = buf + 546 * k1 + b;
#pragma unroll
        for (int a = 0; a < 16; ++a) v[a] = p[33 * a];
        dft_dif<16>(v);
        const float rv2 = (float)b * (1.f / 512.f); const float c = __builtin_amdgcn_cosf(rv2), s = -__builtin_amdgcn_sinf(rv2);
        f32x2 pw[16]; pw[0] = (f32x2){1.f, 0.f}; pw[1] = (f32x2){c, s};
#pragma unroll
        for (int k = 2; k < 16; ++k) pw[k] = cmul(pw[k - 1], pw[1]);
#pragma unroll
        for (int i = 0; i < 16; ++i) { const int ka = brev(i, 4); p[33 * ka] = cmul(v[i], pw[ka]); }
    }
    FFT_BAR();
    {
        const int ka = (tid >> 4) & 15, k1 = tid & 15; f32x2 v[32];
        if (tid < 256) {
            const LAS f32x2* p = buf + 546 * k1 + 33 * ka;
#pragma unroll
            for (int b = 0; b < 32; ++b) v[b] = p[b];
            dft_dif<32>(v);
        }
        FFT_BAR();
        if (tid < 256) {
            LAS f32x2* q = buf + k1 + 16 * ka + (ka >> 1);
#pragma unroll
            for (int i = 0; i < 32; ++i) { const int kb = brev(i, 5); q[264 * kb + 18 * (kb >> 1)] = v[i]; }
        }
    }
    FFT_BAR();
}

__device__ __forceinline__ float hy_sconv(const bf16* xrow, unsigned t, float w0, float w1, float w2, float bias) {
    const unsigned tm = t > 0u ? t - 1u : 0u, tp = t < (unsigned)(SEQ - 1) ? t + 1u : (unsigned)(SEQ - 1);
    const float xm = t > 0u ? bf2f(xrow[tm]) : 0.f, x0 = bf2f(xrow[t]), xp = t < (unsigned)(SEQ - 1) ? bf2f(xrow[tp]) : 0.f;
    return xm * w0 + x0 * w1 + xp * w2 + bias;
}

__device__ __forceinline__ void hy_sconv_row(Frame& F, const Args& args, int l, int row  , size_t dummy_off = 0) {
    const int lane = F.lane, ch = row >> 3;
    bf16* x = WSP(bf16, WS_RB + RB_HYT) + (size_t)ch * M + (size_t)(row & 7) * SEQ;
    const float* cw = FIN(I_HY_CW) + (size_t)l * 3 * 768; const float w0 = cw[ch], w1 = cw[768 + ch], w2 = cw[1536 + ch], bias = FIN(I_HY_CB)[(size_t)l * 768 + ch];
    v4u raw[8];
#pragma unroll
    for (int k = 0; k < 8; ++k) raw[k] = *(const v4u*)(x + 8 * lane + 512 * k);
    float first[8], lastv[8];
#pragma unroll
    for (int k = 0; k < 8; ++k) { first[k] = bflo(raw[k].x); lastv[k] = bfhi(raw[k].w); }
#pragma unroll
    for (int k = 0; k < 8; ++k) {
        float v[10];
        v[1] = bflo(raw[k].x); v[2] = bfhi(raw[k].x); v[3] = bflo(raw[k].y); v[4] = bfhi(raw[k].y); v[5] = bflo(raw[k].z); v[6] = bfhi(raw[k].z); v[7] = bflo(raw[k].w); v[8] = bfhi(raw[k].w);
        const float lft = __shfl_up(lastv[k], 1), lft0 = k > 0 ? __shfl(lastv[k > 0 ? k - 1 : 0], 63) : 0.f;
        const float rgt = __shfl_down(first[k], 1), rgt63 = k < 7 ? __shfl(first[k < 7 ? k + 1 : 7], 0) : 0.f;
        v[0] = lane == 0 ? lft0 : lft; v[9] = lane == 63 ? rgt63 : rgt;
        float o[8];
#pragma unroll
        for (int e = 0; e < 8; ++e) o[e] = v[e] * w0 + v[e + 1] * w1 + v[e + 2] * w2 + bias;
        v4u w; w.x = pk2(o[0], o[1]); w.y = pk2(o[2], o[3]); w.z = pk2(o[4], o[5]); w.w = pk2(o[6], o[7]);
        *(v4u*)((bf16*)((char*)x + dummy_off) + 8 * lane + 512 * k) = w;
    }
}
__device__ __forceinline__ void hy_taps_block(Frame& F, const Args& args, int l, int tb) {
    LAS float* F2 = (LAS float*)F.lds;
    const int tid = F.tid, t0 = tb * 16;
    const float* f2 = WSP(float, WS_HF2) + ((size_t)l * 4096 + t0) * 64;
    __syncthreads();
    for (int i = tid; i < 16 * 64; i += 512) F2[i] = f2[i];
    __syncthreads();
    const float* w3 = FIN(I_HY_W3) + (size_t)l * 64 * 1024;
    float acc0[16], acc1[16];
#pragma unroll
    for (int j = 0; j < 16; ++j) { acc0[j] = 0.f; acc1[j] = 0.f; }
#pragma unroll 4
    for (int i = 0; i < 64; ++i) { const float wa = w3[i * 1024 + tid], wb = w3[i * 1024 + 512 + tid];
#pragma unroll
        for (int j = 0; j < 16; ++j) { const float x = F2[j * 64 + i]; acc0[j] += x * wa; acc1[j] += x * wb; } }
    const int c = tid & 255;
    const float delta = fabsf(-3.0701134573253945f + (float)c * ((-15.350567286626973f + 3.0701134573253945f) / 255.f));
    float* tt = WSP(float, WS_TT);
#pragma unroll
    for (int j = 0; j < 16; j += 4) { f32x4 o0, o1;
#pragma unroll
        for (int q = 0; q < 4; ++q) { const float dec = expf(-(float)(t0 + j + q) * (1.f / 4095.f) * delta); o0[q] = acc0[j + q] * dec; o1[q] = acc1[j + q] * dec; }
        *(f32x4*)(tt + (size_t)tid * SEQ + t0 + j) = o0; *(f32x4*)(tt + (size_t)(512 + tid) * SEQ + t0 + j) = o1; }
}

__device__ __forceinline__ void hyena_item(Frame& F, const Args& args, int l, int c) {
    LAS f32x2* A = (LAS f32x2*)F.lds;
    LAS f32x2* B = A + FBUF;
    LAS float* W3L = (LAS float*)(B + FBUF);
    LAS float* red = W3L + 256;
    const bf16* hyT = WSP(bf16, WS_RB + RB_HYT);
    float* HV = WSP(float, WS_RD + RD_HV) + (size_t)c * 8 * SEQ;
    bf16* yaT = WSP(bf16, WS_RD + RD_YAT) + (size_t)c * M;
    const float* f2 = WSP(float, WS_HF2) + (size_t)l * 4096 * 64;
    __syncthreads();
    __syncthreads();
#pragma unroll 1
    for (int n = 0; n < 2; ++n) {
        int tid = F.tid; asm volatile("" : "+v"(tid));
        float ss = 0.f;
        {   const float* tf = WSP(float, WS_TT) + ((size_t)(0 * 2 + n) * 256 + c) * SEQ; const float* tbk = WSP(float, WS_TT) + ((size_t)(1 * 2 + n) * 256 + c) * SEQ;
#pragma unroll
            for (int j = 0; j < 8; ++j) { const int t = tid + 512 * j; const float fw = tf[t], bw = tbk[t];
                A[tid + (tid >> 5) + 546 * j] = (f32x2){fw, 0.f}; ss += fw * fw;
                if (t >= 1) { A[fpad(8192 - t)] = (f32x2){bw, 0.f}; ss += bw * bw; } } }
        if (tid == 0) A[fpad(4096)] = (f32x2){0.f, 0.f};
        ss = block_sum(F, ss, red);
        const float scale = (1.f / sqrtf(ss)) * (1.f / 8192.f);
        const float biasN = FIN(I_HY_BIAS)[((size_t)l * 2 + n) * 256 + c] * (1.f / 8192.f);
        fft8192(A, tid);
#pragma unroll
        for (int j = 0; j < 16; ++j) { LAS f32x2* p = A + tid + (tid >> 5) + 546 * j; f32x2 a = *p * scale; a.x += biasN; *p = a; }
#pragma unroll 1
        for (int pb = 0; pb < 4; ++pb) {
            int tq = tid; asm volatile("" : "+v"(tq));
            const bf16* zr0 = hyT + (size_t)c * M + (size_t)(2 * pb) * SEQ; const bf16* zr1 = zr0 + SEQ;
            const bf16* gr0 = hyT + (size_t)((n + 1) * 256 + c) * M + (size_t)(2 * pb) * SEQ; const bf16* gr1 = gr0 + SEQ;
            float* hv0 = HV + (size_t)(2 * pb) * SEQ; float* hv1 = hv0 + SEQ;
            __syncthreads();
#pragma unroll
            for (int j = 0; j < 8; ++j) { const unsigned t = (unsigned)tq + 512u * j; float z0, z1;
                if (n == 0) { z0 = bf2f(zr0[t]); z1 = bf2f(zr1[t]); }
                else { z0 = hv0[t]; z1 = hv1[t]; }
                B[tq + (tq >> 5) + 546 * j] = (f32x2){z0, z1}; B[tq + (tq >> 5) + 546 * (j + 8)] = (f32x2){0.f, 0.f}; }
            float g0[8], g1[8];
#pragma unroll
            for (int j = 0; j < 8; ++j) { const unsigned t = (unsigned)tq + 512u * j; g0[j] = bf2f(gr0[t]); g1[j] = bf2f(gr1[t]); }
            FFT_BAR();
            fft8192(B, tq);
#pragma unroll
            for (int j = 0; j < 16; ++j) { const int p = tq + (tq >> 5) + 546 * j; const f32x2 y = cmul(B[p], A[p]); B[p] = (f32x2){y.x, -y.y}; }
            FFT_BAR();
            fft8192(B, tq);
#pragma unroll
            for (int j = 0; j < 8; ++j) { const unsigned t = (unsigned)tq + 512u * j; const f32x2 y = B[tq + (tq >> 5) + 546 * j];
                const float o0 = g0[j] * y.x, o1 = g1[j] * -y.y;
                if (n == 0) { hv0[t] = o0; hv1[t] = o1; }
                else { yaT[(size_t)(2 * pb) * SEQ + t] = (bf16)f2bf(o0); yaT[(size_t)(2 * pb + 1) * SEQ + t] = (bf16)f2bf(o1); } }
        }
        __syncthreads();
    }
}

__device__ __forceinline__ f32x16 mfma32(bf16x8 a, bf16x8 b, f32x16 c) { return __builtin_amdgcn_mfma_f32_32x32x16_bf16(a, b, c, 0, 0, 0); }
__device__ __forceinline__ int crow(int r, int hi) { return (r & 3) + 8 * (r >> 2) + 4 * hi; }
__device__ __forceinline__ float gelu_tanh(float x) {
    const float u = 0.7978845608028654f * (x + 0.044715f * x * x * x);
    const float e = __builtin_amdgcn_exp2f(2.885390081777927f * u);
    const float th = 1.f - 2.f * __builtin_amdgcn_rcpf(e + 1.f);
    return 0.5f * x * (1.f + th);
}
__device__ __forceinline__ void s5_item(Frame& F, const Args& args, int l, int b, int g) {
    constexpr int SP = 129, XP = 136;
    LAS float* S = (LAS float*)F.lds;
    LAS bf16* XB = (LAS bf16*)(F.lds + 128 * SP * 4);
    const int tid = F.tid, lane = F.lane, w = F.wave, r32 = lane & 31, hi = lane >> 5;
    const bf16* U = WSP(bf16, WS_RB + RB_PROJ2) + (size_t)b * SEQ * PROJ2_W + PC_S5 + g * 16;
    const bf16* wst = WSP(bf16, WS_S5W + (size_t)l * S5W_LAYER + S5_WST_OFF) + (size_t)g * 2 * 128 * 512;
    const bf16* wcat = WSP(bf16, WS_S5W + (size_t)l * S5W_LAYER + S5_WCAT_OFF) + (size_t)g * 512 * 768;
    bf16* Z = WSP(bf16, WS_RD + RD_S5Z) + (size_t)b * SEQ * 256 + g * 16;
    __syncthreads();
    for (int dir = 0; dir < 2; ++dir) {
        {
            const int rt = w >> 1, ct0 = 2 * (w & 1);
            f32x16 acc[2]; acc[0] = f32x16{}; acc[1] = f32x16{};
            const bf16* ap = wst + ((size_t)dir * 128 + rt * 32 + r32) * 512 + 8 * hi;
            const bf16* bp0 = U + (size_t)(32 * (ct0 * 32 + r32)) * PROJ2_W + 8 * hi;
            const bf16* bp1 = bp0 + (size_t)(32 * 32) * PROJ2_W;
#pragma unroll 4
            for (int ks = 0; ks < 32; ++ks) {
                const bf16x8 a = *(const bf16x8*)(ap + 16 * ks);
                const bf16x8 b0 = *(const bf16x8*)(bp0 + (size_t)ks * PROJ2_W), b1 = *(const bf16x8*)(bp1 + (size_t)ks * PROJ2_W);
                acc[0] = mfma32(a, b0, acc[0]); acc[1] = mfma32(a, b1, acc[1]);
            }
#pragma unroll
            for (int q = 0; q < 2; ++q)
#pragma unroll
                for (int r = 0; r < 16; ++r) S[((ct0 + q) * 32 + r32) * SP + rt * 32 + crow(r, hi)] = acc[q][r];
        }
        __syncthreads();
        if (tid < 64) {
            const f32x2 a32 = WSP(f32x2, WS_S5A32)[((size_t)(l * 2 + dir) * 16 + g) * 64 + tid];
            f32x2 X = (f32x2){0.f, 0.f};
#pragma unroll 8
            for (int cc = 0; cc < 128; ++cc) { const int c = dir == 0 ? cc : 127 - cc;
                const f32x2 s = (f32x2){S[c * SP + 2 * tid], S[c * SP + 2 * tid + 1]};
                X = cmul(a32, X) + s;
                *(LAS unsigned*)(XB + ((size_t)dir * 128 + c) * XP + 2 * tid) = pk2(X.x, X.y); }
        }
        __syncthreads();
    }
    {
        f32x16 acc[2][4];
#pragma unroll
        for (int i = 0; i < 2; ++i)
#pragma unroll
            for (int j = 0; j < 4; ++j) acc[i][j] = f32x16{};
        const bf16* ap = wcat + (size_t)(2 * w * 32 + r32) * 768 + 8 * hi;
        const bf16* bp = U + (size_t)(32 * r32) * PROJ2_W + 8 * hi;
#pragma unroll 2
        for (int ks = 0; ks < 32; ++ks) {
            const bf16x8 a0 = *(const bf16x8*)(ap + 16 * ks), a1 = *(const bf16x8*)(ap + 32 * 768 + 16 * ks);
#pragma unroll
            for (int ct = 0; ct < 4; ++ct) { const bf16x8 bv = *(const bf16x8*)(bp + (size_t)(32 * 32 * ct + ks) * PROJ2_W);
                acc[0][ct] = mfma32(a0, bv, acc[0][ct]); acc[1][ct] = mfma32(a1, bv, acc[1][ct]); }
        }
#pragma unroll 2
        for (int ks = 0; ks < 16; ++ks) {
            const int dir = ks >> 3, kk = ks & 7;
            const bf16x8 a0 = *(const bf16x8*)(ap + 512 + 16 * ks), a1 = *(const bf16x8*)(ap + 32 * 768 + 512 + 16 * ks);
#pragma unroll
            for (int ct = 0; ct < 4; ++ct) { const int c = ct * 32 + r32, cs = dir == 0 ? c - 1 : c + 1;
                bf16x8 bv = (bf16x8){0, 0, 0, 0, 0, 0, 0, 0};
                if (cs >= 0 && cs < 128) bv = *(const LAS bf16x8*)(XB + ((size_t)dir * 128 + cs) * XP + 16 * kk + 8 * hi);
                acc[0][ct] = mfma32(a0, bv, acc[0][ct]); acc[1][ct] = mfma32(a1, bv, acc[1][ct]); }
        }
#pragma unroll
        for (int i = 0; i < 2; ++i)
#pragma unroll
            for (int ct = 0; ct < 4; ++ct)
#pragma unroll
                for (int q = 0; q < 4; ++q) {
                    const int tl = (2 * w + i) * 2 + (q >> 1), co = 8 * (q & 1) + 4 * hi, c = ct * 32 + r32;
                    v2u o; o.x = pk2(gelu_tanh(acc[i][ct][4 * q]), gelu_tanh(acc[i][ct][4 * q + 1])); o.y = pk2(gelu_tanh(acc[i][ct][4 * q + 2]), gelu_tanh(acc[i][ct][4 * q + 3]));
                    *(v2u*)(Z + (size_t)(32 * c + tl) * 256 + co) = o; }
    }
    __syncthreads();
}

__device__ __forceinline__ void dil_item(Frame& F, const Args& args, int it) {
    constexpr int RS = 144;
    LAS unsigned char* Ks = F.lds; LAS unsigned char* Vs = F.lds + 384 * RS;
    int lane = F.lane; asm volatile("" : "+v"(lane));
    const int r32 = lane & 31, hi = lane >> 5, w = F.wave;
    const int u0 = it * 8, g = u0 >> 12, b = (u0 >> 9) & 7, hh = (u0 >> 7) & 3, tile0 = u0 & 127;
    const int dsh = 2 * g, Lp = SEQ >> dsh, tpr = Lp >> 5, rho = tile0 / tpr, q0 = (tile0 % tpr) * 32, h = g * 4 + hh;
    const float slope2 = exp2f(-8.f * (float)(h + 1) * (1.f / 12.f)) * (float)(1 << dsh) * 1.4426950408889634f;
    const char* P2 = (const char*)(WSP(bf16, WS_RB + RB_PROJ2) + (size_t)b * SEQ * PROJ2_W);
#define DIL_ROWB(tp) ((unsigned)(rho + ((tp) << dsh)) * (unsigned)(PROJ2_W * 2))
    __syncthreads();
    {   int tq = F.tid; asm volatile("" : "+v"(tq));
#pragma unroll
        for (int k = 0; k < 6; ++k) { const int id = tq + 512 * k, row = id >> 3, ch = id & 7;
            int tj = q0 - 64 + row; tj = tj < 0 ? 0 : (tj > Lp - 1 ? Lp - 1 : tj);
            const unsigned ro = DIL_ROWB(tj) + (unsigned)(h * 64 + ch * 8) * 2u;
            const v4u kv = *(const v4u*)(P2 + ro + PC_DK * 2), vv = *(const v4u*)(P2 + ro + PC_DV * 2);
            *(LAS v4u*)(Ks + row * RS + ch * 16) = kv; *(LAS v4u*)(Vs + row * RS + ch * 16) = vv; } }
    const int tau0 = q0 + 32 * w;
    bf16x8 qf[4];
    { const unsigned qo = DIL_ROWB(tau0 + r32) + (unsigned)(PC_DQ + h * 64 + 8 * hi) * 2u;
#pragma unroll
      for (int ks = 0; ks < 4; ++ks) qf[ks] = *(const bf16x8*)(P2 + qo + 32 * ks); }
    __syncthreads();
    f32x16 S[5];
#pragma unroll
    for (int kt = 0; kt < 5; ++kt) {
        const LAS unsigned char* kp = Ks + (32 * w + 32 * kt + r32) * RS + 16 * hi;
        f32x16 a = f32x16{};
#pragma unroll
        for (int ks = 0; ks < 4; ++ks) a = mfma32(*(const LAS bf16x8*)(kp + 32 * ks), qf[ks], a);
        S[kt] = a;
    }
    float mx = -1e30f;
    const float cr32 = (float)r32;
    if (tau0 >= 64 && tau0 + 96 <= Lp) {
#pragma unroll
        for (int kt = 0; kt < 5; ++kt)
#pragma unroll
            for (int r = 0; r < 16; ++r) { const float dlf = (float)(-64 + 32 * kt + crow(r, 0)) + (float)(4 * hi) - cr32;
                float sc = S[kt][r] * (0.125f * 1.4426950408889634f) - slope2 * fabsf(dlf);
                if (kt == 0) sc = dlf >= -64.f ? sc : -1e30f;
                if (kt == 4) sc = dlf <= 64.f ? sc : -1e30f;
                S[kt][r] = sc; mx = fmaxf(mx, sc); }
    } else {
#pragma unroll
        for (int kt = 0; kt < 5; ++kt)
#pragma unroll
            for (int r = 0; r < 16; ++r) { const int dl = -64 + 32 * kt + crow(r, hi) - r32, tj = tau0 + r32 + dl;
                const bool ok = dl >= -64 && dl <= 64 && tj >= 0 && tj < Lp;
                const float sc = S[kt][r] * (0.125f * 1.4426950408889634f) - slope2 * (float)(dl < 0 ? -dl : dl);
                S[kt][r] = ok ? sc : -1e30f; mx = fmaxf(mx, S[kt][r]); }
    }
    mx = fmaxf(mx, __shfl_xor(mx, 32));
    float lsum = 0.f;
#pragma unroll
    for (int kt = 0; kt < 5; ++kt)
#pragma unroll
        for (int r = 0; r < 16; ++r) { const float p = __builtin_amdgcn_exp2f(S[kt][r] - mx); S[kt][r] = p; lsum += p; }
    lsum += __shfl_xor(lsum, 32);
    f32x16 O[2]; O[0] = f32x16{}; O[1] = f32x16{};
    const LAS unsigned short* vb = (const LAS unsigned short*)(Vs + (32 * w + 4 * hi) * RS) + r32;
#pragma unroll
    for (int kt = 0; kt < 5; ++kt)
#pragma unroll
        for (int s = 0; s < 2; ++s) {
            bf16x8 pa; bf16x8 v0, v1;
#pragma unroll
            for (int j = 0; j < 8; j += 2) { const unsigned pw = pk2(S[kt][8 * s + j], S[kt][8 * s + j + 1]); pa[j] = (short)(pw & 0xffff); pa[j + 1] = (short)(pw >> 16); }
#pragma unroll
            for (int j = 0; j < 8; ++j) { const LAS unsigned short* vp = vb + (32 * kt + 16 * s + 8 * (j >> 2) + (j & 3)) * (RS / 2); v0[j] = (short)vp[0]; v1[j] = (short)vp[32]; }
            O[0] = mfma32(pa, v0, O[0]); O[1] = mfma32(pa, v1, O[1]);
        }
    const float linv = 1.f / lsum;
    bf16* Og = WSP(bf16, WS_RD + RD_DILO) + (size_t)g * M * 256 + (size_t)b * SEQ * 256 + hh * 64 + r32;
#pragma unroll
    for (int r = 0; r < 16; ++r) { const int i = crow(r, hi); const float li = __shfl(linv, i);
        const unsigned ro = (unsigned)(rho + ((tau0 + i) << dsh)) * 256u;
        Og[ro] = (bf16)f2bf(O[0][r] * li); Og[ro + 32] = (bf16)f2bf(O[1][r] * li); }
    if (hi == 0) WSP(float, WS_DLSE)[((size_t)g * M + (size_t)b * SEQ + rho + ((tau0 + r32) << dsh)) * 4 + hh] = (mx + log2f(lsum)) * 0.6931471805599453f;
#undef DIL_ROWB
}

__device__ __forceinline__ void gqa_prep_rows(Frame& F, const Args& args, int l, int mA, int mB) {
    const int lane = F.lane, grp = lane >> 4, li = lane & 15;
    const bf16* P2 = WSP(bf16, WS_RB + RB_PROJ2); bf16* QK = WSP(bf16, WS_RD + RD_QKVG);
    const f32x4 qn = *(const f32x4*)(FIN(I_GQ_QN) + l * 64 + 4 * li), kn = *(const f32x4*)(FIN(I_GQ_KN) + l * 64 + 4 * li);
    v2u raw[2][3], vr[2]; f32x4 cs0[2][3], cs1[2][3];
#pragma unroll
    for (int h = 0; h < 2; ++h) { const int m0 = h ? mB : mA;
#pragma unroll
        for (int p = 0; p < 3; ++p) { const int s = 4 * p + grp, rsel = s >= 6 ? 1 : 0, hs = s - 6 * rsel, m = m0 + rsel;
            raw[h][p] = *(const v2u*)(P2 + (size_t)m * PROJ2_W + PC_GQ + hs * 64 + 4 * li);
            const int t = m & (SEQ - 1), pos = li >= 8 ? (t & 63) : (t >> 6);
            const f32x4* cs = (const f32x4*)(WSP(f32x2, WS_ROPE) + pos * 16 + 4 * (li & 3));
            cs0[h][p] = cs[0]; cs1[h][p] = cs[1]; }
        vr[h] = *(const v2u*)(P2 + (size_t)(m0 + (lane >> 5)) * PROJ2_W + PC_GV + 4 * (lane & 31)); }
    asm volatile("" ::: "memory");
#pragma unroll
    for (int h = 0; h < 2; ++h) { const int m0 = h ? mB : mA;
#pragma unroll
        for (int p = 0; p < 3; ++p) {
            const int s = 4 * p + grp, rsel = s >= 6 ? 1 : 0, hs = s - 6 * rsel, m = m0 + rsel;
            f32x4 x = (f32x4){bflo(raw[h][p].x), bfhi(raw[h][p].x), bflo(raw[h][p].y), bfhi(raw[h][p].y)};
            float ss = (x[0] * x[0] + x[1] * x[1]) + (x[2] * x[2] + x[3] * x[3]);
            ss += __shfl_xor(ss, 1); ss += __shfl_xor(ss, 2); ss += __shfl_xor(ss, 4); ss += __shfl_xor(ss, 8);
            const float rn = 1.f / sqrtf(ss * (1.f / 64.f) + RMS_EPS);
            x = x * rn * (hs < 4 ? qn : kn);
            f32x4 pr; pr[0] = __shfl_xor(x[0], 4); pr[1] = __shfl_xor(x[1], 4); pr[2] = __shfl_xor(x[2], 4); pr[3] = __shfl_xor(x[3], 4);
            const f32x4 c0 = cs0[h][p], c1 = cs1[h][p];
            const float sg = (li & 4) ? 1.f : -1.f, sc = hs < 4 ? 0.125f * 1.4426950408889634f : 1.f;
            f32x4 o; o[0] = (x[0] * c0[0] + sg * pr[0] * c0[1]) * sc; o[1] = (x[1] * c0[2] + sg * pr[1] * c0[3]) * sc; o[2] = (x[2] * c1[0] + sg * pr[2] * c1[1]) * sc; o[3] = (x[3] * c1[2] + sg * pr[3] * c1[3]) * sc;
            v2u w; w.x = pk2(o[0], o[1]); w.y = pk2(o[2], o[3]);
            *(v2u*)(QK + (size_t)m * 512 + hs * 64 + 4 * li) = w;
        }
        *(v2u*)(QK + (size_t)(m0 + (lane >> 5)) * 512 + 384 + 4 * (lane & 31)) = vr[h]; }
}

__device__ __forceinline__ void hy_transpose_item(Frame& F, int item) {
    LAS bf16* T = (LAS bf16*)F.lds + F.wave * (64 * 66);
    const int lane = F.lane, mb = item >> 2, cb = item & 3;
    const bf16* src = WSP(bf16, WS_RD + RD_YAT) + (size_t)(cb * 64) * M + (size_t)mb * 64;
    bf16* dst = WSP(bf16, WS_Y) + (size_t)(mb * 64) * 1024 + cb * 64;
#pragma unroll
    for (int i = 0; i < 8; ++i) { const int c = 8 * i + (lane >> 3), m0 = (lane & 7) * 8; const v4u v = *(const v4u*)(src + (size_t)c * M + m0);
        LAS unsigned* tp = (LAS unsigned*)(T + c * 66 + m0); tp[0] = v.x; tp[1] = v.y; tp[2] = v.z; tp[3] = v.w; }
    LDS_WAIT(); asm volatile("" ::: "memory");
#pragma unroll
    for (int i = 0; i < 8; ++i) { const int m = 8 * i + (lane >> 3), c0 = (lane & 7) * 8; unsigned short e[8];
#pragma unroll
        for (int j = 0; j < 8; ++j) e[j] = T[(c0 + j) * 66 + m];
        v4u o; o.x = e[0] | ((unsigned)e[1] << 16); o.y = e[2] | ((unsigned)e[3] << 16); o.z = e[4] | ((unsigned)e[5] << 16); o.w = e[6] | ((unsigned)e[7] << 16);
        *(v4u*)(dst + (size_t)m * 1024 + c0) = o; }
    LDS_WAIT(); asm volatile("" ::: "memory");
}
__device__ __forceinline__ void dil_combine_rows(Frame& F, int m0, int step) {
    const int lane = F.lane, hh = lane >> 4;
    const float* ls = WSP(float, WS_DLSE);
    float l0[4], l1[4], l2[4]; v2u a[4], b[4], c[4];
#pragma unroll
    for (int k = 0; k < 4; ++k) { const int m = m0 + k * step < M ? m0 + k * step : m0;
        l0[k] = ls[((size_t)0 * M + m) * 4 + hh]; l1[k] = ls[((size_t)1 * M + m) * 4 + hh]; l2[k] = ls[((size_t)2 * M + m) * 4 + hh];
        const bf16* o = WSP(bf16, WS_RD + RD_DILO) + (size_t)m * 256 + 4 * lane;
        a[k] = *(const v2u*)o; b[k] = *(const v2u*)(o + (size_t)M * 256); c[k] = *(const v2u*)(o + (size_t)2 * M * 256); }
    asm volatile("" ::: "memory");
#pragma unroll
    for (int k = 0; k < 4; ++k) { const int m = m0 + k * step < M ? m0 + k * step : m0;
        const float mx = fmaxf(l0[k], fmaxf(l1[k], l2[k])); const float e0 = expf(l0[k] - mx), e1 = expf(l1[k] - mx), e2 = expf(l2[k] - mx), inv = 1.f / (e0 + e1 + e2);
        const float w0 = e0 * inv, w1 = e1 * inv, w2 = e2 * inv;
        v2u r; r.x = pk2(w0 * bflo(a[k].x) + w1 * bflo(b[k].x) + w2 * bflo(c[k].x), w0 * bfhi(a[k].x) + w1 * bfhi(b[k].x) + w2 * bfhi(c[k].x));
        r.y = pk2(w0 * bflo(a[k].y) + w1 * bflo(b[k].y) + w2 * bflo(c[k].y), w0 * bfhi(a[k].y) + w1 * bfhi(b[k].y) + w2 * bfhi(c[k].y));
        *(v2u*)(WSP(bf16, WS_Y) + (size_t)m * 1024 + 256 + 4 * lane) = r; }
}

__device__ __forceinline__ void ln1_router_phase(Frame& F, const Args& args, int l) {
    LAS float* RT = (LAS float*)F.lds;
    const float* rw = FIN(I_ROUTER) + (size_t)l * 1024 * 16;
    __syncthreads();
    for (int i = F.tid; i < 1024 * 16; i += 512) { const int col = i >> 4, e = i & 15; RT[e * 1024 + col] = rw[i]; }
    __syncthreads();
    const int gw = F.bid * 8 + F.wave, NGW = F.G * 8, lane = F.lane;
    const bf16* pre = WSP(bf16, WS_RB + RB_PRE);
    v2u nx[2][4];
#pragma unroll
    for (int r = 0; r < 2; ++r) { const int m = gw + r * NGW;
#pragma unroll
        for (int j = 0; j < 4; ++j) nx[r][j] = (v2u){0u, 0u};
        if (m < M) {
#pragma unroll
            for (int j = 0; j < 4; ++j) nx[r][j] = *(const v2u*)(pre + (size_t)m * DM + 4 * lane + 256 * j); } }
    for (int m0 = gw; m0 < M; m0 += 2 * NGW) {
        f32x4 v[2][4];
#pragma unroll
        for (int r = 0; r < 2; ++r)
#pragma unroll
            for (int j = 0; j < 4; ++j) v[r][j] = (f32x4){bflo(nx[r][j].x), bfhi(nx[r][j].x), bflo(nx[r][j].y), bfhi(nx[r][j].y)};
#pragma unroll
        for (int r = 0; r < 2; ++r) { const int m2 = m0 + 2 * NGW + r * NGW;
            if (m2 < M) {
#pragma unroll
                for (int j = 0; j < 4; ++j) nx[r][j] = *(const v2u*)(pre + (size_t)m2 * DM + 4 * lane + 256 * j); } }
#pragma unroll
        for (int r = 0; r < 2; ++r) { const int m = m0 + r * NGW;
            ln_row(v[r], FIN(I_LN1G) + l * DM, FIN(I_LN1B) + l * DM, lane);
            if (m < M) store_row_bf16(v[r], WSP(bf16, WS_HB) + (size_t)m * DM, lane); }
        f32x2 q[16];
#pragma unroll
        for (int j = 0; j < 4; ++j)
#pragma unroll
            for (int c = 0; c < 4; ++c) q[4 * j + c] = (f32x2){v[0][j][c], v[1][j][c]};
        float lg[2][16];
#pragma unroll
        for (int e = 0; e < 16; ++e) { f32x2 a = {0.f, 0.f};
#pragma unroll
            for (int j = 0; j < 4; ++j) { const f32x4 w = *(const LAS f32x4*)(RT + e * 1024 + 4 * lane + 256 * j);
                a = __builtin_elementwise_fma(q[4 * j + 0], (f32x2){w.x, w.x}, a); a = __builtin_elementwise_fma(q[4 * j + 1], (f32x2){w.y, w.y}, a);
                a = __builtin_elementwise_fma(q[4 * j + 2], (f32x2){w.z, w.z}, a); a = __builtin_elementwise_fma(q[4 * j + 3], (f32x2){w.w, w.w}, a); }
            lg[0][e] = a.x; lg[1][e] = a.y; if (e & 1) asm volatile("" ::: "memory"); }
#pragma unroll
        for (int r = 0; r < 2; ++r) { const int m = m0 + r * NGW;
#pragma unroll
            for (int e = 0; e < 8; ++e) { const bool up = (lane & 32) != 0; const float keep = up ? lg[r][e + 8] : lg[r][e], give = up ? lg[r][e] : lg[r][e + 8]; lg[r][e] = keep + __shfl_xor(give, 32); }
#pragma unroll
            for (int e = 0; e < 4; ++e) { const bool up = (lane & 16) != 0; const float keep = up ? lg[r][e + 4] : lg[r][e], give = up ? lg[r][e] : lg[r][e + 4]; lg[r][e] = keep + __shfl_xor(give, 16); }
#pragma unroll
            for (int e = 0; e < 2; ++e) { const bool up = (lane & 8) != 0; const float keep = up ? lg[r][e + 2] : lg[r][e], give = up ? lg[r][e] : lg[r][e + 2]; lg[r][e] = keep + __shfl_xor(give, 8); }
            { const bool up = (lane & 4) != 0; const float keep = up ? lg[r][1] : lg[r][0], give = up ? lg[r][0] : lg[r][1]; lg[r][0] = keep + __shfl_xor(give, 4); }
            float z = lg[r][0]; z += __shfl_xor(z, 2); z += __shfl_xor(z, 1);
            float mx = z; mx = fmaxf(mx, __shfl_xor(mx, 4)); mx = fmaxf(mx, __shfl_xor(mx, 8)); mx = fmaxf(mx, __shfl_xor(mx, 16)); mx = fmaxf(mx, __shfl_xor(mx, 32));
            const float p = expf(z - mx); float den = p; den += __shfl_xor(den, 4); den += __shfl_xor(den, 8); den += __shfl_xor(den, 16); den += __shfl_xor(den, 32);
            if (m < M && (lane & 3) == 0) { const int e = ((lane >> 5) & 1) * 8 + ((lane >> 4) & 1) * 4 + ((lane >> 3) & 1) * 2 + ((lane >> 2) & 1); WSP(float, WS_AFF)[(size_t)m * 16 + e] = p / den; } }
    }
}

__device__ __forceinline__ int wave_incl_scan(int v, int lane) {
#pragma unroll
    for (int o = 1; o < 64; o <<= 1) { const int n = __shfl_up(v, o); if (lane >= o) v += n; }
    return v;
}
__device__ __forceinline__ int block_excl_scan(Frame& F, int v, LAS int* sc) {
    const int inc = wave_incl_scan(v, F.lane);
    __syncthreads();
    if (F.lane == 63) sc[F.wave] = inc;
    __syncthreads();
    int base = 0;
#pragma unroll
    for (int w = 0; w < 8; ++w) { const int x = sc[w]; if (w < F.wave) base += x; }
    return base + inc - v;
}
__device__ __forceinline__ void topk_item(Frame& F, int e, int b, int half, int nhalf) {
    LAS int* H = (LAS int*)F.lds;
    LAS int* SH = H + 256;
    LAS int* SC = SH + 4;
    LAS int* SEL = SC + 16;
    const int tid = F.tid, lane = F.lane, eb = e * 8 + b;
    const float* aff = WSP(float, WS_AFF) + (size_t)b * SEQ * 16 + e;
    unsigned key[8];
#pragma unroll
    for (int j = 0; j < 8; ++j) key[j] = __float_as_uint(aff[(size_t)(8 * tid + j) * 16]);
    unsigned prefix = 0u, pmask = 0u; int need = CAP;
    for (int pass = 3; pass >= 0; --pass) {
        __syncthreads();
        if (tid < 256) H[tid] = 0;
        __syncthreads();
#pragma unroll
        for (int j = 0; j < 8; ++j) if ((key[j] & pmask) == prefix) __hip_atomic_fetch_add(&H[(key[j] >> (8 * pass)) & 255u], 1, __ATOMIC_RELAXED, __HIP_MEMORY_SCOPE_WORKGROUP);
        __syncthreads();
        if (F.wave == 0) {
            const int c0 = H[255 - 4 * lane], c1 = H[254 - 4 * lane], c2 = H[253 - 4 * lane], c3 = H[252 - 4 * lane];
            const int s = c0 + c1 + c2 + c3, inc = wave_incl_scan(s, lane), exc = inc - s;
            if (exc < need && need <= inc) { const int r = need - exc; int bin, nn;
                if (r <= c0) { bin = 255 - 4 * lane; nn = r; } else if (r <= c0 + c1) { bin = 254 - 4 * lane; nn = r - c0; }
                else if (r <= c0 + c1 + c2) { bin = 253 - 4 * lane; nn = r - c0 - c1; } else { bin = 252 - 4 * lane; nn = r - c0 - c1 - c2; }
                SH[0] = bin; SH[1] = nn; }
        }
        __syncthreads();
        prefix |= (unsigned)SH[0] << (8 * pass); pmask |= 0xffu << (8 * pass); need = SH[1];
    }
    const unsigned thr = prefix;
    int eqc = 0;
#pragma unroll
    for (int j = 0; j < 8; ++j) eqc += (key[j] == thr) ? 1 : 0;
    int eq = block_excl_scan(F, eqc, SC);
    int selc = 0; unsigned selm = 0u;
#pragma unroll
    for (int j = 0; j < 8; ++j) { bool s = key[j] > thr; if (key[j] == thr) { s = eq < need; ++eq; } if (s) { selm |= 1u << j; ++selc; } }
    int slot = block_excl_scan(F, selc, SC);
    unsigned short* inv = WSP(unsigned short, WS_INV) + (size_t)eb * SEQ;
    float* gwp = WSP(float, WS_GW) + (size_t)eb * CAP; int* idx = WSP(int, WS_IDX) + (size_t)eb * CAP;
#pragma unroll
    for (int j = 0; j < 8; ++j) { const int t = 8 * tid + j;
        if ((selm >> j) & 1u) { SEL[slot] = t; if (half == 0) { inv[t] = (unsigned short)(slot + 1); gwp[slot] = __uint_as_float(key[j]); idx[slot] = t; } ++slot; }
        else if (half == 0) inv[t] = (unsigned short)0; }
    __syncthreads();
    const bf16* hb = WSP(bf16, WS_HB) + (size_t)b * SEQ * DM; bf16* xs = WSP(bf16, WS_RA + RA_XS) + (size_t)eb * CAP * DM;
    for (int s0 = half * (CAP / nhalf) + F.wave; s0 < (half + 1) * (CAP / nhalf); s0 += 64) {
        v4u a[8][2];
#pragma unroll
        for (int k = 0; k < 8; ++k) { const int t = SEL[s0 + 8 * k]; const v4u* sp = (const v4u*)(hb + (size_t)t * DM); a[k][0] = sp[F.lane]; a[k][1] = sp[F.lane + 64]; }
#pragma unroll
        for (int k = 0; k < 8; ++k) { v4u* dp = (v4u*)(xs + (size_t)(s0 + 8 * k) * DM); dp[F.lane] = a[k][0]; dp[F.lane + 64] = a[k][1]; }
    }
    __syncthreads();
}

__device__ __forceinline__ void ln2_phase(Frame& F, const Args& args, int l, bool dummy = false) {
    const int gw = F.bid * 8 + F.wave, NGW = F.G * 8, lane = F.lane;
    const unsigned short* inv = WSP(unsigned short, WS_INV);
    const bf16* eo = WSP(bf16, WS_RA + RA_EOUT);
    v2u nx[2][4]; unsigned nslv[2];
#pragma unroll
    for (int r = 0; r < 2; ++r) { const int m = gw + r * NGW; nslv[r] = 0u;
#pragma unroll
        for (int j = 0; j < 4; ++j) nx[r][j] = (v2u){0u, 0u};
        if (m < M) { const int b = m >> 12, t = m & (SEQ - 1); if (lane < NE) nslv[r] = inv[((size_t)(lane * 8 + b)) * SEQ + t];
#pragma unroll
            for (int j = 0; j < 4; ++j) nx[r][j] = *(const v2u*)(WSP(bf16, WS_HB) + (size_t)m * DM + 4 * lane + 256 * j); } }
    for (int m0 = gw; m0 < M; m0 += 2 * NGW) {
        f32x4 v[2][4]; unsigned slv[2], mask[2];
#pragma unroll
        for (int r = 0; r < 2; ++r) { slv[r] = nslv[r];
#pragma unroll
            for (int j = 0; j < 4; ++j) v[r][j] = (f32x4){bflo(nx[r][j].x), bfhi(nx[r][j].x), bflo(nx[r][j].y), bfhi(nx[r][j].y)} * DN_ALPHA; }
#pragma unroll
        for (int r = 0; r < 2; ++r) { const int m2 = m0 + 2 * NGW + r * NGW; nslv[r] = 0u;
            if (m2 < M) { const int b2 = m2 >> 12, t2 = m2 & (SEQ - 1); if (lane < NE) nslv[r] = inv[((size_t)(lane * 8 + b2)) * SEQ + t2];
#pragma unroll
                for (int j = 0; j < 4; ++j) nx[r][j] = *(const v2u*)(WSP(bf16, WS_HB) + (size_t)m2 * DM + 4 * lane + 256 * j); } }
#pragma unroll
        for (int r = 0; r < 2; ++r) mask[r] = (unsigned)__ballot(slv[r] != 0u);
        while (mask[0] | mask[1]) {
            v2u w[2][4][4]; float wgt[2][4];
#pragma unroll
            for (int r = 0; r < 2; ++r) { const int m = m0 + r * NGW, b = (m < M ? m : m0) >> 12;
#pragma unroll
                for (int k = 0; k < 4; ++k) { int e = 0; wgt[r][k] = 0.f; if (mask[r]) { e = __builtin_ctz(mask[r]); mask[r] &= mask[r] - 1u; wgt[r][k] = 1.f; }
                    const int ek = __builtin_amdgcn_readfirstlane(e); unsigned sl = (unsigned)__builtin_amdgcn_readlane((int)slv[r], ek); sl = sl ? sl - 1u : 0u;
                    const bf16* rp = eo + ((size_t)(ek * 8 + b) * CAP + sl) * DM + 4 * lane;
#pragma unroll
                    for (int j = 0; j < 4; ++j) w[r][k][j] = *(const v2u*)(rp + 256 * j); } }
#pragma unroll
            for (int r = 0; r < 2; ++r)
#pragma unroll
                for (int k = 0; k < 4; ++k)
#pragma unroll
                    for (int j = 0; j < 4; ++j) { v[r][j].x += wgt[r][k] * bflo(w[r][k][j].x); v[r][j].y += wgt[r][k] * bfhi(w[r][k][j].x); v[r][j].z += wgt[r][k] * bflo(w[r][k][j].y); v[r][j].w += wgt[r][k] * bfhi(w[r][k][j].y); }
        }
#pragma unroll
        for (int r = 0; r < 2; ++r) { const int m = m0 + r * NGW; if (m >= M) break;
            ln_row(v[r], FIN(I_LN2G) + l * DM, FIN(I_LN2B) + l * DM, lane);
            if (l == DEPTH - 1) {
#pragma unroll
                for (int j = 0; j < 4; ++j) *(f32x4*)((dummy ? WSP(float, WS_RB) : F.out) + (size_t)m * DM + 4 * lane + 256 * j) = v[r][j]; }
            else store_row_bf16(v[r], WSP(bf16, dummy ? WS_Y : WS_HB) + (size_t)m * DM, lane); }
    }
}

struct SchedTiles {
    const char* A0; const char* B0; size_t a_tile, b_tile; int nM, nN, G, c;
    __device__ __forceinline__ bool next(int i, pg8::Unit& u) const {
        const int L = i * G + c; if (L >= nM * nN) return false;
        int pm, pn; pg8::tile_of(L, nM, nN, pm, pn);
        u.A = A0 + (size_t)pm * a_tile; u.B = B0 + (size_t)pn * b_tile; u.orow = pm * 256; u.ocol = pn * 256; u.z = 0; return true;
    }
};
struct SchedMerge {
    const char* Y; const char* WB; int G, c;
    __device__ __forceinline__ bool next(int i, pg8::MergeUnit& u) const {
        const int L = (i >> 2) * G + c, z = i & 3; if (L >= 128 * 8) return false;
        int pm, pn; pg8::tile_of(L, 128, 8, pm, pn);
        u.A = Y + ((size_t)pm * 256 * 1024 + z * 256) * 2; u.B = WB + ((size_t)z * 1024 * 256 + (size_t)pn * 128 * 256) * 2; u.orow = pm * 256; u.ocol = pn * 128; u.z = z; return true;
    }
};
struct SchedMoe1 {
    const char* XS; const char* W; int G, c;
    __device__ __forceinline__ bool next(int i, pg8::Unit& u) const {
        const int L = i * G + c; if (L >= 128 * 16) return false;
        const int eb = L >> 4, sub = L & 15, pm2 = sub & 1, pn = sub >> 1, e = eb >> 3;
        u.A = XS + ((size_t)(eb * 512 + pm2 * 256) * 1024) * 2; u.B = W + ((size_t)(e * 2048 + pn * 256) * 1024) * 2; u.orow = eb * 512 + pm2 * 256; u.ocol = pn * 128; u.z = eb; return true;
    }
};
struct SchedMoe2 {
    const char* HID; const char* W; int G, c;
    __device__ __forceinline__ bool next(int i, pg8::Unit& u) const {
        const int L = i * G + c; if (L >= 128 * 8) return false;
        const int eb = L >> 3, sub = L & 7, pm2 = sub & 1, pn = sub >> 1, e = eb >> 3;
        u.A = HID + ((size_t)(eb * 512 + pm2 * 256) * 1024) * 2; u.B = W + ((size_t)(e * 1024 + pn * 256) * 1024) * 2; u.orow = eb * 512 + pm2 * 256; u.ocol = pn * 256; u.z = eb; return true;
    }
};

static_assert((size_t)(CW_Q + (DEPTH * 8 + 8) * 64) * 4 <= CTL_ZERO_BYTES && (size_t)(CW_BAR + 3456) * 4 <= (size_t)CW_Q * 4, "control words inside the per-call memset");
constexpr int NPH = 12;
__global__ void __launch_bounds__(512, 2) fwd_kernel(Args args_k) {
    const Args& args0 = args_k;
    extern __shared__ __attribute__((aligned(16))) unsigned char lds_raw[];
    Frame F;
    F.lds = (LAS unsigned char*)lds_raw;
    F.MISC = (volatile LAS unsigned*)(F.lds + MISC_OFF);
    F.tid = threadIdx.x; F.lane = F.tid & 63; F.wave = __builtin_amdgcn_readfirstlane(F.tid >> 6);
    F.G = gridDim.x; F.bid = blockIdx.x; F.zoff = 0;
    const int wave0 = __builtin_amdgcn_readfirstlane(threadIdx.x >> 6);
    F.ws = args0.ws; F.out = args0.out; F.ctl = (gu32*)(args0.ws + WS_CTL);
    for (int u = F.tid; u < (LDS_BYTES - MISC_OFF) / 4; u += 512) F.MISC[u] = 0u;
    __syncthreads();
#if defined(DBG_PROF) || defined(DBG_DLY)
    if (blockIdx.x == 0 && threadIdx.x == 0) ((unsigned long long*)(args0.ws + WS_CTL))[50000 + 15] = __builtin_amdgcn_s_memrealtime();
#endif
    const bool multi = (args0.l_hi - args0.l_lo > 1) || (args0.ph_hi - args0.ph_lo > 1);
    XcdBarrier bar; bar.bar = (unsigned*)(F.ctl + CW_BAR); bar.x = 0; bar.st = F.MISC + 8;
    if (multi) bar = xcd_barrier_post((unsigned*)(F.ctl + CW_BAR), F.MISC + 8);
    const int lo = args0.ph_lo, hi = args0.ph_hi, l_lo = args0.l_lo, l_hi = args0.l_hi;
#ifndef DBL_MASK
#define DBL_MASK 0
#endif
#define NREP(k) (((DBL_MASK >> (k)) & 1) ? 2 : 1)
#ifndef DBG_ROT
#define DBG_ROT 0
#endif
#ifndef PHASE_MASK
#define PHASE_MASK 0xfff
#endif
#define IN(k) (((PHASE_MASK >> (k)) & 1) && lo <= (k) && (k) < hi)
#ifndef SUB_MASK
#define SUB_MASK 0xff
#endif
#define SUB(k) ((SUB_MASK >> (k)) & 1)
#define FRESH() do { { int b_ = blockIdx.x, g_ = gridDim.x; asm volatile("" : "+s"(b_)); asm volatile("" : "+s"(g_)); F.bid = b_; F.G = g_; } int ln_ = __builtin_amdgcn_mbcnt_hi(~0u, __builtin_amdgcn_mbcnt_lo(~0u, 0u)); asm volatile("" : "+v"(ln_)); int wv_ = wave0; asm volatile("" : "+s"(wv_)); F.lane = ln_; F.wave = wv_; F.tid = wv_ * 64 + ln_; } while (0)
#if defined(DBG_PROF) || defined(DBG_DLY)
#define STAMP(k) do { if (blockIdx.x == 0 && threadIdx.x == 0) ((unsigned long long*)(F.ws + WS_CTL))[50000 + l * 16 + (k)] = __builtin_amdgcn_s_memrealtime(); } while (0)
#else
#define STAMP(k) do {} while (0)
#endif
#define SEAM(k) do { if (((k) + 1 < hi) || (l + 1 < l_hi)) { XcdBarrier b2_ = bar; asm volatile("" : "+s"(b2_.x)); asm volatile("" : "+s"(b2_.bar)); xcd_barrier(b2_, F.tid); } STAMP(k); } while (0)

#pragma unroll 1
    for (int l = l_lo; l < l_hi; ++l) {
        const Args& args = args_k;
        { size_t z_ = 0; asm volatile("" : "+s"(z_)); F.ws = args.ws + z_; F.out = args.out + z_; F.ctl = (gu32*)(F.ws + WS_CTL); }
        unsigned char* wb = F.ws + WS_W;
        const char* HBp = (const char*)(F.ws + WS_HB);
#define NGW (F.G * 8)
#define gw (F.bid * 8 + F.wave)
        if (IN(0) && l == 0) { FRESH(); prologue_phase(F, args); SEAM(0); if (NREP(0) > 1) { FRESH(); prologue_phase(F, args); SEAM(0); } }

        if (IN(1)) _Pragma("unroll 1") for (int rep_ = 0; rep_ < NREP(1); ++rep_) { FRESH();
            const pg8::Gemm g{1024, 1024, 1024};
            if (SUB(0)) {
                SchedTiles S{(const char*)(wb + W_WIN), HBp, (size_t)256 * 1024 * 2, (size_t)256 * 1024 * 2, 3, 128, F.G, F.bid};
                pg8::EpiBf16<0> E{WSP(bf16, WS_RB + RB_HYT), M};
                pg8::gemm_phase(F.lds, g, S, E, F.tid); }
            if (SUB(1)) {
                SchedTiles S{HBp, (const char*)(wb + W_WIN) + (size_t)768 * 1024 * 2, (size_t)256 * 1024 * 2, (size_t)256 * 1024 * 2, 128, 12, F.G, F.bid};
                pg8::EpiBf16<0> E{WSP(bf16, WS_RB + RB_PROJ2), PROJ2_W};
                pg8::gemm_phase(F.lds, g, S, E, F.tid); }
            if (SUB(2)) {
                SchedTiles S{HBp, (const char*)(wb + W_WIN) + (size_t)3840 * 1024 * 2, (size_t)256 * 1024 * 2, (size_t)256 * 1024 * 2, 128, 16, F.G, (F.bid + DBG_ROT) % F.G};
                pg8::EpiBf16<1> E{WSP(bf16, WS_RA + RA_G), 4096};
                pg8::gemm_phase(F.lds, g, S, E, F.tid); }
            SEAM(1);
        }
        if (IN(2)) _Pragma("unroll 1") for (int rep_ = 0; rep_ < NREP(2); ++rep_) { FRESH();
            if (l == 0) { for (int tb = F.bid; tb < 256; tb += F.G) hy_taps_block(F, args, 0, tb); __syncthreads(); }
            for (int m = 2 * gw; m < M; m += 4 * NGW) gqa_prep_rows(F, args, l, m, m + 2 * NGW < M ? m + 2 * NGW : m);
            if (rep_ + 1 < NREP(2)) { for (int r = gw; r < 768 * 8; r += NGW) hy_sconv_row(F, args, l, r, (WS_RD + RD_DILO) - (WS_RB + RB_HYT)); } else
            for (int r = gw; r < 768 * 8; r += NGW) hy_sconv_row(F, args, l, r);
            SEAM(2); }

        if (IN(3)) _Pragma("unroll 1") for (int rep_ = 0; rep_ < NREP(3); ++rep_) { FRESH();
#if MK_STATIC_Q
            if (SUB(0)) for (int it = F.bid; it < 256; it += F.G) hyena_item(F, args, l, it);
            if (SUB(1)) {   const attn_body::bf16* Qp = (const attn_body::bf16*)(F.ws + WS_RD + RD_QKVG);
                attn_body::bf16* Op = (attn_body::bf16*)(F.ws + WS_Y) + 768;
                for (int it = F.bid; it < 512; it += F.G) { __syncthreads();
                    attn_body::attn_unit<8>(it >> 6, (it >> 4) & 3, it & 15, Qp, Qp + 256, Qp + 384, Op, (char*)lds_raw, F.tid); } }
            if (SUB(2)) for (int it = F.bid; it < 128; it += F.G) s5_item(F, args, l, it >> 4, it & 15);
            __syncthreads();
            if (SUB(3)) for (int it = F.bid; it < 1536; it += F.G) dil_item(F, args, it);
#else
#ifndef DBL_SUB
#define DBL_SUB 0
#endif
#define NREPS(t) (((DBL_SUB >> (t)) & 1) ? 2 : 1)
            _Pragma("unroll 1") for (int r2 = 0; r2 < NREPS(2); ++r2) for (;;) { const int it = wq_grab(F, l * 8 + (r2 + rep_) * 4 + 2); if (it >= 128) break; s5_item(F, args, l, it >> 4, it & 15); }
            _Pragma("unroll 1") for (int r2 = 0; r2 < NREPS(0); ++r2) for (;;) { const int it = wq_grab(F, l * 8 + (r2 + rep_) * 4 + 0); if (it >= 256) break; hyena_item(F, args, l, it); }
            {   const attn_body::bf16* Qp = (const attn_body::bf16*)(F.ws + WS_RD + RD_QKVG);
                attn_body::bf16* Op = (attn_body::bf16*)(F.ws + WS_Y) + 768;
                _Pragma("unroll 1") for (int r2 = 0; r2 < NREPS(1); ++r2) for (;;) { const int it = wq_grab(F, l * 8 + (r2 + rep_) * 4 + 1); if (it >= 512) break;
                    attn_body::attn_unit<8>(it >> 6, (it >> 4) & 3, it & 15, Qp, Qp + 256, Qp + 384, Op, (char*)lds_raw, F.tid); } }
            _Pragma("unroll 1") for (int r2 = 0; r2 < NREPS(3); ++r2) for (;;) { const int it = wq_grab(F, l * 8 + (r2 + rep_) * 4 + 3); if (it >= 768) break; dil_item(F, args, 2 * it); dil_item(F, args, 2 * it + 1); }
#endif
            SEAM(3);
        }
        if (IN(4)) _Pragma("unroll 1") for (int rep_ = 0; rep_ < NREP(4); ++rep_) { FRESH();
            if (SUB(0)) {   const pg8::Gemm g{256, 256, 256};
                SchedTiles S{(const char*)(F.ws + WS_RD + RD_S5Z), (const char*)(wb + W_GLU), (size_t)256 * 256 * 2, 0, 128, 1, F.G, F.bid};
                pg8::EpiGlu E{WSP(bf16, WS_RD + RD_S5Z), WSP(bf16, WS_Y), FIN(I_S5_GB) + l * 256};
                pg8::gemm_phase(F.lds, g, S, E, F.tid); }
            __syncthreads();
            if (SUB(1)) for (int it = gw; it < 2048; it += NGW) hy_transpose_item(F, it);
            if (SUB(2)) for (int m = gw; m < M; m += 4 * NGW) dil_combine_rows(F, m, NGW);
            SEAM(4);
        }
        if (IN(5)) _Pragma("unroll 1") for (int rep_ = 0; rep_ < NREP(5); ++rep_) { FRESH();
            const pg8::Gemm g{256, 1024, 256};
            SchedMerge S{(const char*)(F.ws + WS_Y), (const char*)(wb + W_WB), F.G, F.bid};
            pg8::gemm_merge_phase(F.lds, g, S, WSP(bf16, WS_RA + RA_G), WSP(bf16, WS_RB + RB_MB), F.tid);
            SEAM(5);
        }
        if (IN(6)) _Pragma("unroll 1") for (int rep_ = 0; rep_ < NREP(6); ++rep_) { FRESH();
            const pg8::Gemm g{1024, 1024, 1024};
            SchedTiles S{(const char*)(F.ws + WS_RB + RB_MB), (const char*)(wb + W_WO), (size_t)256 * 1024 * 2, (size_t)256 * 1024 * 2, 128, 4, F.G, F.bid};
            pg8::EpiPre E{WSP(bf16, WS_HB), WSP(bf16, WS_RB + RB_PRE), DN_ALPHA};
            pg8::gemm_phase(F.lds, g, S, E, F.tid);
            SEAM(6);
        }
        if (IN(7)) _Pragma("unroll 1") for (int rep_ = 0; rep_ < NREP(7); ++rep_) { FRESH(); ln1_router_phase(F, args, l); SEAM(7); }
        if (IN(8)) _Pragma("unroll 1") for (int rep_ = 0; rep_ < NREP(8); ++rep_) { FRESH(); if (F.G >= 256) { if (F.bid < 256) topk_item(F, (F.bid & 127) >> 3, F.bid & 7, F.bid >> 7, 2); } else for (int it = F.bid; it < 128; it += F.G) topk_item(F, it >> 3, it & 7, 0, 1);
            if (l + 1 < DEPTH) { __syncthreads(); for (int tb = F.bid; tb < 256; tb += F.G) hy_taps_block(F, args, l + 1, tb); }
            SEAM(8); }
        if (IN(9)) _Pragma("unroll 1") for (int rep_ = 0; rep_ < NREP(9); ++rep_) { FRESH();
            const pg8::Gemm g{1024, 1024, 1024};
            SchedMoe1 S{(const char*)(F.ws + WS_RA + RA_XS), (const char*)(wb + W_GU), F.G, F.bid};
            pg8::EpiSwiglu E{WSP(bf16, WS_RB + RB_HID)};
            pg8::gemm_phase(F.lds, g, S, E, F.tid);
            SEAM(9);
        }
        if (IN(10)) _Pragma("unroll 1") for (int rep_ = 0; rep_ < NREP(10); ++rep_) { FRESH();
            const pg8::Gemm g{1024, 1024, 1024};
            SchedMoe2 S{(const char*)(F.ws + WS_RB + RB_HID), (const char*)(wb + W_DN), F.G, F.bid};
            pg8::EpiRowScale E{WSP(bf16, WS_RA + RA_EOUT), WSP(float, WS_GW)};
            pg8::gemm_phase(F.lds, g, S, E, F.tid);
            SEAM(10);
        }
        if (IN(11)) { FRESH();
            if (NREP(11) > 1) { ln2_phase(F, args, l, true); FRESH(); }
            ln2_phase(F, args, l);
            if (l + 1 < DEPTH) convert_layer(F, args, l + 1, gw, NGW);
#ifdef DBG_CONV2
            if (l + 1 < DEPTH) convert_layer(F, args, l + 1, gw, NGW);
#endif
            SEAM(11);
        }
    }
    if (multi) {
        { XcdBarrier b2_ = bar; asm volatile("" : "+s"(b2_.x)); asm volatile("" : "+s"(b2_.bar)); xcd_barrier(b2_, F.tid); }
        if (__hip_atomic_load((unsigned*)(F.ctl + CW_BAR) + XB_TMO, RLX_AGENT) != 0u) {
            const float q = __builtin_nanf("");
            for (size_t i = (size_t)F.bid * 512 + F.tid; i < (size_t)M * DM; i += (size_t)F.G * 512) args0.out[i] = q; }
    }
#ifdef DBG_DLY
    if (blockIdx.x == 0 && threadIdx.x == 0) {
        const unsigned long long* ts = (const unsigned long long*)(args0.ws + WS_CTL) + 50000; unsigned long long s = 0;
        for (int l = 0; l < DEPTH; ++l) for (int p = 0; p < NPH; ++p) { if (!((DBG_DLY >> p) & 1) || (p == 0 && l > 0)) continue;
            const unsigned long long e = ts[l * 16 + p], b = p == 0 ? ts[15] : (p == 1 && l > 0) ? ts[(l - 1) * 16 + 11] : ts[l * 16 + p - 1]; s += e - b; }
        const unsigned long long t0 = __builtin_amdgcn_s_memrealtime();
        while (__builtin_amdgcn_s_memrealtime() - t0 < s * DLY_MULT) __builtin_amdgcn_s_sleep(32);
    }
#endif
#undef IN
#undef gw
#undef NGW
#undef SEAM
}


#ifdef DBG_STOP
__global__ void dbg_dump_kernel(const unsigned char* ws, float* out, size_t off, int isf32, int ld, int ncols) {
    const size_t n = (size_t)M * DM;
    for (size_t i = (size_t)blockIdx.x * blockDim.x + threadIdx.x; i < n; i += (size_t)gridDim.x * blockDim.x) {
        const size_t r = i / DM, c = i % DM; float v = 0.f;
        if ((int)c < ncols) { if (isf32) v = ((const float*)(ws + off))[r * ld + c]; else v = bf2f(((const bf16*)(ws + off))[r * ld + c]); }
        out[i] = v; }
}
#endif

#ifdef DBG_RACE
constexpr int CW_DBG = 65536;
__global__ void dbg_sum_kernel(const unsigned* p, size_t nwords, unsigned long long* slot) {
    unsigned long long s = 0;
    for (size_t i = (size_t)blockIdx.x * blockDim.x + threadIdx.x; i < nwords; i += (size_t)gridDim.x * blockDim.x) s += (unsigned long long)p[i] * (unsigned long long)((i & 1023u) + 1u);
    for (int o = 32; o >= 1; o >>= 1) s += __shfl_xor(s, o);
    if ((threadIdx.x & 63) == 0) atomicAdd(slot, s);
}
__global__ void dbg_final_kernel(const unsigned long long* T, float* out) {
    int V = 0;
    for (int s = 56; s <= 60; ++s) if (T[s] != T[64 + s]) V |= 1 << (s - 56);
    const float c = 10.f * (float)(V + 1);
    for (size_t i = (size_t)blockIdx.x * blockDim.x + threadIdx.x; i < (size_t)M * DM; i += (size_t)gridDim.x * blockDim.x) out[i] = c;
}
#endif

#ifdef DBG_STAT
__global__ void dbg_stat_kernel(const unsigned char* ws, size_t off, int ld, int ncols, unsigned* res) {
    unsigned mx = 0, cnt = 0;
    for (size_t i = (size_t)blockIdx.x * blockDim.x + threadIdx.x; i < (size_t)M * ncols; i += (size_t)gridDim.x * blockDim.x) {
        const size_t r = i / ncols, c = i % ncols; const float v = fabsf(bf2f(((const bf16*)(ws + off))[r * ld + c]));
        const unsigned b = __float_as_uint(v); mx = b > mx ? b : mx; cnt += (v > DBG_THR || v != v) ? 1u : 0u; }
    atomicMax(res, mx); atomicAdd(res + 1, cnt);
    for (size_t r = (size_t)blockIdx.x * blockDim.x + threadIdx.x; r < (size_t)M; r += (size_t)gridDim.x * blockDim.x) { bool bad = false; unsigned first = 0xffffffffu;
        for (int c = 0; c < ncols; ++c) { const float v = fabsf(bf2f(((const bf16*)(ws + off))[r * ld + c])); if (v > DBG_THR || v != v) { bad = true; if (first == 0xffffffffu) first = c; } }
        if (bad) { atomicAdd(res + 2, 1u); atomicMin(res + 3, (unsigned)r); atomicMin(res + 4, first); } }
}
__global__ void dbg_statout_kernel(const unsigned* res, float* out) {
    const float c = DBG_STAT == 0 ? 100.f * __uint_as_float(res[0]) : DBG_STAT == 1 ? sqrtf((float)res[1]) : DBG_STAT == 2 ? sqrtf((float)res[2]) : DBG_STAT == 3 ? (float)(res[3] / 2048u + 20u) : (float)(res[4] / 256u + 20u);
    for (size_t i = (size_t)blockIdx.x * blockDim.x + threadIdx.x; i < (size_t)M * DM; i += (size_t)gridDim.x * blockDim.x) out[i] = c;
}
#endif

#ifdef DBG_PROF
__global__ void dbg_prof_kernel(const unsigned long long* ts, float* out) {
    float tp[12];
    for (int p = 0; p < 12; ++p) { double s = 0; for (int l = 0; l < DEPTH; ++l) { if (p == 0 && l > 0) continue;
        const unsigned long long e = ts[l * 16 + p]; unsigned long long b;
        if (p == 0) b = ts[15]; else if (p == 1 && l > 0) b = ts[(l - 1) * 16 + 11]; else b = ts[l * 16 + p - 1];
        if (p == 11 && l == DEPTH - 1) continue;
        s += (double)(e - b) * 0.01; } tp[p] = (float)s; }
    const float c = tp[DBG_PA], d = 1000.f * tp[DBG_PB];
    for (size_t i = (size_t)blockIdx.x * blockDim.x + threadIdx.x; i < (size_t)M * DM; i += (size_t)gridDim.x * blockDim.x) out[i] = (i == 0) ? d : c;
}
#endif
extern "C" void kernel_launch(void* const* d_in, const int* in_sizes, int n_in, void* d_out, int out_size, void* d_ws, size_t ws_size, hipStream_t stream) {
    static int grid = 0;
    if (grid == 0) {
        if (n_in != N_INPUTS || out_size != M * DM || ws_size < WS_END) { fprintf(stderr, "kernel_launch: unexpected problem (n_in %d, out %d, ws %zu)\n", n_in, out_size, ws_size); grid = -1; return; }
        int dev = 0, cus = 0, per_cu = 0;
        if (hipGetDevice(&dev) != hipSuccess || hipDeviceGetAttribute(&cus, hipDeviceAttributeMultiprocessorCount, dev) != hipSuccess) { grid = -1; return; }
        if (hipFuncSetAttribute((const void*)fwd_kernel, hipFuncAttributeMaxDynamicSharedMemorySize, LDS_BYTES) != hipSuccess) { fprintf(stderr, "kernel_launch: hipFuncSetAttribute failed\n"); grid = -1; return; }
        if (hipOccupancyMaxActiveBlocksPerMultiprocessor(&per_cu, (const void*)fwd_kernel, 512, LDS_BYTES) != hipSuccess || per_cu < 1)
            fprintf(stderr, "kernel_launch: occupancy query reports %d workgroups per CU\n", per_cu);
        (void)hipGetLastError();
        grid = cus;
    }
    if (grid < 0) return;
    if (hipMemsetAsync((char*)d_ws + WS_CTL, 0, CTL_ZERO_BYTES, stream) != hipSuccess) return;
    Args a{};
    for (int i = 0; i < N_INPUTS; ++i) a.in[i] = (const float*)d_in[i];
    a.out = (float*)d_out; a.ws = (unsigned char*)d_ws;
#if MK_ONE_LAUNCH
    a.ph_lo = 0; a.ph_hi = NPH; a.l_lo = 0; a.l_hi = DEPTH;
    hipLaunchKernelGGL(fwd_kernel, dim3(grid), dim3(512), LDS_BYTES, stream, a);
#ifdef DBG_PROF
    hipLaunchKernelGGL(dbg_prof_kernel, dim3(1024), dim3(256), 0, stream, (const unsigned long long*)((char*)d_ws + WS_CTL) + 50000, (float*)d_out);
#endif
#else
#ifdef DBG_RACE
    {
    unsigned char* ws = (unsigned char*)d_ws; unsigned long long* T = (unsigned long long*)(ws + WS_CTL) + CW_DBG / 2;
    auto sum = [&](size_t off, size_t bytes, int slot) { hipLaunchKernelGGL(dbg_sum_kernel, dim3(1024), dim3(256), 0, stream, (const unsigned*)(ws + off), bytes / 4, T + slot); };
    auto sumout = [&](int slot) { hipLaunchKernelGGL(dbg_sum_kernel, dim3(1024), dim3(256), 0, stream, (const unsigned*)d_out, (size_t)M * DM, T + slot); };
    for (int run = 0; run < 2; ++run) {
        if (run == 1) hipMemsetAsync((char*)d_ws + WS_CTL, 0, CW_DBG * 4, stream);
        hipMemsetAsync((char*)d_ws + 1 * MiB, run == 0 ? 0xAA : 0x55, WS_END - 1 * MiB, stream);
        for (int l = 0; l < DBG_LAYERS; ++l)
            for (int p = (l == 0 ? 0 : 1); p < DBG_NPH; ++p) { a.ph_lo = p; a.ph_hi = p + 1; a.l_lo = l; a.l_hi = l + 1;
                hipLaunchKernelGGL(fwd_kernel, dim3(grid), dim3(512), LDS_BYTES, stream, a);
                const int s = run * 64 + l * 12 + p;
                switch (p) {
                case 0: sum(WS_HB, 64 * MiB, s); sumout(s); sum(WS_W, 115 * MiB, s); sum(WS_S5W, 64 * MiB, s); sum(WS_HF2, 4 * MiB, s); sum(WS_ROPE, 8 * KiB, s); sum(WS_S5A32, 64 * KiB, s); break;
                case 1: sum(WS_RB, 240 * MiB, s); sum(WS_RA, 256 * MiB, s); break;
                case 2: sum(WS_RD + RD_QKVG, 32 * MiB, s); break;
                case 3: sum(WS_RD + RD_YAT, 16 * MiB, run * 64 + 56); sum(WS_RD + RD_HV, 32 * MiB, run * 64 + 57); sum(WS_RD + RD_DILO, 48 * MiB, run * 64 + 58); sum(WS_DLSE, 1536 * KiB, run * 64 + 59); sum(WS_RD + RD_S5Z, 16 * MiB, run * 64 + 60); break;
                case 4: sum(WS_Y, 64 * MiB, s); break;
                case 5: sum(WS_RB + RB_MB, 64 * MiB, s); sum(WS_RB, 128 * MiB, s); break;
                case 6: sum(WS_RB, 128 * MiB, s); break;
                case 7: sumout(s); sum(WS_HB, 64 * MiB, s); sum(WS_AFF, 2 * MiB, s); break;
                case 8: sum(WS_RA, 128 * MiB, s); sum(WS_IDX, 512 * KiB, s); sum(WS_INV, 1 * MiB, s); break;
                case 9: sum(WS_RB, 128 * MiB, s); break;
                case 10: sum(WS_RA + RA_EOUT, 128 * MiB, s); break;
                case 11: sumout(s); sum(WS_HB, 64 * MiB, s); break;
                } }
    }
    hipLaunchKernelGGL(dbg_final_kernel, dim3(1024), dim3(256), 0, stream, (const unsigned long long*)T, (float*)d_out);
    }
#elif defined(DBG_STOP)
    for (int l = 0; l <= DBG_STOP_L; ++l)
        for (int p = (l == 0 ? 0 : 1); p < NPH; ++p) { if (l == DBG_STOP_L && p > DBG_STOP) break; a.ph_lo = p; a.ph_hi = p + 1; a.l_lo = l; a.l_hi = l + 1;
            hipLaunchKernelGGL(fwd_kernel, dim3(grid), dim3(512), LDS_BYTES, stream, a);
#ifdef DBG_REPEAT
            if (p == DBG_REPEAT) hipLaunchKernelGGL(fwd_kernel, dim3(grid), dim3(512), LDS_BYTES, stream, a);
#endif
            }
#ifdef DBG_STAT
    { unsigned* res = (unsigned*)((char*)d_ws + WS_CTL) + 100000; hipMemsetAsync(res + 3, 0x7f, 8, stream); hipLaunchKernelGGL(dbg_stat_kernel, dim3(2048), dim3(256), 0, stream, (const unsigned char*)d_ws, (size_t)(DBG_OFF), DBG_LD, DBG_NC, res);
      hipLaunchKernelGGL(dbg_statout_kernel, dim3(2048), dim3(256), 0, stream, (const unsigned*)res, (float*)d_out); }
#elif defined(DBG_OFF)
    hipLaunchKernelGGL(dbg_dump_kernel, dim3(2048), dim3(256), 0, stream, (const unsigned char*)d_ws, (float*)d_out, (size_t)(DBG_OFF), DBG_F32, DBG_LD, DBG_NC);
#endif
#else
    for (int l = 0; l < DEPTH; ++l)
        for (int p = (l == 0 ? 0 : 1); p < NPH; ++p) { a.ph_lo = p; a.ph_hi = p + 1; a.l_lo = l; a.l_hi = l + 1;
            hipLaunchKernelGGL(fwd_kernel, dim3(grid), dim3(512), LDS_BYTES, stream, a); }
#endif
#endif
}
```

```cpp
#include <hip/hip_runtime.h>
#include <hip/hip_bf16.h>
#include <cstdio>
#include <cstdint>
#include <cmath>

#ifndef MK_STATIC_Q
#define MK_STATIC_Q 0
#endif
#ifndef MK_ONE_LAUNCH
#define MK_ONE_LAUNCH 1
#endif

constexpr int BATCH = 8, SEQ = 4096, DM = 1024, DEPTH = 4, M = BATCH * SEQ;
constexpr int NIN = 7936;
constexpr int NE = 16, CAP = 512, FFD = 1024;
constexpr float LN_EPS = 1e-5f, RMS_EPS = 1e-6f;
constexpr float DN_ALPHA = 1.6817928305074292f;
constexpr int PC_DQ = 0, PC_DK = 768, PC_DV = 1536, PC_S5 = 2304, PC_GQ = 2560, PC_GK = 2816, PC_GV = 2944, PROJ2_W = 3072;
enum { I_X = 0, I_LNIN_G, I_LNIN_B, I_WIN, I_HY_CW, I_HY_CB, I_HY_W1, I_HY_B1, I_HY_W2, I_HY_B2, I_HY_W3, I_HY_FREQ, I_HY_BIAS,
       I_S5_LRE, I_S5_LIM, I_S5_LDT, I_S5_BRE, I_S5_BIM, I_S5_CRE, I_S5_CIM, I_S5_D, I_S5_GW, I_S5_GB, I_GQ_QN, I_GQ_KN,
       I_WBR, I_WOUT, I_LN1G, I_LN1B, I_ROUTER, I_EWG, I_EWU, I_EWD, I_LN2G, I_LN2B, N_INPUTS };

constexpr size_t MiB = 1u << 20, KiB = 1u << 10;
constexpr size_t WS_CTL = 0, CTL_ZERO_BYTES = 64 * KiB;
constexpr size_t WS_AFF = 1 * MiB;
constexpr size_t WS_IDX = 3 * MiB;
constexpr size_t WS_GW = 3 * MiB + 256 * KiB;
constexpr size_t WS_INV = 4 * MiB;
constexpr size_t WS_DLSE = 5 * MiB;
constexpr size_t WS_ROPE = 7 * MiB;
constexpr size_t WS_S5A32 = 7 * MiB + 256 * KiB;
constexpr size_t WS_HF2 = 8 * MiB;
constexpr size_t WS_S5W = 12 * MiB;
constexpr size_t S5W_LAYER = 16 * MiB, S5_WST_OFF = 0, S5_WCAT_OFF = 4 * MiB;
constexpr size_t WS_W = 76 * MiB;
constexpr size_t W_WIN = 0;
constexpr size_t W_WB = W_WIN + (size_t)NIN * DM * 2;
constexpr size_t W_WO = W_WB + (size_t)4 * 1024 * 256 * 2;
constexpr size_t W_GLU = W_WO + (size_t)1024 * 1024 * 2;
constexpr size_t W_GU = W_GLU + (size_t)256 * 256 * 2;
constexpr size_t W_DN = W_GU + (size_t)16 * 2048 * 1024 * 2;
constexpr size_t W_END = W_DN + (size_t)16 * 1024 * 1024 * 2;
static_assert(W_END <= 116 * MiB, "weights region");
constexpr size_t WS_HB = 192 * MiB;
constexpr size_t WS_RA = 256 * MiB;
constexpr size_t WS_RB = 512 * MiB;
constexpr size_t RB_HYT = 0, RB_PROJ2 = 48 * MiB, RB_MF32 = 0, RB_PRE = 0, RB_HID = 0, RB_MB = 128 * MiB;
constexpr size_t RA_G = 0, RA_XS = 0, RA_EOUT = 128 * MiB;
constexpr size_t WS_Y = 768 * MiB;
constexpr size_t WS_RD = 832 * MiB;
constexpr size_t RD_YAT = 0;
constexpr size_t RD_DILO = 16 * MiB;
constexpr size_t RD_S5Z = 64 * MiB;
constexpr size_t RD_HV = 80 * MiB;
constexpr size_t RD_QKVG = 112 * MiB;
constexpr size_t WS_TT = 976 * MiB;
constexpr size_t WS_END = 992 * MiB;

constexpr int CW_BAR = 4096;
constexpr int CW_Q = 8192;

constexpr int LDS_SCRATCH = 147456;
constexpr int MISC_OFF = LDS_SCRATCH;
constexpr int LDS_BYTES = LDS_SCRATCH + 1024;

#define GAS __attribute__((address_space(1)))
#define LAS __attribute__((address_space(3)))
typedef unsigned short bf16;
typedef unsigned v4u __attribute__((ext_vector_type(4)));
typedef unsigned v2u __attribute__((ext_vector_type(2)));
typedef float f32x4 __attribute__((ext_vector_type(4)));
typedef float f32x2 __attribute__((ext_vector_type(2)));
typedef float f32x16 __attribute__((ext_vector_type(16)));
typedef short bf16x8 __attribute__((ext_vector_type(8)));
typedef short s16x4 __attribute__((ext_vector_type(4)));
typedef GAS unsigned gu32;
#define RLX_AGENT __ATOMIC_RELAXED, __HIP_MEMORY_SCOPE_AGENT
#define LDS_WAIT() asm volatile("s_waitcnt lgkmcnt(0)" ::: "memory")
#define VM_WAIT() asm volatile("s_waitcnt vmcnt(0)" ::: "memory")

__device__ __forceinline__ unsigned f2bf(float f) { unsigned u = __builtin_bit_cast(unsigned, f); return (u + 0x7fffu + ((u >> 16) & 1u)) >> 16; }
__device__ __forceinline__ unsigned pk2(float lo, float hi) { return f2bf(lo) | (f2bf(hi) << 16); }
__device__ __forceinline__ float bf2f(unsigned short b) { return __builtin_bit_cast(float, (unsigned)b << 16); }
__device__ __forceinline__ float bflo(unsigned w) { return __builtin_bit_cast(float, w << 16); }
__device__ __forceinline__ float bfhi(unsigned w) { return __builtin_bit_cast(float, w & 0xffff0000u); }
__device__ __forceinline__ float sigmoidf_(float x) { return __builtin_amdgcn_rcpf(1.0f + __builtin_amdgcn_exp2f(-1.4426950408889634f * x)); }
__device__ __forceinline__ float wave_sum(float v) {
#pragma unroll
    for (int o = 1; o < 64; o <<= 1) v += __shfl_xor(v, o);
    return v;
}
__device__ __forceinline__ float wave_max(float v) {
#pragma unroll
    for (int o = 1; o < 64; o <<= 1) v = fmaxf(v, __shfl_xor(v, o));
    return v;
}

namespace pg8 {
#define PG8_LAS __attribute__((address_space(3)))
typedef unsigned short bf16_t;
typedef unsigned u32x4 __attribute__((ext_vector_type(4)));
constexpr int BM = 256, BK = 64, HALF = 128, HTB = HALF * BK * 2  , STAGE_BYTES = 8 * HTB, NXCD = 8, WGM = 8;

__host__ __device__ __forceinline__ int lds_byte(int r, int c) { const int st = (r >> 4) * 2 + (c >> 5), rr = r & 15, cc = c & 31, ob = rr * 64 + cc * 2; return st * 1024 + (ob ^ (((ob >> 9) & 1) << 5)); }
__host__ __device__ __forceinline__ void stage_rc(int b, int& R, int& C) { const int st = b / 1024, sb = b % 1024, swz = sb ^ (((sb >> 9) & 1) << 5); R = (st >> 1) * 16 + swz / 64; C = (st & 1) * 32 + (swz % 64) / 2; }
__host__ __device__ __forceinline__ int perm32(int rho) { const int n = rho >> 4, i = rho & 15; return 8 * (i >> 2) + 4 * n + (i & 3); }

struct Unit { const char* A; const char* B; int orow, ocol, z; };
struct Gemm { int K, lda, ldb; };

__device__ __forceinline__ void tile_of(int L, int nM, int nN, int& pm, int& pn) {
    const int nwg = nM * nN; int wgid = L; { const int q = nwg / NXCD, r = nwg % NXCD, xcd = wgid % NXCD, off = wgid / NXCD; wgid = (xcd < r ? xcd * (q + 1) : r * (q + 1) + (xcd - r) * q) + off; }
    const int nig = WGM * nN, gid = wgid / nig, fm = gid * WGM, gsz = (nM - fm) < WGM ? (nM - fm) : WGM;
    pm = fm + ((wgid % nig) % gsz); pn = (wgid % nig) / gsz;
}

typedef __bf16 bf16x2_t __attribute__((ext_vector_type(2)));
__device__ __forceinline__ unsigned cvt_pk_bf16(float lo, float hi) { const f32x2 v = {lo, hi}; const bf16x2_t b = __builtin_convertvector(v, bf16x2_t); return __builtin_bit_cast(unsigned, b); }
template <int ACT  > struct EpiBf16 {
    static constexpr bool PERM = true; static constexpr bool GATHER = false;
    bf16_t* O; int ldc;
    __device__ __forceinline__ void operator()(const f32x4 (&acc)[2][2][4][2], const Unit& u, int wr, int wc, int fr, int fq) const {
        const int row0 = u.orow + wr * 64 + fr, col0 = u.ocol + wc * 32 + 8 * fq;
#pragma unroll
        for (int ai = 0; ai < 2; ++ai)
#pragma unroll
            for (int m = 0; m < 4; ++m) { bf16_t* rowp = O + (size_t)(row0 + ai * HALF + m * 16) * ldc + col0;
#pragma unroll
                for (int bj = 0; bj < 2; ++bj) { f32x4 v0 = acc[ai][bj][m][0], v1 = acc[ai][bj][m][1];
                    if (ACT == 1) {
#pragma unroll
                        for (int j = 0; j < 4; ++j) { v0[j] = sigmoidf_(v0[j]); v1[j] = sigmoidf_(v1[j]); }
#ifdef DBG_HALF
                        for (int j = 0; j < 4; ++j) { v0[j] = 0.5f; v1[j] = 0.5f; }
#endif
                    }
                    u32x4 w; w.x = cvt_pk_bf16(v0[0], v0[1]); w.y = cvt_pk_bf16(v0[2], v0[3]); w.z = cvt_pk_bf16(v1[0], v1[1]); w.w = cvt_pk_bf16(v1[2], v1[3]);
                    *(u32x4*)(rowp + bj * HALF) = w; } }
    }
};
struct EpiMerge {
    static constexpr bool PERM = true; static constexpr bool GATHER = false;
    const bf16_t* G; float* F; bf16_t* MB;
    __device__ __forceinline__ void operator()(const f32x4 (&acc)[2][2][4][2], const Unit& u, int wr, int wc, int fr, int fq) const {
        const int row0 = u.orow + wr * 64 + fr, col0 = u.ocol + wc * 32 + 8 * fq, i = u.z;
#pragma unroll
        for (int ai = 0; ai < 2; ++ai)
#pragma unroll
            for (int m = 0; m < 4; ++m) { const size_t row = (size_t)(row0 + ai * HALF + m * 16);
#pragma unroll
                for (int bj = 0; bj < 2; ++bj) { const int col = col0 + bj * HALF;
                    const u32x4 g = *(const u32x4*)(G + row * 4096 + i * 1024 + col);
                    f32x4 v0 = acc[ai][bj][m][0], v1 = acc[ai][bj][m][1];
                    v0[0] *= bflo(g.x); v0[1] *= bfhi(g.x); v0[2] *= bflo(g.y); v0[3] *= bfhi(g.y);
                    v1[0] *= bflo(g.z); v1[1] *= bfhi(g.z); v1[2] *= bflo(g.w); v1[3] *= bfhi(g.w);
                    float* fp = F + row * 1024 + col;
                    if (i > 0) { f32x4 p0, p1;
                        asm volatile("global_load_dwordx4 %0, %2, off sc0 sc1\n\tglobal_load_dwordx4 %1, %2, off offset:16 sc0 sc1\n\ts_waitcnt vmcnt(0)" : "=&v"(p0), "=&v"(p1) : "v"(fp) : "memory");
                        v0 += p0; v1 += p1; }
                    if (i < 3) { *(f32x4*)fp = v0; *(f32x4*)(fp + 4) = v1; }
                    else { u32x4 w; w.x = cvt_pk_bf16(v0[0], v0[1]); w.y = cvt_pk_bf16(v0[2], v0[3]); w.z = cvt_pk_bf16(v1[0], v1[1]); w.w = cvt_pk_bf16(v1[2], v1[3]);
                        *(u32x4*)(MB + row * 1024 + col) = w; } } }
    }
};
struct EpiPre {
    static constexpr bool PERM = true; static constexpr bool GATHER = false;
    const bf16_t* H; bf16_t* P; float alpha;
    __device__ __forceinline__ void operator()(const f32x4 (&acc)[2][2][4][2], const Unit& u, int wr, int wc, int fr, int fq) const {
        const int row0 = u.orow + wr * 64 + fr, col0 = u.ocol + wc * 32 + 8 * fq;
#pragma unroll
        for (int ai = 0; ai < 2; ++ai)
#pragma unroll
            for (int m = 0; m < 4; ++m) { const size_t off = (size_t)(row0 + ai * HALF + m * 16) * 1024 + col0;
#pragma unroll
                for (int bj = 0; bj < 2; ++bj) { const u32x4 h = *(const u32x4*)(H + off + bj * HALF); const f32x4 a0 = acc[ai][bj][m][0], a1 = acc[ai][bj][m][1];
                    u32x4 w; w.x = cvt_pk_bf16(bflo(h.x) * alpha + a0[0], bfhi(h.x) * alpha + a0[1]); w.y = cvt_pk_bf16(bflo(h.y) * alpha + a0[2], bfhi(h.y) * alpha + a0[3]);
                    w.z = cvt_pk_bf16(bflo(h.z) * alpha + a1[0], bfhi(h.z) * alpha + a1[1]); w.w = cvt_pk_bf16(bflo(h.w) * alpha + a1[2], bfhi(h.w) * alpha + a1[3]);
                    *(u32x4*)(P + off + bj * HALF) = w; } }
    }
};
struct EpiSwiglu {
    static constexpr bool PERM = true; static constexpr bool GATHER = true;
    bf16_t* O;
    const int* idx;
    __device__ __forceinline__ void operator()(const f32x4 (&acc)[2][2][4][2], const Unit& u, int wr, int wc, int fr, int fq) const {
        const int row0 = u.orow + wr * 64 + fr, col0 = u.ocol + wc * 32 + 8 * fq;
#pragma unroll
        for (int ai = 0; ai < 2; ++ai)
#pragma unroll
            for (int m = 0; m < 4; ++m) { f32x4 v[2];
#pragma unroll
                for (int n = 0; n < 2; ++n)
#pragma unroll
                    for (int j = 0; j < 4; ++j) { const float g = acc[ai][0][m][n][j]; v[n][j] = g * sigmoidf_(g) * acc[ai][1][m][n][j]; }
                u32x4 w; w.x = cvt_pk_bf16(v[0][0], v[0][1]); w.y = cvt_pk_bf16(v[0][2], v[0][3]); w.z = cvt_pk_bf16(v[1][0], v[1][1]); w.w = cvt_pk_bf16(v[1][2], v[1][3]);
                *(u32x4*)(O + (size_t)(row0 + ai * HALF + m * 16) * 1024 + col0) = w; }
    }
};
struct EpiRowScale {
    static constexpr bool PERM = true; static constexpr bool GATHER = false;
    bf16_t* O; const float* rs;
    __device__ __forceinline__ void operator()(const f32x4 (&acc)[2][2][4][2], const Unit& u, int wr, int wc, int fr, int fq) const {
        const int row0 = u.orow + wr * 64 + fr, col0 = u.ocol + wc * 32 + 8 * fq;
#pragma unroll
        for (int ai = 0; ai < 2; ++ai)
#pragma unroll
            for (int m = 0; m < 4; ++m) { const int row = row0 + ai * HALF + m * 16; const float s = rs[row];
#pragma unroll
                for (int bj = 0; bj < 2; ++bj) { const f32x4 v0 = acc[ai][bj][m][0] * s, v1 = acc[ai][bj][m][1] * s;
                    u32x4 w; w.x = cvt_pk_bf16(v0[0], v0[1]); w.y = cvt_pk_bf16(v0[2], v0[3]); w.z = cvt_pk_bf16(v1[0], v1[1]); w.w = cvt_pk_bf16(v1[2], v1[3]);
                    *(u32x4*)(O + (size_t)row * 1024 + col0 + bj * HALF) = w; } }
    }
};
struct EpiGlu {
    static constexpr bool PERM = true; static constexpr bool GATHER = false;
    const bf16_t* Z; bf16_t* O; const float* gb;
    __device__ __forceinline__ void operator()(const f32x4 (&acc)[2][2][4][2], const Unit& u, int wr, int wc, int fr, int fq) const {
        const int row0 = u.orow + wr * 64 + fr, col0 = wc * 32 + 8 * fq;
#pragma unroll
        for (int ai = 0; ai < 2; ++ai)
#pragma unroll
            for (int m = 0; m < 4; ++m) { const size_t row = (size_t)(row0 + ai * HALF + m * 16);
#pragma unroll
                for (int bj = 0; bj < 2; ++bj) { const int col = col0 + bj * HALF;
                    const u32x4 z = *(const u32x4*)(Z + row * 256 + col); const f32x4 b0 = *(const f32x4*)(gb + col), b1 = *(const f32x4*)(gb + col + 4);
                    const f32x4 a0 = acc[ai][bj][m][0] + b0, a1 = acc[ai][bj][m][1] + b1; f32x4 v0, v1;
                    v0[0] = bflo(z.x) * sigmoidf_(a0[0]); v0[1] = bfhi(z.x) * sigmoidf_(a0[1]); v0[2] = bflo(z.y) * sigmoidf_(a0[2]); v0[3] = bfhi(z.y) * sigmoidf_(a0[3]);
                    v1[0] = bflo(z.z) * sigmoidf_(a1[0]); v1[1] = bfhi(z.z) * sigmoidf_(a1[1]); v1[2] = bflo(z.w) * sigmoidf_(a1[2]); v1[3] = bfhi(z.w) * sigmoidf_(a1[3]);
                    u32x4 w; w.x = cvt_pk_bf16(v0[0], v0[1]); w.y = cvt_pk_bf16(v0[2], v0[3]); w.z = cvt_pk_bf16(v1[0], v1[1]); w.w = cvt_pk_bf16(v1[2], v1[3]);
                    *(u32x4*)(O + row * 1024 + 512 + col) = w; }
                asm volatile("" ::: "memory"); }
    }
};

#ifndef PG8_SP2
#define PG8_SP2 1
#endif
template <class Epi, class Sched>
__device__ __forceinline__ void gemm_phase(PG8_LAS unsigned char* lds, const Gemm g, const Sched& S, const Epi& E, int tid_in) {
    int tid = tid_in; asm volatile("" : "+v"(tid));
    const int wid = __builtin_amdgcn_readfirstlane(tid >> 6), lane = tid & 63, wr = wid >> 2, wc = wid & 3, fr = lane & 15, fq = lane >> 4;
    int K = g.K; asm volatile("" : "+s"(K)); const int nt = K / BK;
    unsigned voffA[2], voffA1[2], voffB[2];
#pragma unroll
    for (int i = 0; i < 2; ++i) { int R, C; stage_rc(tid * 16 + i * 8192, R, C); const int Rb = Epi::PERM ? ((R & ~31) + perm32(R & 31)) : R;
        voffA[i] = (unsigned)(R * g.lda + C) * 2u; voffA1[i] = voffA[i]; voffB[i] = (unsigned)(Rb * g.ldb + C) * 2u; }
    const size_t kstep = (size_t)(BK * 2);
    const size_t hstepA = Epi::GATHER ? (size_t)0 : (size_t)HALF * g.lda * 2, hstepB = (size_t)HALF * g.ldb * 2;
    PG8_LAS unsigned* gtab = (PG8_LAS unsigned*)(lds + STAGE_BYTES);
#define PG8_GOFF(u) do { _Pragma("unroll") for (int _i = 0; _i < 2; ++_i) { int R_, C_; stage_rc(tid * 16 + _i * 8192, R_, C_); \
        voffA[_i] = gtab[(u) * 256 + R_] + (unsigned)C_ * 2u; voffA1[_i] = gtab[(u) * 256 + 128 + R_] + (unsigned)C_ * 2u; } } while (0)
    const unsigned ldsw = (unsigned)wid * 1024u;
    const int aoff = lds_byte(wr * 64 + fr, fq * 8), boff = lds_byte(wc * 32 + fr, fq * 8);
#define PG8_SA(b, h) (((b) * 2 + (h)) * HTB)
#define PG8_SB(b, h) ((4 + (b) * 2 + (h)) * HTB)
#define PG8_STAGE(bufoff, gbase, voff) do { _Pragma("unroll") for (int _i = 0; _i < 2; ++_i) \
        __builtin_amdgcn_global_load_lds((const unsigned*)((const char*)(gbase) + (voff)[_i]), (PG8_LAS unsigned*)(lds + (bufoff) + ldsw + _i * 8192), 16, 0, 0); } while (0)
#define PG8_LDA(dst, b, h) do { _Pragma("unroll") for (int m = 0; m < 4; ++m) _Pragma("unroll") for (int k = 0; k < 2; ++k) dst[m][k] = *(const PG8_LAS bf16x8*)(lds + PG8_SA(b, h) + aoff + m * 2048 + k * 1024); } while (0)
#define PG8_LDB(dst, b, h) do { _Pragma("unroll") for (int n = 0; n < 2; ++n) _Pragma("unroll") for (int k = 0; k < 2; ++k) dst[n][k] = *(const PG8_LAS bf16x8*)(lds + PG8_SB(b, h) + boff + n * 2048 + k * 1024); } while (0)
#define PG8_MMA(ai, bj, At, Bt) do { __builtin_amdgcn_s_setprio(1); _Pragma("unroll") for (int m = 0; m < 4; ++m) _Pragma("unroll") for (int n = 0; n < 2; ++n) _Pragma("unroll") for (int k = 0; k < 2; ++k) \
        acc[ai][bj][m][n] = __builtin_amdgcn_mfma_f32_16x16x32_bf16(Bt[n][k], At[m][k], acc[ai][bj][m][n], 0, 0, 0); __builtin_amdgcn_s_setprio(0); } while (0)
#define PG8_WAIT_V(n) asm volatile("s_waitcnt vmcnt(" #n ")" ::: "memory")
#define PG8_WAIT_L(n) asm volatile("s_waitcnt lgkmcnt(" #n ")" ::: "memory")
#define PG8_BAR __builtin_amdgcn_s_barrier()
#define PG8_SCHED __builtin_amdgcn_sched_barrier(0)
    Unit cur, nxt; int ui = 0;
    if (!S.next(0, cur)) return;
    if constexpr (Epi::GATHER) {
#pragma unroll
        for (int k = 0; k < 4; ++k) { const int un = (tid >> 8) + 2 * k; Unit tu; if (S.next(un, tu)) gtab[un * 256 + (tid & 255)] = (unsigned)E.idx[tu.orow + (tid & 255)] * (unsigned)(g.lda * 2); }
        __syncthreads();
        PG8_GOFF(0);
    }
    f32x4 acc[2][2][4][2];
#pragma unroll
    for (int a = 0; a < 2; ++a)
#pragma unroll
        for (int b = 0; b < 2; ++b)
#pragma unroll
            for (int m = 0; m < 4; ++m)
#pragma unroll
                for (int n = 0; n < 2; ++n) acc[a][b][m][n] = (f32x4){0.f, 0.f, 0.f, 0.f};
    bf16x8 At[4][2], B0[2][2], B1[2][2];
    const char* cA = cur.A; const char* cB = cur.B;
#if PG8_SP2
    PG8_STAGE(PG8_SB(0, 0), cB, voffB); PG8_STAGE(PG8_SB(0, 1), cB + hstepB, voffB); PG8_STAGE(PG8_SA(0, 0), cA, voffA); PG8_STAGE(PG8_SA(0, 1), cA + hstepA, voffA1);
    if (wr == 1) PG8_BAR;
    PG8_WAIT_V(2); PG8_BAR;
    PG8_STAGE(PG8_SB(1, 0), cB + kstep, voffB); PG8_STAGE(PG8_SA(1, 0), cA + kstep, voffA); PG8_STAGE(PG8_SB(1, 1), cB + hstepB + kstep, voffB);
    PG8_WAIT_V(6); PG8_BAR;
#else
    PG8_STAGE(PG8_SB(0, 0), cB, voffB); PG8_STAGE(PG8_SA(0, 0), cA, voffA); PG8_STAGE(PG8_SB(0, 1), cB + hstepB, voffB); PG8_STAGE(PG8_SA(0, 1), cA + hstepA, voffA1);
    if (wr == 1) PG8_BAR;
    PG8_WAIT_V(4); PG8_BAR;
    PG8_STAGE(PG8_SB(1, 0), cB + kstep, voffB); PG8_STAGE(PG8_SA(1, 0), cA + kstep, voffA); PG8_STAGE(PG8_SB(1, 1), cB + hstepB + kstep, voffB);
    PG8_WAIT_V(6); PG8_BAR;
#endif
    for (;;) {
        const bool has_next = S.next(ui + 1, nxt);
        const char* nA = has_next ? nxt.A : cA; const char* nB = has_next ? nxt.B : cB;
#pragma unroll 1
        for (int t = 0; t < nt; t += 2) {
            const bool last = (t == nt - 2);
            const char* a1 = cA + (size_t)(t + 1) * kstep;
            const char* a2 = last ? nA : cA + (size_t)(t + 2) * kstep; const char* b2 = last ? nB : cB + (size_t)(t + 2) * kstep;
            const char* a3 = a2 + kstep; const char* b3 = b2 + kstep;
#if PG8_SP2
            PG8_LDB(B0, 0, 0); PG8_LDB(B1, 0, 1); PG8_SCHED; PG8_LDA(At, 0, 0); PG8_STAGE(PG8_SA(1, 1), a1 + hstepA, voffA1);
            PG8_WAIT_V(8); PG8_WAIT_L(0); PG8_BAR; PG8_MMA(0, 0, At, B0); PG8_MMA(0, 1, At, B1); PG8_BAR; PG8_SCHED;
            if constexpr (Epi::GATHER) { if (last && has_next) PG8_GOFF(ui + 1); }
            PG8_LDA(At, 0, 1); PG8_STAGE(PG8_SB(0, 0), b2, voffB); PG8_STAGE(PG8_SB(0, 1), b2 + hstepB, voffB); PG8_STAGE(PG8_SA(0, 0), a2, voffA);
            PG8_WAIT_V(8); PG8_WAIT_L(0); PG8_BAR; PG8_MMA(1, 0, At, B0); PG8_MMA(1, 1, At, B1); PG8_BAR; PG8_SCHED;
            PG8_LDB(B0, 1, 0); PG8_LDB(B1, 1, 1); PG8_SCHED; PG8_LDA(At, 1, 0); PG8_STAGE(PG8_SA(0, 1), a2 + hstepA, voffA1);
            PG8_WAIT_V(8); PG8_WAIT_L(0); PG8_BAR; PG8_MMA(0, 0, At, B0); PG8_MMA(0, 1, At, B1); PG8_BAR; PG8_SCHED;
            PG8_LDA(At, 1, 1); PG8_STAGE(PG8_SB(1, 0), b3, voffB); PG8_STAGE(PG8_SB(1, 1), b3 + hstepB, voffB); PG8_STAGE(PG8_SA(1, 0), a3, voffA);
            PG8_WAIT_V(8); PG8_WAIT_L(0); PG8_BAR; PG8_MMA(1, 0, At, B0); PG8_MMA(1, 1, At, B1); PG8_BAR; PG8_SCHED;
#else
            PG8_LDB(B0, 0, 0); PG8_SCHED; PG8_LDA(At, 0, 0); PG8_STAGE(PG8_SA(1, 1), a1 + hstepA, voffA1);
            PG8_WAIT_L(8); PG8_BAR; PG8_WAIT_L(0); PG8_MMA(0, 0, At, B0); PG8_BAR; PG8_SCHED;
            PG8_LDB(B1, 0, 1); PG8_STAGE(PG8_SB(0, 0), b2, voffB);
            PG8_BAR; PG8_WAIT_L(0); PG8_MMA(0, 1, At, B1); PG8_BAR;
            PG8_LDA(At, 0, 1); PG8_STAGE(PG8_SA(0, 0), a2, voffA);
            PG8_BAR; PG8_WAIT_L(0); PG8_MMA(1, 0, At, B0); PG8_BAR; PG8_SCHED;
            PG8_STAGE(PG8_SB(0, 1), b2 + hstepB, voffB);
            PG8_WAIT_V(6); PG8_BAR; PG8_MMA(1, 1, At, B1); PG8_BAR;
            PG8_LDB(B0, 1, 0); PG8_SCHED; PG8_LDA(At, 1, 0); PG8_STAGE(PG8_SA(0, 1), a2 + hstepA, voffA1);
            PG8_WAIT_L(8); PG8_BAR; PG8_WAIT_L(0); PG8_MMA(0, 0, At, B0); PG8_BAR; PG8_SCHED;
            PG8_LDB(B1, 1, 1); PG8_STAGE(PG8_SB(1, 0), b3, voffB);
            PG8_BAR; PG8_WAIT_L(0); PG8_MMA(0, 1, At, B1); PG8_BAR;
            PG8_LDA(At, 1, 1); PG8_STAGE(PG8_SA(1, 0), a3, voffA);
            PG8_BAR; PG8_WAIT_L(0); PG8_MMA(1, 0, At, B0); PG8_BAR; PG8_SCHED;
            PG8_STAGE(PG8_SB(1, 1), b3 + hstepB, voffB);
            PG8_WAIT_V(6); PG8_BAR; PG8_MMA(1, 1, At, B1); PG8_BAR;
#endif
        }
        if (wr == 0) PG8_BAR;
        E(acc, cur, wr, wc, fr, fq);
        if (!has_next) break;
#pragma unroll
        for (int a = 0; a < 2; ++a)
#pragma unroll
            for (int b = 0; b < 2; ++b)
#pragma unroll
                for (int m = 0; m < 4; ++m)
#pragma unroll
                    for (int n = 0; n < 2; ++n) acc[a][b][m][n] = (f32x4){0.f, 0.f, 0.f, 0.f};
        cur = nxt; cA = nA; cB = nB; ++ui;
        if (wr == 1) PG8_BAR;
    }
    PG8_WAIT_V(0);
    PG8_BAR;
#undef PG8_GOFF
#undef PG8_SA
#undef PG8_SB
#undef PG8_STAGE
#undef PG8_LDA
#undef PG8_LDB
#undef PG8_MMA
#undef PG8_WAIT_V
#undef PG8_WAIT_L
#undef PG8_BAR
#undef PG8_SCHED
}

struct MergeUnit { const char* A; const char* B; int orow, ocol, z; };
template <class Sched>
__device__ __forceinline__ void gemm_merge_phase(PG8_LAS unsigned char* lds, const Gemm g, const Sched& S, const bf16_t* G, bf16_t* MB, int tid_in) {
    int tid = tid_in; asm volatile("" : "+v"(tid));
    const int wid = __builtin_amdgcn_readfirstlane(tid >> 6), lane = tid & 63, wr = wid >> 2, wc = wid & 3, fr = lane & 15, fq = lane >> 4;
    int K = g.K; asm volatile("" : "+s"(K)); const int nt = K / BK;
    unsigned voffA[2], voffB[2];
#pragma unroll
    for (int i = 0; i < 2; ++i) { int R, C; stage_rc(tid * 16 + i * 8192, R, C); const int Rb = (R & ~31) + perm32(R & 31);
        voffA[i] = (unsigned)(R * g.lda + C) * 2u; voffB[i] = (unsigned)(Rb * g.ldb + C) * 2u; }
    const size_t kstep = (size_t)(BK * 2);
    const size_t hstepA = (size_t)HALF * g.lda * 2;
    const unsigned ldsw = (unsigned)wid * 1024u;
    const int aoff = lds_byte(wr * 64 + fr, fq * 8), boff = lds_byte(wc * 32 + fr, fq * 8);
#define PG8_SA(b, h) (((b) * 2 + (h)) * HTB)
#define PG8_SB(b, h) ((4 + (b) * 2 + (h)) * HTB)
#define PG8_STAGE(bufoff, gbase, voff) do { _Pragma("unroll") for (int _i = 0; _i < 2; ++_i) \
        __builtin_amdgcn_global_load_lds((const unsigned*)((const char*)(gbase) + (voff)[_i]), (PG8_LAS unsigned*)(lds + (bufoff) + ldsw + _i * 8192), 16, 0, 0); } while (0)
#define PG8_LDA(dst, b, h) do { _Pragma("unroll") for (int m = 0; m < 4; ++m) _Pragma("unroll") for (int k = 0; k < 2; ++k) dst[m][k] = *(const PG8_LAS bf16x8*)(lds + PG8_SA(b, h) + aoff + m * 2048 + k * 1024); } while (0)
#define PG8_LDB(dst, b, h) do { _Pragma("unroll") for (int n = 0; n < 2; ++n) _Pragma("unroll") for (int k = 0; k < 2; ++k) dst[n][k] = *(const PG8_LAS bf16x8*)(lds + PG8_SB(b, h) + boff + n * 2048 + k * 1024); } while (0)
#define PG8_MMA1(ai, At, Bt) do { __builtin_amdgcn_s_setprio(1); _Pragma("unroll") for (int m = 0; m < 4; ++m) _Pragma("unroll") for (int n = 0; n < 2; ++n) _Pragma("unroll") for (int k = 0; k < 2; ++k) \
        acc[ai][m][n] = __builtin_amdgcn_mfma_f32_16x16x32_bf16(Bt[n][k], At[m][k], acc[ai][m][n], 0, 0, 0); __builtin_amdgcn_s_setprio(0); } while (0)
#define PG8_WAIT_V(n) asm volatile("s_waitcnt vmcnt(" #n ")" ::: "memory")
#define PG8_WAIT_L(n) asm volatile("s_waitcnt lgkmcnt(" #n ")" ::: "memory")
#define PG8_BAR __builtin_amdgcn_s_barrier()
#define PG8_SCHED __builtin_amdgcn_sched_barrier(0)
    MergeUnit cur, nxt; int ui = 0;
    if (!S.next(0, cur)) return;
    f32x4 acc[2][4][2], mrg[2][4][2];
#pragma unroll
    for (int a = 0; a < 2; ++a)
#pragma unroll
        for (int m = 0; m < 4; ++m)
#pragma unroll
            for (int n = 0; n < 2; ++n) { acc[a][m][n] = (f32x4){0.f, 0.f, 0.f, 0.f}; mrg[a][m][n] = (f32x4){0.f, 0.f, 0.f, 0.f}; }
    bf16x8 At[4][2], B0[2][2];
    const char* cA = cur.A; const char* cB = cur.B;
    PG8_STAGE(PG8_SB(0, 0), cB, voffB); PG8_STAGE(PG8_SA(0, 0), cA, voffA); PG8_STAGE(PG8_SA(0, 1), cA + hstepA, voffA);
    if (wr == 1) PG8_BAR;
    PG8_WAIT_V(2); PG8_BAR;
    PG8_STAGE(PG8_SB(1, 0), cB + kstep, voffB); PG8_STAGE(PG8_SA(1, 0), cA + kstep, voffA);
    PG8_WAIT_V(4); PG8_BAR;
    for (;;) {
        const bool has_next = S.next(ui + 1, nxt);
        const char* nA = has_next ? nxt.A : cA; const char* nB = has_next ? nxt.B : cB;
#pragma unroll 1
        for (int t = 0; t < nt; t += 2) {
            const bool last = (t == nt - 2);
            const char* a1 = cA + (size_t)(t + 1) * kstep;
            const char* a2 = last ? nA : cA + (size_t)(t + 2) * kstep; const char* b2 = last ? nB : cB + (size_t)(t + 2) * kstep;
            const char* a3 = a2 + kstep; const char* b3 = b2 + kstep;
            PG8_LDB(B0, 0, 0); PG8_SCHED; PG8_LDA(At, 0, 0); PG8_STAGE(PG8_SA(1, 1), a1 + hstepA, voffA);
            PG8_WAIT_V(6); PG8_WAIT_L(0); PG8_BAR; PG8_MMA1(0, At, B0); PG8_BAR; PG8_SCHED;
            PG8_LDA(At, 0, 1); PG8_STAGE(PG8_SB(0, 0), b2, voffB); PG8_STAGE(PG8_SA(0, 0), a2, voffA);
            PG8_WAIT_V(6); PG8_WAIT_L(0); PG8_BAR; PG8_MMA1(1, At, B0); PG8_BAR; PG8_SCHED;
            PG8_LDB(B0, 1, 0); PG8_SCHED; PG8_LDA(At, 1, 0); PG8_STAGE(PG8_SA(0, 1), a2 + hstepA, voffA);
            PG8_WAIT_V(6); PG8_WAIT_L(0); PG8_BAR; PG8_MMA1(0, At, B0); PG8_BAR; PG8_SCHED;
            PG8_LDA(At, 1, 1); PG8_STAGE(PG8_SB(1, 0), b3, voffB); PG8_STAGE(PG8_SA(1, 0), a3, voffA);
            PG8_WAIT_V(6); PG8_WAIT_L(0); PG8_BAR; PG8_MMA1(1, At, B0); PG8_BAR; PG8_SCHED;
        }
        if (wr == 0) PG8_BAR;
        {
            const int row0 = cur.orow + wr * 64 + fr, col0 = cur.ocol + wc * 32 + 8 * fq, z = cur.z;
            u32x4 gq[2][4];
#pragma unroll
            for (int ai = 0; ai < 2; ++ai)
#pragma unroll
                for (int m = 0; m < 4; ++m) gq[ai][m] = *(const u32x4*)(G + (size_t)(row0 + ai * HALF + m * 16) * 4096 + z * 1024 + col0);
#pragma unroll
            for (int ai = 0; ai < 2; ++ai)
#pragma unroll
                for (int m = 0; m < 4; ++m) { const size_t row = (size_t)(row0 + ai * HALF + m * 16);
                    const u32x4 gv = gq[ai][m];
                    f32x4 v0 = acc[ai][m][0], v1 = acc[ai][m][1];
                    v0[0] *= bflo(gv.x); v0[1] *= bfhi(gv.x); v0[2] *= bflo(gv.y); v0[3] *= bfhi(gv.y);
                    v1[0] *= bflo(gv.z); v1[1] *= bfhi(gv.z); v1[2] *= bflo(gv.w); v1[3] *= bfhi(gv.w);
                    if (z == 0) { mrg[ai][m][0] = v0; mrg[ai][m][1] = v1; } else { mrg[ai][m][0] += v0; mrg[ai][m][1] += v1; }
                    acc[ai][m][0] = (f32x4){0.f, 0.f, 0.f, 0.f}; acc[ai][m][1] = (f32x4){0.f, 0.f, 0.f, 0.f};
                    if (z == 3) { const f32x4 o0 = mrg[ai][m][0], o1 = mrg[ai][m][1];
                        u32x4 w; w.x = cvt_pk_bf16(o0[0], o0[1]); w.y = cvt_pk_bf16(o0[2], o0[3]); w.z = cvt_pk_bf16(o1[0], o1[1]); w.w = cvt_pk_bf16(o1[2], o1[3]);
                        *(u32x4*)(MB + row * 1024 + col0) = w; } }
        }
        if (!has_next) break;
        cur = nxt; cA = nA; cB = nB; ++ui;
        if (wr == 1) PG8_BAR;
    }
    PG8_WAIT_V(0);
    PG8_BAR;
#undef PG8_SA
#undef PG8_SB
#undef PG8_STAGE
#undef PG8_LDA
#undef PG8_LDB
#undef PG8_MMA1
#undef PG8_WAIT_V
#undef PG8_WAIT_L
#undef PG8_BAR
#undef PG8_SCHED
}
}
#define XB_TMO      128
#define XB_XCNT(j)  (256  + 64 * (j))
#define XB_XSUB(j)  (1280 + 64 * (j))
#define XB_XGEN(j)  (2304 + 64 * (j))
#define XB_TOP      3328
#define XB_TOPGEN   3392
#define XCD_BAR_WORDS 3456
#define XB_SPIN_CAP (1u << 18)

__device__ __forceinline__ unsigned xb_ld(unsigned* p)              { return __hip_atomic_load(p, __ATOMIC_RELAXED, __HIP_MEMORY_SCOPE_AGENT); }
__device__ __forceinline__ unsigned xb_add(unsigned* p, unsigned v) { return __hip_atomic_fetch_add(p, v, __ATOMIC_RELAXED, __HIP_MEMORY_SCOPE_AGENT); }
__device__ __forceinline__ unsigned xb_xcc_id() { return (unsigned)__builtin_amdgcn_s_getreg((3 << 11) | 20) & 0xFu; }
#define XB_SPIN(cond, bar) do { unsigned _sp = 0; while (cond) { __builtin_amdgcn_s_sleep(1); \
    if ((++_sp & 255u) == 0u) { if (xb_ld(&(bar)[XB_TMO])) break; if (_sp > XB_SPIN_CAP) { atomicAdd(&(bar)[XB_TMO], 1u); break; } } } } while (0)

struct XcdBarrier {
    unsigned* bar; unsigned x;
    volatile LAS unsigned* st;
};

__device__ __forceinline__ XcdBarrier xcd_barrier_post(unsigned* bar, volatile LAS unsigned* st) {
    XcdBarrier b; b.bar = bar; b.x = xb_xcc_id(); b.st = st;
    if (threadIdx.x == 0) (void)xb_add(&bar[XB_XCNT(b.x)], 1u);
    return b;
}
__device__ __forceinline__ void xcd_barrier_complete(unsigned* bar, unsigned x, unsigned& nloc, unsigned& nx) {
    const unsigned G = gridDim.x * gridDim.y * gridDim.z;
    unsigned sum, cnt, mine, sp = 0u;
    for (;;) {
        sum = 0u; cnt = 0u; mine = 0u;
#pragma unroll
        for (unsigned j = 0; j < 16; ++j) { const unsigned c = xb_ld(&bar[XB_XCNT(j)]); sum += c; cnt += (c > 0u) ? 1u : 0u; mine = (j == x) ? c : mine; }
        if (sum == G) break;
        __builtin_amdgcn_s_sleep(1);
        if ((++sp & 255u) == 0u) { if (xb_ld(&bar[XB_TMO])) break; if (sp > XB_SPIN_CAP) { atomicAdd(&bar[XB_TMO], 1u); break; } }
    }
    nloc = mine > 0u ? mine : 1u; nx = cnt > 0u ? cnt : 1u;
}

__device__ __forceinline__ void xcd_barrier(const XcdBarrier& b, int tid_now) {
    asm volatile("s_waitcnt vmcnt(0)" ::: "memory");
    __syncthreads();
    if (tid_now == 0) {
        unsigned* bar = b.bar;
        __builtin_amdgcn_s_waitcnt(0);
        unsigned nloc = b.st[0], nx = b.st[1];
        if (nloc == 0u) { xcd_barrier_complete(bar, b.x, nloc, nx); b.st[0] = nloc; b.st[1] = nx; }
        const unsigned old = xb_add(&bar[XB_XSUB(b.x)], 1u);
        const unsigned gen = old / nloc;
        if (old + 1u == (gen + 1u) * nloc) {
            __builtin_amdgcn_fence(__ATOMIC_RELEASE, "agent");
            asm volatile("s_waitcnt vmcnt(0)" ::: "memory");
            const unsigned og = xb_add(&bar[XB_TOP], 1u);
            const unsigned tg = og / nx;
            if (og + 1u == (tg + 1u) * nx) xb_add(&bar[XB_TOPGEN], 1u);
            else XB_SPIN(xb_ld(&bar[XB_TOPGEN]) == tg, bar);
            __builtin_amdgcn_fence(__ATOMIC_ACQUIRE, "agent");
            xb_add(&bar[XB_XGEN(b.x)], 1u);
            asm volatile("s_waitcnt vmcnt(0)" ::: "memory");
        } else {
            XB_SPIN(xb_ld(&bar[XB_XGEN(b.x)]) == gen, bar);
            __builtin_amdgcn_fence(__ATOMIC_ACQUIRE, "agent");
            asm volatile("s_waitcnt vmcnt(0)" ::: "memory");
        }
    }
    __syncthreads();
}

struct Args { const float* in[N_INPUTS]; float* out; unsigned char* ws; int ph_lo, ph_hi, l_lo, l_hi; };
#ifdef DBG_DLY
#define DSTAMP(F, k) do { if ((F).bid == 0 && (F).tid == 0) ((unsigned long long*)((F).ws + WS_CTL))[52000 + (F).dl * 16 + (k)] = __builtin_amdgcn_s_memrealtime(); } while (0)
#else
#define DSTAMP(F, k) do {} while (0)
#endif
struct Frame {
    LAS unsigned char* lds;
    volatile LAS unsigned* MISC;
    gu32* ctl;
    int tid, lane, wave, G, bid, zoff, dl;
    unsigned char* ws;
    float* out;
};
#define FIN(k) (args.in[k])
#define WSP(T, off) ((T*)(F.ws + (off)))

__device__ __forceinline__ int wq_grab(Frame& F, int qid) {
    __syncthreads();
    if (F.tid == 0) F.MISC[16] = __hip_atomic_fetch_add((unsigned*)(F.ctl + CW_Q + qid * 64), 1u, RLX_AGENT);
    __syncthreads();
    return (int)F.MISC[16];
}
__device__ __forceinline__ float block_sum(Frame& F, float v, LAS float* red  ) {
    v = wave_sum(v);
    __syncthreads();
    if (F.lane == 0) red[F.wave] = v;
    __syncthreads();
    float s = 0.f;
#pragma unroll
    for (int w = 0; w < 8; ++w) s += red[w];
    return s;
}

__device__ __forceinline__ void ln_row(f32x4 (&v)[4], const float* g, const float* b, int lane) {
    float s = 0.f;
#pragma unroll
    for (int j = 0; j < 4; ++j) s += (v[j].x + v[j].y) + (v[j].z + v[j].w);
    const float mean = wave_sum(s) * (1.f / DM); float s2 = 0.f;
#pragma unroll
    for (int j = 0; j < 4; ++j) { v[j] = v[j] - mean; s2 += (v[j].x * v[j].x + v[j].y * v[j].y) + (v[j].z * v[j].z + v[j].w * v[j].w); }
    const float rstd = 1.f / sqrtf(wave_sum(s2) * (1.f / DM) + LN_EPS);
#pragma unroll
    for (int j = 0; j < 4; ++j) { const f32x4 gg = *(const f32x4*)(g + 4 * lane + 256 * j), bb = *(const f32x4*)(b + 4 * lane + 256 * j); v[j] = v[j] * rstd * gg + bb; }
}
__device__ __forceinline__ void store_row_bf16(const f32x4 (&v)[4], bf16* o16, int lane) {
#pragma unroll
    for (int j = 0; j < 4; ++j) { v2u w; w.x = pk2(v[j].x, v[j].y); w.y = pk2(v[j].z, v[j].w); *(v2u*)(o16 + 4 * lane + 256 * j) = w; }
}
__device__ __forceinline__ void load_row_bf16(f32x4 (&v)[4], const bf16* p, int lane, float scale) {
#pragma unroll
    for (int j = 0; j < 4; ++j) { const v2u w = *(const v2u*)(p + 4 * lane + 256 * j); v[j] = (f32x4){bflo(w.x), bfhi(w.x), bflo(w.y), bfhi(w.y)} * scale; }
}
__device__ __forceinline__ void store_row_f32_bf16(const f32x4 (&v)[4], float* o32, bf16* o16, int lane) {
#pragma unroll
    for (int j = 0; j < 4; ++j) { *(f32x4*)(o32 + 4 * lane + 256 * j) = v[j];
        v2u w; w.x = pk2(v[j].x, v[j].y); w.y = pk2(v[j].z, v[j].w); *(v2u*)(o16 + 4 * lane + 256 * j) = w; }
}

struct CvItem { const float* src; bf16* dst; int ldw, ldd; };
constexpr int CV_IN = 16 * 124, CV_BR = 4 * 4 * 16, CV_OUT = 16 * 16, CV_GLU = 4 * 4, CV_EX = 16 * 256, CV_NIT = CV_IN + CV_BR + CV_OUT + CV_GLU + 3 * CV_EX;
__device__ __forceinline__ CvItem cv_decode(Frame& F, const Args& args, int l, int it) {
    unsigned char* wb = F.ws + WS_W; CvItem c; int r = it;
    if (r < CV_IN) { const int kb = r / 124, nb = r % 124; c.src = FIN(I_WIN) + (size_t)l * DM * NIN + (size_t)(64 * kb) * NIN + 64 * nb; c.ldw = NIN;
        c.dst = (bf16*)(wb + W_WIN) + (size_t)(64 * nb) * 1024 + 64 * kb; c.ldd = 1024; return c; } r -= CV_IN;
    if (r < CV_BR) { const int i = r / 64, q = r % 64, kb = q / 16, nb = q % 16; c.src = FIN(I_WBR) + ((size_t)l * 4 + i) * 256 * 1024 + (size_t)(64 * kb) * 1024 + 64 * nb; c.ldw = 1024;
        c.dst = (bf16*)(wb + W_WB) + (size_t)i * 1024 * 256 + (size_t)(64 * nb) * 256 + 64 * kb; c.ldd = 256; return c; } r -= CV_BR;
    if (r < CV_OUT) { const int kb = r / 16, nb = r % 16; c.src = FIN(I_WOUT) + (size_t)l * 1024 * 1024 + (size_t)(64 * kb) * 1024 + 64 * nb; c.ldw = 1024;
        c.dst = (bf16*)(wb + W_WO) + (size_t)(64 * nb) * 1024 + 64 * kb; c.ldd = 1024; return c; } r -= CV_OUT;
    if (r < CV_GLU) { const int kb = r / 4, nb = r % 4; c.src = FIN(I_S5_GW) + (size_t)l * 256 * 256 + (size_t)(64 * kb) * 256 + 64 * nb; c.ldw = 256;
        c.dst = (bf16*)(wb + W_GLU) + (size_t)(64 * nb) * 256 + 64 * kb; c.ldd = 256; return c; } r -= CV_GLU;
    const int which = r / CV_EX, q = r % CV_EX, e = q / 256, q2 = q % 256, kb = q2 / 16, nb = q2 % 16;
    const size_t esz = (size_t)1024 * 1024, so = ((size_t)l * NE + e) * esz + (size_t)(64 * kb) * 1024 + 64 * nb;
    c.ldw = 1024; c.ldd = 1024;
    if (which == 2) { c.src = FIN(I_EWD) + so; c.dst = (bf16*)(wb + W_DN) + (size_t)e * esz + (size_t)(64 * nb) * 1024 + 64 * kb; }
    else {
        c.src = (which == 0 ? FIN(I_EWG) : FIN(I_EWU)) + so; const int f0 = 64 * nb;
        c.dst = (bf16*)(wb + W_GU) + (size_t)e * 2048 * 1024 + (size_t)((f0 >> 7) * 256 + which * 128 + (f0 & 127)) * 1024 + 64 * kb; }
    return c;
}
__device__ __forceinline__ void cv_load(f32x4 (&v)[16], const CvItem& c, int lane) {
    const float* p = c.src + (size_t)(lane >> 4) * c.ldw + 4 * (lane & 15);
#pragma unroll
    for (int i = 0; i < 16; ++i) v[i] = *(const f32x4*)(p + (size_t)(4 * i) * c.ldw);
}
__device__ __forceinline__ void cv_store(const f32x4 (&v)[16], const CvItem& c, LAS float* scr, int lane) {
    LAS float* w = scr + (lane >> 4) * 65 + 4 * (lane & 15);
#pragma unroll
    for (int i = 0; i < 16; ++i) { w[(4 * i) * 65 + 0] = v[i].x; w[(4 * i) * 65 + 1] = v[i].y; w[(4 * i) * 65 + 2] = v[i].z; w[(4 * i) * 65 + 3] = v[i].w; }
    LDS_WAIT(); asm volatile("" ::: "memory");
    const int c8 = lane & 7;
#pragma unroll
    for (int j = 0; j < 8; ++j) { const int n = (lane >> 3) + 8 * j; const LAS float* s = scr + (8 * c8) * 65 + n;
        v4u o; o.x = pg8::cvt_pk_bf16(s[0 * 65], s[1 * 65]); o.y = pg8::cvt_pk_bf16(s[2 * 65], s[3 * 65]); o.z = pg8::cvt_pk_bf16(s[4 * 65], s[5 * 65]); o.w = pg8::cvt_pk_bf16(s[6 * 65], s[7 * 65]);
        *(v4u*)(c.dst + (size_t)n * c.ldd + 8 * c8) = o; }
    LDS_WAIT(); asm volatile("" ::: "memory");
}
__device__ __forceinline__ void convert_layer(Frame& F, const Args& args, int l, int gw, int NGW) {
    LAS float* scr = (LAS float*)(F.lds + F.wave * 16640);
    int it = gw; if (it >= CV_NIT) return;
    CvItem c0 = cv_decode(F, args, l, it); f32x4 a[16]; cv_load(a, c0, F.lane);
    for (;;) {
        const int it1 = it + NGW; const bool more = it1 < CV_NIT; f32x4 b[16];
        const CvItem c1 = cv_decode(F, args, l, more ? it1 : it); cv_load(b, c1, F.lane);
        asm volatile("" ::: "memory");
        cv_store(a, c0, scr, F.lane);
        if (!more) break;
        it = it1; c0 = c1;
#pragma unroll
        for (int i = 0; i < 16; ++i) a[i] = b[i];
    }
}

__device__ __forceinline__ f32x2 cmul(f32x2 a, f32x2 b) { return (f32x2){a.x * b.x - a.y * b.y, a.x * b.y + a.y * b.x}; }

__device__ __forceinline__ void s5_build_item(Frame& F, const Args& args, int l, int g, int q4  ) {
    LAS f32x2* ap = (LAS f32x2*)F.lds;
    LAS f32x2* bb = ap + 2 * 64 * 33;
    LAS f32x2* cm = bb + 2 * 64 * 16;
    LAS float* kern = (LAS float*)(cm + 2 * 16 * 64);
    const int tid = F.tid;
    __syncthreads();
    if (tid < 128) {
        const int dir = tid >> 6, p = tid & 63; const size_t gi = ((size_t)(l * 2 + dir) * 16 + g);
        const float lre = FIN(I_S5_LRE)[gi * 64 + p], lim = FIN(I_S5_LIM)[gi * 64 + p], dt = expf(FIN(I_S5_LDT)[gi]);
        const float x = lre * dt, y = lim * dt;
        for (int tau = 0; tau <= 32; ++tau) { float s, c; sincosf((float)tau * y, &s, &c); const float e = expf((float)tau * x); ap[(dir * 64 + p) * 33 + tau] = (f32x2){e * c, e * s}; }
        if (q4 == 0) { float s, c; sincosf(32.f * y, &s, &c); const float e = expf(32.f * x); WSP(f32x2, WS_S5A32)[gi * 64 + p] = (f32x2){e * c, e * s}; }
        float s1, c1; sincosf(y, &s1, &c1); const float sh = sinf(0.5f * y);
        const f32x2 em1 = (f32x2){expm1f(x) * c1 - 2.f * sh * sh, expf(x) * s1};
        const float inv = 1.f / (lre * lre + lim * lim);
        const f32x2 q = (f32x2){(em1.x * lre + em1.y * lim) * inv, (em1.y * lre - em1.x * lim) * inv};
        for (int ci = 0; ci < 16; ++ci) { const f32x2 bm = (f32x2){FIN(I_S5_BRE)[(gi * 64 + p) * 16 + ci], FIN(I_S5_BIM)[(gi * 64 + p) * 16 + ci]}; bb[(dir * 64 + p) * 16 + ci] = cmul(q, bm); }
    }
    for (int i = tid; i < 2 * 16 * 64; i += 512) { const int dir = i >> 10, co = (i >> 6) & 15, p = i & 63; const size_t gi = ((size_t)(l * 2 + dir) * 16 + g);
        cm[i] = (f32x2){FIN(I_S5_CRE)[(gi * 16 + co) * 64 + p], FIN(I_S5_CIM)[(gi * 16 + co) * 64 + p]}; }
    __syncthreads();
    for (int e4 = tid; e4 < 63 * 64; e4 += 512) {
        const int ti = e4 >> 6, co = 4 * q4 + ((e4 >> 4) & 3), ci = e4 & 15, tau = ti - 31, e = ti * 256 + co * 16 + ci; float acc = 0.f;
        if (tau >= 0) for (int p = 0; p < 64; ++p) { const f32x2 w = cmul(cm[(0 * 16 + co) * 64 + p], ap[(0 * 64 + p) * 33 + tau]); const f32x2 b = bb[(0 * 64 + p) * 16 + ci]; acc += w.x * b.x - w.y * b.y; }
        if (tau <= 0) for (int p = 0; p < 64; ++p) { const f32x2 w = cmul(cm[(1 * 16 + co) * 64 + p], ap[(1 * 64 + p) * 33 - tau]); const f32x2 b = bb[(1 * 64 + p) * 16 + ci]; acc += w.x * b.x - w.y * b.y; }
        if (tau == 0 && co == ci) acc += FIN(I_S5_D)[l * 256 + g * 16 + co];
        kern[e] = acc;
    }
    __syncthreads();
    bf16* wcat = (bf16*)(F.ws + WS_S5W + (size_t)l * S5W_LAYER + S5_WCAT_OFF) + (size_t)g * 512 * 768;
    for (int ch = tid; ch < 128 * 96; ch += 512) {
        const int ml = ch / 96, k8 = ch % 96, t = ml >> 2, co = 4 * q4 + (ml & 3), m = 16 * t + co; float v[8];
        if (k8 < 64) { const int j = k8 >> 1, ci0 = (k8 & 1) * 8;
#pragma unroll
            for (int e = 0; e < 8; ++e) v[e] = kern[(t - j + 31) * 256 + co * 16 + ci0 + e]; }
        else { const int kk = (k8 - 64) * 8, dir = kk >> 7, p0 = (kk & 127) >> 1, tau = dir == 0 ? t + 1 : 32 - t;
#pragma unroll
            for (int pp = 0; pp < 4; ++pp) { const f32x2 w = cmul(cm[(dir * 16 + co) * 64 + p0 + pp], ap[(dir * 64 + p0 + pp) * 33 + tau]); v[2 * pp] = w.x; v[2 * pp + 1] = -w.y; } }
        v4u o; o.x = pk2(v[0], v[1]); o.y = pk2(v[2], v[3]); o.z = pk2(v[4], v[5]); o.w = pk2(v[6], v[7]);
        *(v4u*)(wcat + (size_t)m * 768 + k8 * 8) = o;
    }
    bf16* wst = (bf16*)(F.ws + WS_S5W + (size_t)l * S5W_LAYER + S5_WST_OFF) + (size_t)g * 2 * 128 * 512;
    if (q4 == 0) for (int ch = tid; ch < 2 * 128 * 64; ch += 512) {
        const int dir = ch >> 13, o = (ch >> 6) & 127, k8 = ch & 63, p = o >> 1, ri = o & 1, j = k8 >> 1, ci0 = (k8 & 1) * 8; float v[8];
        const f32x2 a = ap[(dir * 64 + p) * 33 + (dir == 0 ? 31 - j : j)];
#pragma unroll
        for (int e = 0; e < 8; ++e) { const f32x2 w = cmul(a, bb[(dir * 64 + p) * 16 + ci0 + e]); v[e] = ri ? w.y : w.x; }
        v4u q; q.x = pk2(v[0], v[1]); q.y = pk2(v[2], v[3]); q.z = pk2(v[4], v[5]); q.w = pk2(v[6], v[7]);
        *(v4u*)(wst + ((size_t)dir * 128 + o) * 512 + k8 * 8) = q;
    }
    __syncthreads();
}

__device__ __forceinline__ void hf2_item(Frame& F, const Args& args, int l, int t) {
    const int lane = F.lane;
    const float tn = (float)t * (1.f / 4095.f), w = 6.283185307179586f * (float)t * (1.f / 4096.f);
    float zv = 0.f;
    if (lane == 0) zv = tn;
    else if (lane <= 16) { const float f = 1e-4f + (float)(lane - 1) * ((15.f - 1e-4f) / 15.f); zv = cosf(f * w); }
    else if (lane <= 32) { const float f = 1e-4f + (float)(lane - 17) * ((15.f - 1e-4f) / 15.f); zv = -sinf(f * w); }
    float acc = FIN(I_HY_B1)[l * 64 + lane];
    const float* w1 = FIN(I_HY_W1) + (size_t)l * 33 * 64;
    for (int i = 0; i < 33; ++i) acc += __shfl(zv, i) * w1[i * 64 + lane];
    const float f1 = sinf(FIN(I_HY_FREQ)[(l * 2 + 0) * 64 + lane] * acc);
    float acc2 = FIN(I_HY_B2)[l * 64 + lane];
    const float* w2 = FIN(I_HY_W2) + (size_t)l * 64 * 64;
    for (int i = 0; i < 64; ++i) acc2 += __shfl(f1, i) * w2[i * 64 + lane];
    WSP(float, WS_HF2)[((size_t)l * 4096 + t) * 64 + lane] = sinf(FIN(I_HY_FREQ)[(l * 2 + 1) * 64 + lane] * acc2);
}

__device__ __forceinline__ void prologue_phase(Frame& F, const Args& args) {
    const int gw = F.bid * 8 + F.wave, NGW = F.G * 8;
    for (int it = F.bid; it < DEPTH * 16 * 4; it += F.G) s5_build_item(F, args, it >> 6, (it >> 2) & 15, it & 3);
    __syncthreads();
    { const int gi = F.bid * 512 + F.tid; if (gi < 1024) { const int pos = gi >> 4, i = gi & 15; const float inv = expf(-(float)(2 * i) * (1.f / 32.f) * 9.210340371976184f);
        float s, c; sincosf((float)pos * inv, &s, &c); WSP(f32x2, WS_ROPE)[gi] = (f32x2){c, s}; } }
    for (int it = gw; it < DEPTH * 4096; it += NGW) hf2_item(F, args, it >> 12, it & 4095);
    {   f32x4 nx[2][4];
#pragma unroll
        for (int r = 0; r < 2; ++r) { const int m = gw + r * NGW < M ? gw + r * NGW : gw;
#pragma unroll
            for (int j = 0; j < 4; ++j) nx[r][j] = *(const f32x4*)(FIN(I_X) + (size_t)m * DM + 4 * F.lane + 256 * j); }
        for (int m0 = gw; m0 < M; m0 += 2 * NGW) { f32x4 v[2][4];
#pragma unroll
            for (int r = 0; r < 2; ++r)
#pragma unroll
                for (int j = 0; j < 4; ++j) v[r][j] = nx[r][j];
#pragma unroll
            for (int r = 0; r < 2; ++r) { const int m2 = m0 + (2 + r) * NGW < M ? m0 + (2 + r) * NGW : m0;
#pragma unroll
                for (int j = 0; j < 4; ++j) nx[r][j] = *(const f32x4*)(FIN(I_X) + (size_t)m2 * DM + 4 * F.lane + 256 * j); }
#pragma unroll
            for (int r = 0; r < 2; ++r) { const int m = m0 + r * NGW; if (m >= M) break;
                ln_row(v[r], FIN(I_LNIN_G), FIN(I_LNIN_B), F.lane);
                store_row_bf16(v[r], WSP(bf16, WS_HB) + (size_t)m * DM, F.lane); } } }
    convert_layer(F, args, 0, gw, NGW);
}
namespace attn_body {
using bf16=__hip_bfloat16;
using bf16x8=__attribute__((ext_vector_type(8)))short;
using s16x4=__attribute__((ext_vector_type(4)))short;
using f32x16=__attribute__((ext_vector_type(16)))float;
using u32x4=__attribute__((ext_vector_type(4)))unsigned;
constexpr int SEQ=4096,D=64,QP=512,KP=512,VP=512,OP=1024;
constexpr int NW=8,QBLK=32,QB=QBLK*NW,KVBLK=64,NQB=SEQ/QB;
constexpr int ATTN_UNIT_ROWS=QB;
__device__ __forceinline__ int crow(int r,int hi){return (r&3)+8*(r>>2)+4*hi;}
#define SBAR() __builtin_amdgcn_sched_barrier(0)
__device__ __forceinline__ void cmask(f32x16&p0,f32x16&p1,int jb,int qrel,int hi){
  const float NEG=-INFINITY; int kb=64*jb+4*hi;
  #pragma unroll
  for(int r=0;r<16;++r){int kv=kb+(r&3)+8*(r>>2); if(kv>qrel)p0[r]=NEG; if(kv+32>qrel)p1[r]=NEG;}
}

constexpr int NSLOT=3, SLOTB=8192;
constexpr int LDS_K=0, LDS_V=NSLOT*SLOTB, LDS_WS=2*NSLOT*SLOTB, LDS_OST=LDS_WS+NW*64*4, LDS_BYTES=LDS_OST+NW*4096;
constexpr float C2=0.125f*1.4426950408889634f;
__device__ __forceinline__ void glds16(const void*gsrc,unsigned lds_dst){unsigned keep;
  asm volatile("s_mov_b32 %0, m0\n\ts_mov_b32 m0, %2\n\ts_nop 0\n\tglobal_load_lds_dwordx4 %1, off\n\ts_mov_b32 m0, %0":"=&s"(keep):"v"(gsrc),"s"(lds_dst):"memory");}
__device__ __forceinline__ float max3f(float a,float b,float c){float r;asm("v_max3_f32 %0, %1, %2, %3":"=v"(r):"v"(a),"v"(b),"v"(c));return r;}
__device__ __forceinline__ float max2f(float a,float b){float r;asm("v_max_f32_e32 %0, %1, %2":"=v"(r):"v"(a),"v"(b));return r;}
__device__ __forceinline__ float fadd_s(float a,float b){float r;asm("v_add_f32_e32 %0, %1, %2":"=v"(r):"v"(a),"v"(b));return r;}
__device__ __forceinline__ float fsub_s(float a,float b){float r;asm("v_sub_f32_e32 %0, %1, %2":"=v"(r):"v"(a),"v"(b));return r;}
typedef float f32x2_t __attribute__((ext_vector_type(2))); typedef __bf16 bf16x2_t __attribute__((ext_vector_type(2)));
__device__ __forceinline__ unsigned cvtpk_s(float lo,float hi){f32x2_t v={lo,hi};bf16x2_t b=__builtin_convertvector(v,bf16x2_t);return __builtin_bit_cast(unsigned,b);}
#define WAIT_BAR(N) asm volatile("s_waitcnt vmcnt(" #N ") lgkmcnt(0)\n\ts_barrier":::"memory")

__device__ __forceinline__ void qkt(f32x16&p0,f32x16&p1,const char*Kslot,const bf16x8*qr,const f32x16&negm,int r32,int hi){
  const char*kb=Kslot+hi*1024+r32*16;
  #pragma unroll
  for(int d0=0;d0<4;++d0){
    const bf16x8 b0=*reinterpret_cast<const bf16x8*>(kb+d0*2048);
    const bf16x8 b1=*reinterpret_cast<const bf16x8*>(kb+d0*2048+512);
    if(d0==0){p0=__builtin_amdgcn_mfma_f32_32x32x16_bf16(b0,qr[0],negm,0,0,0);p1=__builtin_amdgcn_mfma_f32_32x32x16_bf16(b1,qr[0],negm,0,0,0);}
    else{p0=__builtin_amdgcn_mfma_f32_32x32x16_bf16(b0,qr[d0],p0,0,0,0);p1=__builtin_amdgcn_mfma_f32_32x32x16_bf16(b1,qr[d0],p1,0,0,0);}}
}
typedef __attribute__((address_space(3))) const char* lds_cptr;
typedef short v4i16_t __attribute__((ext_vector_type(4)));
__device__ __forceinline__ void kload8(bf16x8*kf,lds_cptr kp){
  kf[0]=*(const __attribute__((address_space(3))) bf16x8*)(kp);      kf[1]=*(const __attribute__((address_space(3))) bf16x8*)(kp+512);
  kf[2]=*(const __attribute__((address_space(3))) bf16x8*)(kp+2048); kf[3]=*(const __attribute__((address_space(3))) bf16x8*)(kp+2560);
  kf[4]=*(const __attribute__((address_space(3))) bf16x8*)(kp+4096); kf[5]=*(const __attribute__((address_space(3))) bf16x8*)(kp+4608);
  kf[6]=*(const __attribute__((address_space(3))) bf16x8*)(kp+6144); kf[7]=*(const __attribute__((address_space(3))) bf16x8*)(kp+6656);
}
__device__ __forceinline__ void kload2(bf16x8*kf,lds_cptr kp,int j){ kf[2*j]=*(const __attribute__((address_space(3))) bf16x8*)(kp+j*2048); kf[2*j+1]=*(const __attribute__((address_space(3))) bf16x8*)(kp+j*2048+512); }
__device__ __forceinline__ s16x4 vtr(lds_cptr p){ return __builtin_bit_cast(s16x4,__builtin_amdgcn_ds_read_tr16_b64_v4i16((__attribute__((address_space(3))) v4i16_t*)p)); }
__device__ __forceinline__ float rowmax(const f32x16&p0,const f32x16&p1){
  float a=max3f(p0[0],p0[1],p1[0]),b=max3f(p0[2],p0[3],p1[1]);a=max3f(a,p1[2],p1[3]);
  #pragma unroll
  for(int r=4;r<16;r+=4){a=max3f(a,p0[r],p0[r+1]);b=max3f(b,p0[r+2],p0[r+3]);a=max3f(a,p1[r],p1[r+1]);b=max3f(b,p1[r+2],p1[r+3]);}
  const float m=max2f(a,b);
  auto rr=__builtin_amdgcn_permlane32_swap(__float_as_uint(m),__float_as_uint(m),false,false);
  return max2f(__uint_as_float(rr[0]),__uint_as_float(rr[1]));
}
__device__ __forceinline__ void pv(f32x16*o,int vb,bf16x8 pa0,bf16x8 pa1,bf16x8 pa2,bf16x8 pa3){
  #pragma unroll
  for(int d0=0;d0<2;++d0){s16x4 lo[4],hi[4];
    #pragma unroll
    for(int ks=0;ks<4;++ks){
      asm volatile("ds_read_b64_tr_b16 %0,%1 offset:%c2":"=&v"(lo[ks]):"v"(vb),"i"(d0*4096+ks*1024):"memory");
      asm volatile("ds_read_b64_tr_b16 %0,%1 offset:%c2":"=&v"(hi[ks]):"v"(vb),"i"(d0*4096+ks*1024+512):"memory");}
    asm volatile("s_waitcnt lgkmcnt(0)":::"memory");SBAR();
    #define PK(k) (bf16x8){lo[k][0],lo[k][1],lo[k][2],lo[k][3],hi[k][0],hi[k][1],hi[k][2],hi[k][3]}
    o[d0]=__builtin_amdgcn_mfma_f32_32x32x16_bf16(pa0,PK(0),o[d0],0,0,0);
    o[d0]=__builtin_amdgcn_mfma_f32_32x32x16_bf16(pa1,PK(1),o[d0],0,0,0);
    o[d0]=__builtin_amdgcn_mfma_f32_32x32x16_bf16(pa2,PK(2),o[d0],0,0,0);
    o[d0]=__builtin_amdgcn_mfma_f32_32x32x16_bf16(pa3,PK(3),o[d0],0,0,0);
    #undef PK
  }
}

#ifndef ATTN_STORE16
#define ATTN_STORE16(p,v) (*(u32x4*)(p)=(v))
#endif
template<int THRL> __device__ __forceinline__ void attn_unit(int b,int h,int qb,const bf16*Q,const bf16*__restrict__ K,const bf16*__restrict__ V,bf16*O,char*shm,int tid_in){
  int tid=tid_in; asm volatile("":"+v"(tid)); const int lane=tid&63,r32=lane&31,hi=lane>>5; const int wid=__builtin_amdgcn_readfirstlane(tid>>6);
  const long rowbase=(long)b*SEQ; const int q0=qb*QB;
  const bf16*Qw=Q+(rowbase+q0+wid*QBLK)*QP+h*D;
  const bf16*Kh=K+rowbase*KP+(h>>1)*D,*Vh=V+rowbase*VP+(h>>1)*D;
  const unsigned lds0=(unsigned)(uintptr_t)shm;
  float*wsf=(float*)(shm+LDS_WS)+wid*64;
  const bf16*ksrc=Kh+(long)lane*KP+wid*8;
  const bf16*vsrc=Vh+(long)(16*(wid&3)+(lane>>2))*VP+(wid>>2)*32+(lane&3)*8;
  const unsigned kdst=lds0+LDS_K+wid*1024, vdst=lds0+LDS_V+wid*1024;
  #define DMA_K(t,slot) glds16(ksrc+(long)(t)*KVBLK*KP,(unsigned)__builtin_amdgcn_readfirstlane(kdst+(slot)))
  #define DMA_V(t,slot) glds16(vsrc+(long)(t)*KVBLK*VP,(unsigned)__builtin_amdgcn_readfirstlane(vdst+(slot)))
  const int vb0=(int)(lds0+LDS_V)+((lane>>4)&1)*32+(lane&3)*8+(4*hi+((lane&15)>>2))*64;
  const char*Kbase=shm+LDS_K; bf16x8 kf[8];
  const lds_cptr shm3=(lds_cptr)shm; const lds_cptr kp0=shm3+LDS_K+hi*1024+r32*16; const lds_cptr vp0=shm3+LDS_V+((lane>>4)&1)*32+(lane&3)*8+(4*hi+((lane&15)>>2))*64;
  const int NT=SEQ/KVBLK;
  DMA_K(0,0);DMA_V(0,0);DMA_K(1,SLOTB);
  bf16x8 qr[4];
  #pragma unroll
  for(int d0=0;d0<4;++d0)qr[d0]=*reinterpret_cast<const bf16x8*>(&Qw[(long)r32*QP+d0*16+hi*8]);
  float mhat=0.f,l_reg=0.f;f32x16 o[2];o[0]=f32x16{};o[1]=f32x16{};f32x16 negm=f32x16{};asm volatile("":"+v"(negm));
  #define CMASK(P0,P1,t) do{}while(0)
  bool resc=false;
  #define START(P0,P1) do{ const float rm=rowmax(P0,P1); resc=false; \
    { const float dl=rm; mhat=fadd_s(mhat,dl); \
      _Pragma("unroll") for(int r=0;r<16;++r){P0[r]=fsub_s(P0[r],dl);P1[r]=fsub_s(P1[r],dl);} \
      _Pragma("unroll") for(int r=0;r<16;++r)negm[r]=-mhat; asm volatile("":"+v"(negm)); } \
    _Pragma("unroll") for(int r=0;r<16;++r)P0[r]=__builtin_amdgcn_exp2f(P0[r]); }while(0)
  #define RESC() do{ if(resc){ asm volatile("s_waitcnt lgkmcnt(0)":::"memory"); \
      _Pragma("unroll") for(int d_=0;d_<2;++d_) _Pragma("unroll") for(int r=0;r<16;++r)o[d_][r]*=wsf[crow(r,hi)]; } }while(0)
  f32x16 pA0,pA1,pB0,pB1;
  int sl_prev=0,sl_cur=0,sl_next=SLOTB;
  #define ROT() do{sl_prev=sl_cur;sl_cur=sl_next;sl_next=(sl_next==(NSLOT-1)*SLOTB)?0:sl_next+SLOTB;}while(0)
  DMA_K(2,2*SLOTB);
  WAIT_BAR(3);
  qkt(pA0,pA1,Kbase,qr,negm,r32,hi);asm volatile("s_nop 15\n\ts_nop 7":"+v"(pA0),"+v"(pA1));CMASK(pA0,pA1,0);
  START(pA0,pA1);
  _Pragma("unroll") for(int r=0;r<16;++r)pA1[r]=__builtin_amdgcn_exp2f(pA1[r]);
  WAIT_BAR(0);
  DMA_K(3,0);DMA_V(1,SLOTB);
  ROT();
  kload8(kf,kp0+sl_cur);
  WAIT_BAR(2);
  s16x4 vlo[8],vhi[8]; u32x4 pw0,pw1,pw2,pw3;
  #define PKW(P,B) cvtpk_s(P[B],P[B+1])
  #define PAF(k) __builtin_bit_cast(bf16x8,pw##k)
  #define VFR(i) (bf16x8){vlo[i][0],vlo[i][1],vlo[i][2],vlo[i][3],vhi[i][0],vhi[i][1],vhi[i][2],vhi[i][3]}
  #define PIN(x) asm volatile("":"+v"(x))
  #define MX3(a,b,c) __builtin_fmaxf(__builtin_fmaxf((a),(b)),(c))
  #define GAPA(MF,A0,A1,A2,A3,W0,W1,PW) do{ MF; sacc+=A0; sacc+=A1; sacc+=A2; sacc+=A3; PIN(sacc); W0; W1; PIN(PW); SBAR(); }while(0)
  #define EX(v) __builtin_amdgcn_exp2f(v)
  #define GAPB(MF,X,B) do{ MF; X[B]=EX(X[B]); X[B+1]=EX(X[B+1]); X[B+2]=EX(X[B+2]); X[B+3]=EX(X[B+3]); PIN(X); SBAR(); }while(0)
  #define VRD(i) do{ vlo[i]=vtr(vp_+(((i)>>2)*4096+((i)&3)*1024)); vhi[i]=vtr(vp_+(((i)>>2)*4096+((i)&3)*1024+512)); }while(0)
  #define KRD(G,j) do{ if(G){ kload2(kf,kp0+sl_next,j); SBAR(); } }while(0)
  #define STEP(C0,C1,P0,P1,t,GK,GV,GL) do{ SBAR(); \
    const lds_cptr vp_=vp0+sl_prev; \
    VRD(0); SBAR(); float sacc=(P0[0]+P0[1]); \
    GAPA(C0=__builtin_amdgcn_mfma_f32_32x32x16_bf16(kf[0],qr[0],negm,0,0,0), P0[2],P0[3],P0[4],P0[5],     pw0[0]=PKW(P0,0), pw0[1]=PKW(P0,2), pw0); \
    VRD(4); SBAR(); GAPA(C1=__builtin_amdgcn_mfma_f32_32x32x16_bf16(kf[1],qr[0],negm,0,0,0), P0[6],P0[7],P0[8],P0[9],     pw0[2]=PKW(P0,4), pw0[3]=PKW(P0,6), pw0); \
    VRD(1); SBAR(); GAPA(C0=__builtin_amdgcn_mfma_f32_32x32x16_bf16(kf[2],qr[1],C0,0,0,0),   P0[10],P0[11],P0[12],P0[13], pw1[0]=PKW(P0,8), pw1[1]=PKW(P0,10), pw1); \
    VRD(5); SBAR(); GAPA(C1=__builtin_amdgcn_mfma_f32_32x32x16_bf16(kf[3],qr[1],C1,0,0,0),   P0[14],P0[15],P1[0],P1[1],   pw1[2]=PKW(P0,12),pw1[3]=PKW(P0,14), pw1); \
    VRD(2); SBAR(); GAPA(C0=__builtin_amdgcn_mfma_f32_32x32x16_bf16(kf[4],qr[2],C0,0,0,0),   P1[2],P1[3],P1[4],P1[5],     pw2[0]=PKW(P1,0), pw2[1]=PKW(P1,2), pw2); \
    VRD(6); SBAR(); GAPA(C1=__builtin_amdgcn_mfma_f32_32x32x16_bf16(kf[5],qr[2],C1,0,0,0),   P1[6],P1[7],P1[8],P1[9],     pw2[2]=PKW(P1,4), pw2[3]=PKW(P1,6), pw2); \
    VRD(3); SBAR(); GAPA(C0=__builtin_amdgcn_mfma_f32_32x32x16_bf16(kf[6],qr[3],C0,0,0,0),   P1[10],P1[11],P1[12],P1[13], pw3[0]=PKW(P1,8), pw3[1]=PKW(P1,10), pw3); \
    VRD(7); SBAR(); GAPA(C1=__builtin_amdgcn_mfma_f32_32x32x16_bf16(kf[7],qr[3],C1,0,0,0),   P1[14],P1[15],0.f,0.f,       pw3[2]=PKW(P1,12),pw3[3]=PKW(P1,14), pw3); \
    l_reg+=sacc; \
    if(GK){DMA_K((t)+3,sl_cur);} if(GV){DMA_V((t)+1,sl_next);} \
    CMASK(C0,C1,t); \
    { float a=MX3(C0[0],C0[1],C1[0]),b=MX3(C0[2],C0[3],C1[1]); a=MX3(a,C1[2],C1[3]); \
      _Pragma("unroll") for(int r=4;r<16;r+=4){a=MX3(a,C0[r],C0[r+1]);b=MX3(b,C0[r+2],C0[r+3]);a=MX3(a,C1[r],C1[r+1]);b=MX3(b,C1[r+2],C1[r+3]);} \
      float rm=__builtin_fmaxf(a,b); { auto rr=__builtin_amdgcn_permlane32_swap(__float_as_uint(rm),__float_as_uint(rm),false,false); rm=__builtin_fmaxf(__uint_as_float(rr[0]),__uint_as_float(rr[1])); } \
      resc=false; \
      if(__builtin_expect(__any(rm>(float)THRL),0)){ const float dl=__builtin_fmaxf(rm,0.f); mhat+=dl; \
        _Pragma("unroll") for(int r=0;r<16;++r){C0[r]-=dl;C1[r]-=dl;} \
        _Pragma("unroll") for(int r=0;r<16;++r)negm[r]=-mhat; asm volatile("":"+v"(negm)); \
        const float f=__builtin_amdgcn_exp2f(-dl); l_reg*=f; if(hi==0)wsf[r32]=f; resc=true; } } \
    SBAR(); \
    GAPB(o[0]=__builtin_amdgcn_mfma_f32_32x32x16_bf16(PAF(0),VFR(0),o[0],0,0,0), C0,0); \
    GAPB(o[1]=__builtin_amdgcn_mfma_f32_32x32x16_bf16(PAF(0),VFR(4),o[1],0,0,0), C0,4); \
    KRD(GL,0); GAPB(o[0]=__builtin_amdgcn_mfma_f32_32x32x16_bf16(PAF(1),VFR(1),o[0],0,0,0), C0,8); \
    KRD(GL,1); GAPB(o[1]=__builtin_amdgcn_mfma_f32_32x32x16_bf16(PAF(1),VFR(5),o[1],0,0,0), C0,12); \
    KRD(GL,2); GAPB(o[0]=__builtin_amdgcn_mfma_f32_32x32x16_bf16(PAF(2),VFR(2),o[0],0,0,0), C1,0); \
    KRD(GL,3); GAPB(o[1]=__builtin_amdgcn_mfma_f32_32x32x16_bf16(PAF(2),VFR(6),o[1],0,0,0), C1,4); \
    GAPB(o[0]=__builtin_amdgcn_mfma_f32_32x32x16_bf16(PAF(3),VFR(3),o[0],0,0,0), C1,8); \
    GAPB(o[1]=__builtin_amdgcn_mfma_f32_32x32x16_bf16(PAF(3),VFR(7),o[1],0,0,0), C1,12); \
    }while(0)
  int t=1;
  #undef CMASK
  #define CMASK(P0,P1,t) do{}while(0)
  for(;t+5<NT;t+=2){
    STEP(pB0,pB1,pA0,pA1,t,true,true,true);     WAIT_BAR(2); RESC(); ROT();
    STEP(pA0,pA1,pB0,pB1,t+1,true,true,true);   WAIT_BAR(2); RESC(); ROT();
  }
  #undef CMASK
  #define CMASK(P0,P1,t) do{}while(0)
  #define ENDW(tt) do{ if((tt)+3<NT){WAIT_BAR(2);} else if((tt)+2<NT){WAIT_BAR(1);} else {WAIT_BAR(0);} }while(0)
  for(;t+1<NT;t+=2){
    STEP(pB0,pB1,pA0,pA1,t,(t+3<NT),(t+1<NT),(t+1<NT));       ENDW(t);   RESC(); ROT();
    STEP(pA0,pA1,pB0,pB1,t+1,(t+4<NT),(t+2<NT),(t+2<NT));     ENDW(t+1); RESC(); ROT();
  }
  STEP(pB0,pB1,pA0,pA1,NT-1,false,false,false); RESC();
  { float sacc=pB0[0]+pB0[1]; _Pragma("unroll") for(int r=2;r<16;++r)sacc+=pB0[r]; _Pragma("unroll") for(int r=0;r<16;++r)sacc+=pB1[r]; l_reg+=sacc;
    pw0=(u32x4){PKW(pB0,0),PKW(pB0,2),PKW(pB0,4),PKW(pB0,6)};pw1=(u32x4){PKW(pB0,8),PKW(pB0,10),PKW(pB0,12),PKW(pB0,14)};pw2=(u32x4){PKW(pB1,0),PKW(pB1,2),PKW(pB1,4),PKW(pB1,6)};pw3=(u32x4){PKW(pB1,8),PKW(pB1,10),PKW(pB1,12),PKW(pB1,14)};
    SBAR(); pv(o,vb0+sl_cur,PAF(0),PAF(1),PAF(2),PAF(3)); }
  #undef PKW
  #undef PAF
  #undef VFR
  #undef PIN
  #undef MX3
  #undef GAPA
  #undef GAPB
  #undef EX
  #undef VRD
  #undef KRD
  #undef STEP
  #undef ENDW
  {auto rr=__builtin_amdgcn_permlane32_swap(__float_as_uint(l_reg),__float_as_uint(l_reg),false,false);l_reg=__uint_as_float(rr[0])+__uint_as_float(rr[1]);}
  if(hi==0)wsf[32+r32]=l_reg;asm volatile("s_waitcnt lgkmcnt(0)":::"memory");
  float rli[16];
  #pragma unroll
  for(int r=0;r<16;++r)rli[r]=__builtin_amdgcn_rcpf(wsf[32+crow(r,hi)]);
  bf16*Ow=O+(rowbase+q0+wid*QBLK)*OP+h*D;
  { bf16*stg=(bf16*)(shm+LDS_OST)+wid*2048;
    #pragma unroll
    for(int r=0;r<16;++r){const int orow=crow(r,hi);
      #pragma unroll
      for(int d0=0;d0<2;++d0)stg[orow*64+d0*32+r32]=__float2bfloat16(o[d0][r]*rli[r]);}
    asm volatile("s_waitcnt lgkmcnt(0)":::"memory");
    #pragma unroll
    for(int i=0;i<4;++i){const int row=i*8+(lane>>3),ch=lane&7; const u32x4 v=*(const u32x4*)(stg+row*64+ch*8); ATTN_STORE16(Ow+(long)row*OP+ch*8,v);} }
  asm volatile("s_waitcnt lgkmcnt(0)\n\ts_barrier":::"memory");
  #undef DMA_K
  #undef DMA_V
  #undef CMASK
  #undef START
  #undef RESC
  #undef ROT
}
constexpr int ATTN_LDS_BYTES=LDS_BYTES;
#undef SBAR
#undef WAIT_BAR
}

constexpr int FBUF = 8720;
__device__ __forceinline__ int fpad(int i) { return i + (i >> 5) + 18 * (i >> 9); }
constexpr float kTwC[16] = {1.000000000e+00f, 9.807852804e-01f, 9.238795325e-01f, 8.314696123e-01f, 7.071067812e-01f, 5.555702330e-01f, 3.826834324e-01f, 1.950903220e-01f,
                            0.0f, -1.950903220e-01f, -3.826834324e-01f, -5.555702330e-01f, -7.071067812e-01f, -8.314696123e-01f, -9.238795325e-01f, -9.807852804e-01f};
constexpr float kTwS[16] = {0.000000000e+00f, 1.950903220e-01f, 3.826834324e-01f, 5.555702330e-01f, 7.071067812e-01f, 8.314696123e-01f, 9.238795325e-01f, 9.807852804e-01f,
                            1.000000000e+00f, 9.807852804e-01f, 9.238795325e-01f, 8.314696123e-01f, 7.071067812e-01f, 5.555702330e-01f, 3.826834324e-01f, 1.950903220e-01f};
template <int N> __device__ __forceinline__ void dft_dif(f32x2 (&v)[N]) {
#pragma unroll
    for (int len = N; len >= 2; len >>= 1) {
        const int half = len / 2;
#pragma unroll
        for (int base = 0; base < N; base += len)
#pragma unroll
            for (int j = 0; j < half; ++j) {
                const f32x2 a = v[base + j], b = v[base + j + half];
                v[base + j] = a + b;
                const f32x2 d = a - b;
                const int ti = j * (32 / len);
                v[base + j + half] = (ti == 0) ? d : (f32x2){d.x * kTwC[ti] + d.y * kTwS[ti], d.y * kTwC[ti] - d.x * kTwS[ti]};
            }
    }
}
__host__ __device__ constexpr int brev(int i, int bits) { int r = 0; for (int b = 0; b < bits; ++b) r |= ((i >> b) & 1) << (bits - 1 - b); return r; }

#define FFT_BAR() asm volatile("s_waitcnt lgkmcnt(0)\n\ts_barrier" ::: "memory")
__device__ __forceinline__ void fft8192(LAS f32x2* buf, int tid_in) {
    int tid = tid_in; asm volatile("" : "+v"(tid));
    {
        const int n2 = tid; f32x2 v[16];
        LAS f32x2* p = buf + n2 + (n2 >> 5);
#pragma unroll
        for (int n1 = 0; n1 < 16; ++n1) v[n1] = p[546 * n1];
        dft_dif<16>(v);
        const float rv1 = (float)n2 * (1.f / 8192.f); const float c = __builtin_amdgcn_cosf(rv1), s = -__builtin_amdgcn_sinf(rv1);
        f32x2 pw[16]; pw[0] = (f32x2){1.f, 0.f}; pw[1] = (f32x2){c, s};
#pragma unroll
        for (int k = 2; k < 16; ++k) pw[k] = cmul(pw[k - 1], pw[1]);
#pragma unroll
        for (int i = 0; i < 16; ++i) { const int k1 = brev(i, 4); p[546 * k1] = cmul(v[i], pw[k1]); }
    }
    FFT_BAR();
    {
        const int k1 = tid >> 5, b = tid & 31; f32x2 v[16];
        LAS f32x2* p = buf + 546 * k1 + b;
#pragma unroll
        for (int a = 0; a < 16; ++a) v[a] = p[33 * a];
        dft_dif<16>(v);
        const float rv2 = (float)b * (1.f / 512.f); const float c = __builtin_amdgcn_cosf(rv2), s = -__builtin_amdgcn_sinf(rv2);
        f32x2 pw[16]; pw[0] = (f32x2){1.f, 0.f}; pw[1] = (f32x2){c, s};
#pragma unroll
        for (int k = 2; k < 16; ++k) pw[k] = cmul(pw[k - 1], pw[1]);
#pragma unroll
        for (int i = 0; i < 16; ++i) { const int ka = brev(i, 4); p[33 * ka] = cmul(v[i], pw[ka]); }
    }
    FFT_BAR();
    {
        const int ka = (tid >> 4) & 15, k1 = tid & 15; f32x2 v[32];
        if (tid < 256) {
            const LAS f32x2* p = buf + 546 * k1 + 33 * ka;
#pragma unroll
            for (int b = 0; b < 32; ++b) v[b] = p[b];
            dft_dif<32>(v);
        }
        FFT_BAR();
        if (tid < 256) {
            LAS f32x2* q = buf + k1 + 16 * ka + (ka >> 1);
#pragma unroll
            for (int i = 0; i < 32; ++i) { const int kb = brev(i, 5); q[264 * kb + 18 * (kb >> 1)] = v[i]; }
        }
    }
    FFT_BAR();
}

__device__ __forceinline__ float hy_sconv(const bf16* xrow, unsigned t, float w0, float w1, float w2, float bias) {
    const unsigned tm = t > 0u ? t - 1u : 0u, tp = t < (unsigned)(SEQ - 1) ? t + 1u : (unsigned)(SEQ - 1);
    const float xm = t > 0u ? bf2f(xrow[tm]) : 0.f, x0 = bf2f(xrow[t]), xp = t < (unsigned)(SEQ - 1) ? bf2f(xrow[tp]) : 0.f;
    return xm * w0 + x0 * w1 + xp * w2 + bias;
}

__device__ __forceinline__ void hy_sconv_row(Frame& F, const Args& args, int l, int row  , size_t dummy_off = 0) {
    const int lane = F.lane, ch = row >> 3;
    bf16* x = WSP(bf16, WS_RB + RB_HYT) + (size_t)ch * M + (size_t)(row & 7) * SEQ;
    const float* cw = FIN(I_HY_CW) + (size_t)l * 3 * 768; const float w0 = cw[ch], w1 = cw[768 + ch], w2 = cw[1536 + ch], bias = FIN(I_HY_CB)[(size_t)l * 768 + ch];
    v4u raw[8];
#pragma unroll
    for (int k = 0; k < 8; ++k) raw[k] = *(const v4u*)(x + 8 * lane + 512 * k);
    float first[8], lastv[8];
#pragma unroll
    for (int k = 0; k < 8; ++k) { first[k] = bflo(raw[k].x); lastv[k] = bfhi(raw[k].w); }
#pragma unroll
    for (int k = 0; k < 8; ++k) {
        float v[10];
        v[1] = bflo(raw[k].x); v[2] = bfhi(raw[k].x); v[3] = bflo(raw[k].y); v[4] = bfhi(raw[k].y); v[5] = bflo(raw[k].z); v[6] = bfhi(raw[k].z); v[7] = bflo(raw[k].w); v[8] = bfhi(raw[k].w);
        const float lft = __shfl_up(lastv[k], 1), lft0 = k > 0 ? __shfl(lastv[k > 0 ? k - 1 : 0], 63) : 0.f;
        const float rgt = __shfl_down(first[k], 1), rgt63 = k < 7 ? __shfl(first[k < 7 ? k + 1 : 7], 0) : 0.f;
        v[0] = lane == 0 ? lft0 : lft; v[9] = lane == 63 ? rgt63 : rgt;
        float o[8];
#pragma unroll
        for (int e = 0; e < 8; ++e) o[e] = v[e] * w0 + v[e + 1] * w1 + v[e + 2] * w2 + bias;
        v4u w; w.x = pk2(o[0], o[1]); w.y = pk2(o[2], o[3]); w.z = pk2(o[4], o[5]); w.w = pk2(o[6], o[7]);
        *(v4u*)((bf16*)((char*)x + dummy_off) + 8 * lane + 512 * k) = w;
    }
}
__device__ __forceinline__ void hy_taps_block(Frame& F, const Args& args, int l, int tb) {
    LAS float* F2 = (LAS float*)F.lds;
    const int tid = F.tid, t0 = tb * 16;
    const float* f2 = WSP(float, WS_HF2) + ((size_t)l * 4096 + t0) * 64;
    __syncthreads();
    for (int i = tid; i < 16 * 64; i += 512) F2[i] = f2[i];
    __syncthreads();
    const float* w3 = FIN(I_HY_W3) + (size_t)l * 64 * 1024;
    float acc0[16], acc1[16];
#pragma unroll
    for (int j = 0; j < 16; ++j) { acc0[j] = 0.f; acc1[j] = 0.f; }
#pragma unroll 16
    for (int i = 0; i < 64; ++i) { const float wa = w3[i * 1024 + tid], wb = w3[i * 1024 + 512 + tid];
#pragma unroll
        for (int j = 0; j < 16; ++j) { const float x = F2[j * 64 + i]; acc0[j] += x * wa; acc1[j] += x * wb; } }
    const int c = tid & 255;
    const float delta = fabsf(-3.0701134573253945f + (float)c * ((-15.350567286626973f + 3.0701134573253945f) / 255.f));
    float* tt = WSP(float, WS_TT);
#pragma unroll
    for (int j = 0; j < 16; j += 4) { f32x4 o0, o1;
#pragma unroll
        for (int q = 0; q < 4; ++q) { const float dec = expf(-(float)(t0 + j + q) * (1.f / 4095.f) * delta); o0[q] = acc0[j + q] * dec; o1[q] = acc1[j + q] * dec; }
        *(f32x4*)(tt + (size_t)tid * SEQ + t0 + j) = o0; *(f32x4*)(tt + (size_t)(512 + tid) * SEQ + t0 + j) = o1; }
}

__device__ __forceinline__ void hyena_item(Frame& F, const Args& args, int l, int c) {
    LAS f32x2* A = (LAS f32x2*)F.lds;
    LAS f32x2* B = A + FBUF;
    LAS float* W3L = (LAS float*)(B + FBUF);
    LAS float* red = W3L + 256;
    const bf16* hyT = WSP(bf16, WS_RB + RB_HYT);
    float* HV = WSP(float, WS_RD + RD_HV) + (size_t)c * 8 * SEQ;
    bf16* yaT = WSP(bf16, WS_RD + RD_YAT) + (size_t)c * M;
    const float* f2 = WSP(float, WS_HF2) + (size_t)l * 4096 * 64;
    __syncthreads();
    __syncthreads();
#pragma unroll 1
    for (int n = 0; n < 2; ++n) {
        int tid = F.tid; asm volatile("" : "+v"(tid));
        float ss = 0.f;
        {   const float* tf = WSP(float, WS_TT) + ((size_t)(0 * 2 + n) * 256 + c) * SEQ; const float* tbk = WSP(float, WS_TT) + ((size_t)(1 * 2 + n) * 256 + c) * SEQ;
#pragma unroll
            for (int j = 0; j < 8; ++j) { const int t = tid + 512 * j; const float fw = tf[t], bw = tbk[t];
                A[tid + (tid >> 5) + 546 * j] = (f32x2){fw, 0.f}; ss += fw * fw;
                if (t >= 1) { A[fpad(8192 - t)] = (f32x2){bw, 0.f}; ss += bw * bw; } } }
        if (tid == 0) A[fpad(4096)] = (f32x2){0.f, 0.f};
        ss = block_sum(F, ss, red);
        const float scale = (1.f / sqrtf(ss)) * (1.f / 8192.f);
        const float biasN = FIN(I_HY_BIAS)[((size_t)l * 2 + n) * 256 + c] * (1.f / 8192.f);
        fft8192(A, tid);
#pragma unroll
        for (int j = 0; j < 16; ++j) { LAS f32x2* p = A + tid + (tid >> 5) + 546 * j; f32x2 a = *p * scale; a.x += biasN; *p = a; }
#pragma unroll 1
        for (int pb = 0; pb < 4; ++pb) {
            int tq = tid; asm volatile("" : "+v"(tq));
            const bf16* zr0 = hyT + (size_t)c * M + (size_t)(2 * pb) * SEQ; const bf16* zr1 = zr0 + SEQ;
            const bf16* gr0 = hyT + (size_t)((n + 1) * 256 + c) * M + (size_t)(2 * pb) * SEQ; const bf16* gr1 = gr0 + SEQ;
            float* hv0 = HV + (size_t)(2 * pb) * SEQ; float* hv1 = hv0 + SEQ;
            __syncthreads();
#pragma unroll
            for (int j = 0; j < 8; ++j) { const unsigned t = (unsigned)tq + 512u * j; float z0, z1;
                if (n == 0) { z0 = bf2f(zr0[t]); z1 = bf2f(zr1[t]); }
                else { z0 = hv0[t]; z1 = hv1[t]; }
                B[tq + (tq >> 5) + 546 * j] = (f32x2){z0, z1}; B[tq + (tq >> 5) + 546 * (j + 8)] = (f32x2){0.f, 0.f}; }
            float g0[8], g1[8];
#pragma unroll
            for (int j = 0; j < 8; ++j) { const unsigned t = (unsigned)tq + 512u * j; g0[j] = bf2f(gr0[t]); g1[j] = bf2f(gr1[t]); }
            FFT_BAR();
            fft8192(B, tq);
#pragma unroll
            for (int j = 0; j < 16; ++j) { const int p = tq + (tq >> 5) + 546 * j; const f32x2 y = cmul(B[p], A[p]); B[p] = (f32x2){y.x, -y.y}; }
            FFT_BAR();
            fft8192(B, tq);
#pragma unroll
            for (int j = 0; j < 8; ++j) { const unsigned t = (unsigned)tq + 512u * j; const f32x2 y = B[tq + (tq >> 5) + 546 * j];
                const float o0 = g0[j] * y.x, o1 = g1[j] * -y.y;
                if (n == 0) { hv0[t] = o0; hv1[t] = o1; }
                else { yaT[(size_t)(2 * pb) * SEQ + t] = (bf16)f2bf(o0); yaT[(size_t)(2 * pb + 1) * SEQ + t] = (bf16)f2bf(o1); } }
        }
        __syncthreads();
    }
}

__device__ __forceinline__ f32x16 mfma32(bf16x8 a, bf16x8 b, f32x16 c) { return __builtin_amdgcn_mfma_f32_32x32x16_bf16(a, b, c, 0, 0, 0); }
__device__ __forceinline__ int crow(int r, int hi) { return (r & 3) + 8 * (r >> 2) + 4 * hi; }
__device__ __forceinline__ float gelu_tanh(float x) {
    const float u = 0.7978845608028654f * (x + 0.044715f * x * x * x);
    const float e = __builtin_amdgcn_exp2f(2.885390081777927f * u);
    const float th = 1.f - 2.f * __builtin_amdgcn_rcpf(e + 1.f);
    return 0.5f * x * (1.f + th);
}
__device__ __forceinline__ void s5_item(Frame& F, const Args& args, int l, int b, int g) {
    constexpr int SP = 129, XP = 136;
    LAS float* S = (LAS float*)F.lds;
    LAS bf16* XB = (LAS bf16*)(F.lds + 128 * SP * 4);
    const int tid = F.tid, lane = F.lane, w = F.wave, r32 = lane & 31, hi = lane >> 5;
    const bf16* U = WSP(bf16, WS_RB + RB_PROJ2) + (size_t)b * SEQ * PROJ2_W + PC_S5 + g * 16;
    const bf16* wst = WSP(bf16, WS_S5W + (size_t)l * S5W_LAYER + S5_WST_OFF) + (size_t)g * 2 * 128 * 512;
    const bf16* wcat = WSP(bf16, WS_S5W + (size_t)l * S5W_LAYER + S5_WCAT_OFF) + (size_t)g * 512 * 768;
    bf16* Z = WSP(bf16, WS_RD + RD_S5Z) + (size_t)b * SEQ * 256 + g * 16;
    __syncthreads();
    for (int dir = 0; dir < 2; ++dir) {
        {
            const int rt = w >> 1, ct0 = 2 * (w & 1);
            f32x16 acc[2]; acc[0] = f32x16{}; acc[1] = f32x16{};
            const bf16* ap = wst + ((size_t)dir * 128 + rt * 32 + r32) * 512 + 8 * hi;
            const bf16* bp0 = U + (size_t)(32 * (ct0 * 32 + r32)) * PROJ2_W + 8 * hi;
            const bf16* bp1 = bp0 + (size_t)(32 * 32) * PROJ2_W;
#pragma unroll 4
            for (int ks = 0; ks < 32; ++ks) {
                const bf16x8 a = *(const bf16x8*)(ap + 16 * ks);
                const bf16x8 b0 = *(const bf16x8*)(bp0 + (size_t)ks * PROJ2_W), b1 = *(const bf16x8*)(bp1 + (size_t)ks * PROJ2_W);
                acc[0] = mfma32(a, b0, acc[0]); acc[1] = mfma32(a, b1, acc[1]);
            }
#pragma unroll
            for (int q = 0; q < 2; ++q)
#pragma unroll
                for (int r = 0; r < 16; ++r) S[((ct0 + q) * 32 + r32) * SP + rt * 32 + crow(r, hi)] = acc[q][r];
        }
        __syncthreads();
        if (tid < 64) {
            const f32x2 a32 = WSP(f32x2, WS_S5A32)[((size_t)(l * 2 + dir) * 16 + g) * 64 + tid];
            f32x2 X = (f32x2){0.f, 0.f};
#pragma unroll 8
            for (int cc = 0; cc < 128; ++cc) { const int c = dir == 0 ? cc : 127 - cc;
                const f32x2 s = (f32x2){S[c * SP + 2 * tid], S[c * SP + 2 * tid + 1]};
                X = cmul(a32, X) + s;
                *(LAS unsigned*)(XB + ((size_t)dir * 128 + c) * XP + 2 * tid) = pk2(X.x, X.y); }
        }
        __syncthreads();
    }
    {
        f32x16 acc[2][4];
#pragma unroll
        for (int i = 0; i < 2; ++i)
#pragma unroll
            for (int j = 0; j < 4; ++j) acc[i][j] = f32x16{};
        const bf16* ap = wcat + (size_t)(2 * w * 32 + r32) * 768 + 8 * hi;
        const bf16* bp = U + (size_t)(32 * r32) * PROJ2_W + 8 * hi;
#pragma unroll 2
        for (int ks = 0; ks < 32; ++ks) {
            const bf16x8 a0 = *(const bf16x8*)(ap + 16 * ks), a1 = *(const bf16x8*)(ap + 32 * 768 + 16 * ks);
#pragma unroll
            for (int ct = 0; ct < 4; ++ct) { const bf16x8 bv = *(const bf16x8*)(bp + (size_t)(32 * 32 * ct + ks) * PROJ2_W);
                acc[0][ct] = mfma32(a0, bv, acc[0][ct]); acc[1][ct] = mfma32(a1, bv, acc[1][ct]); }
        }
#pragma unroll 2
        for (int ks = 0; ks < 16; ++ks) {
            const int dir = ks >> 3, kk = ks & 7;
            const bf16x8 a0 = *(const bf16x8*)(ap + 512 + 16 * ks), a1 = *(const bf16x8*)(ap + 32 * 768 + 512 + 16 * ks);
#pragma unroll
            for (int ct = 0; ct < 4; ++ct) { const int c = ct * 32 + r32, cs = dir == 0 ? c - 1 : c + 1;
                bf16x8 bv = (bf16x8){0, 0, 0, 0, 0, 0, 0, 0};
                if (cs >= 0 && cs < 128) bv = *(const LAS bf16x8*)(XB + ((size_t)dir * 128 + cs) * XP + 16 * kk + 8 * hi);
                acc[0][ct] = mfma32(a0, bv, acc[0][ct]); acc[1][ct] = mfma32(a1, bv, acc[1][ct]); }
        }
#pragma unroll
        for (int i = 0; i < 2; ++i)
#pragma unroll
            for (int ct = 0; ct < 4; ++ct)
#pragma unroll
                for (int q = 0; q < 4; ++q) {
                    const int tl = (2 * w + i) * 2 + (q >> 1), co = 8 * (q & 1) + 4 * hi, c = ct * 32 + r32;
                    v2u o; o.x = pk2(gelu_tanh(acc[i][ct][4 * q]), gelu_tanh(acc[i][ct][4 * q + 1])); o.y = pk2(gelu_tanh(acc[i][ct][4 * q + 2]), gelu_tanh(acc[i][ct][4 * q + 3]));
                    *(v2u*)(Z + (size_t)(32 * c + tl) * 256 + co) = o; }
    }
    __syncthreads();
}

__device__ __forceinline__ void dil_item(Frame& F, const Args& args, int it) {
    constexpr int RS = 144;
    LAS unsigned char* Ks = F.lds; LAS unsigned char* Vs = F.lds + 384 * RS;
    int lane = F.lane; asm volatile("" : "+v"(lane));
    const int r32 = lane & 31, hi = lane >> 5, w = F.wave;
    const int u0 = it * 8, g = u0 >> 12, b = (u0 >> 9) & 7, hh = (u0 >> 7) & 3, tile0 = u0 & 127;
    const int dsh = 2 * g, Lp = SEQ >> dsh, tpr = Lp >> 5, rho = tile0 / tpr, q0 = (tile0 % tpr) * 32, h = g * 4 + hh;
    const float slope2 = exp2f(-8.f * (float)(h + 1) * (1.f / 12.f)) * (float)(1 << dsh) * 1.4426950408889634f;
    const char* P2 = (const char*)(WSP(bf16, WS_RB + RB_PROJ2) + (size_t)b * SEQ * PROJ2_W);
#define DIL_ROWB(tp) ((unsigned)(rho + ((tp) << dsh)) * (unsigned)(PROJ2_W * 2))
    __syncthreads();
    {   int tq = F.tid; asm volatile("" : "+v"(tq));
#pragma unroll
        for (int k = 0; k < 6; ++k) { const int id = tq + 512 * k, row = id >> 3, ch = id & 7;
            int tj = q0 - 64 + row; tj = tj < 0 ? 0 : (tj > Lp - 1 ? Lp - 1 : tj);
            const unsigned ro = DIL_ROWB(tj) + (unsigned)(h * 64 + ch * 8) * 2u;
            const v4u kv = *(const v4u*)(P2 + ro + PC_DK * 2), vv = *(const v4u*)(P2 + ro + PC_DV * 2);
            *(LAS v4u*)(Ks + row * RS + ch * 16) = kv; *(LAS v4u*)(Vs + row * RS + ch * 16) = vv; } }
    const int tau0 = q0 + 32 * w;
    bf16x8 qf[4];
    { const unsigned qo = DIL_ROWB(tau0 + r32) + (unsigned)(PC_DQ + h * 64 + 8 * hi) * 2u;
#pragma unroll
      for (int ks = 0; ks < 4; ++ks) qf[ks] = *(const bf16x8*)(P2 + qo + 32 * ks); }
    __syncthreads();
    f32x16 S[5];
#pragma unroll
    for (int kt = 0; kt < 5; ++kt) {
        const LAS unsigned char* kp = Ks + (32 * w + 32 * kt + r32) * RS + 16 * hi;
        f32x16 a = f32x16{};
#pragma unroll
        for (int ks = 0; ks < 4; ++ks) a = mfma32(*(const LAS bf16x8*)(kp + 32 * ks), qf[ks], a);
        S[kt] = a;
    }
    float mx = -1e30f;
    const float cr32 = (float)r32;
    if (tau0 >= 64 && tau0 + 96 <= Lp) {
#pragma unroll
        for (int kt = 0; kt < 5; ++kt)
#pragma unroll
            for (int r = 0; r < 16; ++r) { const float dlf = (float)(-64 + 32 * kt + crow(r, 0)) + (float)(4 * hi) - cr32;
                float sc = S[kt][r] * (0.125f * 1.4426950408889634f) - slope2 * fabsf(dlf);
                if (kt == 0) sc = dlf >= -64.f ? sc : -1e30f;
                if (kt == 4) sc = dlf <= 64.f ? sc : -1e30f;
                S[kt][r] = sc; mx = fmaxf(mx, sc); }
    } else {
#pragma unroll
        for (int kt = 0; kt < 5; ++kt)
#pragma unroll
            for (int r = 0; r < 16; ++r) { const int dl = -64 + 32 * kt + crow(r, hi) - r32, tj = tau0 + r32 + dl;
                const bool ok = dl >= -64 && dl <= 64 && tj >= 0 && tj < Lp;
                const float sc = S[kt][r] * (0.125f * 1.4426950408889634f) - slope2 * (float)(dl < 0 ? -dl : dl);
                S[kt][r] = ok ? sc : -1e30f; mx = fmaxf(mx, S[kt][r]); }
    }
    mx = fmaxf(mx, __shfl_xor(mx, 32));
    float lsum = 0.f;
#pragma unroll
    for (int kt = 0; kt < 5; ++kt)
#pragma unroll
        for (int r = 0; r < 16; ++r) { const float p = __builtin_amdgcn_exp2f(S[kt][r] - mx); S[kt][r] = p; lsum += p; }
    lsum += __shfl_xor(lsum, 32);
    f32x16 O[2]; O[0] = f32x16{}; O[1] = f32x16{};
    const LAS unsigned short* vb = (const LAS unsigned short*)(Vs + (32 * w + 4 * hi) * RS) + r32;
#pragma unroll
    for (int kt = 0; kt < 5; ++kt)
#pragma unroll
        for (int s = 0; s < 2; ++s) {
            bf16x8 pa; bf16x8 v0, v1;
#pragma unroll
            for (int j = 0; j < 8; j += 2) { const unsigned pw = pk2(S[kt][8 * s + j], S[kt][8 * s + j + 1]); pa[j] = (short)(pw & 0xffff); pa[j + 1] = (short)(pw >> 16); }
#pragma unroll
            for (int j = 0; j < 8; ++j) { const LAS unsigned short* vp = vb + (32 * kt + 16 * s + 8 * (j >> 2) + (j & 3)) * (RS / 2); v0[j] = (short)vp[0]; v1[j] = (short)vp[32]; }
            O[0] = mfma32(pa, v0, O[0]); O[1] = mfma32(pa, v1, O[1]);
        }
    const float linv = 1.f / lsum;
    bf16* Og = WSP(bf16, WS_RD + RD_DILO) + (size_t)g * M * 256 + (size_t)b * SEQ * 256 + hh * 64 + r32;
#pragma unroll
    for (int r = 0; r < 16; ++r) { const int i = crow(r, hi); const float li = __shfl(linv, i);
        const unsigned ro = (unsigned)(rho + ((tau0 + i) << dsh)) * 256u;
        Og[ro] = (bf16)f2bf(O[0][r] * li); Og[ro + 32] = (bf16)f2bf(O[1][r] * li); }
    if (hi == 0) WSP(float, WS_DLSE)[((size_t)g * M + (size_t)b * SEQ + rho + ((tau0 + r32) << dsh)) * 4 + hh] = (mx + log2f(lsum)) * 0.6931471805599453f;
#undef DIL_ROWB
}

__device__ __forceinline__ void gqa_prep_rows(Frame& F, const Args& args, int l, int mA, int mB) {
    const int lane = F.lane, grp = lane >> 4, li = lane & 15;
    const bf16* P2 = WSP(bf16, WS_RB + RB_PROJ2); bf16* QK = WSP(bf16, WS_RD + RD_QKVG);
    const f32x4 qn = *(const f32x4*)(FIN(I_GQ_QN) + l * 64 + 4 * li), kn = *(const f32x4*)(FIN(I_GQ_KN) + l * 64 + 4 * li);
    v2u raw[2][3], vr[2]; f32x4 cs0[2][3], cs1[2][3];
#pragma unroll
    for (int h = 0; h < 2; ++h) { const int m0 = h ? mB : mA;
#pragma unroll
        for (int p = 0; p < 3; ++p) { const int s = 4 * p + grp, rsel = s >= 6 ? 1 : 0, hs = s - 6 * rsel, m = m0 + rsel;
            raw[h][p] = *(const v2u*)(P2 + (size_t)m * PROJ2_W + PC_GQ + hs * 64 + 4 * li);
            const int t = m & (SEQ - 1), pos = li >= 8 ? (t & 63) : (t >> 6);
            const f32x4* cs = (const f32x4*)(WSP(f32x2, WS_ROPE) + pos * 16 + 4 * (li & 3));
            cs0[h][p] = cs[0]; cs1[h][p] = cs[1]; }
        vr[h] = *(const v2u*)(P2 + (size_t)(m0 + (lane >> 5)) * PROJ2_W + PC_GV + 4 * (lane & 31)); }
    asm volatile("" ::: "memory");
#pragma unroll
    for (int h = 0; h < 2; ++h) { const int m0 = h ? mB : mA;
#pragma unroll
        for (int p = 0; p < 3; ++p) {
            const int s = 4 * p + grp, rsel = s >= 6 ? 1 : 0, hs = s - 6 * rsel, m = m0 + rsel;
            f32x4 x = (f32x4){bflo(raw[h][p].x), bfhi(raw[h][p].x), bflo(raw[h][p].y), bfhi(raw[h][p].y)};
            float ss = (x[0] * x[0] + x[1] * x[1]) + (x[2] * x[2] + x[3] * x[3]);
            ss += __shfl_xor(ss, 1); ss += __shfl_xor(ss, 2); ss += __shfl_xor(ss, 4); ss += __shfl_xor(ss, 8);
            const float rn = 1.f / sqrtf(ss * (1.f / 64.f) + RMS_EPS);
            x = x * rn * (hs < 4 ? qn : kn);
            f32x4 pr; pr[0] = __shfl_xor(x[0], 4); pr[1] = __shfl_xor(x[1], 4); pr[2] = __shfl_xor(x[2], 4); pr[3] = __shfl_xor(x[3], 4);
            const f32x4 c0 = cs0[h][p], c1 = cs1[h][p];
            const float sg = (li & 4) ? 1.f : -1.f, sc = hs < 4 ? 0.125f * 1.4426950408889634f : 1.f;
            f32x4 o; o[0] = (x[0] * c0[0] + sg * pr[0] * c0[1]) * sc; o[1] = (x[1] * c0[2] + sg * pr[1] * c0[3]) * sc; o[2] = (x[2] * c1[0] + sg * pr[2] * c1[1]) * sc; o[3] = (x[3] * c1[2] + sg * pr[3] * c1[3]) * sc;
            v2u w; w.x = pk2(o[0], o[1]); w.y = pk2(o[2], o[3]);
            *(v2u*)(QK + (size_t)m * 512 + hs * 64 + 4 * li) = w;
        }
        *(v2u*)(QK + (size_t)(m0 + (lane >> 5)) * 512 + 384 + 4 * (lane & 31)) = vr[h]; }
}

__device__ __forceinline__ void hy_transpose_item(Frame& F, int item) {
    LAS bf16* T = (LAS bf16*)F.lds + F.wave * (64 * 66);
    const int lane = F.lane, mb = item >> 2, cb = item & 3;
    const bf16* src = WSP(bf16, WS_RD + RD_YAT) + (size_t)(cb * 64) * M + (size_t)mb * 64;
    bf16* dst = WSP(bf16, WS_Y) + (size_t)(mb * 64) * 1024 + cb * 64;
#pragma unroll
    for (int i = 0; i < 8; ++i) { const int c = 8 * i + (lane >> 3), m0 = (lane & 7) * 8; const v4u v = *(const v4u*)(src + (size_t)c * M + m0);
        LAS unsigned* tp = (LAS unsigned*)(T + c * 66 + m0); tp[0] = v.x; tp[1] = v.y; tp[2] = v.z; tp[3] = v.w; }
    LDS_WAIT(); asm volatile("" ::: "memory");
#pragma unroll
    for (int i = 0; i < 8; ++i) { const int m = 8 * i + (lane >> 3), c0 = (lane & 7) * 8; unsigned short e[8];
#pragma unroll
        for (int j = 0; j < 8; ++j) e[j] = T[(c0 + j) * 66 + m];
        v4u o; o.x = e[0] | ((unsigned)e[1] << 16); o.y = e[2] | ((unsigned)e[3] << 16); o.z = e[4] | ((unsigned)e[5] << 16); o.w = e[6] | ((unsigned)e[7] << 16);
        *(v4u*)(dst + (size_t)m * 1024 + c0) = o; }
    LDS_WAIT(); asm volatile("" ::: "memory");
}
__device__ __forceinline__ void dil_combine_rows(Frame& F, int m0, int step) {
    const int lane = F.lane, hh = lane >> 4;
    const float* ls = WSP(float, WS_DLSE);
    float l0[4], l1[4], l2[4]; v2u a[4], b[4], c[4];
#pragma unroll
    for (int k = 0; k < 4; ++k) { const int m = m0 + k * step < M ? m0 + k * step : m0;
        l0[k] = ls[((size_t)0 * M + m) * 4 + hh]; l1[k] = ls[((size_t)1 * M + m) * 4 + hh]; l2[k] = ls[((size_t)2 * M + m) * 4 + hh];
        const bf16* o = WSP(bf16, WS_RD + RD_DILO) + (size_t)m * 256 + 4 * lane;
        a[k] = *(const v2u*)o; b[k] = *(const v2u*)(o + (size_t)M * 256); c[k] = *(const v2u*)(o + (size_t)2 * M * 256); }
    asm volatile("" ::: "memory");
#pragma unroll
    for (int k = 0; k < 4; ++k) { const int m = m0 + k * step < M ? m0 + k * step : m0;
        const float mx = fmaxf(l0[k], fmaxf(l1[k], l2[k])); const float e0 = expf(l0[k] - mx), e1 = expf(l1[k] - mx), e2 = expf(l2[k] - mx), inv = 1.f / (e0 + e1 + e2);
        const float w0 = e0 * inv, w1 = e1 * inv, w2 = e2 * inv;
        v2u r; r.x = pk2(w0 * bflo(a[k].x) + w1 * bflo(b[k].x) + w2 * bflo(c[k].x), w0 * bfhi(a[k].x) + w1 * bfhi(b[k].x) + w2 * bfhi(c[k].x));
        r.y = pk2(w0 * bflo(a[k].y) + w1 * bflo(b[k].y) + w2 * bflo(c[k].y), w0 * bfhi(a[k].y) + w1 * bfhi(b[k].y) + w2 * bfhi(c[k].y));
        *(v2u*)(WSP(bf16, WS_Y) + (size_t)m * 1024 + 256 + 4 * lane) = r; }
}

__device__ __forceinline__ void ln1_router_phase(Frame& F, const Args& args, int l) {
    LAS float* RT = (LAS float*)F.lds;
    const float* rw = FIN(I_ROUTER) + (size_t)l * 1024 * 16;
    __syncthreads();
    for (int i = F.tid; i < 1024 * 16; i += 512) { const int col = i >> 4, e = i & 15; RT[e * 1024 + col] = rw[i]; }
    __syncthreads();
    const int gw = F.bid * 8 + F.wave, NGW = F.G * 8, lane = F.lane;
    const bf16* pre = WSP(bf16, WS_RB + RB_PRE);
    v2u nx[2][4];
#pragma unroll
    for (int r = 0; r < 2; ++r) { const int m = gw + r * NGW;
#pragma unroll
        for (int j = 0; j < 4; ++j) nx[r][j] = (v2u){0u, 0u};
        if (m < M) {
#pragma unroll
            for (int j = 0; j < 4; ++j) nx[r][j] = *(const v2u*)(pre + (size_t)m * DM + 4 * lane + 256 * j); } }
    for (int m0 = gw; m0 < M; m0 += 2 * NGW) {
        f32x4 v[2][4];
#pragma unroll
        for (int r = 0; r < 2; ++r)
#pragma unroll
            for (int j = 0; j < 4; ++j) v[r][j] = (f32x4){bflo(nx[r][j].x), bfhi(nx[r][j].x), bflo(nx[r][j].y), bfhi(nx[r][j].y)};
#pragma unroll
        for (int r = 0; r < 2; ++r) { const int m2 = m0 + 2 * NGW + r * NGW;
            if (m2 < M) {
#pragma unroll
                for (int j = 0; j < 4; ++j) nx[r][j] = *(const v2u*)(pre + (size_t)m2 * DM + 4 * lane + 256 * j); } }
#pragma unroll
        for (int r = 0; r < 2; ++r) { const int m = m0 + r * NGW;
            ln_row(v[r], FIN(I_LN1G) + l * DM, FIN(I_LN1B) + l * DM, lane);
            if (m < M) store_row_bf16(v[r], WSP(bf16, WS_HB) + (size_t)m * DM, lane); }
        f32x2 q[16];
#pragma unroll
        for (int j = 0; j < 4; ++j)
#pragma unroll
            for (int c = 0; c < 4; ++c) q[4 * j + c] = (f32x2){v[0][j][c], v[1][j][c]};
        float lg[2][16];
#pragma unroll
        for (int e = 0; e < 16; ++e) { f32x2 a = {0.f, 0.f};
#pragma unroll
            for (int j = 0; j < 4; ++j) { const f32x4 w = *(const LAS f32x4*)(RT + e * 1024 + 4 * lane + 256 * j);
                a = __builtin_elementwise_fma(q[4 * j + 0], (f32x2){w.x, w.x}, a); a = __builtin_elementwise_fma(q[4 * j + 1], (f32x2){w.y, w.y}, a);
                a = __builtin_elementwise_fma(q[4 * j + 2], (f32x2){w.z, w.z}, a); a = __builtin_elementwise_fma(q[4 * j + 3], (f32x2){w.w, w.w}, a); }
            lg[0][e] = a.x; lg[1][e] = a.y; if (e & 1) asm volatile("" ::: "memory"); }
#pragma unroll
        for (int r = 0; r < 2; ++r) { const int m = m0 + r * NGW;
#pragma unroll
            for (int e = 0; e < 8; ++e) { const bool up = (lane & 32) != 0; const float keep = up ? lg[r][e + 8] : lg[r][e], give = up ? lg[r][e] : lg[r][e + 8]; lg[r][e] = keep + __shfl_xor(give, 32); }
#pragma unroll
            for (int e = 0; e < 4; ++e) { const bool up = (lane & 16) != 0; const float keep = up ? lg[r][e + 4] : lg[r][e], give = up ? lg[r][e] : lg[r][e + 4]; lg[r][e] = keep + __shfl_xor(give, 16); }
#pragma unroll
            for (int e = 0; e < 2; ++e) { const bool up = (lane & 8) != 0; const float keep = up ? lg[r][e + 2] : lg[r][e], give = up ? lg[r][e] : lg[r][e + 2]; lg[r][e] = keep + __shfl_xor(give, 8); }
            { const bool up = (lane & 4) != 0; const float keep = up ? lg[r][1] : lg[r][0], give = up ? lg[r][0] : lg[r][1]; lg[r][0] = keep + __shfl_xor(give, 4); }
            float z = lg[r][0]; z += __shfl_xor(z, 2); z += __shfl_xor(z, 1);
            float mx = z; mx = fmaxf(mx, __shfl_xor(mx, 4)); mx = fmaxf(mx, __shfl_xor(mx, 8)); mx = fmaxf(mx, __shfl_xor(mx, 16)); mx = fmaxf(mx, __shfl_xor(mx, 32));
            const float p = expf(z - mx); float den = p; den += __shfl_xor(den, 4); den += __shfl_xor(den, 8); den += __shfl_xor(den, 16); den += __shfl_xor(den, 32);
            if (m < M && (lane & 3) == 0) { const int e = ((lane >> 5) & 1) * 8 + ((lane >> 4) & 1) * 4 + ((lane >> 3) & 1) * 2 + ((lane >> 2) & 1); WSP(float, WS_AFF)[(size_t)m * 16 + e] = p / den; } }
    }
}

__device__ __forceinline__ int wave_incl_scan(int v, int lane) {
#pragma unroll
    for (int o = 1; o < 64; o <<= 1) { const int n = __shfl_up(v, o); if (lane >= o) v += n; }
    return v;
}
__device__ __forceinline__ int block_excl_scan(Frame& F, int v, LAS int* sc) {
    const int inc = wave_incl_scan(v, F.lane);
    __syncthreads();
    if (F.lane == 63) sc[F.wave] = inc;
    __syncthreads();
    int base = 0;
#pragma unroll
    for (int w = 0; w < 8; ++w) { const int x = sc[w]; if (w < F.wave) base += x; }
    return base + inc - v;
}
__device__ __forceinline__ void topk_item(Frame& F, int e, int b) {
    constexpr int half = 0;
    LAS int* H = (LAS int*)F.lds;
    LAS int* SH = H + 256;
    LAS int* SC = SH + 4;
    LAS int* SEL = SC + 16;
    const int tid = F.tid, lane = F.lane, eb = e * 8 + b;
    const float* aff = WSP(float, WS_AFF) + (size_t)b * SEQ * 16 + e;
    unsigned key[8];
#pragma unroll
    for (int j = 0; j < 8; ++j) key[j] = __float_as_uint(aff[(size_t)(8 * tid + j) * 16]);
    unsigned prefix = 0u, pmask = 0u; int need = CAP;
    for (int pass = 3; pass >= 0; --pass) {
        __syncthreads();
        if (tid < 256) H[tid] = 0;
        __syncthreads();
#pragma unroll
        for (int j = 0; j < 8; ++j) if ((key[j] & pmask) == prefix) __hip_atomic_fetch_add(&H[(key[j] >> (8 * pass)) & 255u], 1, __ATOMIC_RELAXED, __HIP_MEMORY_SCOPE_WORKGROUP);
        __syncthreads();
        if (F.wave == 0) {
            const int c0 = H[255 - 4 * lane], c1 = H[254 - 4 * lane], c2 = H[253 - 4 * lane], c3 = H[252 - 4 * lane];
            const int s = c0 + c1 + c2 + c3, inc = wave_incl_scan(s, lane), exc = inc - s;
            if (exc < need && need <= inc) { const int r = need - exc; int bin, nn;
                if (r <= c0) { bin = 255 - 4 * lane; nn = r; } else if (r <= c0 + c1) { bin = 254 - 4 * lane; nn = r - c0; }
                else if (r <= c0 + c1 + c2) { bin = 253 - 4 * lane; nn = r - c0 - c1; } else { bin = 252 - 4 * lane; nn = r - c0 - c1 - c2; }
                SH[0] = bin; SH[1] = nn; }
        }
        __syncthreads();
        prefix |= (unsigned)SH[0] << (8 * pass); pmask |= 0xffu << (8 * pass); need = SH[1];
    }
    DSTAMP(F, 1);
    const unsigned thr = prefix;
    int eqc = 0;
#pragma unroll
    for (int j = 0; j < 8; ++j) eqc += (key[j] == thr) ? 1 : 0;
    int eq = block_excl_scan(F, eqc, SC);
    int selc = 0; unsigned selm = 0u;
#pragma unroll
    for (int j = 0; j < 8; ++j) { bool s = key[j] > thr; if (key[j] == thr) { s = eq < need; ++eq; } if (s) { selm |= 1u << j; ++selc; } }
    int slot = block_excl_scan(F, selc, SC);
    unsigned short* inv = WSP(unsigned short, WS_INV) + (size_t)eb * SEQ;
    float* gwp = WSP(float, WS_GW) + (size_t)eb * CAP; int* idx = WSP(int, WS_IDX) + (size_t)eb * CAP;
#pragma unroll
    for (int j = 0; j < 8; ++j) { const int t = 8 * tid + j;
        if ((selm >> j) & 1u) { SEL[slot] = t; if (half == 0) { inv[t] = (unsigned short)(slot + 1); gwp[slot] = __uint_as_float(key[j]); idx[slot] = t; } ++slot; }
        else if (half == 0) inv[t] = (unsigned short)0; }
    __syncthreads();
    DSTAMP(F, 2);
    __syncthreads();
}

__device__ __forceinline__ void ln2_phase(Frame& F, const Args& args, int l, bool dummy = false) {
    const int gw = F.bid * 8 + F.wave, NGW = F.G * 8, lane = F.lane;
    const unsigned short* inv = WSP(unsigned short, WS_INV);
    const bf16* eo = WSP(bf16, WS_RA + RA_EOUT);
    v2u nx[2][4]; unsigned nslv[2];
#pragma unroll
    for (int r = 0; r < 2; ++r) { const int m = gw + r * NGW; nslv[r] = 0u;
#pragma unroll
        for (int j = 0; j < 4; ++j) nx[r][j] = (v2u){0u, 0u};
        if (m < M) { const int b = m >> 12, t = m & (SEQ - 1); if (lane < NE) nslv[r] = inv[((size_t)(lane * 8 + b)) * SEQ + t];
#pragma unroll
            for (int j = 0; j < 4; ++j) nx[r][j] = *(const v2u*)(WSP(bf16, WS_HB) + (size_t)m * DM + 4 * lane + 256 * j); } }
    for (int m0 = gw; m0 < M; m0 += 2 * NGW) {
        f32x4 v[2][4]; unsigned slv[2], mask[2];
#pragma unroll
        for (int r = 0; r < 2; ++r) { slv[r] = nslv[r];
#pragma unroll
            for (int j = 0; j < 4; ++j) v[r][j] = (f32x4){bflo(nx[r][j].x), bfhi(nx[r][j].x), bflo(nx[r][j].y), bfhi(nx[r][j].y)} * DN_ALPHA; }
#pragma unroll
        for (int r = 0; r < 2; ++r) { const int m2 = m0 + 2 * NGW + r * NGW; nslv[r] = 0u;
            if (m2 < M) { const int b2 = m2 >> 12, t2 = m2 & (SEQ - 1); if (lane < NE) nslv[r] = inv[((size_t)(lane * 8 + b2)) * SEQ + t2];
#pragma unroll
                for (int j = 0; j < 4; ++j) nx[r][j] = *(const v2u*)(WSP(bf16, WS_HB) + (size_t)m2 * DM + 4 * lane + 256 * j); } }
#pragma unroll
        for (int r = 0; r < 2; ++r) mask[r] = (unsigned)__ballot(slv[r] != 0u);
        while (mask[0] | mask[1]) {
            v2u w[2][4][4]; float wgt[2][4];
#pragma unroll
            for (int r = 0; r < 2; ++r) { const int m = m0 + r * NGW, b = (m < M ? m : m0) >> 12;
#pragma unroll
                for (int k = 0; k < 4; ++k) { int e = 0; wgt[r][k] = 0.f; if (mask[r]) { e = __builtin_ctz(mask[r]); mask[r] &= mask[r] - 1u; wgt[r][k] = 1.f; }
                    const int ek = __builtin_amdgcn_readfirstlane(e); unsigned sl = (unsigned)__builtin_amdgcn_readlane((int)slv[r], ek); sl = sl ? sl - 1u : 0u;
                    const bf16* rp = eo + ((size_t)(ek * 8 + b) * CAP + sl) * DM + 4 * lane;
#pragma unroll
                    for (int j = 0; j < 4; ++j) w[r][k][j] = *(const v2u*)(rp + 256 * j); } }
#pragma unroll
            for (int r = 0; r < 2; ++r)
#pragma unroll
                for (int k = 0; k < 4; ++k)
#pragma unroll
                    for (int j = 0; j < 4; ++j) { v[r][j].x += wgt[r][k] * bflo(w[r][k][j].x); v[r][j].y += wgt[r][k] * bfhi(w[r][k][j].x); v[r][j].z += wgt[r][k] * bflo(w[r][k][j].y); v[r][j].w += wgt[r][k] * bfhi(w[r][k][j].y); }
        }
#pragma unroll
        for (int r = 0; r < 2; ++r) { const int m = m0 + r * NGW; if (m >= M) break;
            ln_row(v[r], FIN(I_LN2G) + l * DM, FIN(I_LN2B) + l * DM, lane);
            if (l == DEPTH - 1) {
#pragma unroll
                for (int j = 0; j < 4; ++j) *(f32x4*)((dummy ? WSP(float, WS_RB) : F.out) + (size_t)m * DM + 4 * lane + 256 * j) = v[r][j]; }
            else store_row_bf16(v[r], WSP(bf16, dummy ? WS_Y : WS_HB) + (size_t)m * DM, lane); }
    }
}

struct SchedTiles {
    const char* A0; const char* B0; size_t a_tile, b_tile; int nM, nN, G, c;
    __device__ __forceinline__ bool next(int i, pg8::Unit& u) const {
        const int L = i * G + c; if (L >= nM * nN) return false;
        int pm, pn; pg8::tile_of(L, nM, nN, pm, pn);
        u.A = A0 + (size_t)pm * a_tile; u.B = B0 + (size_t)pn * b_tile; u.orow = pm * 256; u.ocol = pn * 256; u.z = 0; return true;
    }
};
struct SchedMerge {
    const char* Y; const char* WB; int G, c;
    __device__ __forceinline__ bool next(int i, pg8::MergeUnit& u) const {
        const int L = (i >> 2) * G + c, z = i & 3; if (L >= 128 * 8) return false;
        int pm, pn; pg8::tile_of(L, 128, 8, pm, pn);
        u.A = Y + ((size_t)pm * 256 * 1024 + z * 256) * 2; u.B = WB + ((size_t)z * 1024 * 256 + (size_t)pn * 128 * 256) * 2; u.orow = pm * 256; u.ocol = pn * 128; u.z = z; return true;
    }
};
struct SchedMoe1 {
    const char* XS; const char* W; int G, c;
    __device__ __forceinline__ bool next(int i, pg8::Unit& u) const {
        const int L = i * G + c; if (L >= 128 * 16) return false;
        const int eb = L >> 4, sub = L & 15, pm2 = sub & 1, pn = sub >> 1, e = eb >> 3;
        u.A = XS + ((size_t)(eb & 7) * SEQ * DM) * 2; u.B = W + ((size_t)(e * 2048 + pn * 256) * 1024) * 2; u.orow = eb * 512 + pm2 * 256; u.ocol = pn * 128; u.z = eb; return true;
    }
};
struct SchedOne { pg8::Unit u0; __device__ __forceinline__ bool next(int i, pg8::Unit& u) const { if (i) return false; u = u0; return true; } };
struct SchedMoe2 {
    const char* HID; const char* W; int G, c;
    __device__ __forceinline__ bool next(int i, pg8::Unit& u) const {
        const int L = i * G + c; if (L >= 128 * 8) return false;
        const int eb = L >> 3, sub = L & 7, pm2 = sub & 1, pn = sub >> 1, e = eb >> 3;
        u.A = HID + ((size_t)(eb * 512 + pm2 * 256) * 1024) * 2; u.B = W + ((size_t)(e * 1024 + pn * 256) * 1024) * 2; u.orow = eb * 512 + pm2 * 256; u.ocol = pn * 256; u.z = eb; return true;
    }
};

static_assert((size_t)(CW_Q + (DEPTH * 8 + 8) * 64) * 4 <= CTL_ZERO_BYTES && (size_t)(CW_BAR + 3456) * 4 <= (size_t)CW_Q * 4, "control words inside the per-call memset");
constexpr int NPH = 12;
__global__ void __launch_bounds__(512, 2) fwd_kernel(Args args_k) {
    const Args& args0 = args_k;
    extern __shared__ __attribute__((aligned(16))) unsigned char lds_raw[];
    Frame F;
    F.lds = (LAS unsigned char*)lds_raw;
    F.MISC = (volatile LAS unsigned*)(F.lds + MISC_OFF);
    F.tid = threadIdx.x; F.lane = F.tid & 63; F.wave = __builtin_amdgcn_readfirstlane(F.tid >> 6);
    F.G = gridDim.x; F.bid = blockIdx.x; F.zoff = 0;
    const int wave0 = __builtin_amdgcn_readfirstlane(threadIdx.x >> 6);
    F.ws = args0.ws; F.out = args0.out; F.ctl = (gu32*)(args0.ws + WS_CTL);
    for (int u = F.tid; u < (LDS_BYTES - MISC_OFF) / 4; u += 512) F.MISC[u] = 0u;
    __syncthreads();
#if defined(DBG_PROF) || defined(DBG_DLY)
    if (blockIdx.x == 0 && threadIdx.x == 0) ((unsigned long long*)(args0.ws + WS_CTL))[50000 + 15] = __builtin_amdgcn_s_memrealtime();
#endif
    const bool multi = (args0.l_hi - args0.l_lo > 1) || (args0.ph_hi - args0.ph_lo > 1);
    XcdBarrier bar; bar.bar = (unsigned*)(F.ctl + CW_BAR); bar.x = 0; bar.st = F.MISC + 8;
    if (multi) bar = xcd_barrier_post((unsigned*)(F.ctl + CW_BAR), F.MISC + 8);
    const int lo = args0.ph_lo, hi = args0.ph_hi, l_lo = args0.l_lo, l_hi = args0.l_hi;
#ifndef DBL_MASK
#define DBL_MASK 0
#endif
#define NREP(k) (((DBL_MASK >> (k)) & 1) ? 2 : 1)
#ifndef DBG_ROT
#define DBG_ROT 0
#endif
#ifndef PHASE_MASK
#define PHASE_MASK 0xfff
#endif
#define IN(k) (((PHASE_MASK >> (k)) & 1) && lo <= (k) && (k) < hi)
#ifndef SUB_MASK
#define SUB_MASK 0xff
#endif
#define SUB(k) ((SUB_MASK >> (k)) & 1)
#define FRESH() do { { int b_ = blockIdx.x, g_ = gridDim.x; asm volatile("" : "+s"(b_)); asm volatile("" : "+s"(g_)); F.bid = b_; F.G = g_; } int ln_ = __builtin_amdgcn_mbcnt_hi(~0u, __builtin_amdgcn_mbcnt_lo(~0u, 0u)); asm volatile("" : "+v"(ln_)); int wv_ = wave0; asm volatile("" : "+s"(wv_)); F.lane = ln_; F.wave = wv_; F.tid = wv_ * 64 + ln_; } while (0)
#if defined(DBG_PROF) || defined(DBG_DLY)
#define STAMP(k) do { if (blockIdx.x == 0 && threadIdx.x == 0) ((unsigned long long*)(F.ws + WS_CTL))[50000 + l * 16 + (k)] = __builtin_amdgcn_s_memrealtime(); } while (0)
#else
#define STAMP(k) do {} while (0)
#endif
#define SEAM(k) do { if (((k) + 1 < hi) || (l + 1 < l_hi)) { XcdBarrier b2_ = bar; asm volatile("" : "+s"(b2_.x)); asm volatile("" : "+s"(b2_.bar)); xcd_barrier(b2_, F.tid); } STAMP(k); } while (0)

#pragma unroll 1
    for (int l = l_lo; l < l_hi; ++l) {
        const Args& args = args_k;
        { size_t z_ = 0; asm volatile("" : "+s"(z_)); F.ws = args.ws + z_; F.out = args.out + z_; F.ctl = (gu32*)(F.ws + WS_CTL); }
        F.dl = l;
        unsigned char* wb = F.ws + WS_W;
        const char* HBp = (const char*)(F.ws + WS_HB);
#define NGW (F.G * 8)
#define gw (F.bid * 8 + F.wave)
        if (IN(0) && l == 0) { FRESH(); prologue_phase(F, args); SEAM(0); if (NREP(0) > 1) { FRESH(); prologue_phase(F, args); SEAM(0); } }

        if (IN(1)) _Pragma("unroll 1") for (int rep_ = 0; rep_ < NREP(1); ++rep_) { FRESH();
            const pg8::Gemm g{1024, 1024, 1024};
            if (SUB(0)) {
                SchedTiles S{(const char*)(wb + W_WIN), HBp, (size_t)256 * 1024 * 2, (size_t)256 * 1024 * 2, 3, 128, F.G, F.bid};
                pg8::EpiBf16<0> E{WSP(bf16, WS_RB + RB_HYT), M};
                pg8::gemm_phase(F.lds, g, S, E, F.tid); }
            if (SUB(1)) {
                SchedTiles S{HBp, (const char*)(wb + W_WIN) + (size_t)768 * 1024 * 2, (size_t)256 * 1024 * 2, (size_t)256 * 1024 * 2, 128, 12, F.G, F.bid};
                pg8::EpiBf16<0> E{WSP(bf16, WS_RB + RB_PROJ2), PROJ2_W};
                pg8::gemm_phase(F.lds, g, S, E, F.tid); }
            if (SUB(2)) {
                SchedTiles S{HBp, (const char*)(wb + W_WIN) + (size_t)3840 * 1024 * 2, (size_t)256 * 1024 * 2, (size_t)256 * 1024 * 2, 128, 16, F.G, (F.bid + DBG_ROT) % F.G};
                pg8::EpiBf16<1> E{WSP(bf16, WS_RA + RA_G), 4096};
                pg8::gemm_phase(F.lds, g, S, E, F.tid); }
            SEAM(1);
        }
        if (IN(2)) _Pragma("unroll 1") for (int rep_ = 0; rep_ < NREP(2); ++rep_) { FRESH();
            if (l == 0) { for (int tb = F.bid; tb < 256; tb += F.G) hy_taps_block(F, args, 0, tb); __syncthreads(); }
            for (int m = 2 * gw; m < M; m += 4 * NGW) gqa_prep_rows(F, args, l, m, m + 2 * NGW < M ? m + 2 * NGW : m);
            if (rep_ + 1 < NREP(2)) { for (int r = gw; r < 768 * 8; r += NGW) hy_sconv_row(F, args, l, r, (WS_RD + RD_DILO) - (WS_RB + RB_HYT)); } else
            for (int r = gw; r < 768 * 8; r += NGW) hy_sconv_row(F, args, l, r);
            SEAM(2); }

        if (IN(3)) _Pragma("unroll 1") for (int rep_ = 0; rep_ < NREP(3); ++rep_) { FRESH();
#if MK_STATIC_Q
            if (SUB(0)) for (int it = F.bid; it < 256; it += F.G) hyena_item(F, args, l, it);
            if (SUB(1)) {   const attn_body::bf16* Qp = (const attn_body::bf16*)(F.ws + WS_RD + RD_QKVG);
                attn_body::bf16* Op = (attn_body::bf16*)(F.ws + WS_Y) + 768;
                for (int it = F.bid; it < 512; it += F.G) { __syncthreads();
                    attn_body::attn_unit<8>(it >> 6, (it >> 4) & 3, it & 15, Qp, Qp + 256, Qp + 384, Op, (char*)lds_raw, F.tid); } }
            if (SUB(2)) for (int it = F.bid; it < 128; it += F.G) s5_item(F, args, l, it >> 4, it & 15);
            __syncthreads();
            if (SUB(3)) for (int it = F.bid; it < 1536; it += F.G) dil_item(F, args, it);
#else
#ifndef DBL_SUB
#define DBL_SUB 0
#endif
#define NREPS(t) (((DBL_SUB >> (t)) & 1) ? 2 : 1)
            _Pragma("unroll 1") for (int r2 = 0; r2 < NREPS(2); ++r2) for (;;) { const int it = wq_grab(F, l * 8 + (r2 + rep_) * 4 + 2); if (it >= 128) break; s5_item(F, args, l, it >> 4, it & 15); }
            _Pragma("unroll 1") for (int r2 = 0; r2 < NREPS(0); ++r2) for (;;) { const int it = wq_grab(F, l * 8 + (r2 + rep_) * 4 + 0); if (it >= 256) break; hyena_item(F, args, l, it); }
            {   const attn_body::bf16* Qp = (const attn_body::bf16*)(F.ws + WS_RD + RD_QKVG);
                attn_body::bf16* Op = (attn_body::bf16*)(F.ws + WS_Y) + 768;
                _Pragma("unroll 1") for (int r2 = 0; r2 < NREPS(1); ++r2) for (;;) { const int it = wq_grab(F, l * 8 + (r2 + rep_) * 4 + 1); if (it >= 512) break;
                    attn_body::attn_unit<8>(it >> 6, (it >> 4) & 3, it & 15, Qp, Qp + 256, Qp + 384, Op, (char*)lds_raw, F.tid); } }
            _Pragma("unroll 1") for (int r2 = 0; r2 < NREPS(3); ++r2) for (;;) { const int it = wq_grab(F, l * 8 + (r2 + rep_) * 4 + 3); if (it >= 768) break; dil_item(F, args, 2 * it); dil_item(F, args, 2 * it + 1); }
#endif
            SEAM(3);
        }
        if (IN(4)) _Pragma("unroll 1") for (int rep_ = 0; rep_ < NREP(4); ++rep_) { FRESH();
            if (SUB(0)) {   const pg8::Gemm g{256, 256, 256};
                SchedTiles S{(const char*)(F.ws + WS_RD + RD_S5Z), (const char*)(wb + W_GLU), (size_t)256 * 256 * 2, 0, 128, 1, F.G, F.bid};
                pg8::EpiGlu E{WSP(bf16, WS_RD + RD_S5Z), WSP(bf16, WS_Y), FIN(I_S5_GB) + l * 256};
                pg8::gemm_phase(F.lds, g, S, E, F.tid); }
            __syncthreads();
            if (SUB(1)) for (int it = gw; it < 2048; it += NGW) hy_transpose_item(F, it);
            if (SUB(2)) for (int m = gw; m < M; m += 4 * NGW) dil_combine_rows(F, m, NGW);
            SEAM(4);
        }
        if (IN(5)) _Pragma("unroll 1") for (int rep_ = 0; rep_ < NREP(5); ++rep_) { FRESH();
            const pg8::Gemm g{256, 1024, 256};
            SchedMerge S{(const char*)(F.ws + WS_Y), (const char*)(wb + W_WB), F.G, F.bid};
            pg8::gemm_merge_phase(F.lds, g, S, WSP(bf16, WS_RA + RA_G), WSP(bf16, WS_RB + RB_MB), F.tid);
            SEAM(5);
        }
        if (IN(6)) _Pragma("unroll 1") for (int rep_ = 0; rep_ < NREP(6); ++rep_) { FRESH();
            const pg8::Gemm g{1024, 1024, 1024};
            SchedTiles S{(const char*)(F.ws + WS_RB + RB_MB), (const char*)(wb + W_WO), (size_t)256 * 1024 * 2, (size_t)256 * 1024 * 2, 128, 4, F.G, F.bid};
            pg8::EpiPre E{WSP(bf16, WS_HB), WSP(bf16, WS_RB + RB_PRE), DN_ALPHA};
            pg8::gemm_phase(F.lds, g, S, E, F.tid);
            SEAM(6);
        }
        if (IN(7)) _Pragma("unroll 1") for (int rep_ = 0; rep_ < NREP(7); ++rep_) { FRESH(); ln1_router_phase(F, args, l); SEAM(7); }
        if (IN(8)) _Pragma("unroll 1") for (int rep_ = 0; rep_ < NREP(8); ++rep_) { FRESH(); DSTAMP(F, 0); for (int it = F.bid; it < 128; it += F.G) topk_item(F, it >> 3, it & 7);
            DSTAMP(F, 4);
            if (l + 1 < DEPTH) { __syncthreads(); for (int tb = F.bid; tb < 256; tb += F.G) hy_taps_block(F, args, l + 1, tb); }
            DSTAMP(F, 5);
            SEAM(8); }
        if (IN(9)) _Pragma("unroll 1") for (int rep_ = 0; rep_ < NREP(9); ++rep_) { FRESH();
            const pg8::Gemm g{1024, 1024, 1024};
            SchedMoe1 S{HBp, (const char*)(wb + W_GU), F.G, F.bid};
            pg8::EpiSwiglu E{WSP(bf16, WS_RB + RB_HID), WSP(int, WS_IDX)};
            pg8::gemm_phase(F.lds, g, S, E, F.tid);
            SEAM(9);
        }
        if (IN(10)) _Pragma("unroll 1") for (int rep_ = 0; rep_ < NREP(10); ++rep_) { FRESH();
            const pg8::Gemm g{1024, 1024, 1024};
            SchedMoe2 S{(const char*)(F.ws + WS_RB + RB_HID), (const char*)(wb + W_DN), F.G, F.bid};
            pg8::EpiRowScale E{WSP(bf16, WS_RA + RA_EOUT), WSP(float, WS_GW)};
            pg8::gemm_phase(F.lds, g, S, E, F.tid);
            SEAM(10);
        }
        if (IN(11)) { FRESH();
            if (NREP(11) > 1) { ln2_phase(F, args, l, true); FRESH(); }
            ln2_phase(F, args, l);
            if (l + 1 < DEPTH) convert_layer(F, args, l + 1, gw, NGW);
#ifdef DBG_CONV2
            if (l + 1 < DEPTH) convert_layer(F, args, l + 1, gw, NGW);
#endif
            SEAM(11);
        }
    }
    if (multi) {
        { XcdBarrier b2_ = bar; asm volatile("" : "+s"(b2_.x)); asm volatile("" : "+s"(b2_.bar)); xcd_barrier(b2_, F.tid); }
        if (__hip_atomic_load((unsigned*)(F.ctl + CW_BAR) + XB_TMO, RLX_AGENT) != 0u) {
            const float q = __builtin_nanf("");
            for (size_t i = (size_t)F.bid * 512 + F.tid; i < (size_t)M * DM; i += (size_t)F.G * 512) args0.out[i] = q; }
    }
#ifdef DBG_DLY
    if (blockIdx.x == 0 && threadIdx.x == 0) {
        const unsigned long long* ts = (const unsigned long long*)(args0.ws + WS_CTL) + 50000; unsigned long long s = 0;
        for (int l = 0; l < DEPTH; ++l) for (int p = 0; p < NPH; ++p) { if (!((DBG_DLY >> p) & 1) || (p == 0 && l > 0)) continue;
            const unsigned long long e = ts[l * 16 + p], b = p == 0 ? ts[15] : (p == 1 && l > 0) ? ts[(l - 1) * 16 + 11] : ts[l * 16 + p - 1]; s += e - b; }
#ifdef DLY_A
        for (int l = 0; l < DEPTH; ++l) s += ts[2000 + l * 16 + DLY_B] - ts[2000 + l * 16 + DLY_A];
#endif
        const unsigned long long t0 = __builtin_amdgcn_s_memrealtime();
        while (__builtin_amdgcn_s_memrealtime() - t0 < s * DLY_MULT) __builtin_amdgcn_s_sleep(32);
    }
#endif
#undef IN
#undef gw
#undef NGW
#undef SEAM
}


#ifdef DBG_STOP
__global__ void dbg_dump_kernel(const unsigned char* ws, float* out, size_t off, int isf32, int ld, int ncols) {
    const size_t n = (size_t)M * DM;
    for (size_t i = (size_t)blockIdx.x * blockDim.x + threadIdx.x; i < n; i += (size_t)gridDim.x * blockDim.x) {
        const size_t r = i / DM, c = i % DM; float v = 0.f;
        if ((int)c < ncols) { if (isf32) v = ((const float*)(ws + off))[r * ld + c]; else v = bf2f(((const bf16*)(ws + off))[r * ld + c]); }
        out[i] = v; }
}
#endif

#ifdef DBG_RACE
constexpr int CW_DBG = 65536;
__global__ void dbg_sum_kernel(const unsigned* p, size_t nwords, unsigned long long* slot) {
    unsigned long long s = 0;
    for (size_t i = (size_t)blockIdx.x * blockDim.x + threadIdx.x; i < nwords; i += (size_t)gridDim.x * blockDim.x) s += (unsigned long long)p[i] * (unsigned long long)((i & 1023u) + 1u);
    for (int o = 32; o >= 1; o >>= 1) s += __shfl_xor(s, o);
    if ((threadIdx.x & 63) == 0) atomicAdd(slot, s);
}
__global__ void dbg_final_kernel(const unsigned long long* T, float* out) {
    int V = 0;
    for (int s = 56; s <= 60; ++s) if (T[s] != T[64 + s]) V |= 1 << (s - 56);
    const float c = 10.f * (float)(V + 1);
    for (size_t i = (size_t)blockIdx.x * blockDim.x + threadIdx.x; i < (size_t)M * DM; i += (size_t)gridDim.x * blockDim.x) out[i] = c;
}
#endif

#ifdef DBG_STAT
__global__ void dbg_stat_kernel(const unsigned char* ws, size_t off, int ld, int ncols, unsigned* res) {
    unsigned mx = 0, cnt = 0;
    for (size_t i = (size_t)blockIdx.x * blockDim.x + threadIdx.x; i < (size_t)M * ncols; i += (size_t)gridDim.x * blockDim.x) {
        const size_t r = i / ncols, c = i % ncols; const float v = fabsf(bf2f(((const bf16*)(ws + off))[r * ld + c]));
        const unsigned b = __float_as_uint(v); mx = b > mx ? b : mx; cnt += (v > DBG_THR || v != v) ? 1u : 0u; }
    atomicMax(res, mx); atomicAdd(res + 1, cnt);
    for (size_t r = (size_t)blockIdx.x * blockDim.x + threadIdx.x; r < (size_t)M; r += (size_t)gridDim.x * blockDim.x) { bool bad = false; unsigned first = 0xffffffffu;
        for (int c = 0; c < ncols; ++c) { const float v = fabsf(bf2f(((const bf16*)(ws + off))[r * ld + c])); if (v > DBG_THR || v != v) { bad = true; if (first == 0xffffffffu) first = c; } }
        if (bad) { atomicAdd(res + 2, 1u); atomicMin(res + 3, (unsigned)r); atomicMin(res + 4, first); } }
}
__global__ void dbg_statout_kernel(const unsigned* res, float* out) {
    const float c = DBG_STAT == 0 ? 100.f * __uint_as_float(res[0]) : DBG_STAT == 1 ? sqrtf((float)res[1]) : DBG_STAT == 2 ? sqrtf((float)res[2]) : DBG_STAT == 3 ? (float)(res[3] / 2048u + 20u) : (float)(res[4] / 256u + 20u);
    for (size_t i = (size_t)blockIdx.x * blockDim.x + threadIdx.x; i < (size_t)M * DM; i += (size_t)gridDim.x * blockDim.x) out[i] = c;
}
#endif

#ifdef DBG_PROF
__global__ void dbg_prof_kernel(const unsigned long long* ts, float* out) {
    float tp[12];
    for (int p = 0; p < 12; ++p) { double s = 0; for (int l = 0; l < DEPTH; ++l) { if (p == 0 && l > 0) continue;
        const unsigned long long e = ts[l * 16 + p]; unsigned long long b;
        if (p == 0) b = ts[15]; else if (p == 1 && l > 0) b = ts[(l - 1) * 16 + 11]; else b = ts[l * 16 + p - 1];
        if (p == 11 && l == DEPTH - 1) continue;
        s += (double)(e - b) * 0.01; } tp[p] = (float)s; }
    const float c = tp[DBG_PA], d = 1000.f * tp[DBG_PB];
    for (size_t i = (size_t)blockIdx.x * blockDim.x + threadIdx.x; i < (size_t)M * DM; i += (size_t)gridDim.x * blockDim.x) out[i] = (i == 0) ? d : c;
}
#endif
extern "C" void kernel_launch(void* const* d_in, const int* in_sizes, int n_in, void* d_out, int out_size, void* d_ws, size_t ws_size, hipStream_t stream) {
    static int grid = 0;
    if (grid == 0) {
        if (n_in != N_INPUTS || out_size != M * DM || ws_size < WS_END) { fprintf(stderr, "kernel_launch: unexpected problem (n_in %d, out %d, ws %zu)\n", n_in, out_size, ws_size); grid = -1; return; }
        int dev = 0, cus = 0, per_cu = 0;
        if (hipGetDevice(&dev) != hipSuccess || hipDeviceGetAttribute(&cus, hipDeviceAttributeMultiprocessorCount, dev) != hipSuccess) { grid = -1; return; }
        if (hipFuncSetAttribute((const void*)fwd_kernel, hipFuncAttributeMaxDynamicSharedMemorySize, LDS_BYTES) != hipSuccess) { fprintf(stderr, "kernel_launch: hipFuncSetAttribute failed\n"); grid = -1; return; }
        if (hipOccupancyMaxActiveBlocksPerMultiprocessor(&per_cu, (const void*)fwd_kernel, 512, LDS_BYTES) != hipSuccess || per_cu < 1)
            fprintf(stderr, "kernel_launch: occupancy query reports %d workgroups per CU\n", per_cu);
        (void)hipGetLastError();
        grid = cus;
    }
    if (grid < 0) return;
    if (hipMemsetAsync((char*)d_ws + WS_CTL, 0, CTL_ZERO_BYTES, stream) != hipSuccess) return;
    Args a{};
    for (int i = 0; i < N_INPUTS; ++i) a.in[i] = (const float*)d_in[i];
    a.out = (float*)d_out; a.ws = (unsigned char*)d_ws;
#if MK_ONE_LAUNCH
    a.ph_lo = 0; a.ph_hi = NPH; a.l_lo = 0; a.l_hi = DEPTH;
    hipLaunchKernelGGL(fwd_kernel, dim3(grid), dim3(512), LDS_BYTES, stream, a);
#ifdef DBG_PROF
    hipLaunchKernelGGL(dbg_prof_kernel, dim3(1024), dim3(256), 0, stream, (const unsigned long long*)((char*)d_ws + WS_CTL) + 50000, (float*)d_out);
#endif
#else
#ifdef DBG_RACE
    {
    unsigned char* ws = (unsigned char*)d_ws; unsigned long long* T = (unsigned long long*)(ws + WS_CTL) + CW_DBG / 2;
    auto sum = [&](size_t off, size_t bytes, int slot) { hipLaunchKernelGGL(dbg_sum_kernel, dim3(1024), dim3(256), 0, stream, (const unsigned*)(ws + off), bytes / 4, T + slot); };
    auto sumout = [&](int slot) { hipLaunchKernelGGL(dbg_sum_kernel, dim3(1024), dim3(256), 0, stream, (const unsigned*)d_out, (size_t)M * DM, T + slot); };
    for (int run = 0; run < 2; ++run) {
        if (run == 1) hipMemsetAsync((char*)d_ws + WS_CTL, 0, CW_DBG * 4, stream);
        hipMemsetAsync((char*)d_ws + 1 * MiB, run == 0 ? 0xAA : 0x55, WS_END - 1 * MiB, stream);
        for (int l = 0; l < DBG_LAYERS; ++l)
            for (int p = (l == 0 ? 0 : 1); p < DBG_NPH; ++p) { a.ph_lo = p; a.ph_hi = p + 1; a.l_lo = l; a.l_hi = l + 1;
                hipLaunchKernelGGL(fwd_kernel, dim3(grid), dim3(512), LDS_BYTES, stream, a);
                const int s = run * 64 + l * 12 + p;
                switch (p) {
                case 0: sum(WS_HB, 64 * MiB, s); sumout(s); sum(WS_W, 115 * MiB, s); sum(WS_S5W, 64 * MiB, s); sum(WS_HF2, 4 * MiB, s); sum(WS_ROPE, 8 * KiB, s); sum(WS_S5A32, 64 * KiB, s); break;
                case 1: sum(WS_RB, 240 * MiB, s); sum(WS_RA, 256 * MiB, s); break;
                case 2: sum(WS_RD + RD_QKVG, 32 * MiB, s); break;
                case 3: sum(WS_RD + RD_YAT, 16 * MiB, run * 64 + 56); sum(WS_RD + RD_HV, 32 * MiB, run * 64 + 57); sum(WS_RD + RD_DILO, 48 * MiB, run * 64 + 58); sum(WS_DLSE, 1536 * KiB, run * 64 + 59); sum(WS_RD + RD_S5Z, 16 * MiB, run * 64 + 60); break;
                case 4: sum(WS_Y, 64 * MiB, s); break;
                case 5: sum(WS_RB + RB_MB, 64 * MiB, s); sum(WS_RB, 128 * MiB, s); break;
                case 6: sum(WS_RB, 128 * MiB, s); break;
                case 7: sumout(s); sum(WS_HB, 64 * MiB, s); sum(WS_AFF, 2 * MiB, s); break;
                case 8: sum(WS_RA, 128 * MiB, s); sum(WS_IDX, 512 * KiB, s); sum(WS_INV, 1 * MiB, s); break;
                case 9: sum(WS_RB, 128 * MiB, s); break;
                case 10: sum(WS_RA + RA_EOUT, 128 * MiB, s); break;
                case 11: sumout(s); sum(WS_HB, 64 * MiB, s); break;
                } }
    }
    hipLaunchKernelGGL(dbg_final_kernel, dim3(1024), dim3(256), 0, stream, (const unsigned long long*)T, (float*)d_out);
    }
#elif defined(DBG_STOP)
    for (int l = 0; l <= DBG_STOP_L; ++l)
        for (int p = (l == 0 ? 0 : 1); p < NPH; ++p) { if (l == DBG_STOP_L && p > DBG_STOP) break; a.ph_lo = p; a.ph_hi = p + 1; a.l_lo = l; a.l_hi = l + 1;
            hipLaunchKernelGGL(fwd_kernel, dim3(grid), dim3(512), LDS_BYTES, stream, a);
#ifdef DBG_REPEAT
            if (p == DBG_REPEAT) hipLaunchKernelGGL(fwd_kernel, dim3(grid), dim3(512), LDS_BYTES, stream, a);
#endif
            }
#ifdef DBG_STAT
    { unsigned* res = (unsigned*)((char*)d_ws + WS_CTL) + 100000; hipMemsetAsync(res + 3, 0x7f, 8, stream); hipLaunchKernelGGL(dbg_stat_kernel, dim3(2048), dim3(256), 0, stream, (const unsigned char*)d_ws, (size_t)(DBG_OFF), DBG_LD, DBG_NC, res);
      hipLaunchKernelGGL(dbg_statout_kernel, dim3(2048), dim3(256), 0, stream, (const unsigned*)res, (float*)d_out); }
#elif defined(DBG_OFF)
    hipLaunchKernelGGL(dbg_dump_kernel, dim3(2048), dim3(256), 0, stream, (const unsigned char*)d_ws, (float*)d_out, (size_t)(DBG_OFF), DBG_F32, DBG_LD, DBG_NC);
#endif
#else
    for (int l = 0; l < DEPTH; ++l)
        for (int p = (l == 0 ? 0 : 1); p < NPH; ++p) { a.ph_lo = p; a.ph_hi = p + 1; a.l_lo = l; a.l_hi = l + 1;
            hipLaunchKernelGGL(fwd_kernel, dim3(grid), dim3(512), LDS_BYTES, stream, a); }
#endif
#endif
}
```
